# Optimizing an MI355X kernel written in HIP

```python
import jax, jax.numpy as jnp
from jax import lax
import numpy as np

D_MODEL = 1024
BATCH = 4
SEQ = 4096
DEPTH = 2
DEC_BATCH = 32
DEC_SEQ = 8
PAST_LEN = 8192
PAGE_SIZE = 128

A_GROUPS = ((128, 1), (512, 4), (2048, 16))
N_GROUPS = 3
A_HEADS = 4
A_HD = 128
A_WIDTH = A_HEADS * A_HD
A_BLOCK = 128
B_HEADS = 4
B_DK = 128
B_DV = 128
B_CONV = 4
B_QK = B_HEADS * B_DK
B_V = B_HEADS * B_DV
B_CONV_CH = 2 * B_QK + B_V
C_HEADS = 4
C_DK = 64
C_DV = 128
C_QK = C_HEADS * C_DK
C_V = C_HEADS * C_DV
CHUNK = 64
ROPE_THETA = 10000.0
EPS = 1e-6
D_FF = -(-(8 * D_MODEL) // (3 * 256)) * 256
IN_SIZES = (3 * N_GROUPS * A_WIDTH, B_CONV_CH, B_V, B_HEADS, B_HEADS, C_QK, C_QK, C_V, C_V, 3 * D_MODEL)
N_IN = sum(IN_SIZES)
F32 = jnp.float32

kernel_name = 'hybrid_dilated_delta_retention_decoder_step'


def _rmsnorm(x, g):
    xf = x.astype(F32)
    y = xf * lax.rsqrt(jnp.mean(xf * xf, axis=-1, keepdims=True) + EPS)
    return (y * g.astype(F32)).astype(x.dtype)


def _l2norm(x):
    return x * lax.rsqrt(jnp.sum(x * x, axis=-1, keepdims=True) + EPS)


def _rope(x, pos):
    hd = x.shape[-1]
    inv = ROPE_THETA ** (-jnp.arange(0, hd, 2, dtype=F32) / hd)
    ang = pos.astype(F32)[:, None] * inv[None, :]
    shape = (ang.shape[0],) + (1,) * (x.ndim - 3) + (hd // 2,)
    cos = jnp.cos(ang).reshape(shape)
    sin = jnp.sin(ang).reshape(shape)
    xf = x.astype(F32)
    x1, x2 = xf[..., :hd // 2], xf[..., hd // 2:]
    return jnp.concatenate([x1 * cos - x2 * sin, x2 * cos + x1 * sin], axis=-1).astype(x.dtype)


def _causal_conv(x, buf, w):
    T = x.shape[1]
    xp = jnp.concatenate([buf.astype(x.dtype), x], axis=1)
    out = xp[:, 0:T] * w[0]
    for i in range(1, B_CONV):
        out = out + xp[:, i:i + T] * w[i]
    return out, xp[:, -(B_CONV - 1):]


def _to_chunks(x, C):
    B, T = x.shape[:2]
    nc = -(-T // C)
    x = jnp.pad(x, [(0, 0), (0, nc * C - T)] + [(0, 0)] * (x.ndim - 2))
    x = x.reshape((B, nc, C) + x.shape[2:])
    return x.transpose((1, 0, 3, 2) + tuple(range(4, x.ndim)))


def _from_chunks(x, T):
    nc, B, H, C, d = x.shape
    return x.transpose(1, 0, 3, 2, 4).reshape(B, nc * C, H, d)[:, :T]


def _decay_matrix(gc, incl):
    C = gc.shape[-1]
    i = jnp.arange(C)[:, None]
    j = jnp.arange(C)[None, :]
    mask = (i >= j) if incl else (i > j)
    diff = gc[..., :, None] - gc[..., None, :]
    return jnp.where(mask, jnp.exp(jnp.where(mask, diff, 0.0)), 0.0)


def _gated_delta_rule(q, k, v, beta, g, S0):
    T = q.shape[1]
    dv = v.shape[-1]
    C = min(CHUNK, T)
    qc, kc, vc = (_to_chunks(t.astype(F32), C) for t in (q, k, v))
    bc = _to_chunks(beta.astype(F32), C)
    gc = jnp.cumsum(_to_chunks(g.astype(F32), C), axis=-1)
    kb = kc * bc[..., None]
    eye = jnp.eye(C, dtype=F32)
    lower = _decay_matrix(gc, False) * jnp.einsum('nbhid,nbhjd->nbhij', kb, kc)
    rhs = jnp.concatenate([vc * bc[..., None], kb * jnp.exp(gc)[..., None]], axis=-1)
    sol = lax.linalg.triangular_solve(eye + lower, rhs, left_side=True, lower=True, unit_diagonal=True)
    u, w = sol[..., :dv], sol[..., dv:]
    attn = _decay_matrix(gc, True) * jnp.einsum('nbhid,nbhjd->nbhij', qc, kc)

    def step(S, xs):
        qi, ki, gi, ui, wi, ai = xs
        v_new = ui - jnp.einsum('bhck,bhkv->bhcv', wi, S)
        o = jnp.einsum('bhck,bhkv->bhcv', qi * jnp.exp(gi)[..., None], S) + jnp.einsum('bhij,bhjv->bhiv', ai, v_new)
        gl = gi[..., -1:]
        S = S * jnp.exp(gl)[..., None] + jnp.einsum('bhck,bhcv->bhkv', ki * jnp.exp(gl - gi)[..., None], v_new)
        return S, o

    S, o = lax.scan(step, S0.astype(F32), (qc, kc, gc, u, w, attn))
    return _from_chunks(o, T), S


def _retention(q, k, v, g, R0):
    T = q.shape[1]
    C = min(CHUNK, T)
    qc, kc, vc = (_to_chunks(t.astype(F32), C) for t in (q, k, v))
    gc = jnp.cumsum(_to_chunks(g.astype(F32), C), axis=-1)
    attn = _decay_matrix(gc, True) * jnp.einsum('nbhid,nbhjd->nbhij', qc, kc)
    intra = jnp.einsum('nbhij,nbhjv->nbhiv', attn, vc)

    def step(R, xs):
        qi, ki, vi, gi, oi = xs
        o = oi + jnp.einsum('bhck,bhkv->bhcv', qi * jnp.exp(gi)[..., None], R)
        gl = gi[..., -1:]
        R = R * jnp.exp(gl)[..., None] + jnp.einsum('bhck,bhcv->bhkv', ki * jnp.exp(gl - gi)[..., None], vi)
        return R, o

    R, o = lax.scan(step, R0.astype(F32), (qc, kc, vc, gc, intra))
    return _from_chunks(o, T), R


def _dilated_window_prompt(q, k, v, window, dil):
    B, T, H, hd = q.shape
    Ls = T // dil
    w = window // dil
    bq = min(A_BLOCK, Ls)
    nb = -(-Ls // bq)
    Lp = nb * bq

    def sub(x, front):
        x = x.reshape(B, Ls, dil, H, hd).transpose(0, 2, 1, 3, 4).astype(F32)
        return jnp.pad(x, ((0, 0), (0, 0), (front, Lp - Ls), (0, 0), (0, 0)))

    qb = sub(q, 0).reshape(B, dil, nb, bq, H, hd)
    idx = jnp.arange(nb)[:, None] * bq + jnp.arange(w + bq)[None, :]
    kb = jnp.take(sub(k, w), idx, axis=2)
    vb = jnp.take(sub(v, w), idx, axis=2)
    s = jnp.einsum('brnqhd,brnkhd->brnhqk', qb, kb) * (hd ** -0.5)
    qi = jnp.arange(bq)[:, None]
    kj = jnp.arange(w + bq)[None, :]
    dist = qi - kj + w
    kpos = jnp.arange(nb)[:, None, None] * bq + kj[None] - w
    valid = (dist >= 0) & (dist <= w) & (kpos >= 0)
    s = jnp.where(valid[:, None], s, -jnp.inf)
    m = jnp.max(s, axis=-1, keepdims=True)
    p = jnp.exp(s - m)
    den = jnp.sum(p, axis=-1)
    o = jnp.einsum('brnhqk,brnkhd->brnqhd', p, vb) / jnp.swapaxes(den, -1, -2)[..., None]
    lse = jnp.swapaxes(m[..., 0] + jnp.log(den), -1, -2)

    def unsub(x):
        x = x.reshape((B, dil, Lp) + x.shape[4:])[:, :, :Ls]
        return jnp.swapaxes(x, 1, 2).reshape((B, T) + x.shape[3:])

    return unsub(o), unsub(lse)


def _dilated_window_sample(q, k, v, kv_buf, window, dil):
    DB, S, H, hd = q.shape
    L = kv_buf.shape[1]
    kk = jnp.concatenate([kv_buf[:, :, 0].astype(k.dtype), k], axis=1).astype(F32)
    vv = jnp.concatenate([kv_buf[:, :, 1].astype(v.dtype), v], axis=1).astype(F32)
    n = window // dil + 1
    idx = L + jnp.arange(S)[:, None] - dil * jnp.arange(n)[None, :]
    valid = idx >= 0
    idx = jnp.maximum(idx, 0)
    kg = kk[:, idx]
    vg = vv[:, idx]
    s = jnp.einsum('bqhd,bqkhd->bhqk', q.astype(F32), kg) * (hd ** -0.5)
    s = jnp.where(valid, s, -jnp.inf)
    m = jnp.max(s, axis=-1, keepdims=True)
    p = jnp.exp(s - m)
    den = jnp.sum(p, axis=-1)
    o = jnp.einsum('bhqk,bqkhd->bqhd', p, vg) / jnp.swapaxes(den, 1, 2)[..., None]
    lse = jnp.swapaxes(m[..., 0] + jnp.log(den), 1, 2)
    return o, lse


def _layer(x, pos, kv_bufs, conv_buf, S0, R0, prompt, norm1_g, w_in, a_q_norm_g, a_k_norm_g, b_conv_w,
           b_a_log, b_dt_bias, b_out_norm_g, c_out_norm_g, w_out_a, w_out_b, w_out_c, w_out, norm2_g,
           w_ffn_in, w_ffn_out):
    Bsz, T, _ = x.shape
    h = _rmsnorm(x, norm1_g)
    proj = h @ w_in
    a_qkv, b_qkv, b_z, b_beta, b_a, c_q, c_k, c_v, c_z, gates = jnp.split(
        proj, np.cumsum(IN_SIZES)[:-1].tolist(), axis=-1)

    a_qkv = a_qkv.reshape(Bsz, T, 3, N_GROUPS, A_HEADS, A_HD)
    a_q = _rope(_rmsnorm(a_qkv[:, :, 0], a_q_norm_g), pos)
    a_k = _rope(_rmsnorm(a_qkv[:, :, 1], a_k_norm_g), pos)
    a_v = a_qkv[:, :, 2]
    outs, lses, new_kv = [], [], []
    for gi, (win, dil) in enumerate(A_GROUPS):
        qg, kg, vg = a_q[:, :, gi], a_k[:, :, gi], a_v[:, :, gi]
        if prompt:
            o, lse = _dilated_window_prompt(qg, kg, vg, win, dil)
            keep = min(win, T)
            new_kv.append(jnp.stack([kg[:, T - keep:], vg[:, T - keep:]], axis=2))
        else:
            o, lse = _dilated_window_sample(qg, kg, vg, kv_bufs[gi], win, dil)
            new_kv.append(jnp.stack([kg, vg], axis=2))
        outs.append(o)
        lses.append(lse)
    wts = jax.nn.softmax(jnp.stack(lses), axis=0)
    o_a = jnp.sum(wts[..., None] * jnp.stack(outs), axis=0).reshape(Bsz, T, A_WIDTH).astype(x.dtype)

    b_act, conv_new = _causal_conv(b_qkv, conv_buf, b_conv_w)
    b_act = jax.nn.silu(b_act)
    bq, bk, bv = jnp.split(b_act, [B_QK, 2 * B_QK], axis=-1)
    bq = _l2norm(bq.reshape(Bsz, T, B_HEADS, B_DK).astype(F32)) * (B_DK ** -0.5)
    bk = _l2norm(bk.reshape(Bsz, T, B_HEADS, B_DK).astype(F32))
    bv = bv.reshape(Bsz, T, B_HEADS, B_DV)
    beta = jax.nn.sigmoid(b_beta.astype(F32))
    g = -jnp.exp(b_a_log.astype(F32)) * jax.nn.softplus(b_a.astype(F32) + b_dt_bias.astype(F32))
    o_b, S_new = _gated_delta_rule(bq, bk, bv, beta, g, S0)
    o_b = _rmsnorm(o_b, b_out_norm_g) * jax.nn.silu(b_z.reshape(Bsz, T, B_HEADS, B_DV).astype(F32))
    o_b = o_b.reshape(Bsz, T, B_V).astype(x.dtype)

    cq = _rope(c_q.reshape(Bsz, T, C_HEADS, C_DK), pos)
    ck = _rope(c_k.reshape(Bsz, T, C_HEADS, C_DK), pos) * (C_DK ** -0.5)
    cv = c_v.reshape(Bsz, T, C_HEADS, C_DV)
    log_gamma = jnp.log1p(-jnp.exp2(-5.0 - jnp.arange(C_HEADS, dtype=F32)))
    o_c, R_new = _retention(cq, ck, cv, jnp.broadcast_to(log_gamma, (Bsz, T, C_HEADS)), R0)
    o_c = _rmsnorm(o_c, c_out_norm_g) * jax.nn.silu(c_z.reshape(Bsz, T, C_HEADS, C_DV).astype(F32))
    o_c = o_c.reshape(Bsz, T, C_V).astype(x.dtype)

    gts = jax.nn.sigmoid(gates.reshape(Bsz, T, 3, D_MODEL))
    merged = gts[:, :, 0] * (o_a @ w_out_a) + gts[:, :, 1] * (o_b @ w_out_b) + gts[:, :, 2] * (o_c @ w_out_c)
    x = x + (merged @ w_out).astype(x.dtype)

    ff_g, ff_u = jnp.split(_rmsnorm(x, norm2_g) @ w_ffn_in, 2, axis=-1)
    x = x + ((jax.nn.silu(ff_g) * ff_u) @ w_ffn_out).astype(x.dtype)
    return x, new_kv, conv_new, S_new, R_new


def setup_inputs(seed: int = 0) -> dict:
    key = jax.random.key(seed)
    ks = jax.random.split(key, 32)

    def nrm(k, shape, scale):
        return jax.random.normal(k, shape, F32) * scale

    lens = [min(w, PAST_LEN) for w, _ in A_GROUPS]
    dt = jnp.exp(jax.random.uniform(ks[14], (DEPTH, B_HEADS), F32, np.log(1e-3), np.log(1e-1)))
    return {
        'x_prompt': nrm(ks[0], (BATCH, SEQ, D_MODEL), 1.0),
        'x_sample': nrm(ks[1], (DEC_BATCH, DEC_SEQ, D_MODEL), 1.0),
        'cache_a_kv0': nrm(ks[2], (DEPTH, DEC_BATCH, lens[0], 2, A_HEADS, A_HD), 1.0),
        'cache_a_kv1': nrm(ks[3], (DEPTH, DEC_BATCH, lens[1], 2, A_HEADS, A_HD), 1.0),
        'cache_a_kv2': nrm(ks[4], (DEPTH, DEC_BATCH, lens[2], 2, A_HEADS, A_HD), 1.0),
        'state_b_conv': nrm(ks[5], (DEPTH, DEC_BATCH, B_CONV - 1, B_CONV_CH), 1.0),
        'state_b_S': nrm(ks[6], (DEPTH, DEC_BATCH, B_HEADS, B_DK, B_DV), 0.1),
        'state_c_R': nrm(ks[7], (DEPTH, DEC_BATCH, C_HEADS, C_DK, C_DV), 0.3),
        'norm1_g': 1.0 + nrm(ks[8], (DEPTH, D_MODEL), 0.02),
        'w_in': nrm(ks[9], (DEPTH, D_MODEL, N_IN), D_MODEL ** -0.5),
        'a_q_norm_g': 1.0 + nrm(ks[10], (DEPTH, A_HD), 0.02),
        'a_k_norm_g': 1.0 + nrm(ks[11], (DEPTH, A_HD), 0.02),
        'b_conv_w': nrm(ks[12], (DEPTH, B_CONV, B_CONV_CH), 0.5),
        'b_a_log': jnp.log(jax.random.uniform(ks[13], (DEPTH, B_HEADS), F32, 1.0, 16.0)),
        'b_dt_bias': jnp.log(jnp.expm1(dt)),
        'b_out_norm_g': 1.0 + nrm(ks[15], (DEPTH, B_DV), 0.02),
        'c_out_norm_g': 1.0 + nrm(ks[16], (DEPTH, C_DV), 0.02),
        'w_out_a': nrm(ks[17], (DEPTH, A_WIDTH, D_MODEL), A_WIDTH ** -0.5),
        'w_out_b': nrm(ks[18], (DEPTH, B_V, D_MODEL), B_V ** -0.5),
        'w_out_c': nrm(ks[19], (DEPTH, C_V, D_MODEL), C_V ** -0.5),
        'w_out': nrm(ks[20], (DEPTH, D_MODEL, D_MODEL), D_MODEL ** -0.5),
        'norm2_g': 1.0 + nrm(ks[21], (DEPTH, D_MODEL), 0.02),
        'w_ffn_in': nrm(ks[22], (DEPTH, D_MODEL, 2 * D_FF), D_MODEL ** -0.5),
        'w_ffn_out': nrm(ks[23], (DEPTH, D_FF, D_MODEL), D_FF ** -0.5),
    }


def reference(x_prompt, x_sample, cache_a_kv0, cache_a_kv1, cache_a_kv2, state_b_conv, state_b_S, state_c_R,
              norm1_g, w_in, a_q_norm_g, a_k_norm_g, b_conv_w, b_a_log, b_dt_bias, b_out_norm_g, c_out_norm_g,
              w_out_a, w_out_b, w_out_c, w_out, norm2_g, w_ffn_in, w_ffn_out):
    Bp, T = x_prompt.shape[:2]
    S = x_sample.shape[1]
    pos_p = jnp.arange(T)
    pos_s = PAST_LEN + jnp.arange(S)
    yp, ys = x_prompt, x_sample
    pk, sk = ([], [], []), ([], [], [])
    pc, pS, pR, sc, sS, sR = [], [], [], [], [], []
    for l in range(DEPTH):
        lw = (norm1_g[l], w_in[l], a_q_norm_g[l], a_k_norm_g[l], b_conv_w[l], b_a_log[l], b_dt_bias[l],
              b_out_norm_g[l], c_out_norm_g[l], w_out_a[l], w_out_b[l], w_out_c[l], w_out[l], norm2_g[l],
              w_ffn_in[l], w_ffn_out[l])
        yp, kv, cv, Sn, Rn = _layer(
            yp, pos_p, None, jnp.zeros((Bp, B_CONV - 1, B_CONV_CH), x_prompt.dtype),
            jnp.zeros((Bp, B_HEADS, B_DK, B_DV), F32), jnp.zeros((Bp, C_HEADS, C_DK, C_DV), F32), True, *lw)
        for gi in range(N_GROUPS):
            pk[gi].append(kv[gi])
        pc.append(cv)
        pS.append(Sn)
        pR.append(Rn)
        ys, kv, cv, Sn, Rn = _layer(
            ys, pos_s, (cache_a_kv0[l], cache_a_kv1[l], cache_a_kv2[l]), state_b_conv[l], state_b_S[l],
            state_c_R[l], False, *lw)
        for gi in range(N_GROUPS):
            sk[gi].append(kv[gi])
        sc.append(cv)
        sS.append(Sn)
        sR.append(Rn)
    new_a_kv0_prompt = jnp.stack(pk[0])
    new_a_kv1_prompt = jnp.stack(pk[1])
    new_a_kv2_prompt = jnp.stack(pk[2])
    new_b_conv_prompt = jnp.stack(pc)
    new_b_S_prompt = jnp.stack(pS)
    new_c_R_prompt = jnp.stack(pR)
    new_a_kv0_sample = jnp.stack(sk[0])
    new_a_kv1_sample = jnp.stack(sk[1])
    new_a_kv2_sample = jnp.stack(sk[2])
    new_b_conv_sample = jnp.stack(sc)
    new_b_S_sample = jnp.stack(sS)
    new_c_R_sample = jnp.stack(sR)
    return (yp, ys, new_a_kv0_prompt, new_a_kv1_prompt, new_a_kv2_prompt, new_b_conv_prompt, new_b_S_prompt,
            new_c_R_prompt, new_a_kv0_sample, new_a_kv1_sample, new_a_kv2_sample, new_b_conv_sample,
            new_b_S_sample, new_c_R_sample)
```

```cpp
#include <hip/hip_runtime.h>
#include <hip/hip_cooperative_groups.h>
#include <cstdio>
#include <cstdint>
namespace cg = cooperative_groups;

#ifndef PH_MASK
#define PH_MASK 0x1ff
#endif
#ifndef MK_ONE_LAUNCH
#define MK_ONE_LAUNCH 0
#endif

#define LAS __attribute__((address_space(3)))
typedef unsigned short bf16_t;
typedef short bf16x8 __attribute__((ext_vector_type(8)));
typedef float f32x4 __attribute__((ext_vector_type(4)));
typedef float f32x2 __attribute__((ext_vector_type(2)));
typedef unsigned u32x4 __attribute__((ext_vector_type(4)));
typedef unsigned u32x2 __attribute__((ext_vector_type(2)));

constexpr int D = 1024, BATCH = 4, SEQ = 4096, DEPTH = 2, DB = 32, DS = 8, PAST = 8192;
constexpr int MP = BATCH * SEQ, MS = DB * DS, M = MP + MS;
constexpr int NIN = 11272, NPROJ = 11520, DFF = 2816;
constexpr int PC_AQ = 0, PC_AK = 1536, PC_AV = 3072, PC_BQKV = 4608, PC_BZ = 6144, PC_CQ = 6656, PC_CK = 6912, PC_CV = 7168, PC_CZ = 7680, PC_GATE = 8192, PC_BETA = 11264, PC_BA = 11268;
constexpr float EPS = 1e-6f;
constexpr int NPOS = SEQ + DS;

constexpr size_t O_YP = 0;
constexpr size_t O_YS = O_YP + (size_t)MP * D;
constexpr size_t O_KV0P = O_YS + (size_t)MS * D;
constexpr size_t O_KV1P = O_KV0P + (size_t)DEPTH * BATCH * 128 * 1024;
constexpr size_t O_KV2P = O_KV1P + (size_t)DEPTH * BATCH * 512 * 1024;
constexpr size_t O_BCP = O_KV2P + (size_t)DEPTH * BATCH * 2048 * 1024;
constexpr size_t O_BSP = O_BCP + (size_t)DEPTH * BATCH * 3 * 1536;
constexpr size_t O_CRP = O_BSP + (size_t)DEPTH * BATCH * 4 * 128 * 128;
constexpr size_t O_KV0S = O_CRP + (size_t)DEPTH * BATCH * 4 * 64 * 128;
constexpr size_t O_KV1S = O_KV0S + (size_t)DEPTH * DB * DS * 1024;
constexpr size_t O_KV2S = O_KV1S + (size_t)DEPTH * DB * DS * 1024;
constexpr size_t O_BCS = O_KV2S + (size_t)DEPTH * DB * DS * 1024;
constexpr size_t O_BSS = O_BCS + (size_t)DEPTH * DB * 3 * 1536;
constexpr size_t O_CRS = O_BSS + (size_t)DEPTH * DB * 4 * 128 * 128;
constexpr size_t O_END = O_CRS + (size_t)DEPTH * DB * 4 * 64 * 128;

constexpr size_t al256(size_t x) { return (x + 255) & ~(size_t)255; }
constexpr size_t WS_CTL = 0, CTL_BYTES = 1u << 20;
constexpr size_t WS_WIN = WS_CTL + CTL_BYTES;
constexpr size_t WS_WABC = WS_WIN + al256((size_t)DEPTH * NPROJ * D * 2);
constexpr size_t WS_WOUT = WS_WABC + al256((size_t)DEPTH * 3 * D * 512 * 2);
constexpr size_t WS_WFI = WS_WOUT + al256((size_t)DEPTH * D * D * 2);
constexpr size_t WS_WFO = WS_WFI + al256((size_t)DEPTH * 2 * DFF * D * 2);
constexpr size_t WS_XBA = WS_WFO + al256((size_t)DEPTH * D * DFF * 2);
constexpr size_t WS_XBB = WS_XBA + al256((size_t)M * D * 2);
constexpr size_t WS_X1 = WS_XBB + al256((size_t)M * D * 2);
constexpr size_t WS_X2 = WS_X1 + al256((size_t)M * D * 4);
constexpr size_t WS_RS = WS_X2 + al256((size_t)M * D * 4);
constexpr size_t WS_PROJ = WS_RS + al256((size_t)4 * M * 4);
constexpr size_t WS_BQKV = WS_PROJ + al256((size_t)M * NPROJ * 2);
constexpr size_t WS_BG = WS_BQKV + al256((size_t)M * 1536 * 4);
constexpr size_t WS_CQK = WS_BG + al256((size_t)M * 8 * 4);
constexpr size_t WS_OBR = WS_CQK + al256((size_t)M * 512 * 4);
constexpr size_t WS_OCR = WS_OBR + al256((size_t)M * 512 * 4);
constexpr size_t WS_OABC = WS_OCR + al256((size_t)M * 512 * 4);
constexpr size_t WS_MRG = WS_OABC + al256((size_t)3 * M * 512 * 2);
constexpr size_t WS_ACT = WS_MRG + al256((size_t)M * D * 2);
constexpr size_t WS_ROPEA = WS_ACT + al256((size_t)M * DFF * 2);
constexpr size_t WS_ROPEC = WS_ROPEA + al256((size_t)NPOS * 64 * 2 * 4);
constexpr size_t WS_END = WS_ROPEC + al256((size_t)NPOS * 32 * 2 * 4);
constexpr int CW_MIX0 = 64, CW_MIX1 = 128;

constexpr int NWAVES = 8, NTHREADS = 512;
constexpr int RING_BYTES = 131072, LDS_BYTES = 147456;

__device__ __forceinline__ float bf_lo(unsigned u) { return __uint_as_float(u << 16); }
__device__ __forceinline__ float bf_hi(unsigned u) { return __uint_as_float(u & 0xffff0000u); }
__device__ __forceinline__ float bf1(bf16_t u) { return __uint_as_float(((unsigned)u) << 16); }
__device__ __forceinline__ unsigned cvt_pk_bf16(float lo, float hi) { unsigned r; asm volatile("v_cvt_pk_bf16_f32 %0, %1, %2" : "=v"(r) : "v"(lo), "v"(hi)); return r; }
__device__ __forceinline__ float wave_sum(float v) {
#pragma unroll
    for (int o = 1; o < 64; o <<= 1) v += __shfl_xor(v, o);
    return v;
}
__device__ __forceinline__ float wave_max(float v) {
#pragma unroll
    for (int o = 1; o < 64; o <<= 1) v = fmaxf(v, __shfl_xor(v, o));
    return v;
}
__device__ __forceinline__ float half_sum(float v) {
#pragma unroll
    for (int o = 1; o < 32; o <<= 1) v += __shfl_xor(v, o);
    return v;
}
__device__ __forceinline__ float sigmoidf_(float x) { return __builtin_amdgcn_rcpf(1.f + __expf(-x)); }
__device__ __forceinline__ float rdlane(float v, int l) { return __int_as_float(__builtin_amdgcn_readlane(__float_as_int(v), l)); }

namespace pg8 {
constexpr int BM = 256, BK = 64, HALF = 128, HTB = HALF * BK * 2, NXCD = 8, WGM = 8;
__host__ __device__ __forceinline__ int lds_byte(int r, int c) { const int st = (r >> 4) * 2 + (c >> 5), rr = r & 15, cc = c & 31, ob = rr * 64 + cc * 2; return st * 1024 + (ob ^ (((ob >> 9) & 1) << 5)); }
__host__ __device__ __forceinline__ void stage_rc(int b, int& R, int& C) { const int st = b / 1024, sb = b % 1024, swz = sb ^ (((sb >> 9) & 1) << 5); R = (st >> 1) * 16 + swz / 64; C = (st & 1) * 32 + (swz % 64) / 2; }
__host__ __device__ __forceinline__ int perm32(int rho) { const int n = rho >> 4, i = rho & 15; return 8 * (i >> 2) + 4 * n + (i & 3); }

struct Unit { int pm, pn; };
struct Gemm { const bf16_t* A; const bf16_t* Bt; int K; };

template <int TRIP> struct Order {
    int nM, nN, nwg, G, c;
    __device__ void init(int nM_, int nN_, int G_, int c_) { nM = nM_; nN = nN_; nwg = nM * nN; G = G_; c = c_; }
    __device__ bool next(int i, Unit& u) const {
        const int ii = i / TRIP, sub = i - ii * TRIP;
        const long L = (long)ii * G + c; if (L >= nwg) return false;
        int wgid = (int)L; { const int q = nwg / NXCD, r = nwg % NXCD, xcd = wgid % NXCD, off = wgid / NXCD; wgid = (xcd < r ? xcd * (q + 1) : r * (q + 1) + (xcd - r) * q) + off; }
        const int nig = WGM * nN, gid = wgid / nig, fm = gid * WGM, gsz = (nM - fm) < WGM ? (nM - fm) : WGM;
        u.pm = fm + ((wgid % nig) % gsz) + sub * nM; u.pn = (wgid % nig) / gsz + sub * nN; return true;
    }
};

template <class Epi, class Sched>
__device__ __forceinline__ void gemm_phase(LAS unsigned char* lds, const int tid, const Gemm g, const Sched& S, const Epi& E) {
    const int wid = __builtin_amdgcn_readfirstlane(tid >> 6), lane = tid & 63, wr = wid >> 2, wc = wid & 3, fr = lane & 15, fq = lane >> 4;
    const int K = g.K, nt = K / BK;
    unsigned voffA[2], voffB[2];
#pragma unroll
    for (int i = 0; i < 2; ++i) { int R, C; stage_rc(tid * 16 + i * 8192, R, C); const int Rb = Epi::PERM ? ((R & ~31) + perm32(R & 31)) : R;
        voffA[i] = (unsigned)(R * K + C) * 2u; voffB[i] = (unsigned)(Rb * K + C) * 2u; }
    const size_t kstep = (size_t)(BK * 2);
    const size_t hstep = (size_t)HALF * K * 2;
    const size_t tstep = 2 * hstep;
    const unsigned ldsw = (unsigned)wid * 1024u;
    const int aoff = lds_byte(wr * 64 + fr, fq * 8), boff = lds_byte(wc * 32 + fr, fq * 8);
#define PG8_SA(b, h) (((b) * 2 + (h)) * HTB)
#define PG8_SB(b, h) ((4 + (b) * 2 + (h)) * HTB)
#define PG8_STAGE(bufoff, gbase, voff) do { _Pragma("unroll") for (int _i = 0; _i < 2; ++_i) \
        __builtin_amdgcn_global_load_lds((const unsigned*)((const char*)(gbase) + (voff)[_i]), (LAS unsigned*)(lds + (bufoff) + ldsw + _i * 8192), 16, 0, 0); } while (0)
#define PG8_LDA(dst, b, h) do { _Pragma("unroll") for (int m = 0; m < 4; ++m) _Pragma("unroll") for (int k = 0; k < 2; ++k) dst[m][k] = *(const LAS bf16x8*)(lds + PG8_SA(b, h) + aoff + m * 2048 + k * 1024); } while (0)
#define PG8_LDB(dst, b, h) do { _Pragma("unroll") for (int n = 0; n < 2; ++n) _Pragma("unroll") for (int k = 0; k < 2; ++k) dst[n][k] = *(const LAS bf16x8*)(lds + PG8_SB(b, h) + boff + n * 2048 + k * 1024); } while (0)
#define PG8_MMA(ai, bj, At, Bt) do { __builtin_amdgcn_s_setprio(1); _Pragma("unroll") for (int m = 0; m < 4; ++m) _Pragma("unroll") for (int n = 0; n < 2; ++n) _Pragma("unroll") for (int k = 0; k < 2; ++k) \
        acc[ai][bj][m][n] = __builtin_amdgcn_mfma_f32_16x16x32_bf16(Bt[n][k], At[m][k], acc[ai][bj][m][n], 0, 0, 0); __builtin_amdgcn_s_setprio(0); } while (0)
#define PG8_WAIT_V(n) asm volatile("s_waitcnt vmcnt(" #n ")" ::: "memory")
#define PG8_WAIT_L(n) asm volatile("s_waitcnt lgkmcnt(" #n ")" ::: "memory")
#define PG8_BAR __builtin_amdgcn_s_barrier()
#define PG8_SCHED __builtin_amdgcn_sched_barrier(0)
    Unit cur, nxt; int ui = 0;
    if (!S.next(0, cur)) return;
    f32x4 acc[2][2][4][2];
#pragma unroll
    for (int a = 0; a < 2; ++a)
#pragma unroll
        for (int b = 0; b < 2; ++b)
#pragma unroll
            for (int m = 0; m < 4; ++m)
#pragma unroll
                for (int n = 0; n < 2; ++n) acc[a][b][m][n] = (f32x4){0.f, 0.f, 0.f, 0.f};
    bf16x8 At[4][2], B0[2][2], B1[2][2];
    const char* cA = (const char*)g.A + (size_t)cur.pm * tstep; const char* cB = (const char*)g.Bt + (size_t)cur.pn * tstep;
    PG8_STAGE(PG8_SB(0, 0), cB, voffB); PG8_STAGE(PG8_SB(0, 1), cB + hstep, voffB); PG8_STAGE(PG8_SA(0, 0), cA, voffA); PG8_STAGE(PG8_SA(0, 1), cA + hstep, voffA);
    if (wr == 1) PG8_BAR;
    PG8_WAIT_V(2); PG8_BAR;
    PG8_STAGE(PG8_SB(1, 0), cB + kstep, voffB); PG8_STAGE(PG8_SA(1, 0), cA + kstep, voffA); PG8_STAGE(PG8_SB(1, 1), cB + hstep + kstep, voffB);
    PG8_WAIT_V(6); PG8_BAR;
    for (;;) {
        const bool has_next = S.next(ui + 1, nxt);
        const char* nA = has_next ? (const char*)g.A + (size_t)nxt.pm * tstep : cA; const char* nB = has_next ? (const char*)g.Bt + (size_t)nxt.pn * tstep : cB;
        for (int t = 0; t < nt; t += 2) {
            const bool last = (t == nt - 2);
            const char* a1 = cA + (size_t)(t + 1) * kstep;
            const char* a2 = last ? nA : cA + (size_t)(t + 2) * kstep; const char* b2 = last ? nB : cB + (size_t)(t + 2) * kstep;
            const char* a3 = a2 + kstep; const char* b3 = b2 + kstep;
            PG8_LDB(B0, 0, 0); PG8_LDB(B1, 0, 1); PG8_SCHED; PG8_LDA(At, 0, 0); PG8_STAGE(PG8_SA(1, 1), a1 + hstep, voffA);
            PG8_WAIT_V(8); PG8_WAIT_L(0); PG8_BAR; PG8_MMA(0, 0, At, B0); PG8_MMA(0, 1, At, B1); PG8_BAR; PG8_SCHED;
            PG8_LDA(At, 0, 1); PG8_STAGE(PG8_SB(0, 0), b2, voffB); PG8_STAGE(PG8_SB(0, 1), b2 + hstep, voffB); PG8_STAGE(PG8_SA(0, 0), a2, voffA);
            PG8_WAIT_V(8); PG8_WAIT_L(0); PG8_BAR; PG8_MMA(1, 0, At, B0); PG8_MMA(1, 1, At, B1); PG8_BAR; PG8_SCHED;
            PG8_LDB(B0, 1, 0); PG8_LDB(B1, 1, 1); PG8_SCHED; PG8_LDA(At, 1, 0); PG8_STAGE(PG8_SA(0, 1), a2 + hstep, voffA);
            PG8_WAIT_V(8); PG8_WAIT_L(0); PG8_BAR; PG8_MMA(0, 0, At, B0); PG8_MMA(0, 1, At, B1); PG8_BAR; PG8_SCHED;
            PG8_LDA(At, 1, 1); PG8_STAGE(PG8_SB(1, 0), b3, voffB); PG8_STAGE(PG8_SB(1, 1), b3 + hstep, voffB); PG8_STAGE(PG8_SA(1, 0), a3, voffA);
            PG8_WAIT_V(8); PG8_WAIT_L(0); PG8_BAR; PG8_MMA(1, 0, At, B0); PG8_MMA(1, 1, At, B1); PG8_BAR; PG8_SCHED;
        }
        if (wr == 0) PG8_BAR;
        E(acc, cur, wr, wc, fr, fq);
        if (!has_next) break;
        if (E.reset_after(cur)) {
#pragma unroll
            for (int a = 0; a < 2; ++a)
#pragma unroll
                for (int b = 0; b < 2; ++b)
#pragma unroll
                    for (int m = 0; m < 4; ++m)
#pragma unroll
                        for (int n = 0; n < 2; ++n) acc[a][b][m][n] = (f32x4){0.f, 0.f, 0.f, 0.f};
        }
        cur = nxt; cA = nA; cB = nB; ++ui;
        if (wr == 1) PG8_BAR;
    }
    PG8_WAIT_V(0);
    PG8_BAR;
#undef PG8_SA
#undef PG8_SB
#undef PG8_STAGE
#undef PG8_LDA
#undef PG8_LDB
#undef PG8_MMA
#undef PG8_WAIT_V
#undef PG8_WAIT_L
#undef PG8_BAR
#undef PG8_SCHED
}
}
using pg8::Unit;

struct EpiProj {
    static constexpr bool PERM = true;
    bf16_t* O; const float* rowss;
    __device__ __forceinline__ bool reset_after(const Unit&) const { return true; }
    __device__ __forceinline__ void operator()(f32x4 (&acc)[2][2][4][2], const Unit& u, int wr, int wc, int fr, int fq) const {
        const int row0 = u.pm * 256 + wr * 64 + fr, col0 = u.pn * 256 + wc * 32 + 8 * fq;
        const bool gate = (u.pn >= 32 && u.pn < 44);
#pragma unroll
        for (int ai = 0; ai < 2; ++ai)
#pragma unroll
            for (int m = 0; m < 4; ++m) {
                const int row = row0 + ai * 128 + m * 16;
                const float rs = rsqrtf(rowss[row] * (1.f / 1024.f) + EPS);
                bf16_t* rowp = O + (size_t)row * NPROJ + col0;
#pragma unroll
                for (int bj = 0; bj < 2; ++bj) {
                    f32x4 v0 = acc[ai][bj][m][0] * rs, v1 = acc[ai][bj][m][1] * rs;
                    if (gate) {
#pragma unroll
                        for (int j = 0; j < 4; ++j) { v0[j] = sigmoidf_(v0[j]); v1[j] = sigmoidf_(v1[j]); }
                    }
                    u32x4 w; w.x = cvt_pk_bf16(v0[0], v0[1]); w.y = cvt_pk_bf16(v0[2], v0[3]); w.z = cvt_pk_bf16(v1[0], v1[1]); w.w = cvt_pk_bf16(v1[2], v1[3]);
                    *(u32x4*)(rowp + bj * 128) = w;
                }
            }
    }
};
struct EpiAbc {
    static constexpr bool PERM = true;
    const bf16_t* G; bf16_t* O;
    __device__ __forceinline__ bool reset_after(const Unit& u) const { return (u.pn >> 2) == 2; }
    __device__ __forceinline__ void operator()(f32x4 (&acc)[2][2][4][2], const Unit& u, int wr, int wc, int fr, int fq) const {
        const int sub = u.pn >> 2, pn = u.pn & 3, pm = u.pm - sub * 65;
        const int row0 = pm * 256 + wr * 64 + fr, col0 = pn * 256 + wc * 32 + 8 * fq;
#pragma unroll
        for (int ai = 0; ai < 2; ++ai)
#pragma unroll
            for (int m = 0; m < 4; ++m) {
                const int row = row0 + ai * 128 + m * 16;
                const bf16_t* gp = G + (size_t)row * NPROJ + PC_GATE + sub * 1024 + col0;
#pragma unroll
                for (int bj = 0; bj < 2; ++bj) {
                    const u32x4 ga = *(const u32x4*)(gp + bj * 128);
                    f32x4 g0 = (f32x4){bf_lo(ga.x), bf_hi(ga.x), bf_lo(ga.y), bf_hi(ga.y)}, g1 = (f32x4){bf_lo(ga.z), bf_hi(ga.z), bf_lo(ga.w), bf_hi(ga.w)};
                    if (sub < 2) {
                        const u32x4 gb = *(const u32x4*)(gp + 1024 + bj * 128);
                        const f32x4 h0 = (f32x4){bf_lo(gb.x), bf_hi(gb.x), bf_lo(gb.y), bf_hi(gb.y)}, h1 = (f32x4){bf_lo(gb.z), bf_hi(gb.z), bf_lo(gb.w), bf_hi(gb.w)};
#pragma unroll
                        for (int j = 0; j < 4; ++j) { acc[ai][bj][m][0][j] *= g0[j] * __builtin_amdgcn_rcpf(fmaxf(h0[j], 1e-30f)); acc[ai][bj][m][1][j] *= g1[j] * __builtin_amdgcn_rcpf(fmaxf(h1[j], 1e-30f)); }
                    } else {
                        const f32x4 v0 = acc[ai][bj][m][0] * g0, v1 = acc[ai][bj][m][1] * g1;
                        u32x4 w; w.x = cvt_pk_bf16(v0[0], v0[1]); w.y = cvt_pk_bf16(v0[2], v0[3]); w.z = cvt_pk_bf16(v1[0], v1[1]); w.w = cvt_pk_bf16(v1[2], v1[3]);
                        *(u32x4*)(O + (size_t)row * D + col0 + bj * 128) = w;
                    }
                }
            }
    }
};
struct EpiRes {
    static constexpr bool PERM = false;
    const float* res0; const float* res1; float* out; bf16_t* xb; float* rowss;
    __device__ __forceinline__ bool reset_after(const Unit&) const { return true; }
    __device__ __forceinline__ void operator()(f32x4 (&acc)[2][2][4][2], const Unit& u, int wr, int wc, int fr, int fq) const {
        const int col0 = u.pn * 256 + wc * 32 + 4 * fq;
        const float* rbase = (u.pm < 64) ? res0 + (size_t)u.pm * 256 * D : res1;
#pragma unroll
        for (int ai = 0; ai < 2; ++ai)
#pragma unroll
            for (int m = 0; m < 4; ++m) {
                const int lrow = ai * 128 + wr * 64 + m * 16 + fr; const size_t grow = (size_t)u.pm * 256 + lrow;
                float ss = 0.f;
#pragma unroll
                for (int bj = 0; bj < 2; ++bj)
#pragma unroll
                    for (int n = 0; n < 2; ++n) {
                        const int c = col0 + bj * 128 + n * 16;
                        const f32x4 r4 = *(const f32x4*)(rbase + (size_t)lrow * D + c);
                        const f32x4 o = r4 + acc[ai][bj][m][n];
                        *(f32x4*)(out + grow * D + c) = o;
                        u32x2 w; w.x = cvt_pk_bf16(o[0], o[1]); w.y = cvt_pk_bf16(o[2], o[3]);
                        *(u32x2*)(xb + grow * D + c) = w;
                        ss += (o[0] * o[0] + o[1] * o[1]) + (o[2] * o[2] + o[3] * o[3]);
                    }
                ss += __shfl_xor(ss, 16); ss += __shfl_xor(ss, 32);
                if (fq == 0) atomicAdd(rowss + grow, ss);
                asm volatile("" ::: "memory");
            }
    }
};
struct EpiFfn {
    static constexpr bool PERM = true;
    bf16_t* O; const float* rowss;
    __device__ __forceinline__ bool reset_after(const Unit&) const { return true; }
    __device__ __forceinline__ void operator()(f32x4 (&acc)[2][2][4][2], const Unit& u, int wr, int wc, int fr, int fq) const {
        const int row0 = u.pm * 256 + wr * 64 + fr, f0 = u.pn * 128 + 16 * wc + 4 * fq;
#pragma unroll
        for (int ai = 0; ai < 2; ++ai)
#pragma unroll
            for (int m = 0; m < 4; ++m) {
                const int row = row0 + ai * 128 + m * 16;
                const float rs = rsqrtf(rowss[row] * (1.f / 1024.f) + EPS);
#pragma unroll
                for (int bj = 0; bj < 2; ++bj) {
                    const f32x4 gg = acc[ai][bj][m][0] * rs, uu = acc[ai][bj][m][1] * rs;
                    f32x4 hh;
#pragma unroll
                    for (int j = 0; j < 4; ++j) hh[j] = gg[j] * sigmoidf_(gg[j]) * uu[j];
                    u32x2 w; w.x = cvt_pk_bf16(hh[0], hh[1]); w.y = cvt_pk_bf16(hh[2], hh[3]);
                    *(u32x2*)(O + (size_t)row * DFF + f0 + bj * 64) = w;
                }
            }
    }
};

struct Args { const float* in[24]; float* out; unsigned char* ws; int ph_lo, ph_hi; };
static_assert(sizeof(Args) == 216, "Args layout");
struct Ctx {
    const float* const __attribute__((address_space(4)))* in; float* out; unsigned char* ws;
    LAS unsigned char* lds; int tid, lane, wave, G, bid;
};
#define WSV(T, off) ((T*)(F.ws + (off)))
#define V_WIN WSV(bf16_t, WS_WIN)
#define V_WABC WSV(bf16_t, WS_WABC)
#define V_WOUT WSV(bf16_t, WS_WOUT)
#define V_WFI WSV(bf16_t, WS_WFI)
#define V_WFO WSV(bf16_t, WS_WFO)
#define V_XBA WSV(bf16_t, WS_XBA)
#define V_XBB WSV(bf16_t, WS_XBB)
#define V_PROJ WSV(bf16_t, WS_PROJ)
#define V_OABC WSV(bf16_t, WS_OABC)
#define V_MRG WSV(bf16_t, WS_MRG)
#define V_ACT WSV(bf16_t, WS_ACT)
#define V_X1 WSV(float, WS_X1)
#define V_X2 WSV(float, WS_X2)
#define V_RS WSV(float, WS_RS)
#define V_BQKV WSV(float, WS_BQKV)
#define V_BG WSV(float, WS_BG)
#define V_CQK WSV(float, WS_CQK)
#define V_OBR WSV(float, WS_OBR)
#define V_OCR WSV(float, WS_OCR)
#define V_ROPEA WSV(float, WS_ROPEA)
#define V_ROPEC WSV(float, WS_ROPEC)
#define V_CTL WSV(unsigned, WS_CTL)

__device__ __forceinline__ int src_col(int mode, int n) {
    if (mode == 1) { if (n < 6656) return n; if (n < 11264) return n + 8; if (n < 11272) return n - 11264 + 6656; return -1; }
    if (mode == 2) { const int pn = n >> 8, c = n & 255; const int f = pn * 128 + (c >> 3) * 4 + (c & 3); return ((c >> 2) & 1) * DFF + f; }
    return n;
}
__device__ __forceinline__ void transpose_item(const float* W, int K, int N, int nblk, bf16_t* WT, const float* kscale, int mode, LAS float* scr, int item, int lane) {
    const int kb = item / nblk, nb = item - kb * nblk, k0 = 64 * kb, n0 = 32 * nb;
    const int sc = src_col(mode, n0 + (lane & 31));
#pragma unroll 8
    for (int i = 0; i < 32; ++i) { const int kk = 2 * i + (lane >> 5);
        float v = 0.f; if (sc >= 0) { v = W[(size_t)(k0 + kk) * N + sc]; if (kscale) v *= kscale[k0 + kk]; }
        scr[kk * 33 + (lane & 31)] = v; }
    asm volatile("s_waitcnt lgkmcnt(0)" ::: "memory");
    const int c = lane & 7;
#pragma unroll
    for (int j = 0; j < 4; ++j) { const int n = (lane >> 3) + 8 * j; const LAS float* s = scr + (8 * c) * 33 + n;
        u32x4 o; o.x = cvt_pk_bf16(s[0 * 33], s[1 * 33]); o.y = cvt_pk_bf16(s[2 * 33], s[3 * 33]); o.z = cvt_pk_bf16(s[4 * 33], s[5 * 33]); o.w = cvt_pk_bf16(s[6 * 33], s[7 * 33]);
        *(u32x4*)(WT + (size_t)(n0 + n) * K + k0 + 8 * c) = o; }
    asm volatile("s_waitcnt lgkmcnt(0)" ::: "memory");
}
__device__ __forceinline__ void phase_prep(Ctx& F) {
    LAS float* scr = (LAS float*)(F.lds + F.wave * 16384);
    const int gw = F.bid * NWAVES + F.wave, NGW = F.G * NWAVES, lane = F.lane;
    constexpr int I_IN = 16 * (NPROJ / 32), I_ABC = 8 * 32, I_OUT = 16 * 32, I_FI = 16 * (2 * DFF / 32), I_FO = (DFF / 64) * 32;
    constexpr int I_LAYER = I_IN + 3 * I_ABC + I_OUT + I_FI + I_FO;
    for (int it = gw; it < DEPTH * I_LAYER; it += NGW) {
        const int l = it / I_LAYER; int r = it - l * I_LAYER;
        const float* W; const float* ksc = nullptr; bf16_t* WT; int K = D, N = D, nblk = D / 32, mode = 0;
        if (r < I_IN) { W = F.in[9] + (size_t)l * D * NIN; N = NIN; nblk = NPROJ / 32; WT = V_WIN + (size_t)l * NPROJ * D; ksc = F.in[8] + l * D; mode = 1; }
        else if ((r -= I_IN) < 3 * I_ABC) { const int i = r / I_ABC; r -= i * I_ABC; W = F.in[17 + i] + (size_t)l * 512 * D; K = 512; WT = V_WABC + (size_t)(l * 3 + i) * D * 512; }
        else if ((r -= 3 * I_ABC) < I_OUT) { W = F.in[20] + (size_t)l * D * D; WT = V_WOUT + (size_t)l * D * D; }
        else if ((r -= I_OUT) < I_FI) { W = F.in[22] + (size_t)l * D * 2 * DFF; N = 2 * DFF; nblk = 2 * DFF / 32; WT = V_WFI + (size_t)l * 2 * DFF * D; ksc = F.in[21] + l * D; mode = 2; }
        else { r -= I_FI; W = F.in[23] + (size_t)l * DFF * D; K = DFF; WT = V_WFO + (size_t)l * D * DFF; }
        transpose_item(W, K, N, nblk, WT, ksc, mode, scr, r, lane);
    }
    for (int row = gw; row < M; row += NGW) {
        const float* src = row < MP ? F.in[0] + (size_t)row * D : F.in[1] + (size_t)(row - MP) * D;
        f32x4 v[4]; float ss = 0.f;
#pragma unroll
        for (int j = 0; j < 4; ++j) { v[j] = *(const f32x4*)(src + 4 * lane + 256 * j); ss += (v[j][0] * v[j][0] + v[j][1] * v[j][1]) + (v[j][2] * v[j][2] + v[j][3] * v[j][3]); }
        ss = wave_sum(ss);
        if (lane == 0) V_RS[row] = ss;
#pragma unroll
        for (int j = 0; j < 4; ++j) { u32x2 w; w.x = cvt_pk_bf16(v[j][0], v[j][1]); w.y = cvt_pk_bf16(v[j][2], v[j][3]); *(u32x2*)(V_XBA + (size_t)row * D + 4 * lane + 256 * j) = w; }
    }
    const int gt = F.bid * NTHREADS + F.tid, NGT = F.G * NTHREADS;
    for (int i = gt; i < 3 * M; i += NGT) V_RS[M + i] = 0.f;
    for (int e = gt; e < NPOS * 64; e += NGT) { const int pi = e >> 6, i = e & 63; const double pos = pi < SEQ ? (double)pi : (double)(PAST + pi - SEQ);
        const double inv = exp(-(double)i * (9.210340371976184 / 64.0)); double sn, cs; sincos(pos * inv, &sn, &cs); V_ROPEA[2 * e] = (float)cs; V_ROPEA[2 * e + 1] = (float)sn; }
    for (int e = gt; e < NPOS * 32; e += NGT) { const int pi = e >> 5, i = e & 31; const double pos = pi < SEQ ? (double)pi : (double)(PAST + pi - SEQ);
        const double inv = exp(-(double)i * (9.210340371976184 / 32.0)); double sn, cs; sincos(pos * inv, &sn, &cs); V_ROPEC[2 * e] = (float)cs; V_ROPEC[2 * e + 1] = (float)sn; }
}

__device__ __forceinline__ float* kv_out_ptr(float* out, int g, int l, bool sample, int b, int tt) {
    if (sample) { const size_t base = g == 0 ? O_KV0S : (g == 1 ? O_KV1S : O_KV2S); return out + base + ((size_t)(l * DB + b) * DS + tt) * 1024; }
    const int keep = 128 << (2 * g); const size_t base = g == 0 ? O_KV0P : (g == 1 ? O_KV1P : O_KV2P);
    return out + base + ((size_t)(l * BATCH + b) * keep + tt) * 1024;
}
__device__ __forceinline__ void e1_row(Ctx& F, int l, int row) {
    const int lane = F.lane, j = lane & 31, hh = lane >> 5;
    const bool sample = row >= MP;
    const int b = sample ? (row - MP) >> 3 : row >> 12, t = sample ? (row - MP) & 7 : row & 4095;
    const int pidx = sample ? SEQ + t : t;
    bf16_t* prow = V_PROJ + (size_t)row * NPROJ;
    const f32x4 csA = *(const f32x4*)(V_ROPEA + ((size_t)pidx * 64 + 2 * j) * 2);
#pragma unroll 1
    for (int it = 0; it < 12; ++it) {
        const int hs = 2 * it + hh, which = hs >= 12 ? 1 : 0, gh = hs - 12 * which, g = gh >> 2, h = gh & 3;
        bf16_t* p = prow + which * 1536 + gh * 128;
        const unsigned lo = *(const unsigned*)(p + 2 * j), hi = *(const unsigned*)(p + 64 + 2 * j);
        float x0 = bf_lo(lo), x1 = bf_hi(lo), x2 = bf_lo(hi), x3 = bf_hi(hi);
        const float ss = half_sum((x0 * x0 + x1 * x1) + (x2 * x2 + x3 * x3));
        const float rstd = rsqrtf(ss * (1.f / 128.f) + EPS);
        const float* gn = F.in[10 + which] + l * 128;
        const f32x2 g01 = *(const f32x2*)(gn + 2 * j), g23 = *(const f32x2*)(gn + 64 + 2 * j);
        x0 *= rstd * g01[0]; x1 *= rstd * g01[1]; x2 *= rstd * g23[0]; x3 *= rstd * g23[1];
        const float o0 = x0 * csA[0] - x2 * csA[1], o1 = x1 * csA[2] - x3 * csA[3], o2 = x2 * csA[0] + x0 * csA[1], o3 = x3 * csA[2] + x1 * csA[3];
        *(unsigned*)(p + 2 * j) = cvt_pk_bf16(o0, o1); *(unsigned*)(p + 64 + 2 * j) = cvt_pk_bf16(o2, o3);
        if (which == 1) {
            const int keep = 128 << (2 * g); const int tt = sample ? t : t - (SEQ - keep);
            if (tt >= 0) { float* dst = kv_out_ptr(F.out, g, l, sample, b, tt) + h * 128; *(f32x2*)(dst + 2 * j) = (f32x2){o0, o1}; *(f32x2*)(dst + 64 + 2 * j) = (f32x2){o2, o3}; }
        }
    }
#pragma unroll 1
    for (int g = 0; g < 3; ++g) {
        const int keep = 128 << (2 * g); const int tt = sample ? t : t - (SEQ - keep);
        if (tt >= 0) { float* dst = kv_out_ptr(F.out, g, l, sample, b, tt) + 512;
#pragma unroll
            for (int q = 0; q < 4; ++q) { const unsigned v = *(const unsigned*)(prow + PC_AV + g * 512 + q * 128 + 2 * lane); *(f32x2*)(dst + q * 128 + 2 * lane) = (f32x2){bf_lo(v), bf_hi(v)}; } }
    }
#pragma unroll 1
    for (int it = 0; it < 6; ++it) {
        const int slot = 2 * it + hh, typ = slot >> 2, c = slot * 128 + 4 * j;
        f32x4 a = (f32x4){0.f, 0.f, 0.f, 0.f}, xcur = a;
#pragma unroll
        for (int i = 0; i < 4; ++i) {
            const int tp = t - 3 + i; f32x4 x;
            if (tp >= 0) { const u32x2 u = *(const u32x2*)(V_PROJ + (size_t)(row - 3 + i) * NPROJ + PC_BQKV + c); x = (f32x4){bf_lo(u.x), bf_hi(u.x), bf_lo(u.y), bf_hi(u.y)}; }
            else if (sample) x = *(const f32x4*)(F.in[5] + ((size_t)(l * DB + b) * 3 + (tp + 3)) * 1536 + c);
            else x = (f32x4){0.f, 0.f, 0.f, 0.f};
            const f32x4 w = *(const f32x4*)(F.in[12] + (size_t)(l * 4 + i) * 1536 + c);
            a += w * x; if (i == 3) xcur = x;
        }
#pragma unroll
        for (int q = 0; q < 4; ++q) a[q] = a[q] * sigmoidf_(a[q]);
        if (typ < 2) {
            const float ss = half_sum((a[0] * a[0] + a[1] * a[1]) + (a[2] * a[2] + a[3] * a[3]));
            const float sc = rsqrtf(ss + EPS) * (typ == 0 ? 0.08838834764831845f : 1.f);
            a *= sc;
        }
        *(f32x4*)(V_BQKV + (size_t)row * 1536 + c) = a;
        const int tc = sample ? t - 5 : t - (SEQ - 3);
        if (tc >= 0) { float* dst = F.out + (sample ? O_BCS + ((size_t)(l * DB + b) * 3 + tc) * 1536 : O_BCP + ((size_t)(l * BATCH + b) * 3 + tc) * 1536); *(f32x4*)(dst + c) = xcur; }
    }
    if (lane < 8) {
        const int h = lane & 3; const float x = bf1(prow[PC_BETA + lane]);
        float r;
        if (lane < 4) r = 1.f / (1.f + expf(-x));
        else { const float y = x + F.in[14][l * 4 + h]; const float sp = y > 20.f ? y : log1pf(expf(y)); r = -expf(F.in[13][l * 4 + h]) * sp; }
        V_BG[(size_t)row * 8 + lane] = r;
    }
    {
        const int hs = lane >> 3, i0 = 4 * (lane & 7);
        const bf16_t* p = prow + PC_CQ + hs * 64;
        const u32x2 ulo = *(const u32x2*)(p + i0), uhi = *(const u32x2*)(p + 32 + i0);
        const f32x4 lo = (f32x4){bf_lo(ulo.x), bf_hi(ulo.x), bf_lo(ulo.y), bf_hi(ulo.y)}, hi = (f32x4){bf_lo(uhi.x), bf_hi(uhi.x), bf_lo(uhi.y), bf_hi(uhi.y)};
        const float* cs = V_ROPEC + ((size_t)pidx * 32 + i0) * 2;
        const f32x4 c01 = *(const f32x4*)cs, c23 = *(const f32x4*)(cs + 4);
        const f32x4 cc = (f32x4){c01[0], c01[2], c23[0], c23[2]}, sn = (f32x4){c01[1], c01[3], c23[1], c23[3]};
        const float sc = hs >= 4 ? 0.125f : 1.f;
        const f32x4 olo = (lo * cc - hi * sn) * sc, ohi = (hi * cc + lo * sn) * sc;
        *(f32x4*)(V_CQK + (size_t)row * 512 + hs * 64 + i0) = olo; *(f32x4*)(V_CQK + (size_t)row * 512 + hs * 64 + 32 + i0) = ohi;
    }
}

__device__ __forceinline__ float dot8(const u32x4 q, const u32x4 k) {
    return (bf_lo(q.x) * bf_lo(k.x) + bf_hi(q.x) * bf_hi(k.x)) + (bf_lo(q.y) * bf_lo(k.y) + bf_hi(q.y) * bf_hi(k.y)) + (bf_lo(q.z) * bf_lo(k.z) + bf_hi(q.z) * bf_hi(k.z)) + (bf_lo(q.w) * bf_lo(k.w) + bf_hi(q.w) * bf_hi(k.w));
}
#define WAVE_LDS_SYNC() do { asm volatile("s_waitcnt lgkmcnt(0)" ::: "memory"); __builtin_amdgcn_wave_barrier(); } while (0)
__device__ __forceinline__ void attn_prompt_task(Ctx& F, int row, int h) {
    const int lane = F.lane, t = row & 4095;
    const bf16_t* proj = V_PROJ;
    LAS float* ps = (LAS float*)F.lds + F.wave * 256;
    float mrun = -INFINITY, lsum = 0.f, o0 = 0.f, o1 = 0.f;
#pragma unroll 1
    for (int g = 0; g < 3; ++g) {
        const int sh = 2 * g, nk = min(128, t >> sh) + 1;
        const bf16_t* qrow = proj + (size_t)row * NPROJ + PC_AQ + g * 512 + h * 128;
        u32x4 q[16];
#pragma unroll
        for (int i = 0; i < 16; ++i) q[i] = *(const u32x4*)(qrow + 8 * i);
        WAVE_LDS_SYNC();
#pragma unroll 1
        for (int r = 0; r < 3; ++r) {
            const int jk = r * 64 + lane; const bool valid = jk < nk; const int jj = valid ? jk : 0;
            const bf16_t* krow = proj + (size_t)(row - (jj << sh)) * NPROJ + PC_AK + g * 512 + h * 128;
            float a = 0.f;
#pragma unroll
            for (int i = 0; i < 16; ++i) a += dot8(q[i], *(const u32x4*)(krow + 8 * i));
            ps[jk] = valid ? a * 0.08838834764831845f : -INFINITY;
        }
        WAVE_LDS_SYNC();
        const float s0 = ps[lane], s1 = ps[64 + lane], s2 = ps[128 + lane];
        const float mg = wave_max(fmaxf(fmaxf(s0, s1), s2)), mnew = fmaxf(mrun, mg), alpha = __expf(mrun - mnew);
        const float p0 = __expf(s0 - mnew), p1 = __expf(s1 - mnew), p2 = __expf(s2 - mnew);
        WAVE_LDS_SYNC();
        ps[lane] = p0; ps[64 + lane] = p1; ps[128 + lane] = p2;
        lsum = lsum * alpha + wave_sum(p0 + p1 + p2); o0 *= alpha; o1 *= alpha; mrun = mnew;
        WAVE_LDS_SYNC();
        const bf16_t* vbase = proj + (size_t)row * NPROJ + PC_AV + g * 512 + h * 128 + 2 * lane;
#pragma unroll 4
        for (int jk = 0; jk < nk; ++jk) {
            const float pj = ps[jk];
            const unsigned vv = *(const unsigned*)(vbase - (size_t)(jk << sh) * NPROJ);
            o0 += pj * bf_lo(vv); o1 += pj * bf_hi(vv);
        }
    }
    const float inv = 1.f / lsum;
    *(unsigned*)(V_OABC + (size_t)row * 512 + h * 128 + 2 * lane) = cvt_pk_bf16(o0 * inv, o1 * inv);
}
__device__ __forceinline__ void attn_sample_task(Ctx& F, int l, int bs, int h) {
    const int lane = F.lane, b = bs >> 3, s = bs & 7, row = MP + bs;
    LAS float* ps = (LAS float*)F.lds + F.wave * 256;
    float mrun = -INFINITY, lsum = 0.f, o0 = 0.f, o1 = 0.f;
#pragma unroll 1
    for (int g = 0; g < 3; ++g) {
        const int sh = 2 * g, L = 128 << sh;
        const float* cache = F.in[2 + g] + (size_t)(l * DB + b) * L * 1024;
        const float* newkv = kv_out_ptr(F.out, g, l, true, b, 0);
        const bf16_t* qrow = V_PROJ + (size_t)row * NPROJ + PC_AQ + g * 512 + h * 128;
        u32x4 q[16];
#pragma unroll
        for (int i = 0; i < 16; ++i) q[i] = *(const u32x4*)(qrow + 8 * i);
        WAVE_LDS_SYNC();
#pragma unroll 1
        for (int r = 0; r < 3; ++r) {
            const int jk = r * 64 + lane; const bool valid = jk <= 128; const int jj = valid ? jk : 0;
            const int idx = L + s - (jj << sh);
            const float* krow = (idx < L ? cache + (size_t)idx * 1024 : newkv + (size_t)(idx - L) * 1024) + h * 128;
            float a = 0.f;
#pragma unroll
            for (int i = 0; i < 16; ++i) { const f32x4 k0 = *(const f32x4*)(krow + 8 * i), k1 = *(const f32x4*)(krow + 8 * i + 4); const u32x4 qq = q[i];
                a += (bf_lo(qq.x) * k0[0] + bf_hi(qq.x) * k0[1]) + (bf_lo(qq.y) * k0[2] + bf_hi(qq.y) * k0[3]) + (bf_lo(qq.z) * k1[0] + bf_hi(qq.z) * k1[1]) + (bf_lo(qq.w) * k1[2] + bf_hi(qq.w) * k1[3]);
                if ((i & 3) == 3) asm volatile("" ::: "memory"); }
            ps[jk] = valid ? a * 0.08838834764831845f : -INFINITY;
        }
        WAVE_LDS_SYNC();
        const float s0 = ps[lane], s1 = ps[64 + lane], s2 = ps[128 + lane];
        const float mg = wave_max(fmaxf(fmaxf(s0, s1), s2)), mnew = fmaxf(mrun, mg), alpha = __expf(mrun - mnew);
        const float p0 = __expf(s0 - mnew), p1 = __expf(s1 - mnew), p2 = __expf(s2 - mnew);
        WAVE_LDS_SYNC();
        ps[lane] = p0; ps[64 + lane] = p1; ps[128 + lane] = p2;
        lsum = lsum * alpha + wave_sum(p0 + p1 + p2); o0 *= alpha; o1 *= alpha; mrun = mnew;
        WAVE_LDS_SYNC();
#pragma unroll 4
        for (int jk = 0; jk <= 128; ++jk) {
            const float pj = ps[jk];
            const int idx = L + s - (jk << sh);
            const float* vrow = (idx < L ? cache + (size_t)idx * 1024 : newkv + (size_t)(idx - L) * 1024) + 512 + h * 128 + 2 * lane;
            const f32x2 vv = *(const f32x2*)vrow;
            o0 += pj * vv[0]; o1 += pj * vv[1];
        }
    }
    const float inv = 1.f / lsum;
    *(unsigned*)(V_OABC + (size_t)row * 512 + h * 128 + 2 * lane) = cvt_pk_bf16(o0 * inv, o1 * inv);
}
__device__ __forceinline__ void delta_item(Ctx& F, int l, bool sample, int b, int h) {
    LAS float* sm = (LAS float*)F.lds;
    LAS float* qs = sm, *ks = sm + 2048, *vs = sm + 4096, *bgs = sm + 6144, *pa = sm + 6400, *pb = sm + 6912;
    const int tid = F.tid, c = tid & 127, qr = tid >> 7;
    float s[32];
    if (sample) { const float* S0 = F.in[6] + ((size_t)(l * DB + b) * 4 + h) * 16384;
#pragma unroll
        for (int i = 0; i < 32; ++i) s[i] = S0[(32 * qr + i) * 128 + c]; }
    else {
#pragma unroll
        for (int i = 0; i < 32; ++i) s[i] = 0.f; }
    const int T = sample ? DS : SEQ, row0 = sample ? MP + b * DS : b * SEQ;
    for (int t0 = 0; t0 < T; t0 += 16) {
        const int nt = min(16, T - t0);
        __syncthreads();
#pragma unroll
        for (int r = 0; r < 12; ++r) { const int e = tid + 512 * r, tok = e / 384, w = e - tok * 384, typ = w >> 7, d = w & 127;
            if (tok < nt) sm[typ * 2048 + tok * 128 + d] = V_BQKV[(size_t)(row0 + t0 + tok) * 1536 + typ * 512 + h * 128 + d]; }
        if (tid < 32) { const int tok = tid >> 1, wh = tid & 1; if (tok < nt) bgs[tok * 2 + wh] = V_BG[(size_t)(row0 + t0 + tok) * 8 + wh * 4 + h]; }
        __syncthreads();
        for (int tt = 0; tt < nt; ++tt) {
            const LAS float* kk = ks + tt * 128 + 32 * qr; const LAS float* qq = qs + tt * 128 + 32 * qr;
            float a = 0.f;
#pragma unroll
            for (int i = 0; i < 32; ++i) a += kk[i] * s[i];
            pa[qr * 128 + c] = a;
            __syncthreads();
            const float kS = (pa[c] + pa[128 + c]) + (pa[256 + c] + pa[384 + c]);
            const float e = __expf(bgs[tt * 2 + 1]), be = bgs[tt * 2];
            const float vn = be * (vs[tt * 128 + c] - e * kS);
            float o = 0.f;
#pragma unroll
            for (int i = 0; i < 32; ++i) { s[i] = e * s[i] + kk[i] * vn; o += qq[i] * s[i]; }
            pb[qr * 128 + c] = o;
            __syncthreads();
            if (qr == 0) V_OBR[(size_t)(row0 + t0 + tt) * 512 + h * 128 + c] = (pb[c] + pb[128 + c]) + (pb[256 + c] + pb[384 + c]);
        }
    }
    float* So = F.out + (sample ? O_BSS + ((size_t)(l * DB + b) * 4 + h) * 16384 : O_BSP + ((size_t)(l * BATCH + b) * 4 + h) * 16384);
#pragma unroll
    for (int i = 0; i < 32; ++i) So[(32 * qr + i) * 128 + c] = s[i];
    __syncthreads();
}
__device__ __forceinline__ void ret_item(Ctx& F, int l, bool sample, int b, int h) {
    LAS float* sm = (LAS float*)F.lds;
    LAS float* qs = sm, *ks = sm + 1024, *vs = sm + 2048, *pp = sm + 4096;
    const int tid = F.tid, c = tid & 127, qr = tid >> 7;
    const float gam = 1.f - exp2f(-5.f - (float)h);
    float r[16];
    if (sample) { const float* R0 = F.in[7] + ((size_t)(l * DB + b) * 4 + h) * 8192;
#pragma unroll
        for (int i = 0; i < 16; ++i) r[i] = R0[(16 * qr + i) * 128 + c]; }
    else {
#pragma unroll
        for (int i = 0; i < 16; ++i) r[i] = 0.f; }
    const int T = sample ? DS : SEQ, row0 = sample ? MP + b * DS : b * SEQ;
    for (int t0 = 0; t0 < T; t0 += 16) {
        const int nt = min(16, T - t0);
        __syncthreads();
#pragma unroll
        for (int rr = 0; rr < 4; ++rr) { const int e = tid + 512 * rr, tok = e >> 7, w = e & 127, typ = w >> 6, d = w & 63;
            if (tok < nt) sm[typ * 1024 + tok * 64 + d] = V_CQK[(size_t)(row0 + t0 + tok) * 512 + typ * 256 + h * 64 + d]; }
#pragma unroll
        for (int rr = 0; rr < 4; ++rr) { const int e = tid + 512 * rr, tok = e >> 7, d = e & 127;
            if (tok < nt) vs[tok * 128 + d] = bf1(V_PROJ[(size_t)(row0 + t0 + tok) * NPROJ + PC_CV + h * 128 + d]); }
        __syncthreads();
        for (int tt = 0; tt < nt; ++tt) {
            const LAS float* kk = ks + tt * 64 + 16 * qr; const LAS float* qq = qs + tt * 64 + 16 * qr;
            const float v = vs[tt * 128 + c];
            float o = 0.f;
#pragma unroll
            for (int i = 0; i < 16; ++i) { r[i] = gam * r[i] + kk[i] * v; o += qq[i] * r[i]; }
            LAS float* pq = pp + (tt & 1) * 512;
            pq[qr * 128 + c] = o;
            __syncthreads();
            if (qr == 0) V_OCR[(size_t)(row0 + t0 + tt) * 512 + h * 128 + c] = (pq[c] + pq[128 + c]) + (pq[256 + c] + pq[384 + c]);
        }
    }
    float* Ro = F.out + (sample ? O_CRS + ((size_t)(l * DB + b) * 4 + h) * 8192 : O_CRP + ((size_t)(l * BATCH + b) * 4 + h) * 8192);
#pragma unroll
    for (int i = 0; i < 16; ++i) Ro[(16 * qr + i) * 128 + c] = r[i];
    __syncthreads();
}
constexpr int IT_DP = 0, IT_RP = 16, IT_DS = 32, IT_RS = 160, IT_AT = 288, IT_ATS = IT_AT + MP / 16, IT_END = IT_ATS + MS / 16;
__device__ __forceinline__ void phase_mix(Ctx& F, int l) {
    volatile LAS int* slot = (volatile LAS int*)(F.lds + RING_BYTES);
    unsigned* ctr = V_CTL + (l == 0 ? CW_MIX0 : CW_MIX1);
    for (;;) {
        __syncthreads();
        if (F.tid == 0) *slot = (int)atomicAdd(ctr, 1u);
        __syncthreads();
        const int it = __builtin_amdgcn_readfirstlane(*slot);
        { int t_ = F.tid; asm volatile("" : "+v"(t_)); F.tid = t_; F.lane = t_ & 63; }
        if (it >= IT_END) break;
#ifndef MIXSEL
#define MIXSEL 15
#endif
        if (it < IT_RP) { if (MIXSEL & 1) delta_item(F, l, false, it >> 2, it & 3); }
        else if (it < IT_DS) { if (MIXSEL & 2) ret_item(F, l, false, (it - IT_RP) >> 2, (it - IT_RP) & 3); }
        else if (it < IT_RS) { if (MIXSEL & 1) delta_item(F, l, true, (it - IT_DS) >> 2, (it - IT_DS) & 3); }
        else if (it < IT_AT) { if (MIXSEL & 2) ret_item(F, l, true, (it - IT_RS) >> 2, (it - IT_RS) & 3); }
        else if (!(MIXSEL & 4) && it < IT_ATS) {}
        else if (!(MIXSEL & 8) && it >= IT_ATS) {}
        else if (it < IT_ATS) { const int r0 = (it - IT_AT) * 16;
            for (int k = F.wave; k < 64; k += NWAVES) attn_prompt_task(F, r0 + (k >> 2), k & 3); }
        else { const int r0 = (it - IT_ATS) * 16;
            for (int k = F.wave; k < 64; k += NWAVES) attn_sample_task(F, l, r0 + (k >> 2), k & 3); }
    }
}
__device__ __forceinline__ void fin_row(Ctx& F, int l, int row) {
    const int lane = F.lane;
#pragma unroll 1
    for (int br = 0; br < 2; ++br) {
        const float* src = (br == 0 ? V_OBR : V_OCR) + (size_t)row * 512;
        const float* gn = F.in[15 + br] + l * 128;
        const bf16_t* z = V_PROJ + (size_t)row * NPROJ + (br == 0 ? PC_BZ : PC_CZ);
        bf16_t* dst = V_OABC + (size_t)(1 + br) * M * 512 + (size_t)row * 512;
#pragma unroll
        for (int h = 0; h < 4; ++h) {
            const f32x2 o = *(const f32x2*)(src + h * 128 + 2 * lane);
            const float ss = wave_sum(o[0] * o[0] + o[1] * o[1]);
            const float rstd = rsqrtf(ss * (1.f / 128.f) + EPS);
            const f32x2 g = *(const f32x2*)(gn + 2 * lane);
            const unsigned zz = *(const unsigned*)(z + h * 128 + 2 * lane);
            const float z0 = bf_lo(zz), z1 = bf_hi(zz);
            *(unsigned*)(dst + h * 128 + 2 * lane) = cvt_pk_bf16(o[0] * rstd * g[0] * z0 * sigmoidf_(z0), o[1] * rstd * g[1] * z1 * sigmoidf_(z1));
        }
    }
}

constexpr int N_PHASES = 1 + 8 * DEPTH;
__global__ void __launch_bounds__(NTHREADS, 2) mega_fwd(Args args) {
    extern __shared__ __attribute__((aligned(16))) unsigned char lds_raw[];
    Ctx F;
    F.in = nullptr; F.out = nullptr; F.ws = nullptr; F.tid = 0; F.lane = 0; F.wave = 0;
    F.lds = (LAS unsigned char*)lds_raw;
    F.G = gridDim.x; F.bid = blockIdx.x;
    int ph0 = args.ph_lo;
    if (ph0 == 0) {
        { int tid_ = threadIdx.x; asm volatile("" : "+v"(tid_)); F.tid = tid_; F.lane = tid_ & 63; F.wave = __builtin_amdgcn_readfirstlane(tid_ >> 6);
          const __attribute__((address_space(4))) char* ka = (const __attribute__((address_space(4))) char*)__builtin_amdgcn_kernarg_segment_ptr(); asm volatile("" : "+s"(ka));
          F.in = (const float* const __attribute__((address_space(4)))*)ka; F.out = *(float* const __attribute__((address_space(4)))*)(ka + 192); F.ws = *(unsigned char* const __attribute__((address_space(4)))*)(ka + 200); }
        const int gw = F.bid * NWAVES + F.wave, NGW = F.G * NWAVES;
        if (PH_MASK & 1) phase_prep(F);
        ph0 = 1;
        if (ph0 < args.ph_hi) cg::this_grid().sync();
    }
    for (int ph = ph0; ph < args.ph_hi; ++ph) {
        { int tid_ = threadIdx.x; asm volatile("" : "+v"(tid_)); F.tid = tid_; F.lane = tid_ & 63; F.wave = __builtin_amdgcn_readfirstlane(tid_ >> 6);
          const __attribute__((address_space(4))) char* ka = (const __attribute__((address_space(4))) char*)__builtin_amdgcn_kernarg_segment_ptr(); asm volatile("" : "+s"(ka));
          F.in = (const float* const __attribute__((address_space(4)))*)ka; F.out = *(float* const __attribute__((address_space(4)))*)(ka + 192); F.ws = *(unsigned char* const __attribute__((address_space(4)))*)(ka + 200); }
        const int gw = F.bid * NWAVES + F.wave, NGW = F.G * NWAVES;
        {
            const int l = (ph - 1) >> 3, k = (ph - 1) & 7;
            if (k == 0 && (PH_MASK & 2)) {
                pg8::Gemm g{V_XBA, V_WIN + (size_t)l * NPROJ * D, D}; pg8::Order<1> S; S.init(M / 256, NPROJ / 256, F.G, F.bid);
                EpiProj E{V_PROJ, V_RS + (size_t)(2 * l) * M};
                pg8::gemm_phase(F.lds, F.tid, g, S, E);
            } else if (k == 1 && (PH_MASK & 4)) {
                for (int row = gw; row < M; row += NGW) e1_row(F, l, row);
            } else if (k == 2 && (PH_MASK & 8)) {
                phase_mix(F, l);
            } else if (k == 3 && (PH_MASK & 16)) {
                for (int row = gw; row < M; row += NGW) fin_row(F, l, row);
            } else if (k == 4 && (PH_MASK & 32)) {
                pg8::Gemm g{V_OABC, V_WABC + (size_t)l * 3 * D * 512, 512}; pg8::Order<3> S; S.init(M / 256, D / 256, F.G, F.bid);
                EpiAbc E{V_PROJ, V_MRG};
                pg8::gemm_phase(F.lds, F.tid, g, S, E);
            } else if (k == 5 && (PH_MASK & 64)) {
                pg8::Gemm g{V_MRG, V_WOUT + (size_t)l * D * D, D}; pg8::Order<1> S; S.init(M / 256, D / 256, F.G, F.bid);
                EpiRes E{l == 0 ? F.in[0] : V_X2, l == 0 ? F.in[1] : V_X2 + (size_t)MP * D, V_X1, V_XBB, V_RS + (size_t)(2 * l + 1) * M};
                pg8::gemm_phase(F.lds, F.tid, g, S, E);
            } else if (k == 6 && (PH_MASK & 128)) {
                pg8::Gemm g{V_XBB, V_WFI + (size_t)l * 2 * DFF * D, D}; pg8::Order<1> S; S.init(M / 256, 2 * DFF / 256, F.G, F.bid);
                EpiFfn E{V_ACT, V_RS + (size_t)(2 * l + 1) * M};
                pg8::gemm_phase(F.lds, F.tid, g, S, E);
            } else if (k == 7 && (PH_MASK & 256)) {
                pg8::Gemm g{V_ACT, V_WFO + (size_t)l * D * DFF, DFF}; pg8::Order<1> S; S.init(M / 256, D / 256, F.G, F.bid);
                EpiRes E{V_X1, V_X1 + (size_t)MP * D, l == DEPTH - 1 ? F.out : V_X2, V_XBA, V_RS + (size_t)(l == DEPTH - 1 ? 3 : 2) * M};
                pg8::gemm_phase(F.lds, F.tid, g, S, E);
            }
        }
        if (ph + 1 < args.ph_hi) cg::this_grid().sync();
    }
}

extern "C" void kernel_launch(void* const* d_in, const int* in_sizes, int n_in, void* d_out, int out_size, void* d_ws, size_t ws_size, hipStream_t stream) {
    static int grid = 0;
    if (grid == 0) {
        if (n_in != 24 || (size_t)out_size != O_END || ws_size < WS_END) { fprintf(stderr, "kernel_launch: unexpected shapes (n_in %d out %d ws %zu, need %zu / %zu)\n", n_in, out_size, ws_size, (size_t)O_END, (size_t)WS_END); grid = -1; return; }
        int dev = 0, cus = 0, per_cu = 0;
        if (hipGetDevice(&dev) != hipSuccess || hipDeviceGetAttribute(&cus, hipDeviceAttributeMultiprocessorCount, dev) != hipSuccess) { grid = -1; return; }
        if (hipFuncSetAttribute((const void*)mega_fwd, hipFuncAttributeMaxDynamicSharedMemorySize, LDS_BYTES) != hipSuccess) { fprintf(stderr, "kernel_launch: hipFuncSetAttribute failed\n"); grid = -1; return; }
        if (hipOccupancyMaxActiveBlocksPerMultiprocessor(&per_cu, (const void*)mega_fwd, NTHREADS, LDS_BYTES) != hipSuccess || per_cu < 1) { fprintf(stderr, "kernel_launch: occupancy query says %d\n", per_cu); per_cu = 1; }
        (void)hipGetLastError();
        grid = cus;
    }
    if (grid < 0) return;
    hipMemsetAsync((char*)d_ws + WS_CTL, 0, 4096, stream);
    Args a{};
    for (int i = 0; i < 24; ++i) a.in[i] = (const float*)d_in[i];
    a.out = (float*)d_out; a.ws = (unsigned char*)d_ws;
#if MK_ONE_LAUNCH
    a.ph_lo = 0; a.ph_hi = N_PHASES;
    void* kargs[] = {&a};
    hipError_t e = hipLaunchCooperativeKernel((const void*)mega_fwd, dim3(grid), dim3(NTHREADS), kargs, LDS_BYTES, stream);
    if (e != hipSuccess) fprintf(stderr, "cooperative launch failed: %s (grid %d)\n", hipGetErrorString(e), grid);
#else
    for (int ph = 0; ph < N_PHASES; ++ph) {
        a.ph_lo = ph; a.ph_hi = ph + 1;
        hipLaunchKernelGGL(mega_fwd, dim3(grid), dim3(NTHREADS), LDS_BYTES, stream, a);
    }
#endif
}
```

```cpp
#include <hip/hip_runtime.h>
#include <hip/hip_cooperative_groups.h>
#include <cstdio>
#include <cstdint>
namespace cg = cooperative_groups;

#ifndef DUP_K
#define DUP_K -1
#endif
#ifndef PH_MASK
#define PH_MASK 0x1ff
#endif
#ifndef MK_ONE_LAUNCH
#define MK_ONE_LAUNCH 1
#endif

#define LAS __attribute__((address_space(3)))
typedef unsigned short bf16_t;
typedef short bf16x8 __attribute__((ext_vector_type(8)));
typedef float f32x4 __attribute__((ext_vector_type(4)));
typedef float f32x2 __attribute__((ext_vector_type(2)));
typedef unsigned u32x4 __attribute__((ext_vector_type(4)));
typedef unsigned u32x2 __attribute__((ext_vector_type(2)));

constexpr int D = 1024, BATCH = 4, SEQ = 4096, DEPTH = 2, DB = 32, DS = 8, PAST = 8192;
constexpr int MP = BATCH * SEQ, MS = DB * DS, M = MP + MS;
constexpr int NIN = 11272, NPROJ = 11520, DFF = 2816;
constexpr int PC_AQ = 0, PC_AK = 1536, PC_AV = 3072, PC_BQKV = 4608, PC_BZ = 6144, PC_CQ = 6656, PC_CK = 6912, PC_CV = 7168, PC_CZ = 7680, PC_GATE = 8192, PC_BETA = 11264, PC_BA = 11268;
constexpr float EPS = 1e-6f;
constexpr int NPOS = SEQ + DS;

constexpr size_t O_YP = 0;
constexpr size_t O_YS = O_YP + (size_t)MP * D;
constexpr size_t O_KV0P = O_YS + (size_t)MS * D;
constexpr size_t O_KV1P = O_KV0P + (size_t)DEPTH * BATCH * 128 * 1024;
constexpr size_t O_KV2P = O_KV1P + (size_t)DEPTH * BATCH * 512 * 1024;
constexpr size_t O_BCP = O_KV2P + (size_t)DEPTH * BATCH * 2048 * 1024;
constexpr size_t O_BSP = O_BCP + (size_t)DEPTH * BATCH * 3 * 1536;
constexpr size_t O_CRP = O_BSP + (size_t)DEPTH * BATCH * 4 * 128 * 128;
constexpr size_t O_KV0S = O_CRP + (size_t)DEPTH * BATCH * 4 * 64 * 128;
constexpr size_t O_KV1S = O_KV0S + (size_t)DEPTH * DB * DS * 1024;
constexpr size_t O_KV2S = O_KV1S + (size_t)DEPTH * DB * DS * 1024;
constexpr size_t O_BCS = O_KV2S + (size_t)DEPTH * DB * DS * 1024;
constexpr size_t O_BSS = O_BCS + (size_t)DEPTH * DB * 3 * 1536;
constexpr size_t O_CRS = O_BSS + (size_t)DEPTH * DB * 4 * 128 * 128;
constexpr size_t O_END = O_CRS + (size_t)DEPTH * DB * 4 * 64 * 128;

constexpr size_t al256(size_t x) { return (x + 255) & ~(size_t)255; }
constexpr size_t WS_CTL = 0, CTL_BYTES = 1u << 20;
constexpr size_t WS_WIN = WS_CTL + CTL_BYTES;
constexpr size_t WS_WABC = WS_WIN + al256((size_t)DEPTH * NPROJ * D * 2);
constexpr size_t WS_WOUT = WS_WABC + al256((size_t)DEPTH * 3 * D * 512 * 2);
constexpr size_t WS_WFI = WS_WOUT + al256((size_t)DEPTH * D * D * 2);
constexpr size_t WS_WFO = WS_WFI + al256((size_t)DEPTH * 2 * DFF * D * 2);
constexpr size_t WS_XBA = WS_WFO + al256((size_t)DEPTH * D * DFF * 2);
constexpr size_t WS_XBB = WS_XBA + al256((size_t)M * D * 2);
constexpr size_t WS_X1 = WS_XBB + al256((size_t)M * D * 2);
constexpr size_t WS_X2 = WS_X1 + al256((size_t)M * D * 4);
constexpr size_t WS_RS = WS_X2 + al256((size_t)M * D * 4);
constexpr size_t WS_PROJ = WS_RS + al256((size_t)4 * M * 4);
constexpr size_t WS_BQKV = WS_PROJ + al256((size_t)M * NPROJ * 2);
constexpr size_t WS_BG = WS_BQKV + al256((size_t)M * 1536 * 4);
constexpr size_t WS_CQK = WS_BG + al256((size_t)M * 8 * 4);
constexpr size_t WS_OBR = WS_CQK + al256((size_t)M * 512 * 4);
constexpr size_t WS_OCR = WS_OBR + al256((size_t)M * 512 * 4);
constexpr size_t WS_OABC = WS_OCR + al256((size_t)M * 512 * 4);
constexpr size_t WS_MRG = WS_OABC + al256((size_t)3 * M * 512 * 2);
constexpr size_t WS_ACT = WS_MRG + al256((size_t)M * D * 2);
constexpr size_t WS_ROPEA = WS_ACT + al256((size_t)M * DFF * 2);
constexpr size_t WS_ROPEC = WS_ROPEA + al256((size_t)NPOS * 64 * 2 * 4);
constexpr size_t WS_AO = WS_ROPEC + al256((size_t)NPOS * 32 * 2 * 4);
constexpr size_t WS_LSE = WS_AO + al256((size_t)3 * M * 512 * 2);
constexpr int NCH = BATCH * 4 * 64;
constexpr size_t WS_DW = WS_LSE + al256((size_t)3 * M * 4 * 4);
constexpr size_t WS_DQG = WS_DW + al256((size_t)NCH * 64 * 128 * 2);
constexpr size_t WS_DKT = WS_DQG + al256((size_t)NCH * 64 * 128 * 2);
constexpr size_t WS_DAT = WS_DKT + al256((size_t)NCH * 64 * 128 * 2);
constexpr size_t WS_DU = WS_DAT + al256((size_t)NCH * 64 * 64 * 2);
constexpr size_t WS_DDL = WS_DU + al256((size_t)NCH * 64 * 128 * 4);
constexpr size_t WS_RQG = WS_DDL + al256((size_t)NCH * 4);
constexpr size_t WS_RKT = WS_RQG + al256((size_t)NCH * 64 * 64 * 2);
constexpr size_t WS_RAT = WS_RKT + al256((size_t)NCH * 64 * 64 * 2);
constexpr size_t WS_RU = WS_RAT + al256((size_t)NCH * 64 * 64 * 2);
constexpr size_t WS_SB = WS_RU + al256((size_t)NCH * 64 * 128 * 4);
constexpr size_t WS_VB = WS_SB + al256((size_t)NCH * 16384 * 2);
constexpr size_t WS_END = WS_VB + al256((size_t)NCH * 8192 * 2);
constexpr int CW_MIX0 = 64, CW_MIX1 = 128, CW_BAR = 1024;

constexpr int NWAVES = 8, NTHREADS = 512;
constexpr int RING_BYTES = 131072, LDS_BYTES = 147456;

__device__ __forceinline__ float bf_lo(unsigned u) { return __uint_as_float(u << 16); }
__device__ __forceinline__ float bf_hi(unsigned u) { return __uint_as_float(u & 0xffff0000u); }
__device__ __forceinline__ float bf1(bf16_t u) { return __uint_as_float(((unsigned)u) << 16); }
typedef __bf16 bf16x2_t __attribute__((ext_vector_type(2)));
__device__ __forceinline__ unsigned cvt_pk_bf16(float lo, float hi) { const f32x2 f = {lo, hi}; const bf16x2_t v = __builtin_convertvector(f, bf16x2_t); return __builtin_bit_cast(unsigned, v); }
template <int CTRL> __device__ __forceinline__ float dpp_mov(float v) { return __int_as_float(__builtin_amdgcn_update_dpp(0, __float_as_int(v), CTRL, 0xf, 0xf, true)); }
__device__ __forceinline__ float rdlane(float v, int l) { return __int_as_float(__builtin_amdgcn_readlane(__float_as_int(v), l)); }
__device__ __forceinline__ float row_sum16(float v) { v += dpp_mov<0xB1>(v); v += dpp_mov<0x4E>(v); v += dpp_mov<0x141>(v); v += dpp_mov<0x140>(v); return v; }
__device__ __forceinline__ float row_max16(float v) { v = fmaxf(v, dpp_mov<0xB1>(v)); v = fmaxf(v, dpp_mov<0x4E>(v)); v = fmaxf(v, dpp_mov<0x141>(v)); v = fmaxf(v, dpp_mov<0x140>(v)); return v; }
__device__ __forceinline__ float wave_sum(float v) { v = row_sum16(v); return (rdlane(v, 0) + rdlane(v, 16)) + (rdlane(v, 32) + rdlane(v, 48)); }
__device__ __forceinline__ float wave_max(float v) { v = row_max16(v); return fmaxf(fmaxf(rdlane(v, 0), rdlane(v, 16)), fmaxf(rdlane(v, 32), rdlane(v, 48))); }
__device__ __forceinline__ float half_sum(float v) { v = row_sum16(v); return v + __shfl_xor(v, 16); }
__device__ __forceinline__ float sigmoidf_(float x) { return __builtin_amdgcn_rcpf(1.f + __expf(-x)); }

namespace pg8 {
constexpr int BM = 256, BK = 64, HALF = 128, HTB = HALF * BK * 2, NXCD = 8, WGM = 2;
__host__ __device__ __forceinline__ int lds_byte(int r, int c) { const int st = (r >> 4) * 2 + (c >> 5), rr = r & 15, cc = c & 31, ob = rr * 64 + cc * 2; return st * 1024 + (ob ^ (((ob >> 9) & 1) << 5)); }
__host__ __device__ __forceinline__ void stage_rc(int b, int& R, int& C) { const int st = b / 1024, sb = b % 1024, swz = sb ^ (((sb >> 9) & 1) << 5); R = (st >> 1) * 16 + swz / 64; C = (st & 1) * 32 + (swz % 64) / 2; }
__host__ __device__ __forceinline__ int perm32(int rho) { const int n = rho >> 4, i = rho & 15; return 8 * (i >> 2) + 4 * n + (i & 3); }

struct Unit { int pm, pn; };
struct Gemm { const bf16_t* A; const bf16_t* Bt; int K; };

template <int TRIP> struct Order {
    int nM, nN, nwg, G, c, sub_m;
    __device__ void init(int nM_, int nN_, int G_, int c_) { nM = nM_; nN = nN_; nwg = nM * nN; G = G_; c = c_; sub_m = nM_; }
    __device__ bool next(int i, Unit& u) const {
        const int ii = i / TRIP, sub = i - ii * TRIP;
        const long L = (long)ii * G + c; if (L >= nwg) return false;
        int wgid = (int)L; { const int q = nwg / NXCD, r = nwg % NXCD, xcd = wgid % NXCD, off = wgid / NXCD; wgid = (xcd < r ? xcd * (q + 1) : r * (q + 1) + (xcd - r) * q) + off; }
        const int nig = WGM * nN, gid = wgid / nig, fm = gid * WGM, gsz = (nM - fm) < WGM ? (nM - fm) : WGM;
        u.pm = fm + ((wgid % nig) % gsz) + sub * sub_m; u.pn = (wgid % nig) / gsz + sub * nN; return true;
    }
};

template <class Epi, class Sched>
__device__ __forceinline__ void gemm_phase(LAS unsigned char* lds, const int tid, const Gemm g, const Sched& S, const Epi& E) {
    const int wid = __builtin_amdgcn_readfirstlane(tid >> 6), lane = tid & 63, wr = wid >> 2, wc = wid & 3, fr = lane & 15, fq = lane >> 4;
    const int K = g.K, nt = K / BK;
    unsigned voffA[2], voffB[2];
#pragma unroll
    for (int i = 0; i < 2; ++i) { int R, C; stage_rc(tid * 16 + i * 8192, R, C); const int Rb = Epi::PERM ? ((R & ~31) + perm32(R & 31)) : R;
        voffA[i] = (unsigned)(R * K + C) * 2u; voffB[i] = (unsigned)(Rb * K + C) * 2u; }
    const size_t kstep = (size_t)(BK * 2);
    const size_t hstep = (size_t)HALF * K * 2;
    const size_t tstep = 2 * hstep;
    const unsigned ldsw = (unsigned)wid * 1024u;
    const int aoff = lds_byte(wr * 64 + fr, fq * 8), boff = lds_byte(wc * 32 + fr, fq * 8);
#define PG8_SA(b, h) (((b) * 2 + (h)) * HTB)
#define PG8_SB(b, h) ((4 + (b) * 2 + (h)) * HTB)
#define PG8_STAGE(bufoff, gbase, voff) do { _Pragma("unroll") for (int _i = 0; _i < 2; ++_i) \
        __builtin_amdgcn_global_load_lds((const unsigned*)((const char*)(gbase) + (voff)[_i]), (LAS unsigned*)(lds + (bufoff) + ldsw + _i * 8192), 16, 0, 0); } while (0)
#define PG8_LDA(dst, b, h) do { _Pragma("unroll") for (int m = 0; m < 4; ++m) _Pragma("unroll") for (int k = 0; k < 2; ++k) dst[m][k] = *(const LAS bf16x8*)(lds + PG8_SA(b, h) + aoff + m * 2048 + k * 1024); } while (0)
#define PG8_LDB(dst, b, h) do { _Pragma("unroll") for (int n = 0; n < 2; ++n) _Pragma("unroll") for (int k = 0; k < 2; ++k) dst[n][k] = *(const LAS bf16x8*)(lds + PG8_SB(b, h) + boff + n * 2048 + k * 1024); } while (0)
#define PG8_MMA(ai, bj, At, Bt) do { __builtin_amdgcn_s_setprio(1); _Pragma("unroll") for (int m = 0; m < 4; ++m) _Pragma("unroll") for (int n = 0; n < 2; ++n) _Pragma("unroll") for (int k = 0; k < 2; ++k) \
        acc[ai][bj][m][n] = __builtin_amdgcn_mfma_f32_16x16x32_bf16(Bt[n][k], At[m][k], acc[ai][bj][m][n], 0, 0, 0); __builtin_amdgcn_s_setprio(0); } while (0)
#define PG8_WAIT_V(n) asm volatile("s_waitcnt vmcnt(" #n ")" ::: "memory")
#define PG8_WAIT_L(n) asm volatile("s_waitcnt lgkmcnt(" #n ")" ::: "memory")
#define PG8_BAR __builtin_amdgcn_s_barrier()
#define PG8_SCHED __builtin_amdgcn_sched_barrier(0)
    Unit cur, nxt; int ui = 0;
    if (!S.next(0, cur)) return;
    f32x4 acc[2][2][4][2];
#pragma unroll
    for (int a = 0; a < 2; ++a)
#pragma unroll
        for (int b = 0; b < 2; ++b)
#pragma unroll
            for (int m = 0; m < 4; ++m)
#pragma unroll
                for (int n = 0; n < 2; ++n) acc[a][b][m][n] = (f32x4){0.f, 0.f, 0.f, 0.f};
    bf16x8 At[4][2], B0[2][2], B1[2][2];
    const char* cA = (const char*)g.A + (size_t)cur.pm * tstep; const char* cB = (const char*)g.Bt + (size_t)cur.pn * tstep;
    PG8_STAGE(PG8_SB(0, 0), cB, voffB); PG8_STAGE(PG8_SB(0, 1), cB + hstep, voffB); PG8_STAGE(PG8_SA(0, 0), cA, voffA); PG8_STAGE(PG8_SA(0, 1), cA + hstep, voffA);
    if (wr == 1) PG8_BAR;
    PG8_WAIT_V(2); PG8_BAR;
    PG8_STAGE(PG8_SB(1, 0), cB + kstep, voffB); PG8_STAGE(PG8_SA(1, 0), cA + kstep, voffA); PG8_STAGE(PG8_SB(1, 1), cB + hstep + kstep, voffB);
    PG8_WAIT_V(6); PG8_BAR;
    for (;;) {
        const bool has_next = S.next(ui + 1, nxt);
        const char* nA = has_next ? (const char*)g.A + (size_t)nxt.pm * tstep : cA; const char* nB = has_next ? (const char*)g.Bt + (size_t)nxt.pn * tstep : cB;
        for (int t = 0; t < nt; t += 2) {
            const bool last = (t == nt - 2);
            const char* a1 = cA + (size_t)(t + 1) * kstep;
            const char* a2 = last ? nA : cA + (size_t)(t + 2) * kstep; const char* b2 = last ? nB : cB + (size_t)(t + 2) * kstep;
            const char* a3 = a2 + kstep; const char* b3 = b2 + kstep;
            PG8_LDB(B0, 0, 0); PG8_LDB(B1, 0, 1); PG8_SCHED; PG8_LDA(At, 0, 0); PG8_STAGE(PG8_SA(1, 1), a1 + hstep, voffA);
            PG8_WAIT_V(8); PG8_WAIT_L(0); PG8_BAR; PG8_MMA(0, 0, At, B0); PG8_MMA(0, 1, At, B1); PG8_BAR; PG8_SCHED;
            PG8_LDA(At, 0, 1); PG8_STAGE(PG8_SB(0, 0), b2, voffB); PG8_STAGE(PG8_SB(0, 1), b2 + hstep, voffB); PG8_STAGE(PG8_SA(0, 0), a2, voffA);
            PG8_WAIT_V(8); PG8_WAIT_L(0); PG8_BAR; PG8_MMA(1, 0, At, B0); PG8_MMA(1, 1, At, B1); PG8_BAR; PG8_SCHED;
            PG8_LDB(B0, 1, 0); PG8_LDB(B1, 1, 1); PG8_SCHED; PG8_LDA(At, 1, 0); PG8_STAGE(PG8_SA(0, 1), a2 + hstep, voffA);
            PG8_WAIT_V(8); PG8_WAIT_L(0); PG8_BAR; PG8_MMA(0, 0, At, B0); PG8_MMA(0, 1, At, B1); PG8_BAR; PG8_SCHED;
            PG8_LDA(At, 1, 1); PG8_STAGE(PG8_SB(1, 0), b3, voffB); PG8_STAGE(PG8_SB(1, 1), b3 + hstep, voffB); PG8_STAGE(PG8_SA(1, 0), a3, voffA);
            PG8_WAIT_V(8); PG8_WAIT_L(0); PG8_BAR; PG8_MMA(1, 0, At, B0); PG8_MMA(1, 1, At, B1); PG8_BAR; PG8_SCHED;
        }
        if (wr == 0) PG8_BAR;
        E(acc, cur, wr, wc, fr, fq);
        if (!has_next) break;
        if (E.reset_after(cur)) {
#pragma unroll
            for (int a = 0; a < 2; ++a)
#pragma unroll
                for (int b = 0; b < 2; ++b)
#pragma unroll
                    for (int m = 0; m < 4; ++m)
#pragma unroll
                        for (int n = 0; n < 2; ++n) acc[a][b][m][n] = (f32x4){0.f, 0.f, 0.f, 0.f};
        }
        cur = nxt; cA = nA; cB = nB; ++ui;
        if (wr == 1) PG8_BAR;
    }
    PG8_WAIT_V(0);
    PG8_BAR;
#undef PG8_SA
#undef PG8_SB
#undef PG8_STAGE
#undef PG8_LDA
#undef PG8_LDB
#undef PG8_MMA
#undef PG8_WAIT_V
#undef PG8_WAIT_L
#undef PG8_BAR
#undef PG8_SCHED
}
}
using pg8::Unit;

struct EpiProj {
    static constexpr bool PERM = true;
    bf16_t* O; const float* rowss;
    __device__ __forceinline__ bool reset_after(const Unit&) const { return true; }
    __device__ __forceinline__ void operator()(f32x4 (&acc)[2][2][4][2], const Unit& u, int wr, int wc, int fr, int fq) const {
        const int row0 = u.pm * 256 + wr * 64 + fr, col0 = u.pn * 256 + wc * 32 + 8 * fq;
        const bool gate = (u.pn >= 32 && u.pn < 44);
#pragma unroll
        for (int ai = 0; ai < 2; ++ai)
#pragma unroll
            for (int m = 0; m < 4; ++m) {
                const int row = row0 + ai * 128 + m * 16;
                const float rs = rsqrtf(rowss[row] * (1.f / 1024.f) + EPS);
                bf16_t* rowp = O + (size_t)row * NPROJ + col0;
#pragma unroll
                for (int bj = 0; bj < 2; ++bj) {
                    f32x4 v0 = acc[ai][bj][m][0] * rs, v1 = acc[ai][bj][m][1] * rs;
                    if (gate) {
#pragma unroll
                        for (int j = 0; j < 4; ++j) { v0[j] = sigmoidf_(v0[j]); v1[j] = sigmoidf_(v1[j]); }
                    }
                    u32x4 w; w.x = cvt_pk_bf16(v0[0], v0[1]); w.y = cvt_pk_bf16(v0[2], v0[3]); w.z = cvt_pk_bf16(v1[0], v1[1]); w.w = cvt_pk_bf16(v1[2], v1[3]);
                    *(u32x4*)(rowp + bj * 128) = w;
                }
            }
    }
};
struct EpiAbc {
    static constexpr bool PERM = true;
    const bf16_t* G; bf16_t* O;
    __device__ __forceinline__ bool reset_after(const Unit& u) const { return (u.pn >> 2) == 2; }
    __device__ __forceinline__ void operator()(f32x4 (&acc)[2][2][4][2], const Unit& u, int wr, int wc, int fr, int fq) const {
        const int sub = u.pn >> 2, pn = u.pn & 3, pm = u.pm - sub * 65;
        const int row0 = pm * 256 + wr * 64 + fr, col0 = pn * 256 + wc * 32 + 8 * fq;
#pragma unroll
        for (int ai = 0; ai < 2; ++ai)
#pragma unroll
            for (int m = 0; m < 4; ++m) {
                const int row = row0 + ai * 128 + m * 16;
                const bf16_t* gp = G + (size_t)row * NPROJ + PC_GATE + sub * 1024 + col0;
#pragma unroll
                for (int bj = 0; bj < 2; ++bj) {
                    const u32x4 ga = *(const u32x4*)(gp + bj * 128);
                    f32x4 g0 = (f32x4){bf_lo(ga.x), bf_hi(ga.x), bf_lo(ga.y), bf_hi(ga.y)}, g1 = (f32x4){bf_lo(ga.z), bf_hi(ga.z), bf_lo(ga.w), bf_hi(ga.w)};
                    if (sub < 2) {
                        const u32x4 gb = *(const u32x4*)(gp + 1024 + bj * 128);
                        const f32x4 h0 = (f32x4){bf_lo(gb.x), bf_hi(gb.x), bf_lo(gb.y), bf_hi(gb.y)}, h1 = (f32x4){bf_lo(gb.z), bf_hi(gb.z), bf_lo(gb.w), bf_hi(gb.w)};
#pragma unroll
                        for (int j = 0; j < 4; ++j) { acc[ai][bj][m][0][j] *= g0[j] * __builtin_amdgcn_rcpf(fmaxf(h0[j], 1e-30f)); acc[ai][bj][m][1][j] *= g1[j] * __builtin_amdgcn_rcpf(fmaxf(h1[j], 1e-30f)); }
                    } else {
                        const f32x4 v0 = acc[ai][bj][m][0] * g0, v1 = acc[ai][bj][m][1] * g1;
                        u32x4 w; w.x = cvt_pk_bf16(v0[0], v0[1]); w.y = cvt_pk_bf16(v0[2], v0[3]); w.z = cvt_pk_bf16(v1[0], v1[1]); w.w = cvt_pk_bf16(v1[2], v1[3]);
                        *(u32x4*)(O + (size_t)row * D + col0 + bj * 128) = w;
                    }
                }
            }
    }
};
struct EpiRes {
    static constexpr bool PERM = false;
    const float* res0; const float* res1; const bf16_t* resb; float* out; bf16_t* xb; float* rowss;
    __device__ __forceinline__ bool reset_after(const Unit&) const { return true; }
    __device__ __forceinline__ void operator()(f32x4 (&acc)[2][2][4][2], const Unit& u, int wr, int wc, int fr, int fq) const {
        const int col0 = u.pn * 256 + wc * 32 + 4 * fq;
        const float* rbase = (u.pm < 64) ? res0 + (size_t)u.pm * 256 * D : res1;
#pragma unroll
        for (int ai = 0; ai < 2; ++ai)
#pragma unroll
            for (int m = 0; m < 4; ++m) {
                const int lrow = ai * 128 + wr * 64 + m * 16 + fr; const size_t grow = (size_t)u.pm * 256 + lrow;
                float ss = 0.f;
#pragma unroll
                for (int bj = 0; bj < 2; ++bj)
#pragma unroll
                    for (int n = 0; n < 2; ++n) {
                        const int c = col0 + bj * 128 + n * 16;
                        f32x4 r4;
                        if (resb) { const u32x2 rb = *(const u32x2*)(resb + grow * D + c); r4 = (f32x4){bf_lo(rb.x), bf_hi(rb.x), bf_lo(rb.y), bf_hi(rb.y)}; }
                        else r4 = *(const f32x4*)(rbase + (size_t)lrow * D + c);
                        const f32x4 o = r4 + acc[ai][bj][m][n];
                        if (out) *(f32x4*)(out + grow * D + c) = o;
                        else { u32x2 w; w.x = cvt_pk_bf16(o[0], o[1]); w.y = cvt_pk_bf16(o[2], o[3]); *(u32x2*)(xb + grow * D + c) = w; }
                        ss += (o[0] * o[0] + o[1] * o[1]) + (o[2] * o[2] + o[3] * o[3]);
                    }
                ss += __shfl_xor(ss, 16); ss += __shfl_xor(ss, 32);
                if (fq == 0) atomicAdd(rowss + grow, ss);
                asm volatile("" ::: "memory");
            }
    }
};
struct EpiFfn {
    static constexpr bool PERM = true;
    bf16_t* O; const float* rowss;
    __device__ __forceinline__ bool reset_after(const Unit&) const { return true; }
    __device__ __forceinline__ void operator()(f32x4 (&acc)[2][2][4][2], const Unit& u, int wr, int wc, int fr, int fq) const {
        const int row0 = u.pm * 256 + wr * 64 + fr, f0 = u.pn * 128 + 16 * wc + 4 * fq;
#pragma unroll
        for (int ai = 0; ai < 2; ++ai)
#pragma unroll
            for (int m = 0; m < 4; ++m) {
                const int row = row0 + ai * 128 + m * 16;
                const float rs = rsqrtf(rowss[row] * (1.f / 1024.f) + EPS);
#pragma unroll
                for (int bj = 0; bj < 2; ++bj) {
                    const f32x4 gg = acc[ai][bj][m][0] * rs, uu = acc[ai][bj][m][1] * rs;
                    f32x4 hh;
#pragma unroll
                    for (int j = 0; j < 4; ++j) hh[j] = gg[j] * sigmoidf_(gg[j]) * uu[j];
                    u32x2 w; w.x = cvt_pk_bf16(hh[0], hh[1]); w.y = cvt_pk_bf16(hh[2], hh[3]);
                    *(u32x2*)(O + (size_t)row * DFF + f0 + bj * 64) = w;
                }
            }
    }
};

#define XB_TMO      128
#define XB_XCNT(j)  (256  + 64 * (j))
#define XB_XSUB(j)  (1280 + 64 * (j))
#define XB_XGEN(j)  (2304 + 64 * (j))
#define XB_TOP      3328
#define XB_TOPGEN   3392
#define XCD_BAR_WORDS 3456
#define XB_SPIN_CAP (1u << 18)

__device__ __forceinline__ unsigned xb_ld(unsigned* p)              { return __hip_atomic_load(p, __ATOMIC_RELAXED, __HIP_MEMORY_SCOPE_AGENT); }
__device__ __forceinline__ unsigned xb_add(unsigned* p, unsigned v) { return __hip_atomic_fetch_add(p, v, __ATOMIC_RELAXED, __HIP_MEMORY_SCOPE_AGENT); }
__device__ __forceinline__ unsigned xb_xcc_id() { return (unsigned)__builtin_amdgcn_s_getreg((3 << 11) | 20) & 0xFu; }
#define XB_SPIN(cond, bar) do { unsigned _sp = 0; while (cond) { __builtin_amdgcn_s_sleep(1); \
    if ((++_sp & 255u) == 0u) { if (xb_ld(&(bar)[XB_TMO])) break; if (_sp > XB_SPIN_CAP) { atomicAdd(&(bar)[XB_TMO], 1u); break; } } } } while (0)

struct XcdBarrier {
    unsigned* bar; unsigned x;
    volatile LAS unsigned* st;
};

__device__ __forceinline__ XcdBarrier xcd_barrier_post(unsigned* bar, volatile LAS unsigned* st) {
    XcdBarrier b; b.bar = bar; b.x = xb_xcc_id(); b.st = st;
    if (threadIdx.x == 0) (void)xb_add(&bar[XB_XCNT(b.x)], 1u);
    return b;
}
__device__ __forceinline__ void xcd_barrier_complete(unsigned* bar, unsigned x, unsigned& nloc, unsigned& nx) {
    const unsigned G = gridDim.x * gridDim.y * gridDim.z;
    unsigned sum, cnt, mine, sp = 0u;
    for (;;) {
        sum = 0u; cnt = 0u; mine = 0u;
#pragma unroll
        for (unsigned j = 0; j < 16; ++j) { const unsigned c = xb_ld(&bar[XB_XCNT(j)]); sum += c; cnt += (c > 0u) ? 1u : 0u; mine = (j == x) ? c : mine; }
        if (sum == G) break;
        __builtin_amdgcn_s_sleep(1);
        if ((++sp & 255u) == 0u) { if (xb_ld(&bar[XB_TMO])) break; if (sp > XB_SPIN_CAP) { atomicAdd(&bar[XB_TMO], 1u); break; } }
    }
    nloc = mine > 0u ? mine : 1u; nx = cnt > 0u ? cnt : 1u;
}

__device__ __forceinline__ void xcd_barrier(const XcdBarrier& b) {
    asm volatile("s_waitcnt vmcnt(0)" ::: "memory");
    __syncthreads();
    if (threadIdx.x == 0) {
        unsigned* bar = b.bar;
        __builtin_amdgcn_s_waitcnt(0);
        unsigned nloc = b.st[0], nx = b.st[1];
        if (nloc == 0u) { xcd_barrier_complete(bar, b.x, nloc, nx); b.st[0] = nloc; b.st[1] = nx; }
        const unsigned old = xb_add(&bar[XB_XSUB(b.x)], 1u);
        const unsigned gen = old / nloc;
        if (old + 1u == (gen + 1u) * nloc) {
            __builtin_amdgcn_fence(__ATOMIC_RELEASE, "agent");
            asm volatile("s_waitcnt vmcnt(0)" ::: "memory");
            const unsigned og = xb_add(&bar[XB_TOP], 1u);
            const unsigned tg = og / nx;
            if (og + 1u == (tg + 1u) * nx) xb_add(&bar[XB_TOPGEN], 1u);
            else XB_SPIN(xb_ld(&bar[XB_TOPGEN]) == tg, bar);
            __builtin_amdgcn_fence(__ATOMIC_ACQUIRE, "agent");
            xb_add(&bar[XB_XGEN(b.x)], 1u);
            asm volatile("s_waitcnt vmcnt(0)" ::: "memory");
        } else {
            XB_SPIN(xb_ld(&bar[XB_XGEN(b.x)]) == gen, bar);
            __builtin_amdgcn_fence(__ATOMIC_ACQUIRE, "agent");
            asm volatile("s_waitcnt vmcnt(0)" ::: "memory");
        }
    }
    __syncthreads();
}


struct Args { const float* in[24]; float* out; unsigned char* ws; int ph_lo, ph_hi; };
static_assert(sizeof(Args) == 216, "Args layout");
struct Ctx {
    const float* const __attribute__((address_space(4)))* in; float* out; unsigned char* ws;
    LAS unsigned char* lds; int tid, lane, wave, G, bid;
};
#define WSV(T, off) ((T*)(F.ws + (off)))
#define V_WIN WSV(bf16_t, WS_WIN)
#define V_WABC WSV(bf16_t, WS_WABC)
#define V_WOUT WSV(bf16_t, WS_WOUT)
#define V_WFI WSV(bf16_t, WS_WFI)
#define V_WFO WSV(bf16_t, WS_WFO)
#define V_XBA WSV(bf16_t, WS_XBA)
#define V_XBB WSV(bf16_t, WS_XBB)
#define V_PROJ WSV(bf16_t, WS_PROJ)
#define V_OABC WSV(bf16_t, WS_OABC)
#define V_MRG WSV(bf16_t, WS_MRG)
#define V_ACT WSV(bf16_t, WS_ACT)
#define V_X1 WSV(float, WS_X1)
#define V_X2 WSV(float, WS_X2)
#define V_RS WSV(float, WS_RS)
#define V_BQKV WSV(float, WS_BQKV)
#define V_BG WSV(float, WS_BG)
#define V_CQK WSV(float, WS_CQK)
#define V_OBR WSV(float, WS_OBR)
#define V_OCR WSV(float, WS_OCR)
#define V_ROPEA WSV(float, WS_ROPEA)
#define V_ROPEC WSV(float, WS_ROPEC)
#define V_CTL WSV(unsigned, WS_CTL)
#define V_AO WSV(bf16_t, WS_AO)
#define V_LSE WSV(float, WS_LSE)
#define V_DW WSV(bf16_t, WS_DW)
#define V_DQG WSV(bf16_t, WS_DQG)
#define V_DKT WSV(bf16_t, WS_DKT)
#define V_DAT WSV(bf16_t, WS_DAT)
#define V_DU WSV(float, WS_DU)
#define V_DDL WSV(float, WS_DDL)
#define V_RQG WSV(bf16_t, WS_RQG)
#define V_RKT WSV(bf16_t, WS_RKT)
#define V_RAT WSV(bf16_t, WS_RAT)
#define V_RU WSV(float, WS_RU)
#define V_SB WSV(bf16_t, WS_SB)
#define V_VB WSV(bf16_t, WS_VB)

__device__ __forceinline__ int src_col(int mode, int n) {
    if (mode == 1) { if (n < 6656) return n; if (n < 11264) return n + 8; if (n < 11272) return n - 11264 + 6656; return -1; }
    if (mode == 2) { const int pn = n >> 8, c = n & 255; const int f = pn * 128 + (c >> 3) * 4 + (c & 3); return ((c >> 2) & 1) * DFF + f; }
    return n;
}
__device__ __forceinline__ void transpose_item(const float* W, int K, int N, int nblk, bf16_t* WT, const float* kscale, int mode, LAS float* scr, int item, int lane) {
    const int kb = item / nblk, nb = item - kb * nblk, k0 = 32 * kb, n0 = 128 * nb;
    const int sc = src_col(mode, n0 + 4 * (lane & 31));
    f32x4 v[16];
#pragma unroll
    for (int i = 0; i < 16; ++i) { const int kk = 2 * i + (lane >> 5);
        v[i] = (f32x4){0.f, 0.f, 0.f, 0.f};
        if (sc >= 0) { v[i] = *(const f32x4*)(W + (size_t)(k0 + kk) * N + sc); if (kscale) v[i] *= kscale[k0 + kk]; } }
#pragma unroll
    for (int i = 0; i < 16; ++i) { const int kk = 2 * i + (lane >> 5); *(LAS f32x4*)(scr + kk * 132 + 4 * (lane & 31)) = v[i]; }
    asm volatile("s_waitcnt lgkmcnt(0)" ::: "memory");
#pragma unroll
    for (int h2 = 0; h2 < 2; ++h2) { const int n = lane + 64 * h2; const LAS float* sp = scr + n;
        bf16_t* dst = WT + (size_t)(n0 + n) * K + k0;
#pragma unroll
        for (int q = 0; q < 4; ++q) { u32x4 o; o.x = cvt_pk_bf16(sp[(8 * q + 0) * 132], sp[(8 * q + 1) * 132]); o.y = cvt_pk_bf16(sp[(8 * q + 2) * 132], sp[(8 * q + 3) * 132]);
            o.z = cvt_pk_bf16(sp[(8 * q + 4) * 132], sp[(8 * q + 5) * 132]); o.w = cvt_pk_bf16(sp[(8 * q + 6) * 132], sp[(8 * q + 7) * 132]); *(u32x4*)(dst + 8 * q) = o; } }
    asm volatile("s_waitcnt lgkmcnt(0)" ::: "memory");
}
__device__ __forceinline__ void phase_prep(Ctx& F) {
    LAS float* scr = (LAS float*)(F.lds + F.wave * 16896);
    const int gw = F.bid * NWAVES + F.wave, NGW = F.G * NWAVES, lane = F.lane;
    constexpr int I_IN = 32 * (NPROJ / 128), I_ABC = 16 * 8, I_OUT = 32 * 8, I_FI = 32 * (2 * DFF / 128), I_FO = (DFF / 32) * 8;
    constexpr int I_LAYER = I_IN + 3 * I_ABC + I_OUT + I_FI + I_FO;
    for (int it = gw; it < DEPTH * I_LAYER; it += NGW) {
        const int l = it / I_LAYER; int r = it - l * I_LAYER;
        const float* W; const float* ksc = nullptr; bf16_t* WT; int K = D, N = D, nblk = D / 128, mode = 0;
        if (r < I_IN) { W = F.in[9] + (size_t)l * D * NIN; N = NIN; nblk = NPROJ / 128; WT = V_WIN + (size_t)l * NPROJ * D; ksc = F.in[8] + l * D; mode = 1; }
        else if ((r -= I_IN) < 3 * I_ABC) { const int i = r / I_ABC; r -= i * I_ABC; W = F.in[17 + i] + (size_t)l * 512 * D; K = 512; WT = V_WABC + (size_t)(l * 3 + i) * D * 512; }
        else if ((r -= 3 * I_ABC) < I_OUT) { W = F.in[20] + (size_t)l * D * D; WT = V_WOUT + (size_t)l * D * D; }
        else if ((r -= I_OUT) < I_FI) { W = F.in[22] + (size_t)l * D * 2 * DFF; N = 2 * DFF; nblk = 2 * DFF / 128; WT = V_WFI + (size_t)l * 2 * DFF * D; ksc = F.in[21] + l * D; mode = 2; }
        else { r -= I_FI; W = F.in[23] + (size_t)l * DFF * D; K = DFF; WT = V_WFO + (size_t)l * D * DFF; }
        transpose_item(W, K, N, nblk, WT, ksc, mode, scr, r, lane);
    }
    for (int row0 = gw; row0 < M; row0 += 4 * NGW) {
        f32x4 v[4][4];
#pragma unroll
        for (int r = 0; r < 4; ++r) { const int row = row0 + r * NGW;
            if (row < M) { const float* src = row < MP ? F.in[0] + (size_t)row * D : F.in[1] + (size_t)(row - MP) * D;
#pragma unroll
                for (int j = 0; j < 4; ++j) v[r][j] = *(const f32x4*)(src + 4 * lane + 256 * j); } }
#pragma unroll
        for (int r = 0; r < 4; ++r) { const int row = row0 + r * NGW;
            if (row < M) { float ss = 0.f;
#pragma unroll
                for (int j = 0; j < 4; ++j) ss += (v[r][j][0] * v[r][j][0] + v[r][j][1] * v[r][j][1]) + (v[r][j][2] * v[r][j][2] + v[r][j][3] * v[r][j][3]);
                ss = wave_sum(ss);
                if (lane == 0) V_RS[row] = ss;
#pragma unroll
                for (int j = 0; j < 4; ++j) { u32x2 w; w.x = cvt_pk_bf16(v[r][j][0], v[r][j][1]); w.y = cvt_pk_bf16(v[r][j][2], v[r][j][3]); *(u32x2*)(V_XBA + (size_t)row * D + 4 * lane + 256 * j) = w; } } }
    }
    const int gt = F.bid * NTHREADS + F.tid, NGT = F.G * NTHREADS;
    for (int i = gt; i < 3 * M; i += NGT) V_RS[M + i] = 0.f;
    for (int e = gt; e < NPOS * 64; e += NGT) { const int pi = e >> 6, i = e & 63; const double pos = pi < SEQ ? (double)pi : (double)(PAST + pi - SEQ);
        const double inv = exp(-(double)i * (9.210340371976184 / 64.0)); double sn, cs; sincos(pos * inv, &sn, &cs); V_ROPEA[2 * e] = (float)cs; V_ROPEA[2 * e + 1] = (float)sn; }
    for (int e = gt; e < NPOS * 32; e += NGT) { const int pi = e >> 5, i = e & 31; const double pos = pi < SEQ ? (double)pi : (double)(PAST + pi - SEQ);
        const double inv = exp(-(double)i * (9.210340371976184 / 32.0)); double sn, cs; sincos(pos * inv, &sn, &cs); V_ROPEC[2 * e] = (float)cs; V_ROPEC[2 * e + 1] = (float)sn; }
}

__device__ __forceinline__ float* kv_out_ptr(float* out, int g, int l, bool sample, int b, int tt) {
    if (sample) { const size_t base = g == 0 ? O_KV0S : (g == 1 ? O_KV1S : O_KV2S); return out + base + ((size_t)(l * DB + b) * DS + tt) * 1024; }
    const int keep = 128 << (2 * g); const size_t base = g == 0 ? O_KV0P : (g == 1 ? O_KV1P : O_KV2P);
    return out + base + ((size_t)(l * BATCH + b) * keep + tt) * 1024;
}
template <int NR>
__device__ __forceinline__ void e1_partA(Ctx& F, int l, const int (&rows)[NR], bool store_qk) {
    const int lane = F.lane, jj = lane & 15, hq = lane >> 4;
    u32x2 xlo[NR][6], xhi[NR][6]; f32x4 cc[NR], sn[NR]; unsigned vv[NR][12];
    bool sample[NR]; int bb[NR], tt0[NR];
#pragma unroll
    for (int r = 0; r < NR; ++r) {
        const int row = rows[r];
        sample[r] = row >= MP; bb[r] = sample[r] ? (row - MP) >> 3 : row >> 12; tt0[r] = sample[r] ? (row - MP) & 7 : row & 4095;
        const int pidx = sample[r] ? SEQ + tt0[r] : tt0[r];
        const bf16_t* prow = V_PROJ + (size_t)row * NPROJ;
#pragma unroll
        for (int sl = 0; sl < 6; ++sl) { const bf16_t* p = prow + (4 * sl + hq) * 128; xlo[r][sl] = *(const u32x2*)(p + 4 * jj); xhi[r][sl] = *(const u32x2*)(p + 64 + 4 * jj); }
        const float* cs = V_ROPEA + ((size_t)pidx * 64 + 4 * jj) * 2;
        const f32x4 c01 = *(const f32x4*)cs, c23 = *(const f32x4*)(cs + 4);
        cc[r] = (f32x4){c01[0], c01[2], c23[0], c23[2]}; sn[r] = (f32x4){c01[1], c01[3], c23[1], c23[3]};
#pragma unroll
        for (int q = 0; q < 12; ++q) vv[r][q] = *(const unsigned*)(prow + PC_AV + q * 128 + 2 * lane);
    }
    const f32x4 gq_lo = *(const f32x4*)(F.in[10] + l * 128 + 4 * jj), gq_hi = *(const f32x4*)(F.in[10] + l * 128 + 64 + 4 * jj);
    const f32x4 gk_lo = *(const f32x4*)(F.in[11] + l * 128 + 4 * jj), gk_hi = *(const f32x4*)(F.in[11] + l * 128 + 64 + 4 * jj);
#pragma unroll
    for (int r = 0; r < NR; ++r) {
        const int row = rows[r], t = tt0[r], b = bb[r]; const bool smp = sample[r];
        bf16_t* prow = V_PROJ + (size_t)row * NPROJ;
#pragma unroll
        for (int sl = 0; sl < 6; ++sl) {
            const int hs = 4 * sl + hq, which = sl >= 3 ? 1 : 0, gh = hs - 12 * which, g = gh >> 2, h = gh & 3;
            f32x4 lo = (f32x4){bf_lo(xlo[r][sl].x), bf_hi(xlo[r][sl].x), bf_lo(xlo[r][sl].y), bf_hi(xlo[r][sl].y)}, hi = (f32x4){bf_lo(xhi[r][sl].x), bf_hi(xhi[r][sl].x), bf_lo(xhi[r][sl].y), bf_hi(xhi[r][sl].y)};
            float ss = (lo[0] * lo[0] + lo[1] * lo[1]) + (lo[2] * lo[2] + lo[3] * lo[3]) + (hi[0] * hi[0] + hi[1] * hi[1]) + (hi[2] * hi[2] + hi[3] * hi[3]);
            ss = row_sum16(ss);
            const float rstd = rsqrtf(ss * (1.f / 128.f) + EPS);
            lo = lo * rstd * (which ? gk_lo : gq_lo); hi = hi * rstd * (which ? gk_hi : gq_hi);
            const f32x4 olo = lo * cc[r] - hi * sn[r], ohi = hi * cc[r] + lo * sn[r];
            bf16_t* p = prow + hs * 128;
            if (store_qk) { u32x2 w0, w1; w0.x = cvt_pk_bf16(olo[0], olo[1]); w0.y = cvt_pk_bf16(olo[2], olo[3]); w1.x = cvt_pk_bf16(ohi[0], ohi[1]); w1.y = cvt_pk_bf16(ohi[2], ohi[3]);
                *(u32x2*)(p + 4 * jj) = w0; *(u32x2*)(p + 64 + 4 * jj) = w1; }
            if (which == 1) {
                const int keep = 128 << (2 * g); const int tt = smp ? t : t - (SEQ - keep);
                if (tt >= 0) { float* dst = kv_out_ptr(F.out, g, l, smp, b, tt) + h * 128; *(f32x4*)(dst + 4 * jj) = olo; *(f32x4*)(dst + 64 + 4 * jj) = ohi; }
            }
        }
#pragma unroll
        for (int g = 0; g < 3; ++g) {
            const int keep = 128 << (2 * g); const int tt = smp ? t : t - (SEQ - keep);
            if (tt >= 0) { float* dst = kv_out_ptr(F.out, g, l, smp, b, tt) + 512;
#pragma unroll
                for (int q = 0; q < 4; ++q) { const unsigned v = vv[r][4 * g + q]; *(f32x2*)(dst + q * 128 + 2 * lane) = (f32x2){bf_lo(v), bf_hi(v)}; } }
        }
    }
}
__device__ __forceinline__ void e1_row(Ctx& F, int l, int row) {
    const int lane = F.lane, j = lane & 31, hh = lane >> 5;
    const bool sample = row >= MP;
    const int b = sample ? (row - MP) >> 3 : row >> 12, t = sample ? (row - MP) & 7 : row & 4095;
    const int pidx = sample ? SEQ + t : t;
    bf16_t* prow = V_PROJ + (size_t)row * NPROJ;
    if (!sample && t < SEQ - 3) return;
#pragma unroll 1
    for (int it = 0; it < 6; ++it) {
        const int slot = 2 * it + hh, typ = slot >> 2, c = slot * 128 + 4 * j;
        f32x4 a = (f32x4){0.f, 0.f, 0.f, 0.f}, xcur = a;
#pragma unroll
        for (int i = 0; i < 4; ++i) {
            const int tp = t - 3 + i; f32x4 x;
            if (tp >= 0) { const u32x2 u = *(const u32x2*)(V_PROJ + (size_t)(row - 3 + i) * NPROJ + PC_BQKV + c); x = (f32x4){bf_lo(u.x), bf_hi(u.x), bf_lo(u.y), bf_hi(u.y)}; }
            else if (sample) x = *(const f32x4*)(F.in[5] + ((size_t)(l * DB + b) * 3 + (tp + 3)) * 1536 + c);
            else x = (f32x4){0.f, 0.f, 0.f, 0.f};
            const f32x4 w = *(const f32x4*)(F.in[12] + (size_t)(l * 4 + i) * 1536 + c);
            a += w * x; if (i == 3) xcur = x;
        }
#pragma unroll
        for (int q = 0; q < 4; ++q) a[q] = a[q] * sigmoidf_(a[q]);
        if (typ < 2) {
            const float ss = half_sum((a[0] * a[0] + a[1] * a[1]) + (a[2] * a[2] + a[3] * a[3]));
            const float sc = rsqrtf(ss + EPS) * (typ == 0 ? 0.08838834764831845f : 1.f);
            a *= sc;
        }
        *(f32x4*)(V_BQKV + (size_t)row * 1536 + c) = a;
        const int tc = sample ? t - 5 : t - (SEQ - 3);
        if (tc >= 0) { float* dst = F.out + (sample ? O_BCS + ((size_t)(l * DB + b) * 3 + tc) * 1536 : O_BCP + ((size_t)(l * BATCH + b) * 3 + tc) * 1536); *(f32x4*)(dst + c) = xcur; }
    }
    if (lane < 8) {
        const int h = lane & 3; const float x = bf1(prow[PC_BETA + lane]);
        float r;
        if (lane < 4) r = 1.f / (1.f + expf(-x));
        else { const float y = x + F.in[14][l * 4 + h]; const float sp = y > 20.f ? y : log1pf(expf(y)); r = -expf(F.in[13][l * 4 + h]) * sp; }
        V_BG[(size_t)row * 8 + lane] = r;
    }
    {
        const int hs = lane >> 3, i0 = 4 * (lane & 7);
        const bf16_t* p = prow + PC_CQ + hs * 64;
        const u32x2 ulo = *(const u32x2*)(p + i0), uhi = *(const u32x2*)(p + 32 + i0);
        const f32x4 lo = (f32x4){bf_lo(ulo.x), bf_hi(ulo.x), bf_lo(ulo.y), bf_hi(ulo.y)}, hi = (f32x4){bf_lo(uhi.x), bf_hi(uhi.x), bf_lo(uhi.y), bf_hi(uhi.y)};
        const float* cs = V_ROPEC + ((size_t)pidx * 32 + i0) * 2;
        const f32x4 c01 = *(const f32x4*)cs, c23 = *(const f32x4*)(cs + 4);
        const f32x4 cc = (f32x4){c01[0], c01[2], c23[0], c23[2]}, sn = (f32x4){c01[1], c01[3], c23[1], c23[3]};
        const float sc = hs >= 4 ? 0.125f : 1.f;
        const f32x4 olo = (lo * cc - hi * sn) * sc, ohi = (hi * cc + lo * sn) * sc;
        *(f32x4*)(V_CQK + (size_t)row * 512 + hs * 64 + i0) = olo; *(f32x4*)(V_CQK + (size_t)row * 512 + hs * 64 + 32 + i0) = ohi;
    }
}

__device__ __forceinline__ float dot8(const u32x4 q, const u32x4 k) {
    return (bf_lo(q.x) * bf_lo(k.x) + bf_hi(q.x) * bf_hi(k.x)) + (bf_lo(q.y) * bf_lo(k.y) + bf_hi(q.y) * bf_hi(k.y)) + (bf_lo(q.z) * bf_lo(k.z) + bf_hi(q.z) * bf_hi(k.z)) + (bf_lo(q.w) * bf_lo(k.w) + bf_hi(q.w) * bf_hi(k.w));
}
#define LDS_BARRIER() do { asm volatile("s_waitcnt lgkmcnt(0)" ::: "memory"); __builtin_amdgcn_s_barrier(); asm volatile("" ::: "memory"); } while (0)
#define WAVE_LDS_SYNC() do { asm volatile("s_waitcnt lgkmcnt(0)" ::: "memory"); __builtin_amdgcn_wave_barrier(); } while (0)
__device__ __forceinline__ void attn_prompt_task(Ctx& F, int row, int h) {
    const int lane = F.lane, t = row & 4095;
    const bf16_t* proj = V_PROJ;
    LAS float* ps = (LAS float*)F.lds + F.wave * 256;
    float mrun = -INFINITY, lsum = 0.f, o0 = 0.f, o1 = 0.f;
#pragma unroll 1
    for (int g = 0; g < 3; ++g) {
        const int sh = 2 * g, nk = min(128, t >> sh) + 1;
        const bf16_t* qrow = proj + (size_t)row * NPROJ + PC_AQ + g * 512 + h * 128;
        u32x4 q[16];
#pragma unroll
        for (int i = 0; i < 16; ++i) q[i] = *(const u32x4*)(qrow + 8 * i);
        WAVE_LDS_SYNC();
#pragma unroll 1
        for (int r = 0; r < 3; ++r) {
            const int jk = r * 64 + lane; const bool valid = jk < nk; const int jj = valid ? jk : 0;
            const bf16_t* krow = proj + (size_t)(row - (jj << sh)) * NPROJ + PC_AK + g * 512 + h * 128;
            float a = 0.f;
#pragma unroll
            for (int i = 0; i < 16; ++i) a += dot8(q[i], *(const u32x4*)(krow + 8 * i));
            ps[jk] = valid ? a * 0.08838834764831845f : -INFINITY;
        }
        WAVE_LDS_SYNC();
        const float s0 = ps[lane], s1 = ps[64 + lane], s2 = ps[128 + lane];
        const float mg = wave_max(fmaxf(fmaxf(s0, s1), s2)), mnew = fmaxf(mrun, mg), alpha = __expf(mrun - mnew);
        const float p0 = __expf(s0 - mnew), p1 = __expf(s1 - mnew), p2 = __expf(s2 - mnew);
        WAVE_LDS_SYNC();
        ps[lane] = p0; ps[64 + lane] = p1; ps[128 + lane] = p2;
        lsum = lsum * alpha + wave_sum(p0 + p1 + p2); o0 *= alpha; o1 *= alpha; mrun = mnew;
        WAVE_LDS_SYNC();
        const bf16_t* vbase = proj + (size_t)row * NPROJ + PC_AV + g * 512 + h * 128 + 2 * lane;
#pragma unroll 4
        for (int jk = 0; jk < nk; ++jk) {
            const float pj = ps[jk];
            const unsigned vv = *(const unsigned*)(vbase - (size_t)(jk << sh) * NPROJ);
            o0 += pj * bf_lo(vv); o1 += pj * bf_hi(vv);
        }
    }
    const float inv = 1.f / lsum;
    *(unsigned*)(V_OABC + (size_t)row * 512 + h * 128 + 2 * lane) = cvt_pk_bf16(o0 * inv, o1 * inv);
}
__device__ __forceinline__ void attn_sample_unit(Ctx& F, int l, int bs, int h, int g) {
    const int lane = F.lane, b = bs >> 3, s = bs & 7, row = MP + bs;
    LAS float* ps = (LAS float*)F.lds + F.wave * 256;
    const int sh = 2 * g, L = 128 << sh;
    const float* cache = F.in[2 + g] + (size_t)(l * DB + b) * L * 1024;
    const float* newkv = kv_out_ptr(F.out, g, l, true, b, 0);
    const bf16_t* qrow = V_PROJ + (size_t)row * NPROJ + PC_AQ + g * 512 + h * 128;
    const int hl = lane & 31, hf = lane >> 5;
    const u32x2 qq = *(const u32x2*)(qrow + 4 * hl);
    const float q0 = bf_lo(qq.x) * 0.08838834764831845f, q1 = bf_hi(qq.x) * 0.08838834764831845f, q2 = bf_lo(qq.y) * 0.08838834764831845f, q3 = bf_hi(qq.y) * 0.08838834764831845f;
    WAVE_LDS_SYNC();
#pragma unroll 1
    for (int j0 = 0; j0 < 130; j0 += 26) {
        f32x4 kk[13];
#pragma unroll
        for (int u = 0; u < 13; ++u) { int jk = j0 + 2 * u + hf; jk = jk > 128 ? 128 : jk; const int idx = L + s - (jk << sh);
            kk[u] = *(const f32x4*)((idx < L ? cache + (size_t)idx * 1024 : newkv + (size_t)(idx - L) * 1024) + h * 128 + 4 * hl); }
#pragma unroll
        for (int u = 0; u < 13; ++u) { float a = (q0 * kk[u][0] + q1 * kk[u][1]) + (q2 * kk[u][2] + q3 * kk[u][3]);
            a = row_sum16(a); a += __shfl_xor(a, 16);
            const int jk = j0 + 2 * u + hf; if (hl == 0 && jk <= 128) ps[jk] = a; }
    }
    if (lane >= 1) ps[128 + lane] = -INFINITY;
    WAVE_LDS_SYNC();
    const float s0 = ps[lane], s1 = ps[64 + lane], s2 = ps[128 + lane];
    const float mx = wave_max(fmaxf(fmaxf(s0, s1), s2));
    const float p0 = __expf(s0 - mx), p1 = __expf(s1 - mx), p2 = __expf(s2 - mx);
    WAVE_LDS_SYNC();
    ps[lane] = p0; ps[64 + lane] = p1; ps[128 + lane] = p2;
    const float lsum = wave_sum(p0 + p1 + p2);
    WAVE_LDS_SYNC();
    float o0 = 0.f, o1 = 0.f, o2 = 0.f, o3 = 0.f;
    const float* vc = cache + 512 + h * 128 + 2 * lane; const float* vn2 = newkv + 512 + h * 128 + 2 * lane;
#pragma unroll 1
    for (int j0 = 0; j0 < 128; j0 += 16) {
        f32x2 vv[16];
#pragma unroll
        for (int u = 0; u < 16; ++u) { const int idx = L + s - ((j0 + u) << sh); vv[u] = *(const f32x2*)(idx < L ? vc + (size_t)idx * 1024 : vn2 + (size_t)(idx - L) * 1024); }
#pragma unroll
        for (int u = 0; u < 16; u += 2) { const float pa = ps[j0 + u], pb = ps[j0 + u + 1]; o0 += pa * vv[u][0]; o1 += pa * vv[u][1]; o2 += pb * vv[u + 1][0]; o3 += pb * vv[u + 1][1]; }
    }
    { const int idx = L + s - (128 << sh); const f32x2 vv = *(const f32x2*)(idx < L ? vc + (size_t)idx * 1024 : vn2 + (size_t)(idx - L) * 1024); const float pa = ps[128]; o0 += pa * vv[0]; o1 += pa * vv[1]; }
    const float inv = 1.f / lsum;
    *(unsigned*)(V_AO + ((size_t)g * M + row) * 512 + h * 128 + 2 * lane) = cvt_pk_bf16((o0 + o2) * inv, (o1 + o3) * inv);
    if (lane == 0) V_LSE[((size_t)g * M + row) * 4 + h] = mx + __logf(lsum);
}
constexpr int AT_KSTR = 272, AT_VSTR = 528, AT_VOFF = 256 * AT_KSTR;
__device__ __forceinline__ void attn_mfma_item(Ctx& F, int item) {
    const int tid = F.tid, lane = F.lane, w = F.wave, li = lane & 15, q4 = lane >> 4;
    const int nbr = item & 31; int rest = item >> 5; const int h = rest & 3; rest >>= 2; const int g = rest % 3, b = rest / 3;
    const int sh = 2 * g, nblk_sh = 5 - sh, r = nbr >> nblk_sh, nb = nbr & ((1 << nblk_sh) - 1), n0 = nb * 128;
    const bf16_t* proj = V_PROJ;
    LAS unsigned char* Ks = F.lds; LAS unsigned char* Vt = F.lds + AT_VOFF;
    {
        u32x4 kv[8], vv[8];
#pragma unroll
        for (int p = 0; p < 8; ++p) {
            const int kl = p * 32 + (tid >> 4), ch = tid & 15, np = n0 - 128 + kl;
            if (np >= 0) { const bf16_t* src = proj + (size_t)(b * SEQ + (np << sh) + r) * NPROJ + g * 512 + h * 128 + ch * 8;
                kv[p] = *(const u32x4*)(src + PC_AK); vv[p] = *(const u32x4*)(src + PC_AV); }
            else { kv[p] = (u32x4){0u, 0u, 0u, 0u}; vv[p] = kv[p]; }
        }
#pragma unroll
        for (int p = 0; p < 8; ++p) {
            const int kl = p * 32 + (tid >> 4), ch = tid & 15;
            *(LAS u32x4*)(Ks + kl * AT_KSTR + ch * 16) = kv[p];
            LAS unsigned short* vt = (LAS unsigned short*)(Vt + (ch * 8) * AT_VSTR + kl * 2);
            vt[0 * (AT_VSTR / 2)] = (unsigned short)(vv[p].x & 0xffffu); vt[1 * (AT_VSTR / 2)] = (unsigned short)(vv[p].x >> 16);
            vt[2 * (AT_VSTR / 2)] = (unsigned short)(vv[p].y & 0xffffu); vt[3 * (AT_VSTR / 2)] = (unsigned short)(vv[p].y >> 16);
            vt[4 * (AT_VSTR / 2)] = (unsigned short)(vv[p].z & 0xffffu); vt[5 * (AT_VSTR / 2)] = (unsigned short)(vv[p].z >> 16);
            vt[6 * (AT_VSTR / 2)] = (unsigned short)(vv[p].w & 0xffffu); vt[7 * (AT_VSTR / 2)] = (unsigned short)(vv[p].w >> 16);
        }
    }
    const int ql = 16 * w + li;
    const size_t rowq = (size_t)(b * SEQ + ((n0 + ql) << sh) + r);
    bf16x8 qf[4];
#pragma unroll
    for (int s = 0; s < 4; ++s) qf[s] = *(const bf16x8*)(proj + rowq * NPROJ + PC_AQ + g * 512 + h * 128 + 32 * s + 8 * q4);
    __syncthreads();
    f32x4 st[9];
#pragma unroll
    for (int kt = 0; kt < 9; ++kt) {
        f32x4 acc = (f32x4){0.f, 0.f, 0.f, 0.f};
        const LAS unsigned char* kp = Ks + ((w + kt) * 16 + li) * AT_KSTR + 16 * q4;
#pragma unroll
        for (int s = 0; s < 4; ++s) acc = __builtin_amdgcn_mfma_f32_16x16x32_bf16(*(const LAS bf16x8*)(kp + 64 * s), qf[s], acc, 0, 0, 0);
        st[kt] = acc;
    }
    const int kmin = 128 - n0;
    float mx = -INFINITY;
#pragma unroll
    for (int kt = 0; kt < 9; ++kt)
#pragma unroll
        for (int rg = 0; rg < 4; ++rg) {
            const int a = 4 * q4 + rg, kl = (w + kt) * 16 + a;
            bool ok = kl >= kmin;
            if (kt == 0) ok = ok && (a >= li);
            if (kt == 8) ok = ok && (a <= li);
            st[kt][rg] = ok ? st[kt][rg] : -INFINITY;
            mx = fmaxf(mx, st[kt][rg]);
        }
    mx = fmaxf(mx, __shfl_xor(mx, 16)); mx = fmaxf(mx, __shfl_xor(mx, 32));
    const float c2 = 0.08838834764831845f * 1.4426950408889634f;
    float lsum = 0.f;
#pragma unroll
    for (int kt = 0; kt < 9; ++kt)
#pragma unroll
        for (int rg = 0; rg < 4; ++rg) { const float p = exp2f((st[kt][rg] - mx) * c2); st[kt][rg] = p; lsum += p; }
    lsum += __shfl_xor(lsum, 16); lsum += __shfl_xor(lsum, 32);
    f32x4 o[8];
#pragma unroll
    for (int db = 0; db < 8; ++db) o[db] = (f32x4){0.f, 0.f, 0.f, 0.f};
#pragma unroll
    for (int ks = 0; ks < 5; ++ks) {
        u32x4 pw;
        pw.x = cvt_pk_bf16(st[2 * ks][0], st[2 * ks][1]); pw.y = cvt_pk_bf16(st[2 * ks][2], st[2 * ks][3]);
        if (ks < 4) { pw.z = cvt_pk_bf16(st[2 * ks + 1][0], st[2 * ks + 1][1]); pw.w = cvt_pk_bf16(st[2 * ks + 1][2], st[2 * ks + 1][3]); }
        else { pw.z = 0u; pw.w = 0u; }
        const bf16x8 pf = __builtin_bit_cast(bf16x8, pw);
        const int t0 = w + 2 * ks, t1 = (w + 2 * ks + 1) > 15 ? 15 : (w + 2 * ks + 1);
#pragma unroll
        for (int db = 0; db < 8; ++db) {
            const LAS unsigned char* vp = Vt + (16 * db + li) * AT_VSTR + 8 * q4;
            u32x4 av; const u32x2 a0 = *(const LAS u32x2*)(vp + t0 * 32), a1 = *(const LAS u32x2*)(vp + t1 * 32);
            av.x = a0.x; av.y = a0.y; av.z = a1.x; av.w = a1.y;
            o[db] = __builtin_amdgcn_mfma_f32_16x16x32_bf16(__builtin_bit_cast(bf16x8, av), pf, o[db], 0, 0, 0);
        }
    }
    const float inv = 1.f / lsum;
    bf16_t* dst = V_AO + ((size_t)g * M + rowq) * 512 + h * 128 + 4 * q4;
#pragma unroll
    for (int db = 0; db < 8; ++db) { u32x2 wv; wv.x = cvt_pk_bf16(o[db][0] * inv, o[db][1] * inv); wv.y = cvt_pk_bf16(o[db][2] * inv, o[db][3] * inv); *(u32x2*)(dst + 16 * db) = wv; }
    if (q4 == 0) V_LSE[((size_t)g * M + rowq) * 4 + h] = mx * 0.08838834764831845f + __logf(lsum);
    __syncthreads();
}

constexpr int DP_Q = 0, DP_K = 17408, DP_V = 34816, DP_AM = 52224, DP_TM = 68608, DP_RTV = 77824, DP_RTK = 96256, DP_GC = 114688, DP_BT = 114944;
__device__ __forceinline__ f32x4 mfma16(const bf16x8 a, const bf16x8 b, const f32x4 c) { return __builtin_amdgcn_mfma_f32_16x16x32_bf16(a, b, c, 0, 0, 0); }
__device__ __forceinline__ void delta_prep_item(Ctx& F, int l, int ch) {
    const int tid = F.tid, lane = F.lane, w = F.wave, li = lane & 15, q4 = lane >> 4;
    const int c = ch & 63, h = (ch >> 6) & 3, b = ch >> 8;
    const int row0 = b * SEQ + 64 * c;
    const bf16_t* proj = V_PROJ;
    LAS unsigned char* L = F.lds;
    LAS float* gcs = (LAS float*)(L + DP_GC); LAS float* bts = (LAS float*)(L + DP_BT);
    float b_x = 0.f, b_y = 0.f;
    if (tid < 64) { const bf16_t* pr = proj + (size_t)(row0 + tid) * NPROJ; b_x = bf1(pr[PC_BETA + h]); b_y = bf1(pr[PC_BA + h]); }
    {
        f32x2 wg[3][4]; unsigned xr[3][11];
#pragma unroll
        for (int typ = 0; typ < 3; ++typ) {
            const int cc = typ * 512 + h * 128 + 2 * lane;
#pragma unroll
            for (int i = 0; i < 4; ++i) wg[typ][i] = *(const f32x2*)(F.in[12] + (size_t)(l * 4 + i) * 1536 + cc);
#pragma unroll
            for (int rr = 0; rr < 11; ++rr) { const int tl = 64 * c + 8 * w + rr - 3; xr[typ][rr] = tl >= 0 ? *(const unsigned*)(proj + (size_t)(b * SEQ + tl) * NPROJ + PC_BQKV + cc) : 0u; }
        }
#pragma unroll
        for (int typ = 0; typ < 3; ++typ) {
#pragma unroll
            for (int rr = 0; rr < 8; ++rr) {
                float a0 = 0.f, a1 = 0.f;
#pragma unroll
                for (int i = 0; i < 4; ++i) { a0 += wg[typ][i][0] * bf_lo(xr[typ][rr + i]); a1 += wg[typ][i][1] * bf_hi(xr[typ][rr + i]); }
                a0 = a0 * sigmoidf_(a0); a1 = a1 * sigmoidf_(a1);
                if (typ < 2) { const float ss = wave_sum(a0 * a0 + a1 * a1); const float sc = rsqrtf(ss + EPS) * (typ == 0 ? 0.08838834764831845f : 1.f); a0 *= sc; a1 *= sc; }
                *(LAS unsigned*)(L + typ * 17408 + (8 * w + rr) * 272 + 4 * lane) = cvt_pk_bf16(a0, a1);
            }
        }
    }
    if (tid < 64) {
        const float be = 1.f / (1.f + expf(-b_x));
        const float y = b_y + F.in[14][l * 4 + h]; const float sp = y > 20.f ? y : log1pf(expf(y));
        float g = -expf(F.in[13][l * 4 + h]) * sp;
#pragma unroll
        for (int o = 1; o < 64; o <<= 1) { const float v = __shfl_up(g, o); if (lane >= o) g += v; }
        gcs[tid] = g; bts[tid] = be;
    }
    LDS_BARRIER();
    const size_t chs = (size_t)ch;
    {
        const int mi = w >> 1;
#pragma unroll
        for (int t2 = 0; t2 < 2; ++t2) {
            const int nj = 2 * (w & 1) + t2;
            bf16_t* ad = V_DAT + chs * 4096 + (size_t)(16 * mi + li) * 64 + 32 * (nj >> 1) + 8 * q4 + 4 * (nj & 1);
            if (nj <= mi) {
                f32x4 akk = (f32x4){0.f, 0.f, 0.f, 0.f}, aqk = akk;
                const LAS unsigned char* ki = L + DP_K + (16 * mi + li) * 272 + 16 * q4; const LAS unsigned char* kj = L + DP_K + (16 * nj + li) * 272 + 16 * q4;
                const LAS unsigned char* qi = L + DP_Q + (16 * mi + li) * 272 + 16 * q4;
#pragma unroll
                for (int s2 = 0; s2 < 4; ++s2) { const bf16x8 fkj = *(const LAS bf16x8*)(kj + 64 * s2);
                    akk = mfma16(*(const LAS bf16x8*)(ki + 64 * s2), fkj, akk);
                    aqk = mfma16(fkj, *(const LAS bf16x8*)(qi + 64 * s2), aqk); }
                const float gj = gcs[16 * nj + li], gi2 = gcs[16 * mi + li];
                float ov[4];
#pragma unroll
                for (int rg = 0; rg < 4; ++rg) {
                    const int i = 16 * mi + 4 * q4 + rg, j = 16 * nj + li;
                    ((LAS float*)(L + DP_AM))[i * 64 + j] = (i > j) ? bts[i] * akk[rg] * __expf(gcs[i] - gj) : 0.f;
                    const int j2 = 16 * nj + 4 * q4 + rg, i2 = 16 * mi + li;
                    ov[rg] = (i2 >= j2) ? aqk[rg] * __expf(gi2 - gcs[j2]) : 0.f;
                }
                u32x2 pk; pk.x = cvt_pk_bf16(ov[0], ov[1]); pk.y = cvt_pk_bf16(ov[2], ov[3]); *(u32x2*)ad = pk;
            } else { *(u32x2*)ad = (u32x2){0u, 0u}; }
        }
    }
    LDS_BARRIER();
    if (w == 0) {
        const LAS float* Am = (const LAS float*)(L + DP_AM);
        float t[64];
#pragma unroll
        for (int i = 0; i < 64; ++i) {
            float a0 = (lane == i) ? 1.f : 0.f, a1 = 0.f;
#pragma unroll
            for (int j = 0; j < i; j += 4) {
                const f32x4 av = *(const LAS f32x4*)(Am + i * 64 + j);
                a0 -= av[0] * t[j];
                if (j + 1 < i) a1 -= av[1] * t[j + 1];
                if (j + 2 < i) a0 -= av[2] * t[j + 2];
                if (j + 3 < i) a1 -= av[3] * t[j + 3];
            }
            t[i] = a0 + a1;
        }
#pragma unroll
        for (int i = 0; i < 64; ++i) *(LAS unsigned short*)(L + DP_TM + i * 144 + 2 * lane) = (unsigned short)(cvt_pk_bf16(t[i], 0.f) & 0xffffu);
    } else {
        const int e0 = tid - 64;
        const float gl = gcs[63];
        for (int e = e0; e < 8192; e += 448) {
            const int kk = e >> 12, t = e & 63, dp = (e >> 6) & 63;
            const unsigned u = *(const LAS unsigned*)(L + (kk ? DP_K : DP_V) + t * 272 + 4 * dp);
            const float sc = kk ? bts[t] * __expf(gcs[t]) : bts[t];
            const unsigned pk = cvt_pk_bf16(bf_lo(u) * sc, bf_hi(u) * sc);
            LAS unsigned short* d0 = (LAS unsigned short*)(L + (kk ? DP_RTK : DP_RTV) + (2 * dp) * 144 + 2 * t);
            d0[0] = (unsigned short)(pk & 0xffffu); d0[72] = (unsigned short)(pk >> 16);
        }
        for (int e = e0; e < 1024; e += 448) {
            const int t = e >> 4, c16 = e & 15; const float sc = __expf(gcs[t]);
            const u32x4 u = *(const LAS u32x4*)(L + DP_Q + t * 272 + 16 * c16);
            u32x4 o; o.x = cvt_pk_bf16(bf_lo(u.x) * sc, bf_hi(u.x) * sc); o.y = cvt_pk_bf16(bf_lo(u.y) * sc, bf_hi(u.y) * sc); o.z = cvt_pk_bf16(bf_lo(u.z) * sc, bf_hi(u.z) * sc); o.w = cvt_pk_bf16(bf_lo(u.w) * sc, bf_hi(u.w) * sc);
            { bf16_t* qd = V_DQG + chs * 8192 + (size_t)t * 128 + 32 * (c16 >> 2) + 16 * (c16 & 1) + 4 * ((c16 >> 1) & 1); *(u32x2*)qd = (u32x2){o.x, o.y}; *(u32x2*)(qd + 8) = (u32x2){o.z, o.w}; }
        }
        for (int e = e0; e < 1024; e += 448) {
            const int dk = e >> 3, t8 = (e & 7) * 8;
            float v[8];
#pragma unroll
            for (int q = 0; q < 8; ++q) v[q] = bf1(*(const LAS unsigned short*)(L + DP_K + (t8 + q) * 272 + 2 * dk)) * __expf(gl - gcs[t8 + q]);
            u32x4 o; o.x = cvt_pk_bf16(v[0], v[1]); o.y = cvt_pk_bf16(v[2], v[3]); o.z = cvt_pk_bf16(v[4], v[5]); o.w = cvt_pk_bf16(v[6], v[7]);
            { bf16_t* kd = V_DKT + chs * 8192 + (size_t)dk * 64 + 32 * (t8 >> 5) + 16 * ((t8 >> 3) & 1) + 4 * ((t8 >> 4) & 1); *(u32x2*)kd = (u32x2){o.x, o.y}; *(u32x2*)(kd + 8) = (u32x2){o.z, o.w}; }
        }
        if (tid == 64) V_DDL[ch] = __expf(gl);
    }
    LDS_BARRIER();
#pragma unroll
    for (int q = 0; q < 4; ++q) {
        const int id = 4 * w + q;
        { const int m = id >> 2, n = id & 3;
          const LAS unsigned char* ap = L + DP_RTK + (16 * m + li) * 144 + 16 * q4; const LAS unsigned char* bp = L + DP_TM + (16 * n + li) * 144 + 16 * q4;
          f32x4 acc = (f32x4){0.f, 0.f, 0.f, 0.f};
#pragma unroll
          for (int s2 = 0; s2 < 2; ++s2) acc = mfma16(*(const LAS bf16x8*)(ap + 64 * s2), *(const LAS bf16x8*)(bp + 64 * s2), acc);
          u32x2 pk; pk.x = cvt_pk_bf16(acc[0], acc[1]); pk.y = cvt_pk_bf16(acc[2], acc[3]);
          *(u32x2*)(V_DW + chs * 8192 + (size_t)(16 * n + li) * 128 + 32 * (m >> 1) + 8 * q4 + 4 * (m & 1)) = pk; }
        { const int mb = id & 3, nj = id >> 2;
          const LAS unsigned char* ap = L + DP_TM + (16 * mb + li) * 144 + 16 * q4; const LAS unsigned char* bp = L + DP_RTV + (16 * nj + li) * 144 + 16 * q4;
          f32x4 acc = (f32x4){0.f, 0.f, 0.f, 0.f};
#pragma unroll
          for (int s2 = 0; s2 < 2; ++s2) acc = mfma16(*(const LAS bf16x8*)(ap + 64 * s2), *(const LAS bf16x8*)(bp + 64 * s2), acc);
          *(f32x4*)(V_DU + ((chs * 8 + nj) * 64 + lane) * 16 + 4 * mb) = acc; }
    }
    LDS_BARRIER();
}
__device__ __forceinline__ bf16x8 ld_perm(const LAS unsigned char* p) { const u32x2 a = *(const LAS u32x2*)p, b = *(const LAS u32x2*)(p + 32); u32x4 r; r.x = a.x; r.y = a.y; r.z = b.x; r.w = b.y; return __builtin_bit_cast(bf16x8, r); }
__device__ __forceinline__ bf16x8 pack_b(const f32x4 lo, const f32x4 hi) { u32x4 r; r.x = cvt_pk_bf16(lo[0], lo[1]); r.y = cvt_pk_bf16(lo[2], lo[3]); r.z = cvt_pk_bf16(hi[0], hi[1]); r.w = cvt_pk_bf16(hi[2], hi[3]); return __builtin_bit_cast(bf16x8, r); }
template <int DK, bool HAS_W>
__device__ __forceinline__ void chunk_scan_item(Ctx& F, const bf16_t* gW, const bf16_t* gQG, const bf16_t* gKT, const bf16_t* gAT, const float* gU, const bf16_t* vrow  , const float* gDL, float dl_const,
                                                float* obase  , float* Sout  ) {
    constexpr int RS_ = DK * 2 + 16;
    constexpr int OFF_QG = HAS_W ? 64 * RS_ : 0, OFF_KT = OFF_QG + 64 * RS_, OFF_AT = OFF_KT + DK * 144, BUF = OFF_AT + 64 * 144;
    constexpr int NWQ = (64 * DK / 8) / 512;
    constexpr int MT = DK / 16, KS = DK / 32;
    const int tid = F.tid, lane = F.lane, w = F.wave, li = lane & 15, q4 = lane >> 4;
    LAS unsigned char* L = F.lds;
    f32x4 S[MT];
#pragma unroll
    for (int m = 0; m < MT; ++m) S[m] = (f32x4){0.f, 0.f, 0.f, 0.f};
    u32x4 pfw[NWQ], pfq[NWQ], pfk[NWQ], pfa; f32x4 un[4];
#define CS_LOAD(cv) do { const size_t c_ = (cv); \
        _Pragma("unroll") for (int i_ = 0; i_ < NWQ; ++i_) { if (HAS_W) pfw[i_] = *(const u32x4*)(gW + c_ * (64 * DK) + (size_t)(tid + 512 * i_) * 8); \
            pfq[i_] = *(const u32x4*)(gQG + c_ * (64 * DK) + (size_t)(tid + 512 * i_) * 8); pfk[i_] = *(const u32x4*)(gKT + c_ * (64 * DK) + (size_t)(tid + 512 * i_) * 8); } \
        pfa = *(const u32x4*)(gAT + c_ * 4096 + (size_t)tid * 8); \
        if (HAS_W) { _Pragma("unroll") for (int m_ = 0; m_ < 4; ++m_) un[m_] = *(const f32x4*)(gU + ((c_ * 8 + w) * 64 + lane) * 16 + 4 * m_); } \
        else { const bf16_t* vp_ = vrow + (size_t)(64 * c_ + 4 * q4) * NPROJ + 16 * w + li; _Pragma("unroll") for (int m_ = 0; m_ < 4; ++m_) _Pragma("unroll") for (int r_ = 0; r_ < 4; ++r_) un[m_][r_] = bf1(vp_[(size_t)(16 * m_ + r_) * NPROJ]); } } while (0)
#define CS_STORE(bufv) do { LAS unsigned char* B_ = L + (bufv) * BUF; \
        _Pragma("unroll") for (int i_ = 0; i_ < NWQ; ++i_) { const int u_ = tid + 512 * i_; \
            if (HAS_W) *(LAS u32x4*)(B_ + (u_ / (DK / 8)) * RS_ + (u_ % (DK / 8)) * 16) = pfw[i_]; \
            *(LAS u32x4*)(B_ + OFF_QG + (u_ / (DK / 8)) * RS_ + (u_ % (DK / 8)) * 16) = pfq[i_]; \
            *(LAS u32x4*)(B_ + OFF_KT + (u_ >> 3) * 144 + (u_ & 7) * 16) = pfk[i_]; } \
        *(LAS u32x4*)(B_ + OFF_AT + (tid >> 3) * 144 + (tid & 7) * 16) = pfa; } while (0)
    CS_LOAD(0);
    CS_STORE(0);
    f32x4 uc[4];
#pragma unroll
    for (int m = 0; m < 4; ++m) uc[m] = un[m];
    float dl = gDL ? gDL[0] : dl_const;
    LDS_BARRIER();
#pragma unroll 1
    for (int c = 0; c < 64; ++c) {
        const LAS unsigned char* Bf = L + (c & 1) * BUF;
        float dln = dl_const;
        if (c + 1 < 64) { CS_LOAD(c + 1); if (gDL) dln = gDL[c + 1]; }
        bf16x8 Sb[KS];
#pragma unroll
        for (int s2 = 0; s2 < KS; ++s2) Sb[s2] = pack_b(S[2 * s2], S[2 * s2 + 1]);
        const LAS unsigned char* fb = Bf + li * RS_ + 16 * q4;
        const LAS unsigned char* fb2 = Bf + li * 144 + 16 * q4;
        f32x4 vn[4];
        if (HAS_W) {
            bf16x8 fw[4][KS];
#pragma unroll
            for (int mb = 0; mb < 4; ++mb)
#pragma unroll
                for (int s2 = 0; s2 < KS; ++s2) fw[mb][s2] = *(const LAS bf16x8*)(fb + mb * 16 * RS_ + 64 * s2);
#pragma unroll
            for (int mb = 0; mb < 4; ++mb) vn[mb] = (f32x4){0.f, 0.f, 0.f, 0.f};
#pragma unroll
            for (int s2 = 0; s2 < KS; ++s2)
#pragma unroll
                for (int mb = 0; mb < 4; ++mb) vn[mb] = mfma16(fw[mb][s2], Sb[s2], vn[mb]);
#pragma unroll
            for (int mb = 0; mb < 4; ++mb) vn[mb] = uc[mb] - vn[mb];
        } else {
#pragma unroll
            for (int mb = 0; mb < 4; ++mb) vn[mb] = uc[mb];
        }
        bf16x8 Vb[2];
        Vb[0] = pack_b(vn[0], vn[1]); Vb[1] = pack_b(vn[2], vn[3]);
        {
            bf16x8 fq[4][KS], fa[4][2];
#pragma unroll
            for (int mb = 0; mb < 4; ++mb) {
#pragma unroll
                for (int s2 = 0; s2 < KS; ++s2) fq[mb][s2] = *(const LAS bf16x8*)(fb + OFF_QG + mb * 16 * RS_ + 64 * s2);
#pragma unroll
                for (int s2 = 0; s2 < 2; ++s2) fa[mb][s2] = *(const LAS bf16x8*)(fb2 + OFF_AT + mb * 16 * 144 + 64 * s2);
            }
            f32x4 oa[4];
#pragma unroll
            for (int mb = 0; mb < 4; ++mb) oa[mb] = (f32x4){0.f, 0.f, 0.f, 0.f};
#pragma unroll
            for (int s2 = 0; s2 < KS; ++s2)
#pragma unroll
                for (int mb = 0; mb < 4; ++mb) oa[mb] = mfma16(fq[mb][s2], Sb[s2], oa[mb]);
#pragma unroll
            for (int s2 = 0; s2 < 2; ++s2)
#pragma unroll
                for (int mb = 0; mb < 4; ++mb) oa[mb] = mfma16(fa[mb][s2], Vb[s2], oa[mb]);
            float* od = obase + (size_t)(64 * c + 4 * q4) * 512 + 16 * w + li;
#pragma unroll
            for (int mb = 0; mb < 4; ++mb)
#pragma unroll
                for (int rg = 0; rg < 4; ++rg) od[(size_t)(16 * mb + rg) * 512] = oa[mb][rg];
        }
        {
            bf16x8 fk[MT][2];
#pragma unroll
            for (int m = 0; m < MT; ++m)
#pragma unroll
                for (int s2 = 0; s2 < 2; ++s2) fk[m][s2] = *(const LAS bf16x8*)(fb2 + OFF_KT + m * 16 * 144 + 64 * s2);
#pragma unroll
            for (int m = 0; m < MT; ++m) S[m] = S[m] * dl;
#pragma unroll
            for (int s2 = 0; s2 < 2; ++s2)
#pragma unroll
                for (int m = 0; m < MT; ++m) S[m] = mfma16(fk[m][s2], Vb[s2], S[m]);
        }
        if (c + 1 < 64) { CS_STORE((c + 1) & 1);
#pragma unroll
            for (int m = 0; m < 4; ++m) uc[m] = un[m];
            dl = dln; }
        LDS_BARRIER();
    }
#undef CS_LOAD
#undef CS_STORE
    float* So = Sout + 16 * w + li;
#pragma unroll
    for (int m = 0; m < MT; ++m)
#pragma unroll
        for (int rg = 0; rg < 4; ++rg) So[(size_t)(16 * m + 4 * q4 + rg) * 128] = S[m][rg];
    LDS_BARRIER();
}

constexpr int D2_BUF = 35840, D2_KT = 17408;
__device__ __forceinline__ void delta_scan2_item(Ctx& F, int l, int b, int h) {
    const int tid = F.tid, lane = F.lane, w = F.wave, li = lane & 15, q4 = lane >> 4;
    LAS unsigned char* L = F.lds;
    const size_t ch0 = (size_t)(b * 4 + h) * 64;
    const bf16_t* gW = V_DW + ch0 * 8192; const bf16_t* gKT = V_DKT + ch0 * 8192; const float* gU = V_DU + ch0 * 8192; const float* gDL = V_DDL + ch0;
    bf16_t* gSB = V_SB + ch0 * 16384; bf16_t* gVB = V_VB + ch0 * 8192;
    f32x4 S[8];
#pragma unroll
    for (int m = 0; m < 8; ++m) S[m] = (f32x4){0.f, 0.f, 0.f, 0.f};
    u32x4 pa[4], pb[4]; f32x4 ua[4], ub[4], uc[4]; float dla = 0.f, dlb = 0.f, dl;
#define D2_LOAD(P, U_, DL_, cv) do { const size_t c_ = (cv); \
        P[0] = *(const u32x4*)(gW + c_ * 8192 + (size_t)tid * 8); P[1] = *(const u32x4*)(gW + c_ * 8192 + (size_t)(tid + 512) * 8); \
        P[2] = *(const u32x4*)(gKT + c_ * 8192 + (size_t)tid * 8); P[3] = *(const u32x4*)(gKT + c_ * 8192 + (size_t)(tid + 512) * 8); \
        _Pragma("unroll") for (int m_ = 0; m_ < 4; ++m_) U_[m_] = *(const f32x4*)(gU + ((c_ * 8 + w) * 64 + lane) * 16 + 4 * m_); DL_ = gDL[c_]; } while (0)
#define D2_STORE(P, bufv) do { LAS unsigned char* B_ = L + (bufv) * D2_BUF; \
        *(LAS u32x4*)(B_ + (tid >> 4) * 272 + (tid & 15) * 16) = P[0]; *(LAS u32x4*)(B_ + ((tid >> 4) + 32) * 272 + (tid & 15) * 16) = P[1]; \
        *(LAS u32x4*)(B_ + D2_KT + (tid >> 3) * 144 + (tid & 7) * 16) = P[2]; *(LAS u32x4*)(B_ + D2_KT + ((tid >> 3) + 64) * 144 + (tid & 7) * 16) = P[3]; } while (0)
#define D2_COMPUTE(bufv, cv) do { const LAS unsigned char* Bf = L + (bufv) * D2_BUF; const size_t c_ = (cv); \
        bf16x8 Sb[4]; \
        _Pragma("unroll") for (int s2 = 0; s2 < 4; ++s2) { Sb[s2] = pack_b(S[2 * s2], S[2 * s2 + 1]); *(bf16x8*)(gSB + (((c_ * 8 + w) * 4 + s2) * 64 + lane) * 8) = Sb[s2]; } \
        const LAS unsigned char* fb = Bf + li * 272 + 16 * q4; const LAS unsigned char* fb2 = Bf + D2_KT + li * 144 + 16 * q4; \
        f32x4 vn[4]; \
        { bf16x8 fw[4][4]; \
          _Pragma("unroll") for (int mb = 0; mb < 4; ++mb) _Pragma("unroll") for (int s2 = 0; s2 < 4; ++s2) fw[mb][s2] = *(const LAS bf16x8*)(fb + mb * 16 * 272 + 64 * s2); \
          _Pragma("unroll") for (int mb = 0; mb < 4; ++mb) vn[mb] = (f32x4){0.f, 0.f, 0.f, 0.f}; \
          _Pragma("unroll") for (int s2 = 0; s2 < 4; ++s2) _Pragma("unroll") for (int mb = 0; mb < 4; ++mb) vn[mb] = mfma16(fw[mb][s2], Sb[s2], vn[mb]); } \
        _Pragma("unroll") for (int mb = 0; mb < 4; ++mb) vn[mb] = uc[mb] - vn[mb]; \
        bf16x8 Vb[2]; Vb[0] = pack_b(vn[0], vn[1]); Vb[1] = pack_b(vn[2], vn[3]); \
        _Pragma("unroll") for (int s2 = 0; s2 < 2; ++s2) *(bf16x8*)(gVB + (((c_ * 8 + w) * 2 + s2) * 64 + lane) * 8) = Vb[s2]; \
        { bf16x8 fk[8][2]; \
          _Pragma("unroll") for (int m = 0; m < 8; ++m) _Pragma("unroll") for (int s2 = 0; s2 < 2; ++s2) fk[m][s2] = *(const LAS bf16x8*)(fb2 + m * 16 * 144 + 64 * s2); \
          _Pragma("unroll") for (int m = 0; m < 8; ++m) S[m] = S[m] * dl; \
          _Pragma("unroll") for (int s2 = 0; s2 < 2; ++s2) _Pragma("unroll") for (int m = 0; m < 8; ++m) S[m] = mfma16(fk[m][s2], Vb[s2], S[m]); } } while (0)
    D2_LOAD(pa, ua, dla, 0);
    D2_LOAD(pb, ub, dlb, 1);
    D2_STORE(pa, 0);
#pragma unroll
    for (int m = 0; m < 4; ++m) uc[m] = ua[m];
    dl = dla;
    __syncthreads();
#pragma unroll 1
    for (int c = 0; c < 64; c += 2) {
        if (c + 2 < 64) D2_LOAD(pa, ua, dla, c + 2);
        D2_COMPUTE(0, c);
        D2_STORE(pb, 1);
#pragma unroll
        for (int m = 0; m < 4; ++m) uc[m] = ub[m];
        dl = dlb;
        LDS_BARRIER();
        if (c + 3 < 64) D2_LOAD(pb, ub, dlb, c + 3);
        D2_COMPUTE(1, c + 1);
        if (c + 2 < 64) { D2_STORE(pa, 0);
#pragma unroll
            for (int m = 0; m < 4; ++m) uc[m] = ua[m];
            dl = dla; }
        LDS_BARRIER();
    }
#undef D2_LOAD
#undef D2_STORE
#undef D2_COMPUTE
    float* So = F.out + O_BSP + ((size_t)(l * BATCH + b) * 4 + h) * 16384 + 16 * w + li;
#pragma unroll
    for (int m = 0; m < 8; ++m)
#pragma unroll
        for (int rg = 0; rg < 4; ++rg) So[(size_t)(16 * m + 4 * q4 + rg) * 128] = S[m][rg];
    __syncthreads();
}
__device__ __forceinline__ void delta_out_item(Ctx& F, int l, int ch) {
    const int tid = F.tid, lane = F.lane, w = F.wave, li = lane & 15, q4 = lane >> 4;
    const int c = ch & 63, h = (ch >> 6) & 3, b = ch >> 8;
    const int row0 = b * SEQ + 64 * c;
    LAS unsigned char* L = F.lds;
    const size_t chs = (size_t)ch;
    const u32x4 q0 = *(const u32x4*)(V_DQG + chs * 8192 + (size_t)tid * 8), q1 = *(const u32x4*)(V_DQG + chs * 8192 + (size_t)(tid + 512) * 8), a0 = *(const u32x4*)(V_DAT + chs * 4096 + (size_t)tid * 8);
    bf16x8 Sb[4], Vb[2];
#pragma unroll
    for (int s2 = 0; s2 < 4; ++s2) Sb[s2] = *(const bf16x8*)(V_SB + (((chs * 8 + w) * 4 + s2) * 64 + lane) * 8);
#pragma unroll
    for (int s2 = 0; s2 < 2; ++s2) Vb[s2] = *(const bf16x8*)(V_VB + (((chs * 8 + w) * 2 + s2) * 64 + lane) * 8);
    const float gn = F.in[15][l * 128 + 16 * w + li];
    const bf16_t* zp = V_PROJ + (size_t)(row0 + 4 * q4) * NPROJ + PC_BZ + h * 128 + 16 * w + li;
    float zz[16];
#pragma unroll
    for (int i = 0; i < 16; ++i) zz[i] = bf1(zp[(size_t)(16 * (i >> 2) + (i & 3)) * NPROJ]);
    *(LAS u32x4*)(L + (tid >> 4) * 272 + (tid & 15) * 16) = q0; *(LAS u32x4*)(L + ((tid >> 4) + 32) * 272 + (tid & 15) * 16) = q1;
    *(LAS u32x4*)(L + 17408 + (tid >> 3) * 144 + (tid & 7) * 16) = a0;
    LDS_BARRIER();
    f32x4 oa[4];
    {
        const LAS unsigned char* fb = L + li * 272 + 16 * q4; const LAS unsigned char* fb2 = L + 17408 + li * 144 + 16 * q4;
        bf16x8 fq[4][4], fa[4][2];
#pragma unroll
        for (int mb = 0; mb < 4; ++mb) {
#pragma unroll
            for (int s2 = 0; s2 < 4; ++s2) fq[mb][s2] = *(const LAS bf16x8*)(fb + mb * 16 * 272 + 64 * s2);
#pragma unroll
            for (int s2 = 0; s2 < 2; ++s2) fa[mb][s2] = *(const LAS bf16x8*)(fb2 + mb * 16 * 144 + 64 * s2);
        }
#pragma unroll
        for (int mb = 0; mb < 4; ++mb) oa[mb] = (f32x4){0.f, 0.f, 0.f, 0.f};
#pragma unroll
        for (int s2 = 0; s2 < 4; ++s2)
#pragma unroll
            for (int mb = 0; mb < 4; ++mb) oa[mb] = mfma16(fq[mb][s2], Sb[s2], oa[mb]);
#pragma unroll
        for (int s2 = 0; s2 < 2; ++s2)
#pragma unroll
            for (int mb = 0; mb < 4; ++mb) oa[mb] = mfma16(fa[mb][s2], Vb[s2], oa[mb]);
    }
    LAS float* part = (LAS float*)(L + 32768);
#pragma unroll
    for (int mb = 0; mb < 4; ++mb)
#pragma unroll
        for (int rg = 0; rg < 4; ++rg) { float ss = oa[mb][rg] * oa[mb][rg];
            ss = row_sum16(ss);
            if (li == 0) part[(16 * mb + 4 * q4 + rg) * 8 + w] = ss; }
    LDS_BARRIER();
    bf16_t* od = V_OABC + (size_t)M * 512 + (size_t)(row0 + 4 * q4) * 512 + h * 128 + 16 * w + li;
#pragma unroll
    for (int mb = 0; mb < 4; ++mb)
#pragma unroll
        for (int rg = 0; rg < 4; ++rg) { const int tk = 16 * mb + 4 * q4 + rg;
            const f32x4 p0 = *(const LAS f32x4*)(part + tk * 8), p1 = *(const LAS f32x4*)(part + tk * 8 + 4);
            const float rstd = rsqrtf(((p0[0] + p0[1]) + (p0[2] + p0[3]) + (p1[0] + p1[1]) + (p1[2] + p1[3])) * (1.f / 128.f) + EPS);
            const float z = zz[4 * mb + rg];
            od[(size_t)(16 * mb + rg) * 512] = (bf16_t)(cvt_pk_bf16(oa[mb][rg] * rstd * gn * z * sigmoidf_(z), 0.f) & 0xffffu); }
    LDS_BARRIER();
}
__device__ __forceinline__ void delta_scan_item(Ctx& F, int l, int b, int h) {
    const size_t ch0 = (size_t)(b * 4 + h) * 64;
    chunk_scan_item<128, true>(F, V_DW + ch0 * 8192, V_DQG + ch0 * 8192, V_DKT + ch0 * 8192, V_DAT + ch0 * 4096, V_DU + ch0 * 8192, nullptr, V_DDL + ch0, 0.f,
                               V_OBR + (size_t)(b * SEQ) * 512 + h * 128, F.out + O_BSP + ((size_t)(l * BATCH + b) * 4 + h) * 16384);
}
__device__ __forceinline__ void ret_scan_item(Ctx& F, int l, int b, int h) {
    const size_t ch0 = (size_t)(b * 4 + h) * 64;
    const float lg2 = log2f(1.f - exp2f(-5.f - (float)h));
    chunk_scan_item<64, false>(F, nullptr, V_RQG + ch0 * 4096, V_RKT + ch0 * 4096, V_RAT + ch0 * 4096, nullptr, V_PROJ + (size_t)(b * SEQ) * NPROJ + PC_CV + h * 128, nullptr, exp2f(64.f * lg2),
                               V_OCR + (size_t)(b * SEQ) * 512 + h * 128, F.out + O_CRP + ((size_t)(l * BATCH + b) * 4 + h) * 8192);
}
__device__ __forceinline__ void ret_prep_item(Ctx& F, int l, int item) {
    const int tid = F.tid, lane = F.lane, w = F.wave, li = lane & 15, q4 = lane >> 4;
    const int pj = w >> 1, t2 = tid & 127, w2 = w & 1;
    const int ch = 4 * item + pj, c = ch & 63, h = (ch >> 6) & 3, b = ch >> 8;
    const int row0 = b * SEQ + 64 * c;
    const bf16_t* proj = V_PROJ;
    LAS unsigned char* L = F.lds + pj * 18432;
    const float lg2 = log2f(1.f - exp2f(-5.f - (float)h));
    const size_t chs = (size_t)ch;
#pragma unroll
    for (int k8 = 0; k8 < 8; ++k8) {
        const int task = t2 + 128 * k8, qk = task >> 9, t = (task >> 3) & 63, i0 = 4 * (task & 7);
        const float* cs = V_ROPEC + ((size_t)(64 * c + t) * 32 + i0) * 2;
        const f32x4 c01 = *(const f32x4*)cs, c23 = *(const f32x4*)(cs + 4);
        const f32x4 cc = (f32x4){c01[0], c01[2], c23[0], c23[2]}, sn = (f32x4){c01[1], c01[3], c23[1], c23[3]};
        const bf16_t* p = proj + (size_t)(row0 + t) * NPROJ + (qk ? PC_CK : PC_CQ) + h * 64;
        const u32x2 ulo = *(const u32x2*)(p + i0), uhi = *(const u32x2*)(p + 32 + i0);
        const f32x4 lo = (f32x4){bf_lo(ulo.x), bf_hi(ulo.x), bf_lo(ulo.y), bf_hi(ulo.y)}, hi = (f32x4){bf_lo(uhi.x), bf_hi(uhi.x), bf_lo(uhi.y), bf_hi(uhi.y)};
        const float sc = qk ? 0.125f : 1.f;
        const f32x4 olo = (lo * cc - hi * sn) * sc, ohi = (hi * cc + lo * sn) * sc;
        u32x2 plo, phi; plo.x = cvt_pk_bf16(olo[0], olo[1]); plo.y = cvt_pk_bf16(olo[2], olo[3]); phi.x = cvt_pk_bf16(ohi[0], ohi[1]); phi.y = cvt_pk_bf16(ohi[2], ohi[3]);
        *(LAS u32x2*)(L + qk * 9216 + t * 144 + 2 * i0) = plo; *(LAS u32x2*)(L + qk * 9216 + t * 144 + 64 + 2 * i0) = phi;
    }
    LDS_BARRIER();
#pragma unroll
    for (int t8 = 0; t8 < 8; ++t8) {
        const int tile = 8 * w2 + t8, mi = tile >> 2, nj = tile & 3;
        bf16_t* ad = V_RAT + chs * 4096 + (size_t)(16 * mi + li) * 64 + 32 * (nj >> 1) + 8 * q4 + 4 * (nj & 1);
        if (nj <= mi) {
            f32x4 aqk = (f32x4){0.f, 0.f, 0.f, 0.f};
            const LAS unsigned char* kj = L + 9216 + (16 * nj + li) * 144 + 16 * q4; const LAS unsigned char* qi = L + (16 * mi + li) * 144 + 16 * q4;
#pragma unroll
            for (int s2 = 0; s2 < 2; ++s2) aqk = mfma16(*(const LAS bf16x8*)(kj + 64 * s2), *(const LAS bf16x8*)(qi + 64 * s2), aqk);
            float ov[4];
#pragma unroll
            for (int rg = 0; rg < 4; ++rg) { const int j2 = 16 * nj + 4 * q4 + rg, i2 = 16 * mi + li; ov[rg] = (i2 >= j2) ? aqk[rg] * exp2f((float)(i2 - j2) * lg2) : 0.f; }
            u32x2 pk; pk.x = cvt_pk_bf16(ov[0], ov[1]); pk.y = cvt_pk_bf16(ov[2], ov[3]); *(u32x2*)ad = pk;
        } else { *(u32x2*)ad = (u32x2){0u, 0u}; }
    }
#pragma unroll
    for (int k4 = 0; k4 < 4; ++k4) {
        const int u_ = t2 + 128 * k4;
        { const int t = u_ >> 3, c8 = u_ & 7; const float sc = exp2f((float)(t + 1) * lg2);
          const u32x4 u = *(const LAS u32x4*)(L + t * 144 + 16 * c8);
          u32x4 o; o.x = cvt_pk_bf16(bf_lo(u.x) * sc, bf_hi(u.x) * sc); o.y = cvt_pk_bf16(bf_lo(u.y) * sc, bf_hi(u.y) * sc); o.z = cvt_pk_bf16(bf_lo(u.z) * sc, bf_hi(u.z) * sc); o.w = cvt_pk_bf16(bf_lo(u.w) * sc, bf_hi(u.w) * sc);
          bf16_t* qd = V_RQG + chs * 4096 + (size_t)t * 64 + 32 * (c8 >> 2) + 16 * (c8 & 1) + 4 * ((c8 >> 1) & 1); *(u32x2*)qd = (u32x2){o.x, o.y}; *(u32x2*)(qd + 8) = (u32x2){o.z, o.w}; }
        { const int dk = u_ >> 3, t8 = (u_ & 7) * 8;
          float v[8];
#pragma unroll
          for (int q = 0; q < 8; ++q) v[q] = bf1(*(const LAS unsigned short*)(L + 9216 + (t8 + q) * 144 + 2 * dk)) * exp2f((float)(63 - t8 - q) * lg2);
          u32x4 o2; o2.x = cvt_pk_bf16(v[0], v[1]); o2.y = cvt_pk_bf16(v[2], v[3]); o2.z = cvt_pk_bf16(v[4], v[5]); o2.w = cvt_pk_bf16(v[6], v[7]);
          bf16_t* kd = V_RKT + chs * 4096 + (size_t)dk * 64 + 32 * (t8 >> 5) + 16 * ((t8 >> 3) & 1) + 4 * ((t8 >> 4) & 1); *(u32x2*)kd = (u32x2){o2.x, o2.y}; *(u32x2*)(kd + 8) = (u32x2){o2.z, o2.w}; }
    }
    LDS_BARRIER();
}
__device__ __forceinline__ void delta_item(Ctx& F, int l, bool sample, int b, int h) {
    LAS float* sm = (LAS float*)F.lds;
    LAS float* qs = sm, *ks = sm + 2048, *vs = sm + 4096, *bgs = sm + 6144, *pa = sm + 6400, *pb = sm + 6912;
    const int tid = F.tid, c = tid & 127, qr = tid >> 7;
    float s[32];
    if (sample) { const float* S0 = F.in[6] + ((size_t)(l * DB + b) * 4 + h) * 16384;
#pragma unroll
        for (int i = 0; i < 32; ++i) s[i] = S0[(32 * qr + i) * 128 + c]; }
    else {
#pragma unroll
        for (int i = 0; i < 32; ++i) s[i] = 0.f; }
    const int T = sample ? DS : SEQ, row0 = sample ? MP + b * DS : b * SEQ;
    for (int t0 = 0; t0 < T; t0 += 16) {
        const int nt = min(16, T - t0);
        __syncthreads();
#pragma unroll
        for (int r = 0; r < 12; ++r) { const int e = tid + 512 * r, tok = e / 384, w = e - tok * 384, typ = w >> 7, d = w & 127;
            if (tok < nt) sm[typ * 2048 + tok * 128 + d] = V_BQKV[(size_t)(row0 + t0 + tok) * 1536 + typ * 512 + h * 128 + d]; }
        if (tid < 32) { const int tok = tid >> 1, wh = tid & 1; if (tok < nt) bgs[tok * 2 + wh] = V_BG[(size_t)(row0 + t0 + tok) * 8 + wh * 4 + h]; }
        __syncthreads();
        for (int tt = 0; tt < nt; ++tt) {
            const LAS float* kk = ks + tt * 128 + 32 * qr; const LAS float* qq = qs + tt * 128 + 32 * qr;
            float a = 0.f;
#pragma unroll
            for (int i = 0; i < 32; ++i) a += kk[i] * s[i];
            pa[qr * 128 + c] = a;
            __syncthreads();
            const float kS = (pa[c] + pa[128 + c]) + (pa[256 + c] + pa[384 + c]);
            const float e = __expf(bgs[tt * 2 + 1]), be = bgs[tt * 2];
            const float vn = be * (vs[tt * 128 + c] - e * kS);
            float o = 0.f;
#pragma unroll
            for (int i = 0; i < 32; ++i) { s[i] = e * s[i] + kk[i] * vn; o += qq[i] * s[i]; }
            pb[qr * 128 + c] = o;
            __syncthreads();
            if (qr == 0) V_OBR[(size_t)(row0 + t0 + tt) * 512 + h * 128 + c] = (pb[c] + pb[128 + c]) + (pb[256 + c] + pb[384 + c]);
        }
    }
    float* So = F.out + (sample ? O_BSS + ((size_t)(l * DB + b) * 4 + h) * 16384 : O_BSP + ((size_t)(l * BATCH + b) * 4 + h) * 16384);
#pragma unroll
    for (int i = 0; i < 32; ++i) So[(32 * qr + i) * 128 + c] = s[i];
    __syncthreads();
}
__device__ __forceinline__ void ret_item(Ctx& F, int l, bool sample, int b, int h) {
    LAS float* sm = (LAS float*)F.lds;
    LAS float* qs = sm, *ks = sm + 1024, *vs = sm + 2048, *pp = sm + 4096;
    const int tid = F.tid, c = tid & 127, qr = tid >> 7;
    const float gam = 1.f - exp2f(-5.f - (float)h);
    float r[16];
    if (sample) { const float* R0 = F.in[7] + ((size_t)(l * DB + b) * 4 + h) * 8192;
#pragma unroll
        for (int i = 0; i < 16; ++i) r[i] = R0[(16 * qr + i) * 128 + c]; }
    else {
#pragma unroll
        for (int i = 0; i < 16; ++i) r[i] = 0.f; }
    const int T = sample ? DS : SEQ, row0 = sample ? MP + b * DS : b * SEQ;
    for (int t0 = 0; t0 < T; t0 += 16) {
        const int nt = min(16, T - t0);
        __syncthreads();
#pragma unroll
        for (int rr = 0; rr < 4; ++rr) { const int e = tid + 512 * rr, tok = e >> 7, w = e & 127, typ = w >> 6, d = w & 63;
            if (tok < nt) sm[typ * 1024 + tok * 64 + d] = V_CQK[(size_t)(row0 + t0 + tok) * 512 + typ * 256 + h * 64 + d]; }
#pragma unroll
        for (int rr = 0; rr < 4; ++rr) { const int e = tid + 512 * rr, tok = e >> 7, d = e & 127;
            if (tok < nt) vs[tok * 128 + d] = bf1(V_PROJ[(size_t)(row0 + t0 + tok) * NPROJ + PC_CV + h * 128 + d]); }
        __syncthreads();
        for (int tt = 0; tt < nt; ++tt) {
            const LAS float* kk = ks + tt * 64 + 16 * qr; const LAS float* qq = qs + tt * 64 + 16 * qr;
            const float v = vs[tt * 128 + c];
            float o = 0.f;
#pragma unroll
            for (int i = 0; i < 16; ++i) { r[i] = gam * r[i] + kk[i] * v; o += qq[i] * r[i]; }
            LAS float* pq = pp + (tt & 1) * 512;
            pq[qr * 128 + c] = o;
            __syncthreads();
            if (qr == 0) V_OCR[(size_t)(row0 + t0 + tt) * 512 + h * 128 + c] = (pq[c] + pq[128 + c]) + (pq[256 + c] + pq[384 + c]);
        }
    }
    float* Ro = F.out + (sample ? O_CRS + ((size_t)(l * DB + b) * 4 + h) * 8192 : O_CRP + ((size_t)(l * BATCH + b) * 4 + h) * 8192);
#pragma unroll
    for (int i = 0; i < 16; ++i) Ro[(16 * qr + i) * 128 + c] = r[i];
    __syncthreads();
}
constexpr int IT_DP = 0, IT_RP = 16, IT_ATS = 32, IT_DS = IT_ATS + 384, IT_RS = IT_DS + 128, IT_AT = IT_RS + 128, IT_END = IT_AT + 1536;
__device__ __forceinline__ void phase_mix(Ctx& F, int l, int rep) {
    volatile LAS int* slot = (volatile LAS int*)(F.lds + LDS_BYTES - 64);
    unsigned* ctr = V_CTL + (l == 0 ? CW_MIX0 : CW_MIX1) + 256 * rep;
    for (;;) {
        __syncthreads();
        if (F.tid == 0) *slot = (int)atomicAdd(ctr, 1u);
        __syncthreads();
        const int it = __builtin_amdgcn_readfirstlane(*slot);
        { int t_ = F.tid; asm volatile("" : "+v"(t_)); F.tid = t_; F.lane = t_ & 63; }
        if (it >= IT_END) break;
#ifndef MIXSEL
#define MIXSEL 15
#endif
        if (it < IT_RP) delta_scan2_item(F, l, it >> 2, it & 3);
        else if (it < IT_ATS) ret_scan_item(F, l, (it - IT_RP) >> 2, (it - IT_RP) & 3);
        else if (it < IT_DS) { const int u = (it - IT_ATS) * 8 + F.wave; attn_sample_unit(F, l, u / 12, (u % 12) & 3, (u % 12) >> 2); }
        else if (it < IT_RS) delta_item(F, l, true, (it - IT_DS) >> 2, (it - IT_DS) & 3);
        else if (it < IT_AT) ret_item(F, l, true, (it - IT_RS) >> 2, (it - IT_RS) & 3);
        else attn_mfma_item(F, it - IT_AT);
    }
}
__device__ __forceinline__ void fin_row(Ctx& F, int l, int row) {
    const int lane = F.lane, h = lane >> 4, j8 = 8 * (lane & 15);
    {
        const float l0 = V_LSE[((size_t)0 * M + row) * 4 + h], l1 = V_LSE[((size_t)1 * M + row) * 4 + h], l2 = V_LSE[((size_t)2 * M + row) * 4 + h];
        const u32x4 a0 = *(const u32x4*)(V_AO + ((size_t)0 * M + row) * 512 + h * 128 + j8), a1 = *(const u32x4*)(V_AO + ((size_t)1 * M + row) * 512 + h * 128 + j8), a2 = *(const u32x4*)(V_AO + ((size_t)2 * M + row) * 512 + h * 128 + j8);
        const float mm = fmaxf(l0, fmaxf(l1, l2)); float e0 = __expf(l0 - mm), e1 = __expf(l1 - mm), e2 = __expf(l2 - mm); const float iv = 1.f / (e0 + e1 + e2); e0 *= iv; e1 *= iv; e2 *= iv;
        u32x4 o;
        o.x = cvt_pk_bf16(e0 * bf_lo(a0.x) + e1 * bf_lo(a1.x) + e2 * bf_lo(a2.x), e0 * bf_hi(a0.x) + e1 * bf_hi(a1.x) + e2 * bf_hi(a2.x));
        o.y = cvt_pk_bf16(e0 * bf_lo(a0.y) + e1 * bf_lo(a1.y) + e2 * bf_lo(a2.y), e0 * bf_hi(a0.y) + e1 * bf_hi(a1.y) + e2 * bf_hi(a2.y));
        o.z = cvt_pk_bf16(e0 * bf_lo(a0.z) + e1 * bf_lo(a1.z) + e2 * bf_lo(a2.z), e0 * bf_hi(a0.z) + e1 * bf_hi(a1.z) + e2 * bf_hi(a2.z));
        o.w = cvt_pk_bf16(e0 * bf_lo(a0.w) + e1 * bf_lo(a1.w) + e2 * bf_lo(a2.w), e0 * bf_hi(a0.w) + e1 * bf_hi(a1.w) + e2 * bf_hi(a2.w));
        *(u32x4*)(V_OABC + (size_t)row * 512 + h * 128 + j8) = o;
    }
#pragma unroll
    for (int br = 0; br < 2; ++br) {
        if (br == 0 && row < MP) continue;
        const float* src = (br == 0 ? V_OBR : V_OCR) + (size_t)row * 512 + h * 128 + j8;
        const f32x4 x0 = *(const f32x4*)src, x1 = *(const f32x4*)(src + 4);
        const float* gn = F.in[15 + br] + l * 128 + j8;
        const f32x4 g0 = *(const f32x4*)gn, g1 = *(const f32x4*)(gn + 4);
        const u32x4 zz = *(const u32x4*)(V_PROJ + (size_t)row * NPROJ + (br == 0 ? PC_BZ : PC_CZ) + h * 128 + j8);
        const float ss = row_sum16((x0[0] * x0[0] + x0[1] * x0[1]) + (x0[2] * x0[2] + x0[3] * x0[3]) + (x1[0] * x1[0] + x1[1] * x1[1]) + (x1[2] * x1[2] + x1[3] * x1[3]));
        const float rstd = rsqrtf(ss * (1.f / 128.f) + EPS);
        const float z0 = bf_lo(zz.x), z1 = bf_hi(zz.x), z2 = bf_lo(zz.y), z3 = bf_hi(zz.y), z4 = bf_lo(zz.z), z5 = bf_hi(zz.z), z6 = bf_lo(zz.w), z7 = bf_hi(zz.w);
        u32x4 o;
        o.x = cvt_pk_bf16(x0[0] * rstd * g0[0] * z0 * sigmoidf_(z0), x0[1] * rstd * g0[1] * z1 * sigmoidf_(z1));
        o.y = cvt_pk_bf16(x0[2] * rstd * g0[2] * z2 * sigmoidf_(z2), x0[3] * rstd * g0[3] * z3 * sigmoidf_(z3));
        o.z = cvt_pk_bf16(x1[0] * rstd * g1[0] * z4 * sigmoidf_(z4), x1[1] * rstd * g1[1] * z5 * sigmoidf_(z5));
        o.w = cvt_pk_bf16(x1[2] * rstd * g1[2] * z6 * sigmoidf_(z6), x1[3] * rstd * g1[3] * z7 * sigmoidf_(z7));
        *(u32x4*)(V_OABC + (size_t)(1 + br) * M * 512 + (size_t)row * 512 + h * 128 + j8) = o;
    }
}

typedef float f32x16 __attribute__((ext_vector_type(16)));
template <int NSUB, bool GATED>
__device__ __forceinline__ void mini_gemm_core(Ctx& F, int tile, const bf16_t* A, size_t a_sub, const bf16_t* Bt, size_t b_sub, int K, float (&res)[2], int& orow, int& ocol, int (&oreg)[2]) {
    const int lane = F.lane, w = F.wave, r = lane & 31, hh = lane >> 5;
    const int rb = tile & 7, cb = tile >> 3;
    const int kw = K >> 3, k0 = w * kw;
    f32x16 tot;
#pragma unroll
    for (int i = 0; i < 16; ++i) tot[i] = 0.f;
#pragma unroll 1
    for (int sub = 0; sub < NSUB; ++sub) {
        const bf16_t* ap = A + sub * a_sub + (size_t)(MP + rb * 32 + r) * K + k0 + 8 * hh;
        const bf16_t* bp = Bt + sub * b_sub + (size_t)(cb * 32 + r) * K + k0 + 8 * hh;
        f32x16 acc;
#pragma unroll
        for (int i = 0; i < 16; ++i) acc[i] = 0.f;
#pragma unroll 2
        for (int s2 = 0; s2 < kw; s2 += 16) acc = __builtin_amdgcn_mfma_f32_32x32x16_bf16(*(const bf16x8*)(ap + s2), *(const bf16x8*)(bp + s2), acc, 0, 0, 0);
        if (GATED) {
            const bf16_t* gp = V_PROJ + (size_t)(MP + rb * 32 + 4 * hh) * NPROJ + PC_GATE + sub * 1024 + cb * 32 + r;
#pragma unroll
            for (int i = 0; i < 16; ++i) tot[i] += bf1(gp[(size_t)((i & 3) + 8 * (i >> 2)) * NPROJ]) * acc[i];
        } else tot = acc;
    }
    LAS float* red = (LAS float*)F.lds;
#pragma unroll
    for (int i = 0; i < 16; ++i) red[(w * 16 + i) * 64 + lane] = tot[i];
    __syncthreads();
    const int g = F.tid >> 6;
#pragma unroll
    for (int q = 0; q < 2; ++q) { const int rg = 2 * g + q; float v = 0.f;
#pragma unroll
        for (int ww = 0; ww < 8; ++ww) v += red[(ww * 16 + rg) * 64 + lane];
        res[q] = v; oreg[q] = rg; }
    orow = MP + rb * 32 + 4 * hh; ocol = cb * 32 + r;
    __syncthreads();
}
__device__ __forceinline__ void mini_abc(Ctx& F, int l) {
    for (int tile = F.bid; tile < 256; tile += F.G) {
    float res[2]; int orow, ocol, oreg[2];
    mini_gemm_core<3, true>(F, tile, V_OABC, (size_t)M * 512, V_WABC + (size_t)l * 3 * D * 512, (size_t)D * 512, 512, res, orow, ocol, oreg);
#pragma unroll
    for (int q = 0; q < 2; ++q) { const int row = orow + (oreg[q] & 3) + 8 * (oreg[q] >> 2);
        V_MRG[(size_t)row * D + ocol] = (bf16_t)(cvt_pk_bf16(res[q], 0.f) & 0xffffu); }
    }
}
__device__ __forceinline__ void mini_res(Ctx& F, const bf16_t* A, const bf16_t* Bt, int K, const float* resid  , const bf16_t* resb  , float* out, bf16_t* xb, float* rowss) {
    for (int tile = F.bid; tile < 256; tile += F.G) {
    float res[2]; int orow, ocol, oreg[2];
    mini_gemm_core<1, false>(F, tile, A, 0, Bt, 0, K, res, orow, ocol, oreg);
#pragma unroll
    for (int q = 0; q < 2; ++q) { const int row = orow + (oreg[q] & 3) + 8 * (oreg[q] >> 2);
        const float o = (resb ? bf1(resb[(size_t)row * D + ocol]) : resid[(size_t)(row - MP) * D + ocol]) + res[q];
        if (out) out[(size_t)row * D + ocol] = o; else xb[(size_t)row * D + ocol] = (bf16_t)(cvt_pk_bf16(o, 0.f) & 0xffffu);
        float ss = o * o;
        ss = row_sum16(ss); ss += __shfl_xor(ss, 16);
        if ((F.lane & 31) == 0) atomicAdd(rowss + row, ss); }
    }
}
constexpr int N_PHASES = 1 + 8 * DEPTH;
__global__ void __launch_bounds__(NTHREADS, 2) mega_fwd(Args args) {
    extern __shared__ __attribute__((aligned(16))) unsigned char lds_raw[];
    Ctx F;
    F.in = nullptr; F.out = nullptr; F.ws = nullptr; F.tid = 0; F.lane = 0; F.wave = 0;
    F.lds = (LAS unsigned char*)lds_raw;
    F.G = gridDim.x; F.bid = blockIdx.x;
    volatile LAS unsigned* bst = (volatile LAS unsigned*)(F.lds + LDS_BYTES - 128);
    if (threadIdx.x < 2) bst[threadIdx.x] = 0u;
    __syncthreads();
    (void)xcd_barrier_post((unsigned*)(args.ws + WS_CTL) + CW_BAR, bst);
#define XBAR() do { XcdBarrier xb_; xb_.bar = (unsigned*)(F.ws + WS_CTL) + CW_BAR; xb_.x = xb_xcc_id(); xb_.st = (volatile LAS unsigned*)(F.lds + LDS_BYTES - 128); xcd_barrier(xb_); } while (0)
    int ph0 = args.ph_lo;
    if (ph0 == 0) {
        { int tid_ = threadIdx.x; asm volatile("" : "+v"(tid_)); F.tid = tid_; F.lane = tid_ & 63; F.wave = __builtin_amdgcn_readfirstlane(tid_ >> 6);
          const __attribute__((address_space(4))) char* ka = (const __attribute__((address_space(4))) char*)__builtin_amdgcn_kernarg_segment_ptr(); asm volatile("" : "+s"(ka));
          F.in = (const float* const __attribute__((address_space(4)))*)ka; F.out = *(float* const __attribute__((address_space(4)))*)(ka + 192); F.ws = *(unsigned char* const __attribute__((address_space(4)))*)(ka + 200); }
        const int gw = F.bid * NWAVES + F.wave, NGW = F.G * NWAVES;
        if (PH_MASK & 1) phase_prep(F);
        if (DUP_K == 8) { cg::this_grid().sync(); phase_prep(F); }
        if (DUP_K == 9) { for (int q_ = 0; q_ < 32; ++q_) XBAR(); }
        ph0 = 1;
        if (args.ph_hi > 1000000) cg::this_grid().sync();
        if (ph0 < args.ph_hi) XBAR();
    }
    for (int ph = ph0, rep = 0; ph < args.ph_hi; ++ph) {
        { int tid_ = threadIdx.x; asm volatile("" : "+v"(tid_)); F.tid = tid_; F.lane = tid_ & 63; F.wave = __builtin_amdgcn_readfirstlane(tid_ >> 6);
          const __attribute__((address_space(4))) char* ka = (const __attribute__((address_space(4))) char*)__builtin_amdgcn_kernarg_segment_ptr(); asm volatile("" : "+s"(ka));
          F.in = (const float* const __attribute__((address_space(4)))*)ka; F.out = *(float* const __attribute__((address_space(4)))*)(ka + 192); F.ws = *(unsigned char* const __attribute__((address_space(4)))*)(ka + 200); }
        const int gw = F.bid * NWAVES + F.wave, NGW = F.G * NWAVES;
        {
            const int l = (ph - 1) >> 3, k = (ph - 1) & 7;
            if (k == 0 && (PH_MASK & 2)) {
                pg8::Gemm g{V_XBA, V_WIN + (size_t)l * NPROJ * D, D}; pg8::Order<1> S; S.init(M / 256, NPROJ / 256, F.G, F.bid);
                EpiProj E{V_PROJ, V_RS + (size_t)(2 * l) * M};
                pg8::gemm_phase(F.lds, F.tid, g, S, E);
            } else if (k == 1 && (PH_MASK & 4)) {
                {
                    const bool sq = !(DUP_K == 1 && rep == 0);
                    int row = gw;
                    for (; row + 2 * NGW < M; row += 3 * NGW) { const int rr[3] = {row, row + NGW, row + 2 * NGW}; e1_partA<3>(F, l, rr, sq); }
                    for (; row < M; row += NGW) { const int rr[1] = {row}; e1_partA<1>(F, l, rr, sq); }
                    for (int r2 = gw; r2 < M; r2 += NGW) if (r2 >= MP || (r2 & 4095) >= SEQ - 3) e1_row(F, l, r2);
                }
                __syncthreads();
                for (int it = F.bid; it < NCH; it += F.G) delta_prep_item(F, l, it);
                for (int it = F.bid; it < NCH / 4; it += F.G) ret_prep_item(F, l, it);
            } else if (k == 2 && (PH_MASK & 8)) {
                phase_mix(F, l, rep);
            } else if (k == 3 && (PH_MASK & 16)) {
                for (int row = gw; row < M; row += NGW) fin_row(F, l, row);
                __syncthreads();
                for (int it = F.bid; it < NCH; it += F.G) delta_out_item(F, l, it);
            } else if (k == 4 && (PH_MASK & 32)) {
                mini_abc(F, l);
                pg8::Gemm g{V_OABC, V_WABC + (size_t)l * 3 * D * 512, 512}; pg8::Order<3> S; S.init(MP / 256, D / 256, F.G, F.bid); S.sub_m = M / 256;
                EpiAbc E{V_PROJ, V_MRG};
                pg8::gemm_phase(F.lds, F.tid, g, S, E);
            } else if (k == 5 && (PH_MASK & 64)) {
                mini_res(F, V_MRG, V_WOUT + (size_t)l * D * D, D, l == 0 ? F.in[1] : nullptr, l == 0 ? nullptr : V_XBA, nullptr, V_XBB, V_RS + (size_t)(2 * l + 1) * M);
                pg8::Gemm g{V_MRG, V_WOUT + (size_t)l * D * D, D}; pg8::Order<1> S; S.init(MP / 256, D / 256, F.G, F.bid);
                EpiRes E{F.in[0], F.in[1], l == 0 ? nullptr : V_XBA, nullptr, V_XBB, V_RS + (size_t)(2 * l + 1) * M};
                pg8::gemm_phase(F.lds, F.tid, g, S, E);
            } else if (k == 6 && (PH_MASK & 128)) {
                pg8::Gemm g{V_XBB, V_WFI + (size_t)l * 2 * DFF * D, D}; pg8::Order<1> S; S.init(M / 256, 2 * DFF / 256, F.G, F.bid);
                EpiFfn E{V_ACT, V_RS + (size_t)(2 * l + 1) * M};
                pg8::gemm_phase(F.lds, F.tid, g, S, E);
            } else if (k == 7 && (PH_MASK & 256)) {
                mini_res(F, V_ACT, V_WFO + (size_t)l * D * DFF, DFF, nullptr, V_XBB, l == DEPTH - 1 ? F.out : nullptr, V_XBA, V_RS + (size_t)(l == DEPTH - 1 ? 3 : 2) * M);
                pg8::Gemm g{V_ACT, V_WFO + (size_t)l * D * DFF, DFF}; pg8::Order<1> S; S.init(MP / 256, D / 256, F.G, F.bid);
                EpiRes E{nullptr, nullptr, V_XBB, l == DEPTH - 1 ? F.out : nullptr, V_XBA, V_RS + (size_t)(l == DEPTH - 1 ? 3 : 2) * M};
                pg8::gemm_phase(F.lds, F.tid, g, S, E);
            }
        }
        if (DUP_K >= 0 && ((ph - 1) & 7) == DUP_K && rep == 0) { rep = 1; --ph; XBAR(); continue; }
        rep = 0;
        if (ph + 1 < args.ph_hi) XBAR();
    }
}

extern "C" void kernel_launch(void* const* d_in, const int* in_sizes, int n_in, void* d_out, int out_size, void* d_ws, size_t ws_size, hipStream_t stream) {
    static int grid = 0;
    if (grid == 0) {
        if (n_in != 24 || (size_t)out_size != O_END || ws_size < WS_END) { fprintf(stderr, "kernel_launch: unexpected shapes (n_in %d out %d ws %zu, need %zu / %zu)\n", n_in, out_size, ws_size, (size_t)O_END, (size_t)WS_END); grid = -1; return; }
        int dev = 0, cus = 0, per_cu = 0;
        if (hipGetDevice(&dev) != hipSuccess || hipDeviceGetAttribute(&cus, hipDeviceAttributeMultiprocessorCount, dev) != hipSuccess) { grid = -1; return; }
        if (hipFuncSetAttribute((const void*)mega_fwd, hipFuncAttributeMaxDynamicSharedMemorySize, LDS_BYTES) != hipSuccess) { fprintf(stderr, "kernel_launch: hipFuncSetAttribute failed\n"); grid = -1; return; }
        if (hipOccupancyMaxActiveBlocksPerMultiprocessor(&per_cu, (const void*)mega_fwd, NTHREADS, LDS_BYTES) != hipSuccess || per_cu < 1) { fprintf(stderr, "kernel_launch: occupancy query says %d\n", per_cu); per_cu = 1; }
        (void)hipGetLastError();
        grid = cus;
    }
    if (grid < 0) return;
    (void)hipMemsetAsync((char*)d_ws + WS_CTL, 0, 32768, stream);
    Args a{};
    for (int i = 0; i < 24; ++i) a.in[i] = (const float*)d_in[i];
    a.out = (float*)d_out; a.ws = (unsigned char*)d_ws;
#if MK_ONE_LAUNCH
    a.ph_lo = 0; a.ph_hi = N_PHASES;
    void* kargs[] = {&a};
    hipError_t e = hipLaunchCooperativeKernel((const void*)mega_fwd, dim3(grid), dim3(NTHREADS), kargs, LDS_BYTES, stream);
    if (e != hipSuccess) fprintf(stderr, "cooperative launch failed: %s (grid %d)\n", hipGetErrorString(e), grid);
#else
    for (int ph = 0; ph < N_PHASES; ++ph) {
        a.ph_lo = ph; a.ph_hi = ph + 1;
        hipLaunchKernelGGL(mega_fwd, dim3(grid), dim3(NTHREADS), LDS_BYTES, stream, a);
    }
#endif
}
```

```cpp
#include <hip/hip_runtime.h>
#include <hip/hip_cooperative_groups.h>
#include <cstdio>
#include <cstdint>
namespace cg = cooperative_groups;

#ifndef DUP_K
#define DUP_K -1
#endif
#ifndef PH_MASK
#define PH_MASK 0x1ff
#endif
#ifndef MK_ONE_LAUNCH
#define MK_ONE_LAUNCH 1
#endif

#define LAS __attribute__((address_space(3)))
typedef unsigned short bf16_t;
typedef short bf16x8 __attribute__((ext_vector_type(8)));
typedef float f32x4 __attribute__((ext_vector_type(4)));
typedef float f32x2 __attribute__((ext_vector_type(2)));
typedef unsigned u32x4 __attribute__((ext_vector_type(4)));
typedef unsigned u32x2 __attribute__((ext_vector_type(2)));

constexpr int D = 1024, BATCH = 4, SEQ = 4096, DEPTH = 2, DB = 32, DS = 8, PAST = 8192;
constexpr int MP = BATCH * SEQ, MS = DB * DS, M = MP + MS;
constexpr int NIN = 11272, NPROJ = 11520, DFF = 2816;
constexpr int PC_AQ = 0, PC_AK = 1536, PC_AV = 3072, PC_BQKV = 4608, PC_BZ = 6144, PC_CQ = 6656, PC_CK = 6912, PC_CV = 7168, PC_CZ = 7680, PC_GATE = 8192, PC_BETA = 11264, PC_BA = 11268;
constexpr float EPS = 1e-6f;
constexpr int NPOS = SEQ + DS;

constexpr size_t O_YP = 0;
constexpr size_t O_YS = O_YP + (size_t)MP * D;
constexpr size_t O_KV0P = O_YS + (size_t)MS * D;
constexpr size_t O_KV1P = O_KV0P + (size_t)DEPTH * BATCH * 128 * 1024;
constexpr size_t O_KV2P = O_KV1P + (size_t)DEPTH * BATCH * 512 * 1024;
constexpr size_t O_BCP = O_KV2P + (size_t)DEPTH * BATCH * 2048 * 1024;
constexpr size_t O_BSP = O_BCP + (size_t)DEPTH * BATCH * 3 * 1536;
constexpr size_t O_CRP = O_BSP + (size_t)DEPTH * BATCH * 4 * 128 * 128;
constexpr size_t O_KV0S = O_CRP + (size_t)DEPTH * BATCH * 4 * 64 * 128;
constexpr size_t O_KV1S = O_KV0S + (size_t)DEPTH * DB * DS * 1024;
constexpr size_t O_KV2S = O_KV1S + (size_t)DEPTH * DB * DS * 1024;
constexpr size_t O_BCS = O_KV2S + (size_t)DEPTH * DB * DS * 1024;
constexpr size_t O_BSS = O_BCS + (size_t)DEPTH * DB * 3 * 1536;
constexpr size_t O_CRS = O_BSS + (size_t)DEPTH * DB * 4 * 128 * 128;
constexpr size_t O_END = O_CRS + (size_t)DEPTH * DB * 4 * 64 * 128;

constexpr size_t al256(size_t x) { return (x + 255) & ~(size_t)255; }
constexpr size_t WS_CTL = 0, CTL_BYTES = 1u << 20;
constexpr size_t WS_WIN = WS_CTL + CTL_BYTES;
constexpr size_t WS_WABC = WS_WIN + al256((size_t)DEPTH * NPROJ * D * 2);
constexpr size_t WS_WOUT = WS_WABC + al256((size_t)DEPTH * 3 * D * 512 * 2);
constexpr size_t WS_WFI = WS_WOUT + al256((size_t)DEPTH * D * D * 2);
constexpr size_t WS_WFO = WS_WFI + al256((size_t)DEPTH * 2 * DFF * D * 2);
constexpr size_t WS_XBA = WS_WFO + al256((size_t)DEPTH * D * DFF * 2);
constexpr size_t WS_XBB = WS_XBA + al256((size_t)M * D * 2);
constexpr size_t WS_X1 = WS_XBB + al256((size_t)M * D * 2);
constexpr size_t WS_X2 = WS_X1 + al256((size_t)M * D * 4);
constexpr size_t WS_RS = WS_X2 + al256((size_t)M * D * 4);
constexpr size_t WS_PROJ = WS_RS + al256((size_t)4 * M * 4);
constexpr size_t WS_BQKV = WS_PROJ + al256((size_t)M * NPROJ * 2);
constexpr size_t WS_BG = WS_BQKV + al256((size_t)M * 1536 * 4);
constexpr size_t WS_CQK = WS_BG + al256((size_t)M * 8 * 4);
constexpr size_t WS_OBR = WS_CQK + al256((size_t)M * 512 * 4);
constexpr size_t WS_OCR = WS_OBR + al256((size_t)M * 512 * 4);
constexpr size_t WS_OABC = WS_OCR + al256((size_t)M * 512 * 4);
constexpr size_t WS_MRG = WS_OABC + al256((size_t)3 * M * 512 * 2);
constexpr size_t WS_ACT = WS_MRG + al256((size_t)M * D * 2);
constexpr size_t WS_ROPEA = WS_ACT + al256((size_t)M * DFF * 2);
constexpr size_t WS_ROPEC = WS_ROPEA + al256((size_t)NPOS * 64 * 2 * 4);
constexpr size_t WS_AO = WS_ROPEC + al256((size_t)NPOS * 32 * 2 * 4);
constexpr size_t WS_LSE = WS_AO + al256((size_t)3 * M * 512 * 2);
constexpr int NCH = BATCH * 4 * 64;
constexpr size_t WS_DW = WS_LSE + al256((size_t)3 * M * 4 * 4);
constexpr size_t WS_DQG = WS_DW + al256((size_t)NCH * 64 * 128 * 2);
constexpr size_t WS_DKT = WS_DQG + al256((size_t)NCH * 64 * 128 * 2);
constexpr size_t WS_DAT = WS_DKT + al256((size_t)NCH * 64 * 128 * 2);
constexpr size_t WS_DU = WS_DAT + al256((size_t)NCH * 64 * 64 * 2);
constexpr size_t WS_DDL = WS_DU + al256((size_t)NCH * 64 * 128 * 4);
constexpr size_t WS_RQG = WS_DDL + al256((size_t)NCH * 4);
constexpr size_t WS_RKT = WS_RQG + al256((size_t)NCH * 64 * 64 * 2);
constexpr size_t WS_RAT = WS_RKT + al256((size_t)NCH * 64 * 64 * 2);
constexpr size_t WS_RU = WS_RAT + al256((size_t)NCH * 64 * 64 * 2);
constexpr size_t WS_SB = WS_RU + al256((size_t)NCH * 64 * 128 * 4);
constexpr size_t WS_VB = WS_SB + al256((size_t)NCH * 16384 * 2);
constexpr size_t WS_END = WS_VB + al256((size_t)NCH * 8192 * 2);
constexpr int CW_MIX0 = 64, CW_MIX1 = 128, CW_BAR = 1024;

constexpr int NWAVES = 8, NTHREADS = 512;
constexpr int RING_BYTES = 131072, LDS_BYTES = 147456;

__device__ __forceinline__ float bf_lo(unsigned u) { return __uint_as_float(u << 16); }
__device__ __forceinline__ float bf_hi(unsigned u) { return __uint_as_float(u & 0xffff0000u); }
__device__ __forceinline__ float bf1(bf16_t u) { return __uint_as_float(((unsigned)u) << 16); }
typedef __bf16 bf16x2_t __attribute__((ext_vector_type(2)));
__device__ __forceinline__ unsigned cvt_pk_bf16(float lo, float hi) { const f32x2 f = {lo, hi}; const bf16x2_t v = __builtin_convertvector(f, bf16x2_t); return __builtin_bit_cast(unsigned, v); }
template <int CTRL> __device__ __forceinline__ float dpp_mov(float v) { return __int_as_float(__builtin_amdgcn_update_dpp(0, __float_as_int(v), CTRL, 0xf, 0xf, true)); }
__device__ __forceinline__ float rdlane(float v, int l) { return __int_as_float(__builtin_amdgcn_readlane(__float_as_int(v), l)); }
__device__ __forceinline__ float row_sum16(float v) { v += dpp_mov<0xB1>(v); v += dpp_mov<0x4E>(v); v += dpp_mov<0x141>(v); v += dpp_mov<0x140>(v); return v; }
__device__ __forceinline__ float row_max16(float v) { v = fmaxf(v, dpp_mov<0xB1>(v)); v = fmaxf(v, dpp_mov<0x4E>(v)); v = fmaxf(v, dpp_mov<0x141>(v)); v = fmaxf(v, dpp_mov<0x140>(v)); return v; }
__device__ __forceinline__ float wave_sum(float v) { v = row_sum16(v); return (rdlane(v, 0) + rdlane(v, 16)) + (rdlane(v, 32) + rdlane(v, 48)); }
__device__ __forceinline__ float wave_max(float v) { v = row_max16(v); return fmaxf(fmaxf(rdlane(v, 0), rdlane(v, 16)), fmaxf(rdlane(v, 32), rdlane(v, 48))); }
__device__ __forceinline__ float half_sum(float v) { v = row_sum16(v); return v + __shfl_xor(v, 16); }
__device__ __forceinline__ float sigmoidf_(float x) { return __builtin_amdgcn_rcpf(1.f + __expf(-x)); }

namespace pg8 {
constexpr int BM = 256, BK = 64, HALF = 128, HTB = HALF * BK * 2, NXCD = 8, WGM = 2;
__host__ __device__ __forceinline__ int lds_byte(int r, int c) { const int st = (r >> 4) * 2 + (c >> 5), rr = r & 15, cc = c & 31, ob = rr * 64 + cc * 2; return st * 1024 + (ob ^ (((ob >> 9) & 1) << 5)); }
__host__ __device__ __forceinline__ void stage_rc(int b, int& R, int& C) { const int st = b / 1024, sb = b % 1024, swz = sb ^ (((sb >> 9) & 1) << 5); R = (st >> 1) * 16 + swz / 64; C = (st & 1) * 32 + (swz % 64) / 2; }
__host__ __device__ __forceinline__ int perm32(int rho) { const int n = rho >> 4, i = rho & 15; return 8 * (i >> 2) + 4 * n + (i & 3); }

struct Unit { int pm, pn; };
struct Gemm { const bf16_t* A; const bf16_t* Bt; int K; };

template <int TRIP> struct Order {
    int nM, nN, nwg, G, c, sub_m;
    __device__ void init(int nM_, int nN_, int G_, int c_) { nM = nM_; nN = nN_; nwg = nM * nN; G = G_; c = c_; sub_m = nM_; }
    __device__ bool next(int i, Unit& u) const {
        const int ii = i / TRIP, sub = i - ii * TRIP;
        const long L = (long)ii * G + c; if (L >= nwg) return false;
        int wgid = (int)L; { const int q = nwg / NXCD, r = nwg % NXCD, xcd = wgid % NXCD, off = wgid / NXCD; wgid = (xcd < r ? xcd * (q + 1) : r * (q + 1) + (xcd - r) * q) + off; }
        const int nig = WGM * nN, gid = wgid / nig, fm = gid * WGM, gsz = (nM - fm) < WGM ? (nM - fm) : WGM;
        u.pm = fm + ((wgid % nig) % gsz) + sub * sub_m; u.pn = (wgid % nig) / gsz + sub * nN; return true;
    }
};

template <class Epi, class Sched>
__device__ __forceinline__ void gemm_phase(LAS unsigned char* lds, const int tid, const Gemm g, const Sched& S, const Epi& E) {
    const int wid = __builtin_amdgcn_readfirstlane(tid >> 6), lane = tid & 63, wr = wid >> 2, wc = wid & 3, fr = lane & 15, fq = lane >> 4;
    const int K = g.K, nt = K / BK;
    unsigned voffA[2], voffB[2];
#pragma unroll
    for (int i = 0; i < 2; ++i) { int R, C; stage_rc(tid * 16 + i * 8192, R, C); const int Rb = Epi::PERM ? ((R & ~31) + perm32(R & 31)) : R;
        voffA[i] = (unsigned)(R * K + C) * 2u; voffB[i] = (unsigned)(Rb * K + C) * 2u; }
    const size_t kstep = (size_t)(BK * 2);
    const size_t hstep = (size_t)HALF * K * 2;
    const size_t tstep = 2 * hstep;
    const unsigned ldsw = (unsigned)wid * 1024u;
    const int aoff = lds_byte(wr * 64 + fr, fq * 8), boff = lds_byte(wc * 32 + fr, fq * 8);
#define PG8_SA(b, h) (((b) * 2 + (h)) * HTB)
#define PG8_SB(b, h) ((4 + (b) * 2 + (h)) * HTB)
#define PG8_STAGE(bufoff, gbase, voff) do { _Pragma("unroll") for (int _i = 0; _i < 2; ++_i) \
        __builtin_amdgcn_global_load_lds((const unsigned*)((const char*)(gbase) + (voff)[_i]), (LAS unsigned*)(lds + (bufoff) + ldsw + _i * 8192), 16, 0, 0); } while (0)
#define PG8_LDA(dst, b, h) do { _Pragma("unroll") for (int m = 0; m < 4; ++m) _Pragma("unroll") for (int k = 0; k < 2; ++k) dst[m][k] = *(const LAS bf16x8*)(lds + PG8_SA(b, h) + aoff + m * 2048 + k * 1024); } while (0)
#define PG8_LDB(dst, b, h) do { _Pragma("unroll") for (int n = 0; n < 2; ++n) _Pragma("unroll") for (int k = 0; k < 2; ++k) dst[n][k] = *(const LAS bf16x8*)(lds + PG8_SB(b, h) + boff + n * 2048 + k * 1024); } while (0)
#define PG8_MMA(ai, bj, At, Bt) do { __builtin_amdgcn_s_setprio(1); _Pragma("unroll") for (int m = 0; m < 4; ++m) _Pragma("unroll") for (int n = 0; n < 2; ++n) _Pragma("unroll") for (int k = 0; k < 2; ++k) \
        acc[ai][bj][m][n] = __builtin_amdgcn_mfma_f32_16x16x32_bf16(Bt[n][k], At[m][k], acc[ai][bj][m][n], 0, 0, 0); __builtin_amdgcn_s_setprio(0); } while (0)
#define PG8_WAIT_V(n) asm volatile("s_waitcnt vmcnt(" #n ")" ::: "memory")
#define PG8_WAIT_L(n) asm volatile("s_waitcnt lgkmcnt(" #n ")" ::: "memory")
#define PG8_BAR __builtin_amdgcn_s_barrier()
#define PG8_SCHED __builtin_amdgcn_sched_barrier(0)
    Unit cur, nxt; int ui = 0;
    if (!S.next(0, cur)) return;
    f32x4 acc[2][2][4][2];
#pragma unroll
    for (int a = 0; a < 2; ++a)
#pragma unroll
        for (int b = 0; b < 2; ++b)
#pragma unroll
            for (int m = 0; m < 4; ++m)
#pragma unroll
                for (int n = 0; n < 2; ++n) acc[a][b][m][n] = (f32x4){0.f, 0.f, 0.f, 0.f};
    bf16x8 At[4][2], B0[2][2], B1[2][2];
    const char* cA = (const char*)g.A + (size_t)cur.pm * tstep; const char* cB = (const char*)g.Bt + (size_t)cur.pn * tstep;
    PG8_STAGE(PG8_SB(0, 0), cB, voffB); PG8_STAGE(PG8_SB(0, 1), cB + hstep, voffB); PG8_STAGE(PG8_SA(0, 0), cA, voffA); PG8_STAGE(PG8_SA(0, 1), cA + hstep, voffA);
    if (wr == 1) PG8_BAR;
    PG8_WAIT_V(2); PG8_BAR;
    PG8_STAGE(PG8_SB(1, 0), cB + kstep, voffB); PG8_STAGE(PG8_SA(1, 0), cA + kstep, voffA); PG8_STAGE(PG8_SB(1, 1), cB + hstep + kstep, voffB);
    PG8_WAIT_V(6); PG8_BAR;
    for (;;) {
        const bool has_next = S.next(ui + 1, nxt);
        const char* nA = has_next ? (const char*)g.A + (size_t)nxt.pm * tstep : cA; const char* nB = has_next ? (const char*)g.Bt + (size_t)nxt.pn * tstep : cB;
        for (int t = 0; t < nt; t += 2) {
            const bool last = (t == nt - 2);
            const char* a1 = cA + (size_t)(t + 1) * kstep;
            const char* a2 = last ? nA : cA + (size_t)(t + 2) * kstep; const char* b2 = last ? nB : cB + (size_t)(t + 2) * kstep;
            const char* a3 = a2 + kstep; const char* b3 = b2 + kstep;
            PG8_LDB(B0, 0, 0); PG8_LDB(B1, 0, 1); PG8_SCHED; PG8_LDA(At, 0, 0); PG8_STAGE(PG8_SA(1, 1), a1 + hstep, voffA);
            PG8_WAIT_V(8); PG8_WAIT_L(0); PG8_BAR; PG8_MMA(0, 0, At, B0); PG8_MMA(0, 1, At, B1); PG8_BAR; PG8_SCHED;
            PG8_LDA(At, 0, 1); PG8_STAGE(PG8_SB(0, 0), b2, voffB); PG8_STAGE(PG8_SB(0, 1), b2 + hstep, voffB); PG8_STAGE(PG8_SA(0, 0), a2, voffA);
            PG8_WAIT_V(8); PG8_WAIT_L(0); PG8_BAR; PG8_MMA(1, 0, At, B0); PG8_MMA(1, 1, At, B1); PG8_BAR; PG8_SCHED;
            PG8_LDB(B0, 1, 0); PG8_LDB(B1, 1, 1); PG8_SCHED; PG8_LDA(At, 1, 0); PG8_STAGE(PG8_SA(0, 1), a2 + hstep, voffA);
            PG8_WAIT_V(8); PG8_WAIT_L(0); PG8_BAR; PG8_MMA(0, 0, At, B0); PG8_MMA(0, 1, At, B1); PG8_BAR; PG8_SCHED;
            PG8_LDA(At, 1, 1); PG8_STAGE(PG8_SB(1, 0), b3, voffB); PG8_STAGE(PG8_SB(1, 1), b3 + hstep, voffB); PG8_STAGE(PG8_SA(1, 0), a3, voffA);
            PG8_WAIT_V(8); PG8_WAIT_L(0); PG8_BAR; PG8_MMA(1, 0, At, B0); PG8_MMA(1, 1, At, B1); PG8_BAR; PG8_SCHED;
        }
        if (wr == 0) PG8_BAR;
        E(acc, cur, wr, wc, fr, fq);
        if (!has_next) break;
        if (E.reset_after(cur)) {
#pragma unroll
            for (int a = 0; a < 2; ++a)
#pragma unroll
                for (int b = 0; b < 2; ++b)
#pragma unroll
                    for (int m = 0; m < 4; ++m)
#pragma unroll
                        for (int n = 0; n < 2; ++n) acc[a][b][m][n] = (f32x4){0.f, 0.f, 0.f, 0.f};
        }
        cur = nxt; cA = nA; cB = nB; ++ui;
        if (wr == 1) PG8_BAR;
    }
    PG8_WAIT_V(0);
    PG8_BAR;
#undef PG8_SA
#undef PG8_SB
#undef PG8_STAGE
#undef PG8_LDA
#undef PG8_LDB
#undef PG8_MMA
#undef PG8_WAIT_V
#undef PG8_WAIT_L
#undef PG8_BAR
#undef PG8_SCHED
}
}
using pg8::Unit;

struct EpiProj {
    static constexpr bool PERM = true;
    bf16_t* O; const float* rowss;
    __device__ __forceinline__ bool reset_after(const Unit&) const { return true; }
    __device__ __forceinline__ void operator()(f32x4 (&acc)[2][2][4][2], const Unit& u, int wr, int wc, int fr, int fq) const {
        const int row0 = u.pm * 256 + wr * 64 + fr, col0 = u.pn * 256 + wc * 32 + 8 * fq;
        const bool gate = (u.pn >= 32 && u.pn < 44);
#pragma unroll
        for (int ai = 0; ai < 2; ++ai)
#pragma unroll
            for (int m = 0; m < 4; ++m) {
                const int row = row0 + ai * 128 + m * 16;
                const float rs = rsqrtf(rowss[row] * (1.f / 1024.f) + EPS);
                bf16_t* rowp = O + (size_t)row * NPROJ + col0;
#pragma unroll
                for (int bj = 0; bj < 2; ++bj) {
                    f32x4 v0 = acc[ai][bj][m][0] * rs, v1 = acc[ai][bj][m][1] * rs;
                    if (gate) {
#pragma unroll
                        for (int j = 0; j < 4; ++j) { v0[j] = sigmoidf_(v0[j]); v1[j] = sigmoidf_(v1[j]); }
                    }
                    u32x4 w; w.x = cvt_pk_bf16(v0[0], v0[1]); w.y = cvt_pk_bf16(v0[2], v0[3]); w.z = cvt_pk_bf16(v1[0], v1[1]); w.w = cvt_pk_bf16(v1[2], v1[3]);
                    *(u32x4*)(rowp + bj * 128) = w;
                }
            }
    }
};
struct EpiAbc {
    static constexpr bool PERM = true;
    const bf16_t* G; bf16_t* O;
    __device__ __forceinline__ bool reset_after(const Unit& u) const { return (u.pn >> 2) == 2; }
    __device__ __forceinline__ void operator()(f32x4 (&acc)[2][2][4][2], const Unit& u, int wr, int wc, int fr, int fq) const {
        const int sub = u.pn >> 2, pn = u.pn & 3, pm = u.pm - sub * 65;
        const int row0 = pm * 256 + wr * 64 + fr, col0 = pn * 256 + wc * 32 + 8 * fq;
#pragma unroll
        for (int ai = 0; ai < 2; ++ai)
#pragma unroll
            for (int m = 0; m < 4; ++m) {
                const int row = row0 + ai * 128 + m * 16;
                const bf16_t* gp = G + (size_t)row * NPROJ + PC_GATE + sub * 1024 + col0;
#pragma unroll
                for (int bj = 0; bj < 2; ++bj) {
                    const u32x4 ga = *(const u32x4*)(gp + bj * 128);
                    f32x4 g0 = (f32x4){bf_lo(ga.x), bf_hi(ga.x), bf_lo(ga.y), bf_hi(ga.y)}, g1 = (f32x4){bf_lo(ga.z), bf_hi(ga.z), bf_lo(ga.w), bf_hi(ga.w)};
                    if (sub < 2) {
                        const u32x4 gb = *(const u32x4*)(gp + 1024 + bj * 128);
                        const f32x4 h0 = (f32x4){bf_lo(gb.x), bf_hi(gb.x), bf_lo(gb.y), bf_hi(gb.y)}, h1 = (f32x4){bf_lo(gb.z), bf_hi(gb.z), bf_lo(gb.w), bf_hi(gb.w)};
#pragma unroll
                        for (int j = 0; j < 4; ++j) { acc[ai][bj][m][0][j] *= g0[j] * __builtin_amdgcn_rcpf(fmaxf(h0[j], 1e-30f)); acc[ai][bj][m][1][j] *= g1[j] * __builtin_amdgcn_rcpf(fmaxf(h1[j], 1e-30f)); }
                    } else {
                        const f32x4 v0 = acc[ai][bj][m][0] * g0, v1 = acc[ai][bj][m][1] * g1;
                        u32x4 w; w.x = cvt_pk_bf16(v0[0], v0[1]); w.y = cvt_pk_bf16(v0[2], v0[3]); w.z = cvt_pk_bf16(v1[0], v1[1]); w.w = cvt_pk_bf16(v1[2], v1[3]);
                        *(u32x4*)(O + (size_t)row * D + col0 + bj * 128) = w;
                    }
                }
            }
    }
};
struct EpiRes {
    static constexpr bool PERM = false;
    const float* res0; const float* res1; const bf16_t* resb; float* out; bf16_t* xb; float* rowss;
    __device__ __forceinline__ bool reset_after(const Unit&) const { return true; }
    __device__ __forceinline__ void operator()(f32x4 (&acc)[2][2][4][2], const Unit& u, int wr, int wc, int fr, int fq) const {
        const int col0 = u.pn * 256 + wc * 32 + 4 * fq;
        const float* rbase = (u.pm < 64) ? res0 + (size_t)u.pm * 256 * D : res1;
#pragma unroll
        for (int ai = 0; ai < 2; ++ai)
#pragma unroll
            for (int m = 0; m < 4; ++m) {
                const int lrow = ai * 128 + wr * 64 + m * 16 + fr; const size_t grow = (size_t)u.pm * 256 + lrow;
                float ss = 0.f;
#pragma unroll
                for (int bj = 0; bj < 2; ++bj)
#pragma unroll
                    for (int n = 0; n < 2; ++n) {
                        const int c = col0 + bj * 128 + n * 16;
                        f32x4 r4;
                        if (resb) { const u32x2 rb = *(const u32x2*)(resb + grow * D + c); r4 = (f32x4){bf_lo(rb.x), bf_hi(rb.x), bf_lo(rb.y), bf_hi(rb.y)}; }
                        else r4 = *(const f32x4*)(rbase + (size_t)lrow * D + c);
                        const f32x4 o = r4 + acc[ai][bj][m][n];
                        if (out) *(f32x4*)(out + grow * D + c) = o;
                        else { u32x2 w; w.x = cvt_pk_bf16(o[0], o[1]); w.y = cvt_pk_bf16(o[2], o[3]); *(u32x2*)(xb + grow * D + c) = w; }
                        ss += (o[0] * o[0] + o[1] * o[1]) + (o[2] * o[2] + o[3] * o[3]);
                    }
                ss += __shfl_xor(ss, 16); ss += __shfl_xor(ss, 32);
                if (fq == 0) atomicAdd(rowss + grow, ss);
                asm volatile("" ::: "memory");
            }
    }
};
struct EpiFfn {
    static constexpr bool PERM = true;
    bf16_t* O; const float* rowss;
    __device__ __forceinline__ bool reset_after(const Unit&) const { return true; }
    __device__ __forceinline__ void operator()(f32x4 (&acc)[2][2][4][2], const Unit& u, int wr, int wc, int fr, int fq) const {
        const int row0 = u.pm * 256 + wr * 64 + fr, f0 = u.pn * 128 + 16 * wc + 4 * fq;
#pragma unroll
        for (int ai = 0; ai < 2; ++ai)
#pragma unroll
            for (int m = 0; m < 4; ++m) {
                const int row = row0 + ai * 128 + m * 16;
                const float rs = rsqrtf(rowss[row] * (1.f / 1024.f) + EPS);
#pragma unroll
                for (int bj = 0; bj < 2; ++bj) {
                    const f32x4 gg = acc[ai][bj][m][0] * rs, uu = acc[ai][bj][m][1] * rs;
                    f32x4 hh;
#pragma unroll
                    for (int j = 0; j < 4; ++j) hh[j] = gg[j] * sigmoidf_(gg[j]) * uu[j];
                    u32x2 w; w.x = cvt_pk_bf16(hh[0], hh[1]); w.y = cvt_pk_bf16(hh[2], hh[3]);
                    *(u32x2*)(O + (size_t)row * DFF + f0 + bj * 64) = w;
                }
            }
    }
};

#define XB_TMO      128
#define XB_XCNT(j)  (256  + 64 * (j))
#define XB_XSUB(j)  (1280 + 64 * (j))
#define XB_XGEN(j)  (2304 + 64 * (j))
#define XB_TOP      3328
#define XB_TOPGEN   3392
#define XCD_BAR_WORDS 3456
#define XB_SPIN_CAP (1u << 18)

__device__ __forceinline__ unsigned xb_ld(unsigned* p)              { return __hip_atomic_load(p, __ATOMIC_RELAXED, __HIP_MEMORY_SCOPE_AGENT); }
__device__ __forceinline__ unsigned xb_add(unsigned* p, unsigned v) { return __hip_atomic_fetch_add(p, v, __ATOMIC_RELAXED, __HIP_MEMORY_SCOPE_AGENT); }
__device__ __forceinline__ unsigned xb_xcc_id() { return (unsigned)__builtin_amdgcn_s_getreg((3 << 11) | 20) & 0xFu; }
#define XB_SPIN(cond, bar) do { unsigned _sp = 0; while (cond) { __builtin_amdgcn_s_sleep(1); \
    if ((++_sp & 255u) == 0u) { if (xb_ld(&(bar)[XB_TMO])) break; if (_sp > XB_SPIN_CAP) { atomicAdd(&(bar)[XB_TMO], 1u); break; } } } } while (0)

struct XcdBarrier {
    unsigned* bar; unsigned x;
    volatile LAS unsigned* st;
};

__device__ __forceinline__ XcdBarrier xcd_barrier_post(unsigned* bar, volatile LAS unsigned* st) {
    XcdBarrier b; b.bar = bar; b.x = xb_xcc_id(); b.st = st;
    if (threadIdx.x == 0) (void)xb_add(&bar[XB_XCNT(b.x)], 1u);
    return b;
}
__device__ __forceinline__ void xcd_barrier_complete(unsigned* bar, unsigned x, unsigned& nloc, unsigned& nx) {
    const unsigned G = gridDim.x * gridDim.y * gridDim.z;
    unsigned sum, cnt, mine, sp = 0u;
    for (;;) {
        sum = 0u; cnt = 0u; mine = 0u;
#pragma unroll
        for (unsigned j = 0; j < 16; ++j) { const unsigned c = xb_ld(&bar[XB_XCNT(j)]); sum += c; cnt += (c > 0u) ? 1u : 0u; mine = (j == x) ? c : mine; }
        if (sum == G) break;
        __builtin_amdgcn_s_sleep(1);
        if ((++sp & 255u) == 0u) { if (xb_ld(&bar[XB_TMO])) break; if (sp > XB_SPIN_CAP) { atomicAdd(&bar[XB_TMO], 1u); break; } }
    }
    nloc = mine > 0u ? mine : 1u; nx = cnt > 0u ? cnt : 1u;
}

__device__ __forceinline__ void xcd_barrier(const XcdBarrier& b) {
    asm volatile("s_waitcnt vmcnt(0)" ::: "memory");
    __syncthreads();
    if (threadIdx.x == 0) {
        unsigned* bar = b.bar;
        __builtin_amdgcn_s_waitcnt(0);
        unsigned nloc = b.st[0], nx = b.st[1];
        if (nloc == 0u) { xcd_barrier_complete(bar, b.x, nloc, nx); b.st[0] = nloc; b.st[1] = nx; }
        const unsigned old = xb_add(&bar[XB_XSUB(b.x)], 1u);
        const unsigned gen = old / nloc;
        if (old + 1u == (gen + 1u) * nloc) {
            __builtin_amdgcn_fence(__ATOMIC_RELEASE, "agent");
            asm volatile("s_waitcnt vmcnt(0)" ::: "memory");
            const unsigned og = xb_add(&bar[XB_TOP], 1u);
            const unsigned tg = og / nx;
            if (og + 1u == (tg + 1u) * nx) xb_add(&bar[XB_TOPGEN], 1u);
            else XB_SPIN(xb_ld(&bar[XB_TOPGEN]) == tg, bar);
            __builtin_amdgcn_fence(__ATOMIC_ACQUIRE, "agent");
            xb_add(&bar[XB_XGEN(b.x)], 1u);
            asm volatile("s_waitcnt vmcnt(0)" ::: "memory");
        } else {
            XB_SPIN(xb_ld(&bar[XB_XGEN(b.x)]) == gen, bar);
            __builtin_amdgcn_fence(__ATOMIC_ACQUIRE, "agent");
            asm volatile("s_waitcnt vmcnt(0)" ::: "memory");
        }
    }
    __syncthreads();
}


struct Args { const float* in[24]; float* out; unsigned char* ws; int ph_lo, ph_hi; };
static_assert(sizeof(Args) == 216, "Args layout");
struct Ctx {
    const float* const __attribute__((address_space(4)))* in; float* out; unsigned char* ws;
    LAS unsigned char* lds; int tid, lane, wave, G, bid;
};
#define WSV(T, off) ((T*)(F.ws + (off)))
#define V_WIN WSV(bf16_t, WS_WIN)
#define V_WABC WSV(bf16_t, WS_WABC)
#define V_WOUT WSV(bf16_t, WS_WOUT)
#define V_WFI WSV(bf16_t, WS_WFI)
#define V_WFO WSV(bf16_t, WS_WFO)
#define V_XBA WSV(bf16_t, WS_XBA)
#define V_XBB WSV(bf16_t, WS_XBB)
#define V_PROJ WSV(bf16_t, WS_PROJ)
#define V_OABC WSV(bf16_t, WS_OABC)
#define V_MRG WSV(bf16_t, WS_MRG)
#define V_ACT WSV(bf16_t, WS_ACT)
#define V_X1 WSV(float, WS_X1)
#define V_X2 WSV(float, WS_X2)
#define V_RS WSV(float, WS_RS)
#define V_BQKV WSV(float, WS_BQKV)
#define V_BG WSV(float, WS_BG)
#define V_CQK WSV(float, WS_CQK)
#define V_OBR WSV(float, WS_OBR)
#define V_OCR WSV(float, WS_OCR)
#define V_ROPEA WSV(float, WS_ROPEA)
#define V_ROPEC WSV(float, WS_ROPEC)
#define V_CTL WSV(unsigned, WS_CTL)
#define V_AO WSV(bf16_t, WS_AO)
#define V_LSE WSV(float, WS_LSE)
#define V_DW WSV(bf16_t, WS_DW)
#define V_DQG WSV(bf16_t, WS_DQG)
#define V_DKT WSV(bf16_t, WS_DKT)
#define V_DAT WSV(bf16_t, WS_DAT)
#define V_DU WSV(float, WS_DU)
#define V_DDL WSV(float, WS_DDL)
#define V_RQG WSV(bf16_t, WS_RQG)
#define V_RKT WSV(bf16_t, WS_RKT)
#define V_RAT WSV(bf16_t, WS_RAT)
#define V_RU WSV(float, WS_RU)
#define V_SB WSV(bf16_t, WS_SB)
#define V_VB WSV(bf16_t, WS_VB)

__device__ __forceinline__ int src_col(int mode, int n) {
    if (mode == 1) { if (n < 6656) return n; if (n < 11264) return n + 8; if (n < 11272) return n - 11264 + 6656; return -1; }
    if (mode == 2) { const int pn = n >> 8, c = n & 255; const int f = pn * 128 + (c >> 3) * 4 + (c & 3); return ((c >> 2) & 1) * DFF + f; }
    return n;
}
__device__ __forceinline__ void transpose_item(const float* W, int K, int N, int nblk, bf16_t* WT, const float* kscale, int mode, LAS float* scr, int item, int lane) {
    const int kb = item / nblk, nb = item - kb * nblk, k0 = 32 * kb, n0 = 128 * nb;
    const int sc = src_col(mode, n0 + 4 * (lane & 31));
    f32x4 v[16];
#pragma unroll
    for (int i = 0; i < 16; ++i) { const int kk = 2 * i + (lane >> 5);
        v[i] = (f32x4){0.f, 0.f, 0.f, 0.f};
        if (sc >= 0) { v[i] = *(const f32x4*)(W + (size_t)(k0 + kk) * N + sc); if (kscale) v[i] *= kscale[k0 + kk]; } }
#pragma unroll
    for (int i = 0; i < 16; ++i) { const int kk = 2 * i + (lane >> 5); *(LAS f32x4*)(scr + kk * 132 + 4 * (lane & 31)) = v[i]; }
    asm volatile("s_waitcnt lgkmcnt(0)" ::: "memory");
#pragma unroll
    for (int h2 = 0; h2 < 2; ++h2) { const int n = lane + 64 * h2; const LAS float* sp = scr + n;
        bf16_t* dst = WT + (size_t)(n0 + n) * K + k0;
#pragma unroll
        for (int q = 0; q < 4; ++q) { u32x4 o; o.x = cvt_pk_bf16(sp[(8 * q + 0) * 132], sp[(8 * q + 1) * 132]); o.y = cvt_pk_bf16(sp[(8 * q + 2) * 132], sp[(8 * q + 3) * 132]);
            o.z = cvt_pk_bf16(sp[(8 * q + 4) * 132], sp[(8 * q + 5) * 132]); o.w = cvt_pk_bf16(sp[(8 * q + 6) * 132], sp[(8 * q + 7) * 132]); *(u32x4*)(dst + 8 * q) = o; } }
    asm volatile("s_waitcnt lgkmcnt(0)" ::: "memory");
}
__device__ __forceinline__ void phase_prep(Ctx& F) {
    LAS float* scr = (LAS float*)(F.lds + F.wave * 16896);
    const int gw = F.bid * NWAVES + F.wave, NGW = F.G * NWAVES, lane = F.lane;
    constexpr int I_IN = 32 * (NPROJ / 128), I_ABC = 16 * 8, I_OUT = 32 * 8, I_FI = 32 * (2 * DFF / 128), I_FO = (DFF / 32) * 8;
    constexpr int I_LAYER = I_IN + 3 * I_ABC + I_OUT + I_FI + I_FO;
    for (int it = gw; it < DEPTH * I_LAYER; it += NGW) {
        const int l = it / I_LAYER; int r = it - l * I_LAYER;
        const float* W; const float* ksc = nullptr; bf16_t* WT; int K = D, N = D, nblk = D / 128, mode = 0;
        if (r < I_IN) { W = F.in[9] + (size_t)l * D * NIN; N = NIN; nblk = NPROJ / 128; WT = V_WIN + (size_t)l * NPROJ * D; ksc = F.in[8] + l * D; mode = 1; }
        else if ((r -= I_IN) < 3 * I_ABC) { const int i = r / I_ABC; r -= i * I_ABC; W = F.in[17 + i] + (size_t)l * 512 * D; K = 512; WT = V_WABC + (size_t)(l * 3 + i) * D * 512; }
        else if ((r -= 3 * I_ABC) < I_OUT) { W = F.in[20] + (size_t)l * D * D; WT = V_WOUT + (size_t)l * D * D; }
        else if ((r -= I_OUT) < I_FI) { W = F.in[22] + (size_t)l * D * 2 * DFF; N = 2 * DFF; nblk = 2 * DFF / 128; WT = V_WFI + (size_t)l * 2 * DFF * D; ksc = F.in[21] + l * D; mode = 2; }
        else { r -= I_FI; W = F.in[23] + (size_t)l * DFF * D; K = DFF; WT = V_WFO + (size_t)l * D * DFF; }
        transpose_item(W, K, N, nblk, WT, ksc, mode, scr, r, lane);
    }
    for (int row0 = gw; row0 < M; row0 += 4 * NGW) {
        f32x4 v[4][4];
#pragma unroll
        for (int r = 0; r < 4; ++r) { const int row = row0 + r * NGW;
            if (row < M) { const float* src = row < MP ? F.in[0] + (size_t)row * D : F.in[1] + (size_t)(row - MP) * D;
#pragma unroll
                for (int j = 0; j < 4; ++j) v[r][j] = *(const f32x4*)(src + 4 * lane + 256 * j); } }
#pragma unroll
        for (int r = 0; r < 4; ++r) { const int row = row0 + r * NGW;
            if (row < M) { float ss = 0.f;
#pragma unroll
                for (int j = 0; j < 4; ++j) ss += (v[r][j][0] * v[r][j][0] + v[r][j][1] * v[r][j][1]) + (v[r][j][2] * v[r][j][2] + v[r][j][3] * v[r][j][3]);
                ss = wave_sum(ss);
                if (lane == 0) V_RS[row] = ss;
#pragma unroll
                for (int j = 0; j < 4; ++j) { u32x2 w; w.x = cvt_pk_bf16(v[r][j][0], v[r][j][1]); w.y = cvt_pk_bf16(v[r][j][2], v[r][j][3]); *(u32x2*)(V_XBA + (size_t)row * D + 4 * lane + 256 * j) = w; } } }
    }
    const int gt = F.bid * NTHREADS + F.tid, NGT = F.G * NTHREADS;
    for (int i = gt; i < 3 * M; i += NGT) V_RS[M + i] = 0.f;
    {
        const int i64 = gt & 63; const double invA = exp(-(double)i64 * (9.210340371976184 / 64.0));
        for (int e = gt; e < NPOS * 64; e += NGT) { const int pi = e >> 6; const double pos = pi < SEQ ? (double)pi : (double)(PAST + pi - SEQ);
            double a = pos * invA; a -= floor(a * 0.15915494309189535) * 6.283185307179586; float sn, cs; sincosf((float)a, &sn, &cs); *(f32x2*)(V_ROPEA + 2 * e) = (f32x2){cs, sn}; }
        const int i32 = gt & 31; const double invC = exp(-(double)i32 * (9.210340371976184 / 32.0));
        for (int e = gt; e < NPOS * 32; e += NGT) { const int pi = e >> 5; const double pos = pi < SEQ ? (double)pi : (double)(PAST + pi - SEQ);
            double a = pos * invC; a -= floor(a * 0.15915494309189535) * 6.283185307179586; float sn, cs; sincosf((float)a, &sn, &cs); *(f32x2*)(V_ROPEC + 2 * e) = (f32x2){cs, sn}; }
    }
}

__device__ __forceinline__ float* kv_out_ptr(float* out, int g, int l, bool sample, int b, int tt) {
    if (sample) { const size_t base = g == 0 ? O_KV0S : (g == 1 ? O_KV1S : O_KV2S); return out + base + ((size_t)(l * DB + b) * DS + tt) * 1024; }
    const int keep = 128 << (2 * g); const size_t base = g == 0 ? O_KV0P : (g == 1 ? O_KV1P : O_KV2P);
    return out + base + ((size_t)(l * BATCH + b) * keep + tt) * 1024;
}
template <int NR>
__device__ __forceinline__ void e1_partA(Ctx& F, int l, const int (&rows)[NR], bool store_qk) {
    const int lane = F.lane, jj = lane & 15, hq = lane >> 4;
    u32x2 xlo[NR][6], xhi[NR][6]; f32x4 cc[NR], sn[NR]; unsigned vv[NR][12];
    bool sample[NR]; int bb[NR], tt0[NR];
#pragma unroll
    for (int r = 0; r < NR; ++r) {
        const int row = rows[r];
        sample[r] = row >= MP; bb[r] = sample[r] ? (row - MP) >> 3 : row >> 12; tt0[r] = sample[r] ? (row - MP) & 7 : row & 4095;
        const int pidx = sample[r] ? SEQ + tt0[r] : tt0[r];
        const bf16_t* prow = V_PROJ + (size_t)row * NPROJ;
#pragma unroll
        for (int sl = 0; sl < 6; ++sl) { const bf16_t* p = prow + (4 * sl + hq) * 128; xlo[r][sl] = *(const u32x2*)(p + 4 * jj); xhi[r][sl] = *(const u32x2*)(p + 64 + 4 * jj); }
        const float* cs = V_ROPEA + ((size_t)pidx * 64 + 4 * jj) * 2;
        const f32x4 c01 = *(const f32x4*)cs, c23 = *(const f32x4*)(cs + 4);
        cc[r] = (f32x4){c01[0], c01[2], c23[0], c23[2]}; sn[r] = (f32x4){c01[1], c01[3], c23[1], c23[3]};
#pragma unroll
        for (int q = 0; q < 12; ++q) vv[r][q] = *(const unsigned*)(prow + PC_AV + q * 128 + 2 * lane);
    }
    const f32x4 gq_lo = *(const f32x4*)(F.in[10] + l * 128 + 4 * jj), gq_hi = *(const f32x4*)(F.in[10] + l * 128 + 64 + 4 * jj);
    const f32x4 gk_lo = *(const f32x4*)(F.in[11] + l * 128 + 4 * jj), gk_hi = *(const f32x4*)(F.in[11] + l * 128 + 64 + 4 * jj);
#pragma unroll
    for (int r = 0; r < NR; ++r) {
        const int row = rows[r], t = tt0[r], b = bb[r]; const bool smp = sample[r];
        bf16_t* prow = V_PROJ + (size_t)row * NPROJ;
#pragma unroll
        for (int sl = 0; sl < 6; ++sl) {
            const int hs = 4 * sl + hq, which = sl >= 3 ? 1 : 0, gh = hs - 12 * which, g = gh >> 2, h = gh & 3;
            f32x4 lo = (f32x4){bf_lo(xlo[r][sl].x), bf_hi(xlo[r][sl].x), bf_lo(xlo[r][sl].y), bf_hi(xlo[r][sl].y)}, hi = (f32x4){bf_lo(xhi[r][sl].x), bf_hi(xhi[r][sl].x), bf_lo(xhi[r][sl].y), bf_hi(xhi[r][sl].y)};
            float ss = (lo[0] * lo[0] + lo[1] * lo[1]) + (lo[2] * lo[2] + lo[3] * lo[3]) + (hi[0] * hi[0] + hi[1] * hi[1]) + (hi[2] * hi[2] + hi[3] * hi[3]);
            ss = row_sum16(ss);
            const float rstd = rsqrtf(ss * (1.f / 128.f) + EPS);
            lo = lo * rstd * (which ? gk_lo : gq_lo); hi = hi * rstd * (which ? gk_hi : gq_hi);
            const f32x4 olo = lo * cc[r] - hi * sn[r], ohi = hi * cc[r] + lo * sn[r];
            bf16_t* p = prow + hs * 128;
            if (store_qk) { u32x2 w0, w1; w0.x = cvt_pk_bf16(olo[0], olo[1]); w0.y = cvt_pk_bf16(olo[2], olo[3]); w1.x = cvt_pk_bf16(ohi[0], ohi[1]); w1.y = cvt_pk_bf16(ohi[2], ohi[3]);
                *(u32x2*)(p + 4 * jj) = w0; *(u32x2*)(p + 64 + 4 * jj) = w1; }
            if (which == 1) {
                const int keep = 128 << (2 * g); const int tt = smp ? t : t - (SEQ - keep);
                if (tt >= 0) { float* dst = kv_out_ptr(F.out, g, l, smp, b, tt) + h * 128; *(f32x4*)(dst + 4 * jj) = olo; *(f32x4*)(dst + 64 + 4 * jj) = ohi; }
            }
        }
#pragma unroll
        for (int g = 0; g < 3; ++g) {
            const int keep = 128 << (2 * g); const int tt = smp ? t : t - (SEQ - keep);
            if (tt >= 0) { float* dst = kv_out_ptr(F.out, g, l, smp, b, tt) + 512;
#pragma unroll
                for (int q = 0; q < 4; ++q) { const unsigned v = vv[r][4 * g + q]; *(f32x2*)(dst + q * 128 + 2 * lane) = (f32x2){bf_lo(v), bf_hi(v)}; } }
        }
    }
}
__device__ __forceinline__ void e1_row(Ctx& F, int l, int row) {
    const int lane = F.lane, j = lane & 31, hh = lane >> 5;
    const bool sample = row >= MP;
    const int b = sample ? (row - MP) >> 3 : row >> 12, t = sample ? (row - MP) & 7 : row & 4095;
    const int pidx = sample ? SEQ + t : t;
    bf16_t* prow = V_PROJ + (size_t)row * NPROJ;
    if (!sample && t < SEQ - 3) return;
#pragma unroll 1
    for (int it = 0; it < 6; ++it) {
        const int slot = 2 * it + hh, typ = slot >> 2, c = slot * 128 + 4 * j;
        f32x4 a = (f32x4){0.f, 0.f, 0.f, 0.f}, xcur = a;
#pragma unroll
        for (int i = 0; i < 4; ++i) {
            const int tp = t - 3 + i; f32x4 x;
            if (tp >= 0) { const u32x2 u = *(const u32x2*)(V_PROJ + (size_t)(row - 3 + i) * NPROJ + PC_BQKV + c); x = (f32x4){bf_lo(u.x), bf_hi(u.x), bf_lo(u.y), bf_hi(u.y)}; }
            else if (sample) x = *(const f32x4*)(F.in[5] + ((size_t)(l * DB + b) * 3 + (tp + 3)) * 1536 + c);
            else x = (f32x4){0.f, 0.f, 0.f, 0.f};
            const f32x4 w = *(const f32x4*)(F.in[12] + (size_t)(l * 4 + i) * 1536 + c);
            a += w * x; if (i == 3) xcur = x;
        }
#pragma unroll
        for (int q = 0; q < 4; ++q) a[q] = a[q] * sigmoidf_(a[q]);
        if (typ < 2) {
            const float ss = half_sum((a[0] * a[0] + a[1] * a[1]) + (a[2] * a[2] + a[3] * a[3]));
            const float sc = rsqrtf(ss + EPS) * (typ == 0 ? 0.08838834764831845f : 1.f);
            a *= sc;
        }
        *(f32x4*)(V_BQKV + (size_t)row * 1536 + c) = a;
        const int tc = sample ? t - 5 : t - (SEQ - 3);
        if (tc >= 0) { float* dst = F.out + (sample ? O_BCS + ((size_t)(l * DB + b) * 3 + tc) * 1536 : O_BCP + ((size_t)(l * BATCH + b) * 3 + tc) * 1536); *(f32x4*)(dst + c) = xcur; }
    }
    if (lane < 8) {
        const int h = lane & 3; const float x = bf1(prow[PC_BETA + lane]);
        float r;
        if (lane < 4) r = 1.f / (1.f + expf(-x));
        else { const float y = x + F.in[14][l * 4 + h]; const float sp = y > 20.f ? y : log1pf(expf(y)); r = -expf(F.in[13][l * 4 + h]) * sp; }
        V_BG[(size_t)row * 8 + lane] = r;
    }
    {
        const int hs = lane >> 3, i0 = 4 * (lane & 7);
        const bf16_t* p = prow + PC_CQ + hs * 64;
        const u32x2 ulo = *(const u32x2*)(p + i0), uhi = *(const u32x2*)(p + 32 + i0);
        const f32x4 lo = (f32x4){bf_lo(ulo.x), bf_hi(ulo.x), bf_lo(ulo.y), bf_hi(ulo.y)}, hi = (f32x4){bf_lo(uhi.x), bf_hi(uhi.x), bf_lo(uhi.y), bf_hi(uhi.y)};
        const float* cs = V_ROPEC + ((size_t)pidx * 32 + i0) * 2;
        const f32x4 c01 = *(const f32x4*)cs, c23 = *(const f32x4*)(cs + 4);
        const f32x4 cc = (f32x4){c01[0], c01[2], c23[0], c23[2]}, sn = (f32x4){c01[1], c01[3], c23[1], c23[3]};
        const float sc = hs >= 4 ? 0.125f : 1.f;
        const f32x4 olo = (lo * cc - hi * sn) * sc, ohi = (hi * cc + lo * sn) * sc;
        *(f32x4*)(V_CQK + (size_t)row * 512 + hs * 64 + i0) = olo; *(f32x4*)(V_CQK + (size_t)row * 512 + hs * 64 + 32 + i0) = ohi;
    }
}

__device__ __forceinline__ float dot8(const u32x4 q, const u32x4 k) {
    return (bf_lo(q.x) * bf_lo(k.x) + bf_hi(q.x) * bf_hi(k.x)) + (bf_lo(q.y) * bf_lo(k.y) + bf_hi(q.y) * bf_hi(k.y)) + (bf_lo(q.z) * bf_lo(k.z) + bf_hi(q.z) * bf_hi(k.z)) + (bf_lo(q.w) * bf_lo(k.w) + bf_hi(q.w) * bf_hi(k.w));
}
#define WAVE_LDS_SYNC() do { asm volatile("s_waitcnt lgkmcnt(0)" ::: "memory"); __builtin_amdgcn_wave_barrier(); } while (0)
__device__ __forceinline__ void attn_prompt_task(Ctx& F, int row, int h) {
    const int lane = F.lane, t = row & 4095;
    const bf16_t* proj = V_PROJ;
    LAS float* ps = (LAS float*)F.lds + F.wave * 256;
    float mrun = -INFINITY, lsum = 0.f, o0 = 0.f, o1 = 0.f;
#pragma unroll 1
    for (int g = 0; g < 3; ++g) {
        const int sh = 2 * g, nk = min(128, t >> sh) + 1;
        const bf16_t* qrow = proj + (size_t)row * NPROJ + PC_AQ + g * 512 + h * 128;
        u32x4 q[16];
#pragma unroll
        for (int i = 0; i < 16; ++i) q[i] = *(const u32x4*)(qrow + 8 * i);
        WAVE_LDS_SYNC();
#pragma unroll 1
        for (int r = 0; r < 3; ++r) {
            const int jk = r * 64 + lane; const bool valid = jk < nk; const int jj = valid ? jk : 0;
            const bf16_t* krow = proj + (size_t)(row - (jj << sh)) * NPROJ + PC_AK + g * 512 + h * 128;
            float a = 0.f;
#pragma unroll
            for (int i = 0; i < 16; ++i) a += dot8(q[i], *(const u32x4*)(krow + 8 * i));
            ps[jk] = valid ? a * 0.08838834764831845f : -INFINITY;
        }
        WAVE_LDS_SYNC();
        const float s0 = ps[lane], s1 = ps[64 + lane], s2 = ps[128 + lane];
        const float mg = wave_max(fmaxf(fmaxf(s0, s1), s2)), mnew = fmaxf(mrun, mg), alpha = __expf(mrun - mnew);
        const float p0 = __expf(s0 - mnew), p1 = __expf(s1 - mnew), p2 = __expf(s2 - mnew);
        WAVE_LDS_SYNC();
        ps[lane] = p0; ps[64 + lane] = p1; ps[128 + lane] = p2;
        lsum = lsum * alpha + wave_sum(p0 + p1 + p2); o0 *= alpha; o1 *= alpha; mrun = mnew;
        WAVE_LDS_SYNC();
        const bf16_t* vbase = proj + (size_t)row * NPROJ + PC_AV + g * 512 + h * 128 + 2 * lane;
#pragma unroll 4
        for (int jk = 0; jk < nk; ++jk) {
            const float pj = ps[jk];
            const unsigned vv = *(const unsigned*)(vbase - (size_t)(jk << sh) * NPROJ);
            o0 += pj * bf_lo(vv); o1 += pj * bf_hi(vv);
        }
    }
    const float inv = 1.f / lsum;
    *(unsigned*)(V_OABC + (size_t)row * 512 + h * 128 + 2 * lane) = cvt_pk_bf16(o0 * inv, o1 * inv);
}
__device__ __forceinline__ void attn_sample_unit(Ctx& F, int l, int bs, int h, int g) {
    const int lane = F.lane, b = bs >> 3, s = bs & 7, row = MP + bs;
    LAS float* ps = (LAS float*)F.lds + F.wave * 256;
    const int sh = 2 * g, L = 128 << sh;
    const float* cache = F.in[2 + g] + (size_t)(l * DB + b) * L * 1024;
    const float* newkv = kv_out_ptr(F.out, g, l, true, b, 0);
    const bf16_t* qrow = V_PROJ + (size_t)row * NPROJ + PC_AQ + g * 512 + h * 128;
    const int hl = lane & 31, hf = lane >> 5;
    const u32x2 qq = *(const u32x2*)(qrow + 4 * hl);
    const float q0 = bf_lo(qq.x) * 0.08838834764831845f, q1 = bf_hi(qq.x) * 0.08838834764831845f, q2 = bf_lo(qq.y) * 0.08838834764831845f, q3 = bf_hi(qq.y) * 0.08838834764831845f;
    WAVE_LDS_SYNC();
#pragma unroll 1
    for (int j0 = 0; j0 < 130; j0 += 26) {
        f32x4 kk[13];
#pragma unroll
        for (int u = 0; u < 13; ++u) { int jk = j0 + 2 * u + hf; jk = jk > 128 ? 128 : jk; const int idx = L + s - (jk << sh);
            kk[u] = *(const f32x4*)((idx < L ? cache + (size_t)idx * 1024 : newkv + (size_t)(idx - L) * 1024) + h * 128 + 4 * hl); }
#pragma unroll
        for (int u = 0; u < 13; ++u) { float a = (q0 * kk[u][0] + q1 * kk[u][1]) + (q2 * kk[u][2] + q3 * kk[u][3]);
            a = row_sum16(a); a += __shfl_xor(a, 16);
            const int jk = j0 + 2 * u + hf; if (hl == 0 && jk <= 128) ps[jk] = a; }
    }
    if (lane >= 1) ps[128 + lane] = -INFINITY;
    WAVE_LDS_SYNC();
    const float s0 = ps[lane], s1 = ps[64 + lane], s2 = ps[128 + lane];
    const float mx = wave_max(fmaxf(fmaxf(s0, s1), s2));
    const float p0 = __expf(s0 - mx), p1 = __expf(s1 - mx), p2 = __expf(s2 - mx);
    WAVE_LDS_SYNC();
    ps[lane] = p0; ps[64 + lane] = p1; ps[128 + lane] = p2;
    const float lsum = wave_sum(p0 + p1 + p2);
    WAVE_LDS_SYNC();
    float o0 = 0.f, o1 = 0.f, o2 = 0.f, o3 = 0.f;
    const float* vc = cache + 512 + h * 128 + 2 * lane; const float* vn2 = newkv + 512 + h * 128 + 2 * lane;
#pragma unroll 1
    for (int j0 = 0; j0 < 128; j0 += 16) {
        f32x2 vv[16];
#pragma unroll
        for (int u = 0; u < 16; ++u) { const int idx = L + s - ((j0 + u) << sh); vv[u] = *(const f32x2*)(idx < L ? vc + (size_t)idx * 1024 : vn2 + (size_t)(idx - L) * 1024); }
#pragma unroll
        for (int u = 0; u < 16; u += 2) { const float pa = ps[j0 + u], pb = ps[j0 + u + 1]; o0 += pa * vv[u][0]; o1 += pa * vv[u][1]; o2 += pb * vv[u + 1][0]; o3 += pb * vv[u + 1][1]; }
    }
    { const int idx = L + s - (128 << sh); const f32x2 vv = *(const f32x2*)(idx < L ? vc + (size_t)idx * 1024 : vn2 + (size_t)(idx - L) * 1024); const float pa = ps[128]; o0 += pa * vv[0]; o1 += pa * vv[1]; }
    const float inv = 1.f / lsum;
    *(unsigned*)(V_AO + ((size_t)g * M + row) * 512 + h * 128 + 2 * lane) = cvt_pk_bf16((o0 + o2) * inv, (o1 + o3) * inv);
    if (lane == 0) V_LSE[((size_t)g * M + row) * 4 + h] = mx + __logf(lsum);
}
constexpr int AT_KSTR = 272, AT_VSTR = 528, AT_VOFF = 256 * AT_KSTR;
template <int NP>
__device__ __forceinline__ void attn_ld(const bf16_t* proj, int b, int sh, int r, int g, int h, int npk0, int tid, u32x4 (&kv)[NP], u32x4 (&vv)[NP]) {
#pragma unroll
    for (int p = 0; p < NP; ++p) {
        const int kl = p * 32 + (tid >> 4), ch = tid & 15, np = npk0 + kl;
        if (np >= 0) { const bf16_t* src = proj + (size_t)(b * SEQ + (np << sh) + r) * NPROJ + g * 512 + h * 128 + ch * 8;
            kv[p] = *(const u32x4*)(src + PC_AK); vv[p] = *(const u32x4*)(src + PC_AV); }
        else { kv[p] = (u32x4){0u, 0u, 0u, 0u}; vv[p] = kv[p]; }
    }
}
template <int NP>
__device__ __forceinline__ void attn_st(LAS unsigned char* Ks, LAS unsigned char* Vt, int row0, int tid, const u32x4 (&kv)[NP], const u32x4 (&vv)[NP]) {
#pragma unroll
    for (int p = 0; p < NP; ++p) {
        const int kl = row0 + p * 32 + (tid >> 4), ch = tid & 15;
        *(LAS u32x4*)(Ks + kl * AT_KSTR + ch * 16) = kv[p];
        LAS unsigned short* vt = (LAS unsigned short*)(Vt + (ch * 8) * AT_VSTR + kl * 2);
        vt[0 * (AT_VSTR / 2)] = (unsigned short)(vv[p].x & 0xffffu); vt[1 * (AT_VSTR / 2)] = (unsigned short)(vv[p].x >> 16);
        vt[2 * (AT_VSTR / 2)] = (unsigned short)(vv[p].y & 0xffffu); vt[3 * (AT_VSTR / 2)] = (unsigned short)(vv[p].y >> 16);
        vt[4 * (AT_VSTR / 2)] = (unsigned short)(vv[p].z & 0xffffu); vt[5 * (AT_VSTR / 2)] = (unsigned short)(vv[p].z >> 16);
        vt[6 * (AT_VSTR / 2)] = (unsigned short)(vv[p].w & 0xffffu); vt[7 * (AT_VSTR / 2)] = (unsigned short)(vv[p].w >> 16);
    }
}
__device__ __forceinline__ void attn_blk(Ctx& F, const LAS unsigned char* Ks, const LAS unsigned char* Vt, int tb, int kmin, size_t rowq, int g, int h, const bf16x8 (&qf)[4]) {
    const int lane = F.lane, w = F.wave, li = lane & 15, q4 = lane >> 4;
    f32x4 st[9];
#pragma unroll
    for (int kt = 0; kt < 9; ++kt) {
        f32x4 acc = (f32x4){0.f, 0.f, 0.f, 0.f};
        const LAS unsigned char* kp = Ks + (((w + kt + tb) & 15) * 16 + li) * AT_KSTR + 16 * q4;
#pragma unroll
        for (int s = 0; s < 4; ++s) acc = __builtin_amdgcn_mfma_f32_16x16x32_bf16(*(const LAS bf16x8*)(kp + 64 * s), qf[s], acc, 0, 0, 0);
        st[kt] = acc;
    }
    float mx = -INFINITY;
#pragma unroll
    for (int kt = 0; kt < 9; ++kt)
#pragma unroll
        for (int rg = 0; rg < 4; ++rg) {
            const int a = 4 * q4 + rg, kl = (w + kt) * 16 + a;
            bool ok = kl >= kmin;
            if (kt == 0) ok = ok && (a >= li);
            if (kt == 8) ok = ok && (a <= li);
            st[kt][rg] = ok ? st[kt][rg] : -INFINITY;
            mx = fmaxf(mx, st[kt][rg]);
        }
    mx = fmaxf(mx, __shfl_xor(mx, 16)); mx = fmaxf(mx, __shfl_xor(mx, 32));
    const float c2 = 0.08838834764831845f * 1.4426950408889634f;
    float lsum = 0.f;
#pragma unroll
    for (int kt = 0; kt < 9; ++kt)
#pragma unroll
        for (int rg = 0; rg < 4; ++rg) { const float p = exp2f((st[kt][rg] - mx) * c2); st[kt][rg] = p; lsum += p; }
    lsum += __shfl_xor(lsum, 16); lsum += __shfl_xor(lsum, 32);
    f32x4 o[8];
#pragma unroll
    for (int db = 0; db < 8; ++db) o[db] = (f32x4){0.f, 0.f, 0.f, 0.f};
#pragma unroll
    for (int ks = 0; ks < 5; ++ks) {
        u32x4 pw;
        pw.x = cvt_pk_bf16(st[2 * ks][0], st[2 * ks][1]); pw.y = cvt_pk_bf16(st[2 * ks][2], st[2 * ks][3]);
        if (ks < 4) { pw.z = cvt_pk_bf16(st[2 * ks + 1][0], st[2 * ks + 1][1]); pw.w = cvt_pk_bf16(st[2 * ks + 1][2], st[2 * ks + 1][3]); }
        else { pw.z = 0u; pw.w = 0u; }
        const bf16x8 pf = __builtin_bit_cast(bf16x8, pw);
        const int t0 = (w + 2 * ks + tb) & 15, t1 = (w + 2 * ks + 1 + tb) & 15;
#pragma unroll
        for (int db = 0; db < 8; ++db) {
            const LAS unsigned char* vp = Vt + (16 * db + li) * AT_VSTR + 8 * q4;
            u32x4 av; const u32x2 a0 = *(const LAS u32x2*)(vp + t0 * 32), a1 = *(const LAS u32x2*)(vp + t1 * 32);
            av.x = a0.x; av.y = a0.y; av.z = a1.x; av.w = a1.y;
            o[db] = __builtin_amdgcn_mfma_f32_16x16x32_bf16(__builtin_bit_cast(bf16x8, av), pf, o[db], 0, 0, 0);
        }
    }
    const float inv = 1.f / lsum;
    bf16_t* dst = V_AO + ((size_t)g * M + rowq) * 512 + h * 128 + 4 * q4;
#pragma unroll
    for (int db = 0; db < 8; ++db) { u32x2 wv; wv.x = cvt_pk_bf16(o[db][0] * inv, o[db][1] * inv); wv.y = cvt_pk_bf16(o[db][2] * inv, o[db][3] * inv); *(u32x2*)(dst + 16 * db) = wv; }
    if (q4 == 0) V_LSE[((size_t)g * M + rowq) * 4 + h] = mx * 0.08838834764831845f + __logf(lsum);
}
__device__ __forceinline__ void attn_mfma_item(Ctx& F, int item) {
    const int tid = F.tid, lane = F.lane, w = F.wave, li = lane & 15, q4 = lane >> 4;
    const int nbr = item & 15; int rest = item >> 4; const int h = rest & 3; rest >>= 2; const int g = rest % 3, b = rest / 3;
    const int sh = 2 * g, psh = 4 - sh, r = nbr >> psh, nbp = nbr & ((1 << psh) - 1), n0 = nbp * 256;
    const bf16_t* proj = V_PROJ;
    LAS unsigned char* Ks = F.lds; LAS unsigned char* Vt = F.lds + AT_VOFF;
    u32x4 k2[4], v2[4];
    {
        u32x4 kv[8], vv[8];
        attn_ld<8>(proj, b, sh, r, g, h, n0 - 128, tid, kv, vv);
        attn_ld<4>(proj, b, sh, r, g, h, n0 + 128, tid, k2, v2);
        attn_st<8>(Ks, Vt, 0, tid, kv, vv);
    }
    const int ql = 16 * w + li;
#pragma unroll 1
    for (int j = 0; j < 2; ++j) {
        const size_t rowq = (size_t)(b * SEQ + ((n0 + 128 * j + ql) << sh) + r);
        bf16x8 qf[4];
#pragma unroll
        for (int s = 0; s < 4; ++s) qf[s] = *(const bf16x8*)(proj + rowq * NPROJ + PC_AQ + g * 512 + h * 128 + 32 * s + 8 * q4);
        __syncthreads();
        attn_blk(F, Ks, Vt, 8 * j, j == 0 ? 128 - n0 : 0, rowq, g, h, qf);
        __syncthreads();
        if (j == 0) attn_st<4>(Ks, Vt, 0, tid, k2, v2);
    }
}
constexpr int DP_Q = 0, DP_K = 17408, DP_V = 34816, DP_AM = 52224, DP_TM = 68608, DP_RTV = 77824, DP_RTK = 96256, DP_GC = 114688, DP_BT = 114944;
__device__ __forceinline__ f32x4 mfma16(const bf16x8 a, const bf16x8 b, const f32x4 c) { return __builtin_amdgcn_mfma_f32_16x16x32_bf16(a, b, c, 0, 0, 0); }
__device__ __forceinline__ void delta_prep_item(Ctx& F, int l, int ch) {
    const int tid = F.tid, lane = F.lane, w = F.wave, li = lane & 15, q4 = lane >> 4;
    const int c = ch & 63, h = (ch >> 6) & 3, b = ch >> 8;
    const int row0 = b * SEQ + 64 * c;
    const bf16_t* proj = V_PROJ;
    LAS unsigned char* L = F.lds;
    LAS float* gcs = (LAS float*)(L + DP_GC); LAS float* bts = (LAS float*)(L + DP_BT);
    float b_x = 0.f, b_y = 0.f;
    if (tid < 64) { const bf16_t* pr = proj + (size_t)(row0 + tid) * NPROJ; b_x = bf1(pr[PC_BETA + h]); b_y = bf1(pr[PC_BA + h]); }
    {
        f32x2 wg[3][4]; unsigned xr[3][11];
#pragma unroll
        for (int typ = 0; typ < 3; ++typ) {
            const int cc = typ * 512 + h * 128 + 2 * lane;
#pragma unroll
            for (int i = 0; i < 4; ++i) wg[typ][i] = *(const f32x2*)(F.in[12] + (size_t)(l * 4 + i) * 1536 + cc);
#pragma unroll
            for (int rr = 0; rr < 11; ++rr) { const int tl = 64 * c + 8 * w + rr - 3; xr[typ][rr] = tl >= 0 ? *(const unsigned*)(proj + (size_t)(b * SEQ + tl) * NPROJ + PC_BQKV + cc) : 0u; }
        }
#pragma unroll
        for (int typ = 0; typ < 3; ++typ) {
#pragma unroll
            for (int rr = 0; rr < 8; ++rr) {
                float a0 = 0.f, a1 = 0.f;
#pragma unroll
                for (int i = 0; i < 4; ++i) { a0 += wg[typ][i][0] * bf_lo(xr[typ][rr + i]); a1 += wg[typ][i][1] * bf_hi(xr[typ][rr + i]); }
                a0 = a0 * sigmoidf_(a0); a1 = a1 * sigmoidf_(a1);
                if (typ < 2) { const float ss = wave_sum(a0 * a0 + a1 * a1); const float sc = rsqrtf(ss + EPS) * (typ == 0 ? 0.08838834764831845f : 1.f); a0 *= sc; a1 *= sc; }
                *(LAS unsigned*)(L + typ * 17408 + (8 * w + rr) * 272 + 4 * lane) = cvt_pk_bf16(a0, a1);
            }
        }
    }
    if (tid < 64) {
        const float be = 1.f / (1.f + expf(-b_x));
        const float y = b_y + F.in[14][l * 4 + h]; const float sp = y > 20.f ? y : log1pf(expf(y));
        float g = -expf(F.in[13][l * 4 + h]) * sp;
#pragma unroll
        for (int o = 1; o < 64; o <<= 1) { const float v = __shfl_up(g, o); if (lane >= o) g += v; }
        gcs[tid] = g; bts[tid] = be;
    }
    __syncthreads();
    const size_t chs = (size_t)ch;
    {
        const int mi = w >> 1;
#pragma unroll
        for (int t2 = 0; t2 < 2; ++t2) {
            const int nj = 2 * (w & 1) + t2;
            bf16_t* ad = V_DAT + chs * 4096 + (size_t)(16 * mi + li) * 64 + 32 * (nj >> 1) + 8 * q4 + 4 * (nj & 1);
            if (nj <= mi) {
                f32x4 akk = (f32x4){0.f, 0.f, 0.f, 0.f}, aqk = akk;
                const LAS unsigned char* ki = L + DP_K + (16 * mi + li) * 272 + 16 * q4; const LAS unsigned char* kj = L + DP_K + (16 * nj + li) * 272 + 16 * q4;
                const LAS unsigned char* qi = L + DP_Q + (16 * mi + li) * 272 + 16 * q4;
#pragma unroll
                for (int s2 = 0; s2 < 4; ++s2) { const bf16x8 fkj = *(const LAS bf16x8*)(kj + 64 * s2);
                    akk = mfma16(*(const LAS bf16x8*)(ki + 64 * s2), fkj, akk);
                    aqk = mfma16(fkj, *(const LAS bf16x8*)(qi + 64 * s2), aqk); }
                const float gj = gcs[16 * nj + li], gi2 = gcs[16 * mi + li];
                float ov[4];
#pragma unroll
                for (int rg = 0; rg < 4; ++rg) {
                    const int i = 16 * mi + 4 * q4 + rg, j = 16 * nj + li;
                    ((LAS float*)(L + DP_AM))[i * 64 + j] = (i > j) ? bts[i] * akk[rg] * __expf(gcs[i] - gj) : 0.f;
                    const int j2 = 16 * nj + 4 * q4 + rg, i2 = 16 * mi + li;
                    ov[rg] = (i2 >= j2) ? aqk[rg] * __expf(gi2 - gcs[j2]) : 0.f;
                }
                u32x2 pk; pk.x = cvt_pk_bf16(ov[0], ov[1]); pk.y = cvt_pk_bf16(ov[2], ov[3]); *(u32x2*)ad = pk;
            } else { *(u32x2*)ad = (u32x2){0u, 0u}; }
        }
    }
    __syncthreads();
    if (w == 0) {
        const LAS float* Am = (const LAS float*)(L + DP_AM);
        float t[64];
#pragma unroll
        for (int i = 0; i < 64; ++i) {
            float a0 = (lane == i) ? 1.f : 0.f, a1 = 0.f;
#pragma unroll
            for (int j = 0; j < i; j += 4) {
                const f32x4 av = *(const LAS f32x4*)(Am + i * 64 + j);
                a0 -= av[0] * t[j];
                if (j + 1 < i) a1 -= av[1] * t[j + 1];
                if (j + 2 < i) a0 -= av[2] * t[j + 2];
                if (j + 3 < i) a1 -= av[3] * t[j + 3];
            }
            t[i] = a0 + a1;
            *(LAS unsigned short*)(L + DP_TM + i * 144 + 2 * lane) = (unsigned short)(cvt_pk_bf16(t[i], 0.f) & 0xffffu);
        }
    } else {
        const int e0 = tid - 64;
        const float gl = gcs[63];
        for (int e = e0; e < 8192; e += 448) {
            const int kk = e >> 12, t = e & 63, dp = (e >> 6) & 63;
            const unsigned u = *(const LAS unsigned*)(L + (kk ? DP_K : DP_V) + t * 272 + 4 * dp);
            const float sc = kk ? bts[t] * __expf(gcs[t]) : bts[t];
            const unsigned pk = cvt_pk_bf16(bf_lo(u) * sc, bf_hi(u) * sc);
            LAS unsigned short* d0 = (LAS unsigned short*)(L + (kk ? DP_RTK : DP_RTV) + (2 * dp) * 144 + 2 * t);
            d0[0] = (unsigned short)(pk & 0xffffu); d0[72] = (unsigned short)(pk >> 16);
        }
        for (int e = e0; e < 1024; e += 448) {
            const int t = e >> 4, c16 = e & 15; const float sc = __expf(gcs[t]);
            const u32x4 u = *(const LAS u32x4*)(L + DP_Q + t * 272 + 16 * c16);
            u32x4 o; o.x = cvt_pk_bf16(bf_lo(u.x) * sc, bf_hi(u.x) * sc); o.y = cvt_pk_bf16(bf_lo(u.y) * sc, bf_hi(u.y) * sc); o.z = cvt_pk_bf16(bf_lo(u.z) * sc, bf_hi(u.z) * sc); o.w = cvt_pk_bf16(bf_lo(u.w) * sc, bf_hi(u.w) * sc);
            { bf16_t* qd = V_DQG + chs * 8192 + (size_t)t * 128 + 32 * (c16 >> 2) + 16 * (c16 & 1) + 4 * ((c16 >> 1) & 1); *(u32x2*)qd = (u32x2){o.x, o.y}; *(u32x2*)(qd + 8) = (u32x2){o.z, o.w}; }
        }
        for (int e = e0; e < 1024; e += 448) {
            const int dk = e >> 3, t8 = (e & 7) * 8;
            float v[8];
#pragma unroll
            for (int q = 0; q < 8; ++q) v[q] = bf1(*(const LAS unsigned short*)(L + DP_K + (t8 + q) * 272 + 2 * dk)) * __expf(gl - gcs[t8 + q]);
            u32x4 o; o.x = cvt_pk_bf16(v[0], v[1]); o.y = cvt_pk_bf16(v[2], v[3]); o.z = cvt_pk_bf16(v[4], v[5]); o.w = cvt_pk_bf16(v[6], v[7]);
            { bf16_t* kd = V_DKT + chs * 8192 + (size_t)dk * 64 + 32 * (t8 >> 5) + 16 * ((t8 >> 3) & 1) + 4 * ((t8 >> 4) & 1); *(u32x2*)kd = (u32x2){o.x, o.y}; *(u32x2*)(kd + 8) = (u32x2){o.z, o.w}; }
        }
        if (tid == 64) V_DDL[ch] = __expf(gl);
    }
    __syncthreads();
#pragma unroll
    for (int q = 0; q < 4; ++q) {
        const int id = 4 * w + q;
        { const int m = id >> 2, n = id & 3;
          const LAS unsigned char* ap = L + DP_RTK + (16 * m + li) * 144 + 16 * q4; const LAS unsigned char* bp = L + DP_TM + (16 * n + li) * 144 + 16 * q4;
          f32x4 acc = (f32x4){0.f, 0.f, 0.f, 0.f};
#pragma unroll
          for (int s2 = 0; s2 < 2; ++s2) acc = mfma16(*(const LAS bf16x8*)(ap + 64 * s2), *(const LAS bf16x8*)(bp + 64 * s2), acc);
          u32x2 pk; pk.x = cvt_pk_bf16(acc[0], acc[1]); pk.y = cvt_pk_bf16(acc[2], acc[3]);
          *(u32x2*)(V_DW + chs * 8192 + (size_t)(16 * n + li) * 128 + 32 * (m >> 1) + 8 * q4 + 4 * (m & 1)) = pk; }
        { const int mb = id & 3, nj = id >> 2;
          const LAS unsigned char* ap = L + DP_TM + (16 * mb + li) * 144 + 16 * q4; const LAS unsigned char* bp = L + DP_RTV + (16 * nj + li) * 144 + 16 * q4;
          f32x4 acc = (f32x4){0.f, 0.f, 0.f, 0.f};
#pragma unroll
          for (int s2 = 0; s2 < 2; ++s2) acc = mfma16(*(const LAS bf16x8*)(ap + 64 * s2), *(const LAS bf16x8*)(bp + 64 * s2), acc);
          *(f32x4*)(V_DU + ((chs * 8 + nj) * 64 + lane) * 16 + 4 * mb) = acc; }
    }
    __syncthreads();
}
__device__ __forceinline__ bf16x8 ld_perm(const LAS unsigned char* p) { const u32x2 a = *(const LAS u32x2*)p, b = *(const LAS u32x2*)(p + 32); u32x4 r; r.x = a.x; r.y = a.y; r.z = b.x; r.w = b.y; return __builtin_bit_cast(bf16x8, r); }
__device__ __forceinline__ bf16x8 pack_b(const f32x4 lo, const f32x4 hi) { u32x4 r; r.x = cvt_pk_bf16(lo[0], lo[1]); r.y = cvt_pk_bf16(lo[2], lo[3]); r.z = cvt_pk_bf16(hi[0], hi[1]); r.w = cvt_pk_bf16(hi[2], hi[3]); return __builtin_bit_cast(bf16x8, r); }
template <int DK, bool HAS_W>
__device__ __forceinline__ void chunk_scan_item(Ctx& F, const bf16_t* gW, const bf16_t* gQG, const bf16_t* gKT, const bf16_t* gAT, const float* gU, const bf16_t* vrow  , const float* gDL, float dl_const,
                                                float* obase  , float* Sout  ) {
    constexpr int RS_ = DK * 2 + 16;
    constexpr int OFF_QG = HAS_W ? 64 * RS_ : 0, OFF_KT = OFF_QG + 64 * RS_, OFF_AT = OFF_KT + DK * 144, BUF = OFF_AT + 64 * 144;
    constexpr int NWQ = (64 * DK / 8) / 512;
    constexpr int MT = DK / 16, KS = DK / 32;
    const int tid = F.tid, lane = F.lane, w = F.wave, li = lane & 15, q4 = lane >> 4;
    LAS unsigned char* L = F.lds;
    f32x4 S[MT];
#pragma unroll
    for (int m = 0; m < MT; ++m) S[m] = (f32x4){0.f, 0.f, 0.f, 0.f};
    u32x4 pfw[NWQ], pfq[NWQ], pfk[NWQ], pfa; f32x4 un[4];
#define CS_LOAD(cv) do { const size_t c_ = (cv); \
        _Pragma("unroll") for (int i_ = 0; i_ < NWQ; ++i_) { if (HAS_W) pfw[i_] = *(const u32x4*)(gW + c_ * (64 * DK) + (size_t)(tid + 512 * i_) * 8); \
            pfq[i_] = *(const u32x4*)(gQG + c_ * (64 * DK) + (size_t)(tid + 512 * i_) * 8); pfk[i_] = *(const u32x4*)(gKT + c_ * (64 * DK) + (size_t)(tid + 512 * i_) * 8); } \
        pfa = *(const u32x4*)(gAT + c_ * 4096 + (size_t)tid * 8); \
        if (HAS_W) { _Pragma("unroll") for (int m_ = 0; m_ < 4; ++m_) un[m_] = *(const f32x4*)(gU + ((c_ * 8 + w) * 64 + lane) * 16 + 4 * m_); } \
        else { const bf16_t* vp_ = vrow + (size_t)(64 * c_ + 4 * q4) * NPROJ + 16 * w + li; _Pragma("unroll") for (int m_ = 0; m_ < 4; ++m_) _Pragma("unroll") for (int r_ = 0; r_ < 4; ++r_) un[m_][r_] = bf1(vp_[(size_t)(16 * m_ + r_) * NPROJ]); } } while (0)
#define CS_STORE(bufv) do { LAS unsigned char* B_ = L + (bufv) * BUF; \
        _Pragma("unroll") for (int i_ = 0; i_ < NWQ; ++i_) { const int u_ = tid + 512 * i_; \
            if (HAS_W) *(LAS u32x4*)(B_ + (u_ / (DK / 8)) * RS_ + (u_ % (DK / 8)) * 16) = pfw[i_]; \
            *(LAS u32x4*)(B_ + OFF_QG + (u_ / (DK / 8)) * RS_ + (u_ % (DK / 8)) * 16) = pfq[i_]; \
            *(LAS u32x4*)(B_ + OFF_KT + (u_ >> 3) * 144 + (u_ & 7) * 16) = pfk[i_]; } \
        *(LAS u32x4*)(B_ + OFF_AT + (tid >> 3) * 144 + (tid & 7) * 16) = pfa; } while (0)
    CS_LOAD(0);
    CS_STORE(0);
    f32x4 uc[4];
#pragma unroll
    for (int m = 0; m < 4; ++m) uc[m] = un[m];
    float dl = gDL ? gDL[0] : dl_const;
    __syncthreads();
#pragma unroll 1
    for (int c = 0; c < 64; ++c) {
        const LAS unsigned char* Bf = L + (c & 1) * BUF;
        float dln = dl_const;
        if (c + 1 < 64) { CS_LOAD(c + 1); if (gDL) dln = gDL[c + 1]; }
        bf16x8 Sb[KS];
#pragma unroll
        for (int s2 = 0; s2 < KS; ++s2) Sb[s2] = pack_b(S[2 * s2], S[2 * s2 + 1]);
        const LAS unsigned char* fb = Bf + li * RS_ + 16 * q4;
        const LAS unsigned char* fb2 = Bf + li * 144 + 16 * q4;
        f32x4 vn[4];
        if (HAS_W) {
            bf16x8 fw[4][KS];
#pragma unroll
            for (int mb = 0; mb < 4; ++mb)
#pragma unroll
                for (int s2 = 0; s2 < KS; ++s2) fw[mb][s2] = *(const LAS bf16x8*)(fb + mb * 16 * RS_ + 64 * s2);
#pragma unroll
            for (int mb = 0; mb < 4; ++mb) vn[mb] = (f32x4){0.f, 0.f, 0.f, 0.f};
#pragma unroll
            for (int s2 = 0; s2 < KS; ++s2)
#pragma unroll
                for (int mb = 0; mb < 4; ++mb) vn[mb] = mfma16(fw[mb][s2], Sb[s2], vn[mb]);
#pragma unroll
            for (int mb = 0; mb < 4; ++mb) vn[mb] = uc[mb] - vn[mb];
        } else {
#pragma unroll
            for (int mb = 0; mb < 4; ++mb) vn[mb] = uc[mb];
        }
        bf16x8 Vb[2];
        Vb[0] = pack_b(vn[0], vn[1]); Vb[1] = pack_b(vn[2], vn[3]);
        {
            bf16x8 fq[4][KS], fa[4][2];
#pragma unroll
            for (int mb = 0; mb < 4; ++mb) {
#pragma unroll
                for (int s2 = 0; s2 < KS; ++s2) fq[mb][s2] = *(const LAS bf16x8*)(fb + OFF_QG + mb * 16 * RS_ + 64 * s2);
#pragma unroll
                for (int s2 = 0; s2 < 2; ++s2) fa[mb][s2] = *(const LAS bf16x8*)(fb2 + OFF_AT + mb * 16 * 144 + 64 * s2);
            }
            f32x4 oa[4];
#pragma unroll
            for (int mb = 0; mb < 4; ++mb) oa[mb] = (f32x4){0.f, 0.f, 0.f, 0.f};
#pragma unroll
            for (int s2 = 0; s2 < KS; ++s2)
#pragma unroll
                for (int mb = 0; mb < 4; ++mb) oa[mb] = mfma16(fq[mb][s2], Sb[s2], oa[mb]);
#pragma unroll
            for (int s2 = 0; s2 < 2; ++s2)
#pragma unroll
                for (int mb = 0; mb < 4; ++mb) oa[mb] = mfma16(fa[mb][s2], Vb[s2], oa[mb]);
            float* od = obase + (size_t)(64 * c + 4 * q4) * 512 + 16 * w + li;
#pragma unroll
            for (int mb = 0; mb < 4; ++mb)
#pragma unroll
                for (int rg = 0; rg < 4; ++rg) od[(size_t)(16 * mb + rg) * 512] = oa[mb][rg];
        }
        {
            bf16x8 fk[MT][2];
#pragma unroll
            for (int m = 0; m < MT; ++m)
#pragma unroll
                for (int s2 = 0; s2 < 2; ++s2) fk[m][s2] = *(const LAS bf16x8*)(fb2 + OFF_KT + m * 16 * 144 + 64 * s2);
#pragma unroll
            for (int m = 0; m < MT; ++m) S[m] = S[m] * dl;
#pragma unroll
            for (int s2 = 0; s2 < 2; ++s2)
#pragma unroll
                for (int m = 0; m < MT; ++m) S[m] = mfma16(fk[m][s2], Vb[s2], S[m]);
        }
        if (c + 1 < 64) { CS_STORE((c + 1) & 1);
#pragma unroll
            for (int m = 0; m < 4; ++m) uc[m] = un[m];
            dl = dln; }
        __syncthreads();
    }
#undef CS_LOAD
#undef CS_STORE
    float* So = Sout + 16 * w + li;
#pragma unroll
    for (int m = 0; m < MT; ++m)
#pragma unroll
        for (int rg = 0; rg < 4; ++rg) So[(size_t)(16 * m + 4 * q4 + rg) * 128] = S[m][rg];
    __syncthreads();
}

constexpr int D2_BUF = 35840, D2_KT = 17408;
__device__ __forceinline__ void delta_scan2_item(Ctx& F, int l, int b, int h) {
    const int tid = F.tid, lane = F.lane, w = F.wave, li = lane & 15, q4 = lane >> 4;
    LAS unsigned char* L = F.lds;
    const size_t ch0 = (size_t)(b * 4 + h) * 64;
    const bf16_t* gW = V_DW + ch0 * 8192; const bf16_t* gKT = V_DKT + ch0 * 8192; const float* gU = V_DU + ch0 * 8192; const float* gDL = V_DDL + ch0;
    bf16_t* gSB = V_SB + ch0 * 16384; bf16_t* gVB = V_VB + ch0 * 8192;
    f32x4 S[8];
#pragma unroll
    for (int m = 0; m < 8; ++m) S[m] = (f32x4){0.f, 0.f, 0.f, 0.f};
    u32x4 pa[4], pb[4]; f32x4 ua[4], ub[4], uc[4]; float dla = 0.f, dlb = 0.f, dl;
#define D2_LOAD(P, U_, DL_, cv) do { const size_t c_ = (cv); \
        P[0] = *(const u32x4*)(gW + c_ * 8192 + (size_t)tid * 8); P[1] = *(const u32x4*)(gW + c_ * 8192 + (size_t)(tid + 512) * 8); \
        P[2] = *(const u32x4*)(gKT + c_ * 8192 + (size_t)tid * 8); P[3] = *(const u32x4*)(gKT + c_ * 8192 + (size_t)(tid + 512) * 8); \
        _Pragma("unroll") for (int m_ = 0; m_ < 4; ++m_) U_[m_] = *(const f32x4*)(gU + ((c_ * 8 + w) * 64 + lane) * 16 + 4 * m_); DL_ = gDL[c_]; } while (0)
#define D2_STORE(P, bufv) do { LAS unsigned char* B_ = L + (bufv) * D2_BUF; \
        *(LAS u32x4*)(B_ + (tid >> 4) * 272 + (tid & 15) * 16) = P[0]; *(LAS u32x4*)(B_ + ((tid >> 4) + 32) * 272 + (tid & 15) * 16) = P[1]; \
        *(LAS u32x4*)(B_ + D2_KT + (tid >> 3) * 144 + (tid & 7) * 16) = P[2]; *(LAS u32x4*)(B_ + D2_KT + ((tid >> 3) + 64) * 144 + (tid & 7) * 16) = P[3]; } while (0)
#define D2_COMPUTE(bufv, cv) do { const LAS unsigned char* Bf = L + (bufv) * D2_BUF; const size_t c_ = (cv); \
        bf16x8 Sb[4]; \
        _Pragma("unroll") for (int s2 = 0; s2 < 4; ++s2) { Sb[s2] = pack_b(S[2 * s2], S[2 * s2 + 1]); *(bf16x8*)(gSB + (((c_ * 8 + w) * 4 + s2) * 64 + lane) * 8) = Sb[s2]; } \
        const LAS unsigned char* fb = Bf + li * 272 + 16 * q4; const LAS unsigned char* fb2 = Bf + D2_KT + li * 144 + 16 * q4; \
        f32x4 vn[4]; \
        { bf16x8 fw[4][4]; \
          _Pragma("unroll") for (int mb = 0; mb < 4; ++mb) _Pragma("unroll") for (int s2 = 0; s2 < 4; ++s2) fw[mb][s2] = *(const LAS bf16x8*)(fb + mb * 16 * 272 + 64 * s2); \
          _Pragma("unroll") for (int mb = 0; mb < 4; ++mb) vn[mb] = (f32x4){0.f, 0.f, 0.f, 0.f}; \
          _Pragma("unroll") for (int s2 = 0; s2 < 4; ++s2) _Pragma("unroll") for (int mb = 0; mb < 4; ++mb) vn[mb] = mfma16(fw[mb][s2], Sb[s2], vn[mb]); } \
        _Pragma("unroll") for (int mb = 0; mb < 4; ++mb) vn[mb] = uc[mb] - vn[mb]; \
        bf16x8 Vb[2]; Vb[0] = pack_b(vn[0], vn[1]); Vb[1] = pack_b(vn[2], vn[3]); \
        _Pragma("unroll") for (int s2 = 0; s2 < 2; ++s2) *(bf16x8*)(gVB + (((c_ * 8 + w) * 2 + s2) * 64 + lane) * 8) = Vb[s2]; \
        { bf16x8 fk[8][2]; \
          _Pragma("unroll") for (int m = 0; m < 8; ++m) _Pragma("unroll") for (int s2 = 0; s2 < 2; ++s2) fk[m][s2] = *(const LAS bf16x8*)(fb2 + m * 16 * 144 + 64 * s2); \
          _Pragma("unroll") for (int m = 0; m < 8; ++m) S[m] = S[m] * dl; \
          _Pragma("unroll") for (int s2 = 0; s2 < 2; ++s2) _Pragma("unroll") for (int m = 0; m < 8; ++m) S[m] = mfma16(fk[m][s2], Vb[s2], S[m]); } } while (0)
    D2_LOAD(pa, ua, dla, 0);
    D2_LOAD(pb, ub, dlb, 1);
    D2_STORE(pa, 0);
#pragma unroll
    for (int m = 0; m < 4; ++m) uc[m] = ua[m];
    dl = dla;
    __syncthreads();
#pragma unroll 1
    for (int c = 0; c < 64; c += 2) {
        if (c + 2 < 64) D2_LOAD(pa, ua, dla, c + 2);
        D2_COMPUTE(0, c);
        D2_STORE(pb, 1);
#pragma unroll
        for (int m = 0; m < 4; ++m) uc[m] = ub[m];
        dl = dlb;
        __syncthreads();
        if (c + 3 < 64) D2_LOAD(pb, ub, dlb, c + 3);
        D2_COMPUTE(1, c + 1);
        if (c + 2 < 64) { D2_STORE(pa, 0);
#pragma unroll
            for (int m = 0; m < 4; ++m) uc[m] = ua[m];
            dl = dla; }
        __syncthreads();
    }
#undef D2_LOAD
#undef D2_STORE
#undef D2_COMPUTE
    float* So = F.out + O_BSP + ((size_t)(l * BATCH + b) * 4 + h) * 16384 + 16 * w + li;
#pragma unroll
    for (int m = 0; m < 8; ++m)
#pragma unroll
        for (int rg = 0; rg < 4; ++rg) So[(size_t)(16 * m + 4 * q4 + rg) * 128] = S[m][rg];
    __syncthreads();
}
__device__ __forceinline__ void delta_out_item(Ctx& F, int l, int ch) {
    const int tid = F.tid, lane = F.lane, w = F.wave, li = lane & 15, q4 = lane >> 4;
    const int c = ch & 63, h = (ch >> 6) & 3, b = ch >> 8;
    const int row0 = b * SEQ + 64 * c;
    LAS unsigned char* L = F.lds;
    const size_t chs = (size_t)ch;
    const u32x4 q0 = *(const u32x4*)(V_DQG + chs * 8192 + (size_t)tid * 8), q1 = *(const u32x4*)(V_DQG + chs * 8192 + (size_t)(tid + 512) * 8), a0 = *(const u32x4*)(V_DAT + chs * 4096 + (size_t)tid * 8);
    bf16x8 Sb[4], Vb[2];
#pragma unroll
    for (int s2 = 0; s2 < 4; ++s2) Sb[s2] = *(const bf16x8*)(V_SB + (((chs * 8 + w) * 4 + s2) * 64 + lane) * 8);
#pragma unroll
    for (int s2 = 0; s2 < 2; ++s2) Vb[s2] = *(const bf16x8*)(V_VB + (((chs * 8 + w) * 2 + s2) * 64 + lane) * 8);
    const float gn = F.in[15][l * 128 + 16 * w + li];
    const bf16_t* zp = V_PROJ + (size_t)(row0 + 4 * q4) * NPROJ + PC_BZ + h * 128 + 16 * w + li;
    float zz[16];
#pragma unroll
    for (int i = 0; i < 16; ++i) zz[i] = bf1(zp[(size_t)(16 * (i >> 2) + (i & 3)) * NPROJ]);
    *(LAS u32x4*)(L + (tid >> 4) * 272 + (tid & 15) * 16) = q0; *(LAS u32x4*)(L + ((tid >> 4) + 32) * 272 + (tid & 15) * 16) = q1;
    *(LAS u32x4*)(L + 17408 + (tid >> 3) * 144 + (tid & 7) * 16) = a0;
    __syncthreads();
    f32x4 oa[4];
    {
        const LAS unsigned char* fb = L + li * 272 + 16 * q4; const LAS unsigned char* fb2 = L + 17408 + li * 144 + 16 * q4;
        bf16x8 fq[4][4], fa[4][2];
#pragma unroll
        for (int mb = 0; mb < 4; ++mb) {
#pragma unroll
            for (int s2 = 0; s2 < 4; ++s2) fq[mb][s2] = *(const LAS bf16x8*)(fb + mb * 16 * 272 + 64 * s2);
#pragma unroll
            for (int s2 = 0; s2 < 2; ++s2) fa[mb][s2] = *(const LAS bf16x8*)(fb2 + mb * 16 * 144 + 64 * s2);
        }
#pragma unroll
        for (int mb = 0; mb < 4; ++mb) oa[mb] = (f32x4){0.f, 0.f, 0.f, 0.f};
#pragma unroll
        for (int s2 = 0; s2 < 4; ++s2)
#pragma unroll
            for (int mb = 0; mb < 4; ++mb) oa[mb] = mfma16(fq[mb][s2], Sb[s2], oa[mb]);
#pragma unroll
        for (int s2 = 0; s2 < 2; ++s2)
#pragma unroll
            for (int mb = 0; mb < 4; ++mb) oa[mb] = mfma16(fa[mb][s2], Vb[s2], oa[mb]);
    }
    LAS float* part = (LAS float*)(L + 32768);
#pragma unroll
    for (int mb = 0; mb < 4; ++mb)
#pragma unroll
        for (int rg = 0; rg < 4; ++rg) { float ss = oa[mb][rg] * oa[mb][rg];
            ss = row_sum16(ss);
            if (li == 0) part[(16 * mb + 4 * q4 + rg) * 8 + w] = ss; }
    __syncthreads();
    bf16_t* od = V_OABC + (size_t)M * 512 + (size_t)(row0 + 4 * q4) * 512 + h * 128 + 16 * w + li;
#pragma unroll
    for (int mb = 0; mb < 4; ++mb)
#pragma unroll
        for (int rg = 0; rg < 4; ++rg) { const int tk = 16 * mb + 4 * q4 + rg;
            const f32x4 p0 = *(const LAS f32x4*)(part + tk * 8), p1 = *(const LAS f32x4*)(part + tk * 8 + 4);
            const float rstd = rsqrtf(((p0[0] + p0[1]) + (p0[2] + p0[3]) + (p1[0] + p1[1]) + (p1[2] + p1[3])) * (1.f / 128.f) + EPS);
            const float z = zz[4 * mb + rg];
            od[(size_t)(16 * mb + rg) * 512] = (bf16_t)(cvt_pk_bf16(oa[mb][rg] * rstd * gn * z * sigmoidf_(z), 0.f) & 0xffffu); }
    __syncthreads();
}
__device__ __forceinline__ void delta_scan_item(Ctx& F, int l, int b, int h) {
    const size_t ch0 = (size_t)(b * 4 + h) * 64;
    chunk_scan_item<128, true>(F, V_DW + ch0 * 8192, V_DQG + ch0 * 8192, V_DKT + ch0 * 8192, V_DAT + ch0 * 4096, V_DU + ch0 * 8192, nullptr, V_DDL + ch0, 0.f,
                               V_OBR + (size_t)(b * SEQ) * 512 + h * 128, F.out + O_BSP + ((size_t)(l * BATCH + b) * 4 + h) * 16384);
}
__device__ __forceinline__ void ret_scan_item(Ctx& F, int l, int b, int h) {
    const size_t ch0 = (size_t)(b * 4 + h) * 64;
    const float lg2 = log2f(1.f - exp2f(-5.f - (float)h));
    chunk_scan_item<64, false>(F, nullptr, V_RQG + ch0 * 4096, V_RKT + ch0 * 4096, V_RAT + ch0 * 4096, nullptr, V_PROJ + (size_t)(b * SEQ) * NPROJ + PC_CV + h * 128, nullptr, exp2f(64.f * lg2),
                               V_OCR + (size_t)(b * SEQ) * 512 + h * 128, F.out + O_CRP + ((size_t)(l * BATCH + b) * 4 + h) * 8192);
}
__device__ __forceinline__ void ret_prep_item(Ctx& F, int l, int item) {
    const int tid = F.tid, lane = F.lane, w = F.wave, li = lane & 15, q4 = lane >> 4;
    const int pj = w >> 1, t2 = tid & 127, w2 = w & 1;
    const int ch = 4 * item + pj, c = ch & 63, h = (ch >> 6) & 3, b = ch >> 8;
    const int row0 = b * SEQ + 64 * c;
    const bf16_t* proj = V_PROJ;
    LAS unsigned char* L = F.lds + pj * 18432;
    const float lg2 = log2f(1.f - exp2f(-5.f - (float)h));
    const size_t chs = (size_t)ch;
#pragma unroll
    for (int k8 = 0; k8 < 8; ++k8) {
        const int task = t2 + 128 * k8, qk = task >> 9, t = (task >> 3) & 63, i0 = 4 * (task & 7);
        const float* cs = V_ROPEC + ((size_t)(64 * c + t) * 32 + i0) * 2;
        const f32x4 c01 = *(const f32x4*)cs, c23 = *(const f32x4*)(cs + 4);
        const f32x4 cc = (f32x4){c01[0], c01[2], c23[0], c23[2]}, sn = (f32x4){c01[1], c01[3], c23[1], c23[3]};
        const bf16_t* p = proj + (size_t)(row0 + t) * NPROJ + (qk ? PC_CK : PC_CQ) + h * 64;
        const u32x2 ulo = *(const u32x2*)(p + i0), uhi = *(const u32x2*)(p + 32 + i0);
        const f32x4 lo = (f32x4){bf_lo(ulo.x), bf_hi(ulo.x), bf_lo(ulo.y), bf_hi(ulo.y)}, hi = (f32x4){bf_lo(uhi.x), bf_hi(uhi.x), bf_lo(uhi.y), bf_hi(uhi.y)};
        const float sc = qk ? 0.125f : 1.f;
        const f32x4 olo = (lo * cc - hi * sn) * sc, ohi = (hi * cc + lo * sn) * sc;
        u32x2 plo, phi; plo.x = cvt_pk_bf16(olo[0], olo[1]); plo.y = cvt_pk_bf16(olo[2], olo[3]); phi.x = cvt_pk_bf16(ohi[0], ohi[1]); phi.y = cvt_pk_bf16(ohi[2], ohi[3]);
        *(LAS u32x2*)(L + qk * 9216 + t * 144 + 2 * i0) = plo; *(LAS u32x2*)(L + qk * 9216 + t * 144 + 64 + 2 * i0) = phi;
    }
    __syncthreads();
#pragma unroll
    for (int t8 = 0; t8 < 8; ++t8) {
        const int tile = 8 * w2 + t8, mi = tile >> 2, nj = tile & 3;
        bf16_t* ad = V_RAT + chs * 4096 + (size_t)(16 * mi + li) * 64 + 32 * (nj >> 1) + 8 * q4 + 4 * (nj & 1);
        if (nj <= mi) {
            f32x4 aqk = (f32x4){0.f, 0.f, 0.f, 0.f};
            const LAS unsigned char* kj = L + 9216 + (16 * nj + li) * 144 + 16 * q4; const LAS unsigned char* qi = L + (16 * mi + li) * 144 + 16 * q4;
#pragma unroll
            for (int s2 = 0; s2 < 2; ++s2) aqk = mfma16(*(const LAS bf16x8*)(kj + 64 * s2), *(const LAS bf16x8*)(qi + 64 * s2), aqk);
            float ov[4];
#pragma unroll
            for (int rg = 0; rg < 4; ++rg) { const int j2 = 16 * nj + 4 * q4 + rg, i2 = 16 * mi + li; ov[rg] = (i2 >= j2) ? aqk[rg] * exp2f((float)(i2 - j2) * lg2) : 0.f; }
            u32x2 pk; pk.x = cvt_pk_bf16(ov[0], ov[1]); pk.y = cvt_pk_bf16(ov[2], ov[3]); *(u32x2*)ad = pk;
        } else { *(u32x2*)ad = (u32x2){0u, 0u}; }
    }
#pragma unroll
    for (int k4 = 0; k4 < 4; ++k4) {
        const int u_ = t2 + 128 * k4;
        { const int t = u_ >> 3, c8 = u_ & 7; const float sc = exp2f((float)(t + 1) * lg2);
          const u32x4 u = *(const LAS u32x4*)(L + t * 144 + 16 * c8);
          u32x4 o; o.x = cvt_pk_bf16(bf_lo(u.x) * sc, bf_hi(u.x) * sc); o.y = cvt_pk_bf16(bf_lo(u.y) * sc, bf_hi(u.y) * sc); o.z = cvt_pk_bf16(bf_lo(u.z) * sc, bf_hi(u.z) * sc); o.w = cvt_pk_bf16(bf_lo(u.w) * sc, bf_hi(u.w) * sc);
          bf16_t* qd = V_RQG + chs * 4096 + (size_t)t * 64 + 32 * (c8 >> 2) + 16 * (c8 & 1) + 4 * ((c8 >> 1) & 1); *(u32x2*)qd = (u32x2){o.x, o.y}; *(u32x2*)(qd + 8) = (u32x2){o.z, o.w}; }
        { const int dk = u_ >> 3, t8 = (u_ & 7) * 8;
          float v[8];
#pragma unroll
          for (int q = 0; q < 8; ++q) v[q] = bf1(*(const LAS unsigned short*)(L + 9216 + (t8 + q) * 144 + 2 * dk)) * exp2f((float)(63 - t8 - q) * lg2);
          u32x4 o2; o2.x = cvt_pk_bf16(v[0], v[1]); o2.y = cvt_pk_bf16(v[2], v[3]); o2.z = cvt_pk_bf16(v[4], v[5]); o2.w = cvt_pk_bf16(v[6], v[7]);
          bf16_t* kd = V_RKT + chs * 4096 + (size_t)dk * 64 + 32 * (t8 >> 5) + 16 * ((t8 >> 3) & 1) + 4 * ((t8 >> 4) & 1); *(u32x2*)kd = (u32x2){o2.x, o2.y}; *(u32x2*)(kd + 8) = (u32x2){o2.z, o2.w}; }
    }
    __syncthreads();
}
__device__ __forceinline__ void delta_item(Ctx& F, int l, bool sample, int b, int h) {
    LAS float* sm = (LAS float*)F.lds;
    LAS float* qs = sm, *ks = sm + 2048, *vs = sm + 4096, *bgs = sm + 6144, *pa = sm + 6400, *pb = sm + 6912;
    const int tid = F.tid, c = tid & 127, qr = tid >> 7;
    float s[32];
    if (sample) { const float* S0 = F.in[6] + ((size_t)(l * DB + b) * 4 + h) * 16384;
#pragma unroll
        for (int i = 0; i < 32; ++i) s[i] = S0[(32 * qr + i) * 128 + c]; }
    else {
#pragma unroll
        for (int i = 0; i < 32; ++i) s[i] = 0.f; }
    const int T = sample ? DS : SEQ, row0 = sample ? MP + b * DS : b * SEQ;
    for (int t0 = 0; t0 < T; t0 += 16) {
        const int nt = min(16, T - t0);
        __syncthreads();
#pragma unroll
        for (int r = 0; r < 12; ++r) { const int e = tid + 512 * r, tok = e / 384, w = e - tok * 384, typ = w >> 7, d = w & 127;
            if (tok < nt) sm[typ * 2048 + tok * 128 + d] = V_BQKV[(size_t)(row0 + t0 + tok) * 1536 + typ * 512 + h * 128 + d]; }
        if (tid < 32) { const int tok = tid >> 1, wh = tid & 1; if (tok < nt) bgs[tok * 2 + wh] = V_BG[(size_t)(row0 + t0 + tok) * 8 + wh * 4 + h]; }
        __syncthreads();
        for (int tt = 0; tt < nt; ++tt) {
            const LAS float* kk = ks + tt * 128 + 32 * qr; const LAS float* qq = qs + tt * 128 + 32 * qr;
            float a = 0.f;
#pragma unroll
            for (int i = 0; i < 32; ++i) a += kk[i] * s[i];
            pa[qr * 128 + c] = a;
            __syncthreads();
            const float kS = (pa[c] + pa[128 + c]) + (pa[256 + c] + pa[384 + c]);
            const float e = __expf(bgs[tt * 2 + 1]), be = bgs[tt * 2];
            const float vn = be * (vs[tt * 128 + c] - e * kS);
            float o = 0.f;
#pragma unroll
            for (int i = 0; i < 32; ++i) { s[i] = e * s[i] + kk[i] * vn; o += qq[i] * s[i]; }
            pb[qr * 128 + c] = o;
            __syncthreads();
            if (qr == 0) V_OBR[(size_t)(row0 + t0 + tt) * 512 + h * 128 + c] = (pb[c] + pb[128 + c]) + (pb[256 + c] + pb[384 + c]);
        }
    }
    float* So = F.out + (sample ? O_BSS + ((size_t)(l * DB + b) * 4 + h) * 16384 : O_BSP + ((size_t)(l * BATCH + b) * 4 + h) * 16384);
#pragma unroll
    for (int i = 0; i < 32; ++i) So[(32 * qr + i) * 128 + c] = s[i];
    __syncthreads();
}
__device__ __forceinline__ void ret_item(Ctx& F, int l, bool sample, int b, int h) {
    LAS float* sm = (LAS float*)F.lds;
    LAS float* qs = sm, *ks = sm + 1024, *vs = sm + 2048, *pp = sm + 4096;
    const int tid = F.tid, c = tid & 127, qr = tid >> 7;
    const float gam = 1.f - exp2f(-5.f - (float)h);
    float r[16];
    if (sample) { const float* R0 = F.in[7] + ((size_t)(l * DB + b) * 4 + h) * 8192;
#pragma unroll
        for (int i = 0; i < 16; ++i) r[i] = R0[(16 * qr + i) * 128 + c]; }
    else {
#pragma unroll
        for (int i = 0; i < 16; ++i) r[i] = 0.f; }
    const int T = sample ? DS : SEQ, row0 = sample ? MP + b * DS : b * SEQ;
    for (int t0 = 0; t0 < T; t0 += 16) {
        const int nt = min(16, T - t0);
        __syncthreads();
#pragma unroll
        for (int rr = 0; rr < 4; ++rr) { const int e = tid + 512 * rr, tok = e >> 7, w = e & 127, typ = w >> 6, d = w & 63;
            if (tok < nt) sm[typ * 1024 + tok * 64 + d] = V_CQK[(size_t)(row0 + t0 + tok) * 512 + typ * 256 + h * 64 + d]; }
#pragma unroll
        for (int rr = 0; rr < 4; ++rr) { const int e = tid + 512 * rr, tok = e >> 7, d = e & 127;
            if (tok < nt) vs[tok * 128 + d] = bf1(V_PROJ[(size_t)(row0 + t0 + tok) * NPROJ + PC_CV + h * 128 + d]); }
        __syncthreads();
        for (int tt = 0; tt < nt; ++tt) {
            const LAS float* kk = ks + tt * 64 + 16 * qr; const LAS float* qq = qs + tt * 64 + 16 * qr;
            const float v = vs[tt * 128 + c];
            float o = 0.f;
#pragma unroll
            for (int i = 0; i < 16; ++i) { r[i] = gam * r[i] + kk[i] * v; o += qq[i] * r[i]; }
            LAS float* pq = pp + (tt & 1) * 512;
            pq[qr * 128 + c] = o;
            __syncthreads();
            if (qr == 0) V_OCR[(size_t)(row0 + t0 + tt) * 512 + h * 128 + c] = (pq[c] + pq[128 + c]) + (pq[256 + c] + pq[384 + c]);
        }
    }
    float* Ro = F.out + (sample ? O_CRS + ((size_t)(l * DB + b) * 4 + h) * 8192 : O_CRP + ((size_t)(l * BATCH + b) * 4 + h) * 8192);
#pragma unroll
    for (int i = 0; i < 16; ++i) Ro[(16 * qr + i) * 128 + c] = r[i];
    __syncthreads();
}
constexpr int IT_DP = 0, IT_RP = 16, IT_ATS = 32, IT_DS = IT_ATS + 384, IT_RS = IT_DS + 128, IT_AT = IT_RS + 128, IT_END = IT_AT + 768;
__device__ __forceinline__ void phase_mix(Ctx& F, int l, int rep) {
    volatile LAS int* slot = (volatile LAS int*)(F.lds + LDS_BYTES - 64);
    unsigned* ctr = V_CTL + (l == 0 ? CW_MIX0 : CW_MIX1) + 256 * rep;
    for (;;) {
        __syncthreads();
        if (F.tid == 0) *slot = (int)atomicAdd(ctr, 1u);
        __syncthreads();
        const int it = __builtin_amdgcn_readfirstlane(*slot);
        { int t_ = F.tid; asm volatile("" : "+v"(t_)); F.tid = t_; F.lane = t_ & 63; }
        if (it >= IT_END) break;
#ifndef MIXSEL
#define MIXSEL 15
#endif
        if (it < IT_RP) delta_scan2_item(F, l, it >> 2, it & 3);
        else if (it < IT_ATS) ret_scan_item(F, l, (it - IT_RP) >> 2, (it - IT_RP) & 3);
        else if (it < IT_DS) { const int u = (it - IT_ATS) * 8 + F.wave; attn_sample_unit(F, l, u / 12, (u % 12) & 3, (u % 12) >> 2); }
        else if (it < IT_RS) delta_item(F, l, true, (it - IT_DS) >> 2, (it - IT_DS) & 3);
        else if (it < IT_AT) ret_item(F, l, true, (it - IT_RS) >> 2, (it - IT_RS) & 3);
        else attn_mfma_item(F, it - IT_AT);
    }
}
__device__ __forceinline__ void fin_row(Ctx& F, int l, int row) {
    const int lane = F.lane, h = lane >> 4, j8 = 8 * (lane & 15);
    {
        const float l0 = V_LSE[((size_t)0 * M + row) * 4 + h], l1 = V_LSE[((size_t)1 * M + row) * 4 + h], l2 = V_LSE[((size_t)2 * M + row) * 4 + h];
        const u32x4 a0 = *(const u32x4*)(V_AO + ((size_t)0 * M + row) * 512 + h * 128 + j8), a1 = *(const u32x4*)(V_AO + ((size_t)1 * M + row) * 512 + h * 128 + j8), a2 = *(const u32x4*)(V_AO + ((size_t)2 * M + row) * 512 + h * 128 + j8);
        const float mm = fmaxf(l0, fmaxf(l1, l2)); float e0 = __expf(l0 - mm), e1 = __expf(l1 - mm), e2 = __expf(l2 - mm); const float iv = 1.f / (e0 + e1 + e2); e0 *= iv; e1 *= iv; e2 *= iv;
        u32x4 o;
        o.x = cvt_pk_bf16(e0 * bf_lo(a0.x) + e1 * bf_lo(a1.x) + e2 * bf_lo(a2.x), e0 * bf_hi(a0.x) + e1 * bf_hi(a1.x) + e2 * bf_hi(a2.x));
        o.y = cvt_pk_bf16(e0 * bf_lo(a0.y) + e1 * bf_lo(a1.y) + e2 * bf_lo(a2.y), e0 * bf_hi(a0.y) + e1 * bf_hi(a1.y) + e2 * bf_hi(a2.y));
        o.z = cvt_pk_bf16(e0 * bf_lo(a0.z) + e1 * bf_lo(a1.z) + e2 * bf_lo(a2.z), e0 * bf_hi(a0.z) + e1 * bf_hi(a1.z) + e2 * bf_hi(a2.z));
        o.w = cvt_pk_bf16(e0 * bf_lo(a0.w) + e1 * bf_lo(a1.w) + e2 * bf_lo(a2.w), e0 * bf_hi(a0.w) + e1 * bf_hi(a1.w) + e2 * bf_hi(a2.w));
        *(u32x4*)(V_OABC + (size_t)row * 512 + h * 128 + j8) = o;
    }
#pragma unroll
    for (int br = 0; br < 2; ++br) {
        if (br == 0 && row < MP) continue;
        const float* src = (br == 0 ? V_OBR : V_OCR) + (size_t)row * 512 + h * 128 + j8;
        const f32x4 x0 = *(const f32x4*)src, x1 = *(const f32x4*)(src + 4);
        const float* gn = F.in[15 + br] + l * 128 + j8;
        const f32x4 g0 = *(const f32x4*)gn, g1 = *(const f32x4*)(gn + 4);
        const u32x4 zz = *(const u32x4*)(V_PROJ + (size_t)row * NPROJ + (br == 0 ? PC_BZ : PC_CZ) + h * 128 + j8);
        const float ss = row_sum16((x0[0] * x0[0] + x0[1] * x0[1]) + (x0[2] * x0[2] + x0[3] * x0[3]) + (x1[0] * x1[0] + x1[1] * x1[1]) + (x1[2] * x1[2] + x1[3] * x1[3]));
        const float rstd = rsqrtf(ss * (1.f / 128.f) + EPS);
        const float z0 = bf_lo(zz.x), z1 = bf_hi(zz.x), z2 = bf_lo(zz.y), z3 = bf_hi(zz.y), z4 = bf_lo(zz.z), z5 = bf_hi(zz.z), z6 = bf_lo(zz.w), z7 = bf_hi(zz.w);
        u32x4 o;
        o.x = cvt_pk_bf16(x0[0] * rstd * g0[0] * z0 * sigmoidf_(z0), x0[1] * rstd * g0[1] * z1 * sigmoidf_(z1));
        o.y = cvt_pk_bf16(x0[2] * rstd * g0[2] * z2 * sigmoidf_(z2), x0[3] * rstd * g0[3] * z3 * sigmoidf_(z3));
        o.z = cvt_pk_bf16(x1[0] * rstd * g1[0] * z4 * sigmoidf_(z4), x1[1] * rstd * g1[1] * z5 * sigmoidf_(z5));
        o.w = cvt_pk_bf16(x1[2] * rstd * g1[2] * z6 * sigmoidf_(z6), x1[3] * rstd * g1[3] * z7 * sigmoidf_(z7));
        *(u32x4*)(V_OABC + (size_t)(1 + br) * M * 512 + (size_t)row * 512 + h * 128 + j8) = o;
    }
}

typedef float f32x16 __attribute__((ext_vector_type(16)));
template <int NSUB, bool GATED>
__device__ __forceinline__ void mini_gemm_core(Ctx& F, int tile, const bf16_t* A, size_t a_sub, const bf16_t* Bt, size_t b_sub, int K, float (&res)[2], int& orow, int& ocol, int (&oreg)[2]) {
    const int lane = F.lane, w = F.wave, r = lane & 31, hh = lane >> 5;
    const int rb = tile & 7, cb = tile >> 3;
    const int kw = K >> 3, k0 = w * kw;
    f32x16 tot;
#pragma unroll
    for (int i = 0; i < 16; ++i) tot[i] = 0.f;
#pragma unroll 1
    for (int sub = 0; sub < NSUB; ++sub) {
        const bf16_t* ap = A + sub * a_sub + (size_t)(MP + rb * 32 + r) * K + k0 + 8 * hh;
        const bf16_t* bp = Bt + sub * b_sub + (size_t)(cb * 32 + r) * K + k0 + 8 * hh;
        f32x16 acc;
#pragma unroll
        for (int i = 0; i < 16; ++i) acc[i] = 0.f;
#pragma unroll 2
        for (int s2 = 0; s2 < kw; s2 += 16) acc = __builtin_amdgcn_mfma_f32_32x32x16_bf16(*(const bf16x8*)(ap + s2), *(const bf16x8*)(bp + s2), acc, 0, 0, 0);
        if (GATED) {
            const bf16_t* gp = V_PROJ + (size_t)(MP + rb * 32 + 4 * hh) * NPROJ + PC_GATE + sub * 1024 + cb * 32 + r;
#pragma unroll
            for (int i = 0; i < 16; ++i) tot[i] += bf1(gp[(size_t)((i & 3) + 8 * (i >> 2)) * NPROJ]) * acc[i];
        } else tot = acc;
    }
    LAS float* red = (LAS float*)F.lds;
#pragma unroll
    for (int i = 0; i < 16; ++i) red[(w * 16 + i) * 64 + lane] = tot[i];
    __syncthreads();
    const int g = F.tid >> 6;
#pragma unroll
    for (int q = 0; q < 2; ++q) { const int rg = 2 * g + q; float v = 0.f;
#pragma unroll
        for (int ww = 0; ww < 8; ++ww) v += red[(ww * 16 + rg) * 64 + lane];
        res[q] = v; oreg[q] = rg; }
    orow = MP + rb * 32 + 4 * hh; ocol = cb * 32 + r;
    __syncthreads();
}
__device__ __forceinline__ void mini_abc(Ctx& F, int l) {
    for (int tile = F.bid; tile < 256; tile += F.G) {
    float res[2]; int orow, ocol, oreg[2];
    mini_gemm_core<3, true>(F, tile, V_OABC, (size_t)M * 512, V_WABC + (size_t)l * 3 * D * 512, (size_t)D * 512, 512, res, orow, ocol, oreg);
#pragma unroll
    for (int q = 0; q < 2; ++q) { const int row = orow + (oreg[q] & 3) + 8 * (oreg[q] >> 2);
        V_MRG[(size_t)row * D + ocol] = (bf16_t)(cvt_pk_bf16(res[q], 0.f) & 0xffffu); }
    }
}
__device__ __forceinline__ void mini_res(Ctx& F, const bf16_t* A, const bf16_t* Bt, int K, const float* resid  , const bf16_t* resb  , float* out, bf16_t* xb, float* rowss) {
    for (int tile = F.bid; tile < 256; tile += F.G) {
    float res[2]; int orow, ocol, oreg[2];
    mini_gemm_core<1, false>(F, tile, A, 0, Bt, 0, K, res, orow, ocol, oreg);
#pragma unroll
    for (int q = 0; q < 2; ++q) { const int row = orow + (oreg[q] & 3) + 8 * (oreg[q] >> 2);
        const float o = (resb ? bf1(resb[(size_t)row * D + ocol]) : resid[(size_t)(row - MP) * D + ocol]) + res[q];
        if (out) out[(size_t)row * D + ocol] = o; else xb[(size_t)row * D + ocol] = (bf16_t)(cvt_pk_bf16(o, 0.f) & 0xffffu);
        float ss = o * o;
        ss = row_sum16(ss); ss += __shfl_xor(ss, 16);
        if ((F.lane & 31) == 0) atomicAdd(rowss + row, ss); }
    }
}
constexpr int N_PHASES = 1 + 8 * DEPTH;
__global__ void __launch_bounds__(NTHREADS, 2) mega_fwd(Args args) {
    extern __shared__ __attribute__((aligned(16))) unsigned char lds_raw[];
    Ctx F;
    F.in = nullptr; F.out = nullptr; F.ws = nullptr; F.tid = 0; F.lane = 0; F.wave = 0;
    F.lds = (LAS unsigned char*)lds_raw;
    F.G = gridDim.x; F.bid = blockIdx.x;
    volatile LAS unsigned* bst = (volatile LAS unsigned*)(F.lds + LDS_BYTES - 128);
    if (threadIdx.x < 2) bst[threadIdx.x] = 0u;
    __syncthreads();
    (void)xcd_barrier_post((unsigned*)(args.ws + WS_CTL) + CW_BAR, bst);
#define XBAR() do { XcdBarrier xb_; xb_.bar = (unsigned*)(F.ws + WS_CTL) + CW_BAR; xb_.x = xb_xcc_id(); xb_.st = (volatile LAS unsigned*)(F.lds + LDS_BYTES - 128); xcd_barrier(xb_); } while (0)
    int ph0 = args.ph_lo;
    if (ph0 == 0) {
        { int tid_ = threadIdx.x; asm volatile("" : "+v"(tid_)); F.tid = tid_; F.lane = tid_ & 63; F.wave = __builtin_amdgcn_readfirstlane(tid_ >> 6);
          const __attribute__((address_space(4))) char* ka = (const __attribute__((address_space(4))) char*)__builtin_amdgcn_kernarg_segment_ptr(); asm volatile("" : "+s"(ka));
          F.in = (const float* const __attribute__((address_space(4)))*)ka; F.out = *(float* const __attribute__((address_space(4)))*)(ka + 192); F.ws = *(unsigned char* const __attribute__((address_space(4)))*)(ka + 200); }
        const int gw = F.bid * NWAVES + F.wave, NGW = F.G * NWAVES;
        if (PH_MASK & 1) phase_prep(F);
        if (DUP_K == 8) { cg::this_grid().sync(); phase_prep(F); }
        if (DUP_K == 9) { for (int q_ = 0; q_ < 32; ++q_) XBAR(); }
        ph0 = 1;
        if (args.ph_hi > 1000000) cg::this_grid().sync();
        if (ph0 < args.ph_hi) XBAR();
    }
    for (int ph = ph0, rep = 0; ph < args.ph_hi; ++ph) {
        { int tid_ = threadIdx.x; asm volatile("" : "+v"(tid_)); F.tid = tid_; F.lane = tid_ & 63; F.wave = __builtin_amdgcn_readfirstlane(tid_ >> 6);
          const __attribute__((address_space(4))) char* ka = (const __attribute__((address_space(4))) char*)__builtin_amdgcn_kernarg_segment_ptr(); asm volatile("" : "+s"(ka));
          F.in = (const float* const __attribute__((address_space(4)))*)ka; F.out = *(float* const __attribute__((address_space(4)))*)(ka + 192); F.ws = *(unsigned char* const __attribute__((address_space(4)))*)(ka + 200); }
        const int gw = F.bid * NWAVES + F.wave, NGW = F.G * NWAVES;
        {
            const int l = (ph - 1) >> 3, k = (ph - 1) & 7;
            if (k == 0 && (PH_MASK & 2)) {
                pg8::Gemm g{V_XBA, V_WIN + (size_t)l * NPROJ * D, D}; pg8::Order<1> S; S.init(M / 256, NPROJ / 256, F.G, F.bid);
                EpiProj E{V_PROJ, V_RS + (size_t)(2 * l) * M};
                pg8::gemm_phase(F.lds, F.tid, g, S, E);
            } else if (k == 1 && (PH_MASK & 4)) {
                {
                    const bool sq = !(DUP_K == 1 && rep == 0);
                    int row = gw;
                    for (; row + 2 * NGW < M; row += 3 * NGW) { const int rr[3] = {row, row + NGW, row + 2 * NGW}; e1_partA<3>(F, l, rr, sq); }
                    for (; row < M; row += NGW) { const int rr[1] = {row}; e1_partA<1>(F, l, rr, sq); }
                    for (int r2 = gw; r2 < M; r2 += NGW) if (r2 >= MP || (r2 & 4095) >= SEQ - 3) e1_row(F, l, r2);
                }
                __syncthreads();
                for (int it = F.bid; it < NCH; it += F.G) delta_prep_item(F, l, it);
                for (int it = F.bid; it < NCH / 4; it += F.G) ret_prep_item(F, l, it);
            } else if (k == 2 && (PH_MASK & 8)) {
                phase_mix(F, l, rep);
            } else if (k == 3 && (PH_MASK & 16)) {
                for (int row = gw; row < M; row += NGW) fin_row(F, l, row);
                __syncthreads();
                for (int it = F.bid; it < NCH; it += F.G) delta_out_item(F, l, it);
            } else if (k == 4 && (PH_MASK & 32)) {
                mini_abc(F, l);
                pg8::Gemm g{V_OABC, V_WABC + (size_t)l * 3 * D * 512, 512}; pg8::Order<3> S; S.init(MP / 256, D / 256, F.G, F.bid); S.sub_m = M / 256;
                EpiAbc E{V_PROJ, V_MRG};
                pg8::gemm_phase(F.lds, F.tid, g, S, E);
            } else if (k == 5 && (PH_MASK & 64)) {
                mini_res(F, V_MRG, V_WOUT + (size_t)l * D * D, D, l == 0 ? F.in[1] : nullptr, l == 0 ? nullptr : V_XBA, nullptr, V_XBB, V_RS + (size_t)(2 * l + 1) * M);
                pg8::Gemm g{V_MRG, V_WOUT + (size_t)l * D * D, D}; pg8::Order<1> S; S.init(MP / 256, D / 256, F.G, F.bid);
                EpiRes E{F.in[0], F.in[1], l == 0 ? nullptr : V_XBA, nullptr, V_XBB, V_RS + (size_t)(2 * l + 1) * M};
                pg8::gemm_phase(F.lds, F.tid, g, S, E);
            } else if (k == 6 && (PH_MASK & 128)) {
                pg8::Gemm g{V_XBB, V_WFI + (size_t)l * 2 * DFF * D, D}; pg8::Order<1> S; S.init(M / 256, 2 * DFF / 256, F.G, F.bid);
                EpiFfn E{V_ACT, V_RS + (size_t)(2 * l + 1) * M};
                pg8::gemm_phase(F.lds, F.tid, g, S, E);
            } else if (k == 7 && (PH_MASK & 256)) {
                mini_res(F, V_ACT, V_WFO + (size_t)l * D * DFF, DFF, nullptr, V_XBB, l == DEPTH - 1 ? F.out : nullptr, V_XBA, V_RS + (size_t)(l == DEPTH - 1 ? 3 : 2) * M);
                pg8::Gemm g{V_ACT, V_WFO + (size_t)l * D * DFF, DFF}; pg8::Order<1> S; S.init(MP / 256, D / 256, F.G, F.bid);
                EpiRes E{nullptr, nullptr, V_XBB, l == DEPTH - 1 ? F.out : nullptr, V_XBA, V_RS + (size_t)(l == DEPTH - 1 ? 3 : 2) * M};
                pg8::gemm_phase(F.lds, F.tid, g, S, E);
            }
        }
        if (DUP_K >= 0 && ((ph - 1) & 7) == DUP_K && rep == 0) { rep = 1; --ph; XBAR(); continue; }
        rep = 0;
        if (ph + 1 < args.ph_hi) XBAR();
    }
}

extern "C" void kernel_launch(void* const* d_in, const int* in_sizes, int n_in, void* d_out, int out_size, void* d_ws, size_t ws_size, hipStream_t stream) {
    static int grid = 0;
    if (grid == 0) {
        if (n_in != 24 || (size_t)out_size != O_END || ws_size < WS_END) { fprintf(stderr, "kernel_launch: unexpected shapes (n_in %d out %d ws %zu, need %zu / %zu)\n", n_in, out_size, ws_size, (size_t)O_END, (size_t)WS_END); grid = -1; return; }
        int dev = 0, cus = 0, per_cu = 0;
        if (hipGetDevice(&dev) != hipSuccess || hipDeviceGetAttribute(&cus, hipDeviceAttributeMultiprocessorCount, dev) != hipSuccess) { grid = -1; return; }
        if (hipFuncSetAttribute((const void*)mega_fwd, hipFuncAttributeMaxDynamicSharedMemorySize, LDS_BYTES) != hipSuccess) { fprintf(stderr, "kernel_launch: hipFuncSetAttribute failed\n"); grid = -1; return; }
        if (hipOccupancyMaxActiveBlocksPerMultiprocessor(&per_cu, (const void*)mega_fwd, NTHREADS, LDS_BYTES) != hipSuccess || per_cu < 1) { fprintf(stderr, "kernel_launch: occupancy query says %d\n", per_cu); per_cu = 1; }
        (void)hipGetLastError();
        grid = cus;
    }
    if (grid < 0) return;
    (void)hipMemsetAsync((char*)d_ws + WS_CTL, 0, 32768, stream);
    Args a{};
    for (int i = 0; i < 24; ++i) a.in[i] = (const float*)d_in[i];
    a.out = (float*)d_out; a.ws = (unsigned char*)d_ws;
#if MK_ONE_LAUNCH
    a.ph_lo = 0; a.ph_hi = N_PHASES;
    void* kargs[] = {&a};
    hipError_t e = hipLaunchCooperativeKernel((const void*)mega_fwd, dim3(grid), dim3(NTHREADS), kargs, LDS_BYTES, stream);
    if (e != hipSuccess) fprintf(stderr, "cooperative launch failed: %s (grid %d)\n", hipGetErrorString(e), grid);
#else
    for (int ph = 0; ph < N_PHASES; ++ph) {
        a.ph_lo = ph; a.ph_hi = ph + 1;
        hipLaunchKernelGGL(mega_fwd, dim3(grid), dim3(NTHREADS), LDS_BYTES, stream, a);
    }
#endif
}
```

```cpp
#include <hip/hip_runtime.h>
#include <hip/hip_cooperative_groups.h>
#include <cstdio>
#include <cstdint>
namespace cg = cooperative_groups;

#ifndef DUP_K
#define DUP_K -1
#endif
#ifndef PH_MASK
#define PH_MASK 0x1ff
#endif
#ifndef MK_ONE_LAUNCH
#define MK_ONE_LAUNCH 1
#endif

#define LAS __attribute__((address_space(3)))
typedef unsigned short bf16_t;
typedef short bf16x8 __attribute__((ext_vector_type(8)));
typedef float f32x4 __attribute__((ext_vector_type(4)));
typedef float f32x2 __attribute__((ext_vector_type(2)));
typedef unsigned u32x4 __attribute__((ext_vector_type(4)));
typedef unsigned u32x2 __attribute__((ext_vector_type(2)));

constexpr int D = 1024, BATCH = 4, SEQ = 4096, DEPTH = 2, DB = 32, DS = 8, PAST = 8192;
constexpr int MP = BATCH * SEQ, MS = DB * DS, M = MP + MS;
constexpr int NIN = 11272, NPROJ = 11520, DFF = 2816;
constexpr int PC_AQ = 0, PC_AK = 1536, PC_AV = 3072, PC_BQKV = 4608, PC_BZ = 6144, PC_CQ = 6656, PC_CK = 6912, PC_CV = 7168, PC_CZ = 7680, PC_GATE = 8192, PC_BETA = 11264, PC_BA = 11268;
constexpr float EPS = 1e-6f;
constexpr int NPOS = SEQ + DS;

constexpr size_t O_YP = 0;
constexpr size_t O_YS = O_YP + (size_t)MP * D;
constexpr size_t O_KV0P = O_YS + (size_t)MS * D;
constexpr size_t O_KV1P = O_KV0P + (size_t)DEPTH * BATCH * 128 * 1024;
constexpr size_t O_KV2P = O_KV1P + (size_t)DEPTH * BATCH * 512 * 1024;
constexpr size_t O_BCP = O_KV2P + (size_t)DEPTH * BATCH * 2048 * 1024;
constexpr size_t O_BSP = O_BCP + (size_t)DEPTH * BATCH * 3 * 1536;
constexpr size_t O_CRP = O_BSP + (size_t)DEPTH * BATCH * 4 * 128 * 128;
constexpr size_t O_KV0S = O_CRP + (size_t)DEPTH * BATCH * 4 * 64 * 128;
constexpr size_t O_KV1S = O_KV0S + (size_t)DEPTH * DB * DS * 1024;
constexpr size_t O_KV2S = O_KV1S + (size_t)DEPTH * DB * DS * 1024;
constexpr size_t O_BCS = O_KV2S + (size_t)DEPTH * DB * DS * 1024;
constexpr size_t O_BSS = O_BCS + (size_t)DEPTH * DB * 3 * 1536;
constexpr size_t O_CRS = O_BSS + (size_t)DEPTH * DB * 4 * 128 * 128;
constexpr size_t O_END = O_CRS + (size_t)DEPTH * DB * 4 * 64 * 128;

constexpr size_t al256(size_t x) { return (x + 255) & ~(size_t)255; }
constexpr size_t WS_CTL = 0, CTL_BYTES = 1u << 20;
constexpr size_t WS_WIN = WS_CTL + CTL_BYTES;
constexpr size_t WS_WABC = WS_WIN + al256((size_t)DEPTH * NPROJ * D * 2);
constexpr size_t WS_WOUT = WS_WABC + al256((size_t)DEPTH * 3 * D * 512 * 2);
constexpr size_t WS_WFI = WS_WOUT + al256((size_t)DEPTH * D * D * 2);
constexpr size_t WS_WFO = WS_WFI + al256((size_t)DEPTH * 2 * DFF * D * 2);
constexpr size_t WS_XBA = WS_WFO + al256((size_t)DEPTH * D * DFF * 2);
constexpr size_t WS_XBB = WS_XBA + al256((size_t)M * D * 2);
constexpr size_t WS_X1 = WS_XBB + al256((size_t)M * D * 2);
constexpr size_t WS_X2 = WS_X1 + al256((size_t)M * D * 4);
constexpr size_t WS_RS = WS_X2 + al256((size_t)M * D * 4);
constexpr size_t WS_PROJ = WS_RS + al256((size_t)4 * M * 4);
constexpr size_t WS_BQKV = WS_PROJ + al256((size_t)M * NPROJ * 2);
constexpr size_t WS_BG = WS_BQKV + al256((size_t)M * 1536 * 4);
constexpr size_t WS_CQK = WS_BG + al256((size_t)M * 8 * 4);
constexpr size_t WS_OBR = WS_CQK + al256((size_t)M * 512 * 4);
constexpr size_t WS_OCR = WS_OBR + al256((size_t)M * 512 * 4);
constexpr size_t WS_OABC = WS_OCR + al256((size_t)M * 512 * 4);
constexpr size_t WS_MRG = WS_OABC + al256((size_t)3 * M * 512 * 2);
constexpr size_t WS_ACT = WS_MRG + al256((size_t)M * D * 2);
constexpr size_t WS_ROPEA = WS_ACT + al256((size_t)M * DFF * 2);
constexpr size_t WS_ROPEC = WS_ROPEA + al256((size_t)NPOS * 64 * 2 * 4);
constexpr size_t WS_AO = WS_ROPEC + al256((size_t)NPOS * 32 * 2 * 4);
constexpr size_t WS_LSE = WS_AO + al256((size_t)3 * M * 512 * 2);
constexpr int NCH = BATCH * 4 * 64;
constexpr size_t WS_DW = WS_LSE + al256((size_t)3 * M * 4 * 4);
constexpr size_t WS_DQG = WS_DW + al256((size_t)NCH * 64 * 128 * 2);
constexpr size_t WS_DKT = WS_DQG + al256((size_t)NCH * 64 * 128 * 2);
constexpr size_t WS_DAT = WS_DKT + al256((size_t)NCH * 64 * 128 * 2);
constexpr size_t WS_DU = WS_DAT + al256((size_t)NCH * 64 * 64 * 2);
constexpr size_t WS_DDL = WS_DU + al256((size_t)NCH * 64 * 128 * 4);
constexpr size_t WS_RQG = WS_DDL + al256((size_t)NCH * 4);
constexpr size_t WS_RKT = WS_RQG + al256((size_t)NCH * 64 * 64 * 2);
constexpr size_t WS_RAT = WS_RKT + al256((size_t)NCH * 64 * 64 * 2);
constexpr size_t WS_RU = WS_RAT + al256((size_t)NCH * 64 * 64 * 2);
constexpr size_t WS_SB = WS_RU + al256((size_t)NCH * 64 * 128 * 4);
constexpr size_t WS_VB = WS_SB + al256((size_t)NCH * 16384 * 2);
constexpr size_t WS_END = WS_VB + al256((size_t)NCH * 8192 * 2);
constexpr int CW_MIX0 = 64, CW_MIX1 = 128, CW_BAR = 1024;

constexpr int NWAVES = 8, NTHREADS = 512;
constexpr int RING_BYTES = 131072, LDS_BYTES = 147456;

__device__ __forceinline__ float bf_lo(unsigned u) { return __uint_as_float(u << 16); }
__device__ __forceinline__ float bf_hi(unsigned u) { return __uint_as_float(u & 0xffff0000u); }
__device__ __forceinline__ float bf1(bf16_t u) { return __uint_as_float(((unsigned)u) << 16); }
typedef __bf16 bf16x2_t __attribute__((ext_vector_type(2)));
__device__ __forceinline__ unsigned cvt_pk_bf16(float lo, float hi) { const f32x2 f = {lo, hi}; const bf16x2_t v = __builtin_convertvector(f, bf16x2_t); return __builtin_bit_cast(unsigned, v); }
template <int CTRL> __device__ __forceinline__ float dpp_mov(float v) { return __int_as_float(__builtin_amdgcn_update_dpp(0, __float_as_int(v), CTRL, 0xf, 0xf, true)); }
__device__ __forceinline__ float rdlane(float v, int l) { return __int_as_float(__builtin_amdgcn_readlane(__float_as_int(v), l)); }
__device__ __forceinline__ float row_sum16(float v) { v += dpp_mov<0xB1>(v); v += dpp_mov<0x4E>(v); v += dpp_mov<0x141>(v); v += dpp_mov<0x140>(v); return v; }
__device__ __forceinline__ float row_max16(float v) { v = fmaxf(v, dpp_mov<0xB1>(v)); v = fmaxf(v, dpp_mov<0x4E>(v)); v = fmaxf(v, dpp_mov<0x141>(v)); v = fmaxf(v, dpp_mov<0x140>(v)); return v; }
__device__ __forceinline__ float wave_sum(float v) { v = row_sum16(v); return (rdlane(v, 0) + rdlane(v, 16)) + (rdlane(v, 32) + rdlane(v, 48)); }
__device__ __forceinline__ float wave_max(float v) { v = row_max16(v); return fmaxf(fmaxf(rdlane(v, 0), rdlane(v, 16)), fmaxf(rdlane(v, 32), rdlane(v, 48))); }
__device__ __forceinline__ float half_sum(float v) { v = row_sum16(v); return v + __shfl_xor(v, 16); }
__device__ __forceinline__ float sigmoidf_(float x) { return __builtin_amdgcn_rcpf(1.f + __expf(-x)); }

namespace pg8 {
constexpr int BM = 256, BK = 64, HALF = 128, HTB = HALF * BK * 2, NXCD = 8, WGM = 2;
__host__ __device__ __forceinline__ int lds_byte(int r, int c) { const int st = (r >> 4) * 2 + (c >> 5), rr = r & 15, cc = c & 31, ob = rr * 64 + cc * 2; return st * 1024 + (ob ^ (((ob >> 9) & 1) << 5)); }
__host__ __device__ __forceinline__ void stage_rc(int b, int& R, int& C) { const int st = b / 1024, sb = b % 1024, swz = sb ^ (((sb >> 9) & 1) << 5); R = (st >> 1) * 16 + swz / 64; C = (st & 1) * 32 + (swz % 64) / 2; }
__host__ __device__ __forceinline__ int perm32(int rho) { const int n = rho >> 4, i = rho & 15; return 8 * (i >> 2) + 4 * n + (i & 3); }

struct Unit { int pm, pn; };
struct Gemm { const bf16_t* A; const bf16_t* Bt; int K; };

template <int TRIP> struct Order {
    int nM, nN, nwg, G, c, sub_m;
    __device__ void init(int nM_, int nN_, int G_, int c_) { nM = nM_; nN = nN_; nwg = nM * nN; G = G_; c = c_; sub_m = nM_; }
    __device__ bool next(int i, Unit& u) const {
        const int ii = i / TRIP, sub = i - ii * TRIP;
        const long L = (long)ii * G + c; if (L >= nwg) return false;
        int wgid = (int)L; { const int q = nwg / NXCD, r = nwg % NXCD, xcd = wgid % NXCD, off = wgid / NXCD; wgid = (xcd < r ? xcd * (q + 1) : r * (q + 1) + (xcd - r) * q) + off; }
        const int nig = WGM * nN, gid = wgid / nig, fm = gid * WGM, gsz = (nM - fm) < WGM ? (nM - fm) : WGM;
        u.pm = fm + ((wgid % nig) % gsz) + sub * sub_m; u.pn = (wgid % nig) / gsz + sub * nN; return true;
    }
};

template <class Epi, class Sched>
__device__ __forceinline__ void gemm_phase(LAS unsigned char* lds, const int tid, const Gemm g, const Sched& S, const Epi& E) {
    const int wid = __builtin_amdgcn_readfirstlane(tid >> 6), lane = tid & 63, wr = wid >> 2, wc = wid & 3, fr = lane & 15, fq = lane >> 4;
    const int K = g.K, nt = K / BK;
    unsigned voffA[2], voffB[2];
#pragma unroll
    for (int i = 0; i < 2; ++i) { int R, C; stage_rc(tid * 16 + i * 8192, R, C); const int Rb = Epi::PERM ? ((R & ~31) + perm32(R & 31)) : R;
        voffA[i] = (unsigned)(R * K + C) * 2u; voffB[i] = (unsigned)(Rb * K + C) * 2u; }
    const size_t kstep = (size_t)(BK * 2);
    const size_t hstep = (size_t)HALF * K * 2;
    const size_t tstep = 2 * hstep;
    const unsigned ldsw = (unsigned)wid * 1024u;
    const int aoff = lds_byte(wr * 64 + fr, fq * 8), boff = lds_byte(wc * 32 + fr, fq * 8);
#define PG8_SA(b, h) (((b) * 2 + (h)) * HTB)
#define PG8_SB(b, h) ((4 + (b) * 2 + (h)) * HTB)
#define PG8_STAGE(bufoff, gbase, voff) do { _Pragma("unroll") for (int _i = 0; _i < 2; ++_i) \
        __builtin_amdgcn_global_load_lds((const unsigned*)((const char*)(gbase) + (voff)[_i]), (LAS unsigned*)(lds + (bufoff) + ldsw + _i * 8192), 16, 0, 0); } while (0)
#define PG8_LDA(dst, b, h) do { _Pragma("unroll") for (int m = 0; m < 4; ++m) _Pragma("unroll") for (int k = 0; k < 2; ++k) dst[m][k] = *(const LAS bf16x8*)(lds + PG8_SA(b, h) + aoff + m * 2048 + k * 1024); } while (0)
#define PG8_LDB(dst, b, h) do { _Pragma("unroll") for (int n = 0; n < 2; ++n) _Pragma("unroll") for (int k = 0; k < 2; ++k) dst[n][k] = *(const LAS bf16x8*)(lds + PG8_SB(b, h) + boff + n * 2048 + k * 1024); } while (0)
#define PG8_MMA(ai, bj, At, Bt) do { __builtin_amdgcn_s_setprio(1); _Pragma("unroll") for (int m = 0; m < 4; ++m) _Pragma("unroll") for (int n = 0; n < 2; ++n) _Pragma("unroll") for (int k = 0; k < 2; ++k) \
        acc[ai][bj][m][n] = __builtin_amdgcn_mfma_f32_16x16x32_bf16(Bt[n][k], At[m][k], acc[ai][bj][m][n], 0, 0, 0); __builtin_amdgcn_s_setprio(0); } while (0)
#define PG8_WAIT_V(n) asm volatile("s_waitcnt vmcnt(" #n ")" ::: "memory")
#define PG8_WAIT_L(n) asm volatile("s_waitcnt lgkmcnt(" #n ")" ::: "memory")
#define PG8_BAR __builtin_amdgcn_s_barrier()
#define PG8_SCHED __builtin_amdgcn_sched_barrier(0)
    Unit cur, nxt; int ui = 0;
    if (!S.next(0, cur)) return;
    f32x4 acc[2][2][4][2];
#pragma unroll
    for (int a = 0; a < 2; ++a)
#pragma unroll
        for (int b = 0; b < 2; ++b)
#pragma unroll
            for (int m = 0; m < 4; ++m)
#pragma unroll
                for (int n = 0; n < 2; ++n) acc[a][b][m][n] = (f32x4){0.f, 0.f, 0.f, 0.f};
    bf16x8 At[4][2], B0[2][2], B1[2][2];
    const char* cA = (const char*)g.A + (size_t)cur.pm * tstep; const char* cB = (const char*)g.Bt + (size_t)cur.pn * tstep;
    PG8_STAGE(PG8_SB(0, 0), cB, voffB); PG8_STAGE(PG8_SB(0, 1), cB + hstep, voffB); PG8_STAGE(PG8_SA(0, 0), cA, voffA); PG8_STAGE(PG8_SA(0, 1), cA + hstep, voffA);
    if (wr == 1) PG8_BAR;
    PG8_WAIT_V(2); PG8_BAR;
    PG8_STAGE(PG8_SB(1, 0), cB + kstep, voffB); PG8_STAGE(PG8_SA(1, 0), cA + kstep, voffA); PG8_STAGE(PG8_SB(1, 1), cB + hstep + kstep, voffB);
    PG8_WAIT_V(6); PG8_BAR;
    for (;;) {
        const bool has_next = S.next(ui + 1, nxt);
        const char* nA = has_next ? (const char*)g.A + (size_t)nxt.pm * tstep : cA; const char* nB = has_next ? (const char*)g.Bt + (size_t)nxt.pn * tstep : cB;
        for (int t = 0; t < nt; t += 2) {
            const bool last = (t == nt - 2);
            const char* a1 = cA + (size_t)(t + 1) * kstep;
            const char* a2 = last ? nA : cA + (size_t)(t + 2) * kstep; const char* b2 = last ? nB : cB + (size_t)(t + 2) * kstep;
            const char* a3 = a2 + kstep; const char* b3 = b2 + kstep;
            PG8_LDB(B0, 0, 0); PG8_LDB(B1, 0, 1); PG8_SCHED; PG8_LDA(At, 0, 0); PG8_STAGE(PG8_SA(1, 1), a1 + hstep, voffA);
            PG8_WAIT_V(8); PG8_WAIT_L(0); PG8_BAR; PG8_MMA(0, 0, At, B0); PG8_MMA(0, 1, At, B1); PG8_BAR; PG8_SCHED;
            PG8_LDA(At, 0, 1); PG8_STAGE(PG8_SB(0, 0), b2, voffB); PG8_STAGE(PG8_SB(0, 1), b2 + hstep, voffB); PG8_STAGE(PG8_SA(0, 0), a2, voffA);
            PG8_WAIT_V(8); PG8_WAIT_L(0); PG8_BAR; PG8_MMA(1, 0, At, B0); PG8_MMA(1, 1, At, B1); PG8_BAR; PG8_SCHED;
            PG8_LDB(B0, 1, 0); PG8_LDB(B1, 1, 1); PG8_SCHED; PG8_LDA(At, 1, 0); PG8_STAGE(PG8_SA(0, 1), a2 + hstep, voffA);
            PG8_WAIT_V(8); PG8_WAIT_L(0); PG8_BAR; PG8_MMA(0, 0, At, B0); PG8_MMA(0, 1, At, B1); PG8_BAR; PG8_SCHED;
            PG8_LDA(At, 1, 1); PG8_STAGE(PG8_SB(1, 0), b3, voffB); PG8_STAGE(PG8_SB(1, 1), b3 + hstep, voffB); PG8_STAGE(PG8_SA(1, 0), a3, voffA);
            PG8_WAIT_V(8); PG8_WAIT_L(0); PG8_BAR; PG8_MMA(1, 0, At, B0); PG8_MMA(1, 1, At, B1); PG8_BAR; PG8_SCHED;
        }
        if (wr == 0) PG8_BAR;
        E(acc, cur, wr, wc, fr, fq);
        if (!has_next) break;
        if (E.reset_after(cur)) {
#pragma unroll
            for (int a = 0; a < 2; ++a)
#pragma unroll
                for (int b = 0; b < 2; ++b)
#pragma unroll
                    for (int m = 0; m < 4; ++m)
#pragma unroll
                        for (int n = 0; n < 2; ++n) acc[a][b][m][n] = (f32x4){0.f, 0.f, 0.f, 0.f};
        }
        cur = nxt; cA = nA; cB = nB; ++ui;
        if (wr == 1) PG8_BAR;
    }
    PG8_WAIT_V(0);
    PG8_BAR;
#undef PG8_SA
#undef PG8_SB
#undef PG8_STAGE
#undef PG8_LDA
#undef PG8_LDB
#undef PG8_MMA
#undef PG8_WAIT_V
#undef PG8_WAIT_L
#undef PG8_BAR
#undef PG8_SCHED
}
}
using pg8::Unit;

struct EpiProj {
    static constexpr bool PERM = true;
    bf16_t* O; const float* rowss;
    __device__ __forceinline__ bool reset_after(const Unit&) const { return true; }
    __device__ __forceinline__ void operator()(f32x4 (&acc)[2][2][4][2], const Unit& u, int wr, int wc, int fr, int fq) const {
        const int row0 = u.pm * 256 + wr * 64 + fr, col0 = u.pn * 256 + wc * 32 + 8 * fq;
        const bool gate = (u.pn >= 32 && u.pn < 44);
#pragma unroll
        for (int ai = 0; ai < 2; ++ai)
#pragma unroll
            for (int m = 0; m < 4; ++m) {
                const int row = row0 + ai * 128 + m * 16;
                const float rs = rsqrtf(rowss[row] * (1.f / 1024.f) + EPS);
                bf16_t* rowp = O + (size_t)row * NPROJ + col0;
#pragma unroll
                for (int bj = 0; bj < 2; ++bj) {
                    f32x4 v0 = acc[ai][bj][m][0] * rs, v1 = acc[ai][bj][m][1] * rs;
                    if (gate) {
#pragma unroll
                        for (int j = 0; j < 4; ++j) { v0[j] = sigmoidf_(v0[j]); v1[j] = sigmoidf_(v1[j]); }
                    }
                    u32x4 w; w.x = cvt_pk_bf16(v0[0], v0[1]); w.y = cvt_pk_bf16(v0[2], v0[3]); w.z = cvt_pk_bf16(v1[0], v1[1]); w.w = cvt_pk_bf16(v1[2], v1[3]);
                    *(u32x4*)(rowp + bj * 128) = w;
                }
            }
    }
};
struct EpiAbc {
    static constexpr bool PERM = true;
    const bf16_t* G; bf16_t* O;
    __device__ __forceinline__ bool reset_after(const Unit& u) const { return (u.pn >> 2) == 2; }
    __device__ __forceinline__ void operator()(f32x4 (&acc)[2][2][4][2], const Unit& u, int wr, int wc, int fr, int fq) const {
        const int sub = u.pn >> 2, pn = u.pn & 3, pm = u.pm - sub * 65;
        const int row0 = pm * 256 + wr * 64 + fr, col0 = pn * 256 + wc * 32 + 8 * fq;
#pragma unroll
        for (int ai = 0; ai < 2; ++ai)
#pragma unroll
            for (int m = 0; m < 4; ++m) {
                const int row = row0 + ai * 128 + m * 16;
                const bf16_t* gp = G + (size_t)row * NPROJ + PC_GATE + sub * 1024 + col0;
#pragma unroll
                for (int bj = 0; bj < 2; ++bj) {
                    const u32x4 ga = *(const u32x4*)(gp + bj * 128);
                    f32x4 g0 = (f32x4){bf_lo(ga.x), bf_hi(ga.x), bf_lo(ga.y), bf_hi(ga.y)}, g1 = (f32x4){bf_lo(ga.z), bf_hi(ga.z), bf_lo(ga.w), bf_hi(ga.w)};
                    if (sub < 2) {
                        const u32x4 gb = *(const u32x4*)(gp + 1024 + bj * 128);
                        const f32x4 h0 = (f32x4){bf_lo(gb.x), bf_hi(gb.x), bf_lo(gb.y), bf_hi(gb.y)}, h1 = (f32x4){bf_lo(gb.z), bf_hi(gb.z), bf_lo(gb.w), bf_hi(gb.w)};
#pragma unroll
                        for (int j = 0; j < 4; ++j) { acc[ai][bj][m][0][j] *= g0[j] * __builtin_amdgcn_rcpf(fmaxf(h0[j], 1e-30f)); acc[ai][bj][m][1][j] *= g1[j] * __builtin_amdgcn_rcpf(fmaxf(h1[j], 1e-30f)); }
                    } else {
                        const f32x4 v0 = acc[ai][bj][m][0] * g0, v1 = acc[ai][bj][m][1] * g1;
                        u32x4 w; w.x = cvt_pk_bf16(v0[0], v0[1]); w.y = cvt_pk_bf16(v0[2], v0[3]); w.z = cvt_pk_bf16(v1[0], v1[1]); w.w = cvt_pk_bf16(v1[2], v1[3]);
                        *(u32x4*)(O + (size_t)row * D + col0 + bj * 128) = w;
                    }
                }
            }
    }
};
struct EpiRes {
    static constexpr bool PERM = false;
    const float* res0; const float* res1; const bf16_t* resb; float* out; bf16_t* xb; float* rowss;
    __device__ __forceinline__ bool reset_after(const Unit&) const { return true; }
    __device__ __forceinline__ void operator()(f32x4 (&acc)[2][2][4][2], const Unit& u, int wr, int wc, int fr, int fq) const {
        const int col0 = u.pn * 256 + wc * 32 + 4 * fq;
        const float* rbase = (u.pm < 64) ? res0 + (size_t)u.pm * 256 * D : res1;
#pragma unroll
        for (int ai = 0; ai < 2; ++ai)
#pragma unroll
            for (int m = 0; m < 4; ++m) {
                const int lrow = ai * 128 + wr * 64 + m * 16 + fr; const size_t grow = (size_t)u.pm * 256 + lrow;
                float ss = 0.f;
#pragma unroll
                for (int bj = 0; bj < 2; ++bj)
#pragma unroll
                    for (int n = 0; n < 2; ++n) {
                        const int c = col0 + bj * 128 + n * 16;
                        f32x4 r4;
                        if (resb) { const u32x2 rb = *(const u32x2*)(resb + grow * D + c); r4 = (f32x4){bf_lo(rb.x), bf_hi(rb.x), bf_lo(rb.y), bf_hi(rb.y)}; }
                        else r4 = *(const f32x4*)(rbase + (size_t)lrow * D + c);
                        const f32x4 o = r4 + acc[ai][bj][m][n];
                        if (out) *(f32x4*)(out + grow * D + c) = o;
                        else { u32x2 w; w.x = cvt_pk_bf16(o[0], o[1]); w.y = cvt_pk_bf16(o[2], o[3]); *(u32x2*)(xb + grow * D + c) = w; }
                        ss += (o[0] * o[0] + o[1] * o[1]) + (o[2] * o[2] + o[3] * o[3]);
                    }
                ss += __shfl_xor(ss, 16); ss += __shfl_xor(ss, 32);
                if (fq == 0) atomicAdd(rowss + grow, ss);
                asm volatile("" ::: "memory");
            }
    }
};
struct EpiFfn {
    static constexpr bool PERM = true;
    bf16_t* O; const float* rowss;
    __device__ __forceinline__ bool reset_after(const Unit&) const { return true; }
    __device__ __forceinline__ void operator()(f32x4 (&acc)[2][2][4][2], const Unit& u, int wr, int wc, int fr, int fq) const {
        const int row0 = u.pm * 256 + wr * 64 + fr, f0 = u.pn * 128 + 16 * wc + 4 * fq;
#pragma unroll
        for (int ai = 0; ai < 2; ++ai)
#pragma unroll
            for (int m = 0; m < 4; ++m) {
                const int row = row0 + ai * 128 + m * 16;
                const float rs = rsqrtf(rowss[row] * (1.f / 1024.f) + EPS);
#pragma unroll
                for (int bj = 0; bj < 2; ++bj) {
                    const f32x4 gg = acc[ai][bj][m][0] * rs, uu = acc[ai][bj][m][1] * rs;
                    f32x4 hh;
#pragma unroll
                    for (int j = 0; j < 4; ++j) hh[j] = gg[j] * sigmoidf_(gg[j]) * uu[j];
                    u32x2 w; w.x = cvt_pk_bf16(hh[0], hh[1]); w.y = cvt_pk_bf16(hh[2], hh[3]);
                    *(u32x2*)(O + (size_t)row * DFF + f0 + bj * 64) = w;
                }
            }
    }
};

#define XB_TMO      128
#define XB_XCNT(j)  (256  + 64 * (j))
#define XB_XSUB(j)  (1280 + 64 * (j))
#define XB_XGEN(j)  (2304 + 64 * (j))
#define XB_TOP      3328
#define XB_TOPGEN   3392
#define XCD_BAR_WORDS 3456
#define XB_SPIN_CAP (1u << 18)

__device__ __forceinline__ unsigned xb_ld(unsigned* p)              { return __hip_atomic_load(p, __ATOMIC_RELAXED, __HIP_MEMORY_SCOPE_AGENT); }
__device__ __forceinline__ unsigned xb_add(unsigned* p, unsigned v) { return __hip_atomic_fetch_add(p, v, __ATOMIC_RELAXED, __HIP_MEMORY_SCOPE_AGENT); }
__device__ __forceinline__ unsigned xb_xcc_id() { return (unsigned)__builtin_amdgcn_s_getreg((3 << 11) | 20) & 0xFu; }
#define XB_SPIN(cond, bar) do { unsigned _sp = 0; while (cond) { __builtin_amdgcn_s_sleep(1); \
    if ((++_sp & 255u) == 0u) { if (xb_ld(&(bar)[XB_TMO])) break; if (_sp > XB_SPIN_CAP) { atomicAdd(&(bar)[XB_TMO], 1u); break; } } } } while (0)

struct XcdBarrier {
    unsigned* bar; unsigned x;
    volatile LAS unsigned* st;
};

__device__ __forceinline__ XcdBarrier xcd_barrier_post(unsigned* bar, volatile LAS unsigned* st) {
    XcdBarrier b; b.bar = bar; b.x = xb_xcc_id(); b.st = st;
    if (threadIdx.x == 0) (void)xb_add(&bar[XB_XCNT(b.x)], 1u);
    return b;
}
__device__ __forceinline__ void xcd_barrier_complete(unsigned* bar, unsigned x, unsigned& nloc, unsigned& nx) {
    const unsigned G = gridDim.x * gridDim.y * gridDim.z;
    unsigned sum, cnt, mine, sp = 0u;
    for (;;) {
        sum = 0u; cnt = 0u; mine = 0u;
#pragma unroll
        for (unsigned j = 0; j < 16; ++j) { const unsigned c = xb_ld(&bar[XB_XCNT(j)]); sum += c; cnt += (c > 0u) ? 1u : 0u; mine = (j == x) ? c : mine; }
        if (sum == G) break;
        __builtin_amdgcn_s_sleep(1);
        if ((++sp & 255u) == 0u) { if (xb_ld(&bar[XB_TMO])) break; if (sp > XB_SPIN_CAP) { atomicAdd(&bar[XB_TMO], 1u); break; } }
    }
    nloc = mine > 0u ? mine : 1u; nx = cnt > 0u ? cnt : 1u;
}

__device__ __forceinline__ void xcd_barrier(const XcdBarrier& b, int tid_l) {
    asm volatile("s_waitcnt vmcnt(0)" ::: "memory");
    __syncthreads();
    if (tid_l == 0) {
        unsigned* bar = b.bar;
        __builtin_amdgcn_s_waitcnt(0);
        unsigned nloc = b.st[0], nx = b.st[1];
        if (nloc == 0u) { xcd_barrier_complete(bar, b.x, nloc, nx); b.st[0] = nloc; b.st[1] = nx; }
        const unsigned old = xb_add(&bar[XB_XSUB(b.x)], 1u);
        const unsigned gen = old / nloc;
        if (old + 1u == (gen + 1u) * nloc) {
            __builtin_amdgcn_fence(__ATOMIC_RELEASE, "agent");
            asm volatile("s_waitcnt vmcnt(0)" ::: "memory");
            const unsigned og = xb_add(&bar[XB_TOP], 1u);
            const unsigned tg = og / nx;
            if (og + 1u == (tg + 1u) * nx) xb_add(&bar[XB_TOPGEN], 1u);
            else XB_SPIN(xb_ld(&bar[XB_TOPGEN]) == tg, bar);
            __builtin_amdgcn_fence(__ATOMIC_ACQUIRE, "agent");
            xb_add(&bar[XB_XGEN(b.x)], 1u);
            asm volatile("s_waitcnt vmcnt(0)" ::: "memory");
        } else {
            XB_SPIN(xb_ld(&bar[XB_XGEN(b.x)]) == gen, bar);
            __builtin_amdgcn_fence(__ATOMIC_ACQUIRE, "agent");
            asm volatile("s_waitcnt vmcnt(0)" ::: "memory");
        }
    }
    __syncthreads();
}


struct Args { const float* in[24]; float* out; unsigned char* ws; int ph_lo, ph_hi; };
static_assert(sizeof(Args) == 216, "Args layout");
struct Ctx {
    const float* const __attribute__((address_space(4)))* in; float* out; unsigned char* ws;
    LAS unsigned char* lds; int tid, lane, wave, G, bid;
};
#define WSV(T, off) ((T*)(F.ws + (off)))
#define V_WIN WSV(bf16_t, WS_WIN)
#define V_WABC WSV(bf16_t, WS_WABC)
#define V_WOUT WSV(bf16_t, WS_WOUT)
#define V_WFI WSV(bf16_t, WS_WFI)
#define V_WFO WSV(bf16_t, WS_WFO)
#define V_XBA WSV(bf16_t, WS_XBA)
#define V_XBB WSV(bf16_t, WS_XBB)
#define V_PROJ WSV(bf16_t, WS_PROJ)
#define V_OABC WSV(bf16_t, WS_OABC)
#define V_MRG WSV(bf16_t, WS_MRG)
#define V_ACT WSV(bf16_t, WS_ACT)
#define V_X1 WSV(float, WS_X1)
#define V_X2 WSV(float, WS_X2)
#define V_RS WSV(float, WS_RS)
#define V_BQKV WSV(float, WS_BQKV)
#define V_BG WSV(float, WS_BG)
#define V_CQK WSV(float, WS_CQK)
#define V_OBR WSV(float, WS_OBR)
#define V_OCR WSV(float, WS_OCR)
#define V_ROPEA WSV(float, WS_ROPEA)
#define V_ROPEC WSV(float, WS_ROPEC)
#define V_CTL WSV(unsigned, WS_CTL)
#define V_AO WSV(bf16_t, WS_AO)
#define V_LSE WSV(float, WS_LSE)
#define V_DW WSV(bf16_t, WS_DW)
#define V_DQG WSV(bf16_t, WS_DQG)
#define V_DKT WSV(bf16_t, WS_DKT)
#define V_DAT WSV(bf16_t, WS_DAT)
#define V_DU WSV(float, WS_DU)
#define V_DDL WSV(float, WS_DDL)
#define V_RQG WSV(bf16_t, WS_RQG)
#define V_RKT WSV(bf16_t, WS_RKT)
#define V_RAT WSV(bf16_t, WS_RAT)
#define V_RU WSV(float, WS_RU)
#define V_SB WSV(bf16_t, WS_SB)
#define V_VB WSV(bf16_t, WS_VB)

__device__ __forceinline__ int src_col(int mode, int n) {
    if (mode == 1) { if (n < 6656) return n; if (n < 11264) return n + 8; if (n < 11272) return n - 11264 + 6656; return -1; }
    if (mode == 2) { const int pn = n >> 8, c = n & 255; const int f = pn * 128 + (c >> 3) * 4 + (c & 3); return ((c >> 2) & 1) * DFF + f; }
    return n;
}
__device__ __forceinline__ void transpose_item(const float* W, int K, int N, int nblk, bf16_t* WT, const float* kscale, int mode, LAS float* scr, int item, int lane) {
    const int kb = item / nblk, nb = item - kb * nblk, k0 = 32 * kb, n0 = 128 * nb;
    const int sc = src_col(mode, n0 + 4 * (lane & 31));
    f32x4 v[16];
#pragma unroll
    for (int i = 0; i < 16; ++i) { const int kk = 2 * i + (lane >> 5);
        v[i] = (f32x4){0.f, 0.f, 0.f, 0.f};
        if (sc >= 0) { v[i] = *(const f32x4*)(W + (size_t)(k0 + kk) * N + sc); if (kscale) v[i] *= kscale[k0 + kk]; } }
#pragma unroll
    for (int i = 0; i < 16; ++i) { const int kk = 2 * i + (lane >> 5); *(LAS f32x4*)(scr + kk * 132 + 4 * (lane & 31)) = v[i]; }
    asm volatile("s_waitcnt lgkmcnt(0)" ::: "memory");
#pragma unroll
    for (int h2 = 0; h2 < 2; ++h2) { const int n = lane + 64 * h2; const LAS float* sp = scr + n;
        bf16_t* dst = WT + (size_t)(n0 + n) * K + k0;
#pragma unroll
        for (int q = 0; q < 4; ++q) { u32x4 o; o.x = cvt_pk_bf16(sp[(8 * q + 0) * 132], sp[(8 * q + 1) * 132]); o.y = cvt_pk_bf16(sp[(8 * q + 2) * 132], sp[(8 * q + 3) * 132]);
            o.z = cvt_pk_bf16(sp[(8 * q + 4) * 132], sp[(8 * q + 5) * 132]); o.w = cvt_pk_bf16(sp[(8 * q + 6) * 132], sp[(8 * q + 7) * 132]); *(u32x4*)(dst + 8 * q) = o; } }
    asm volatile("s_waitcnt lgkmcnt(0)" ::: "memory");
}
__device__ __forceinline__ void phase_prep(Ctx& F) {
    LAS float* scr = (LAS float*)(F.lds + F.wave * 16896);
    const int gw = F.bid * NWAVES + F.wave, NGW = F.G * NWAVES, lane = F.lane;
    constexpr int I_IN = 32 * (NPROJ / 128), I_ABC = 16 * 8, I_OUT = 32 * 8, I_FI = 32 * (2 * DFF / 128), I_FO = (DFF / 32) * 8;
    constexpr int I_LAYER = I_IN + 3 * I_ABC + I_OUT + I_FI + I_FO;
    for (int it = gw; it < DEPTH * I_LAYER; it += NGW) {
        const int l = it / I_LAYER; int r = it - l * I_LAYER;
        const float* W; const float* ksc = nullptr; bf16_t* WT; int K = D, N = D, nblk = D / 128, mode = 0;
        if (r < I_IN) { W = F.in[9] + (size_t)l * D * NIN; N = NIN; nblk = NPROJ / 128; WT = V_WIN + (size_t)l * NPROJ * D; ksc = F.in[8] + l * D; mode = 1; }
        else if ((r -= I_IN) < 3 * I_ABC) { const int i = r / I_ABC; r -= i * I_ABC; W = F.in[17 + i] + (size_t)l * 512 * D; K = 512; WT = V_WABC + (size_t)(l * 3 + i) * D * 512; }
        else if ((r -= 3 * I_ABC) < I_OUT) { W = F.in[20] + (size_t)l * D * D; WT = V_WOUT + (size_t)l * D * D; }
        else if ((r -= I_OUT) < I_FI) { W = F.in[22] + (size_t)l * D * 2 * DFF; N = 2 * DFF; nblk = 2 * DFF / 128; WT = V_WFI + (size_t)l * 2 * DFF * D; ksc = F.in[21] + l * D; mode = 2; }
        else { r -= I_FI; W = F.in[23] + (size_t)l * DFF * D; K = DFF; WT = V_WFO + (size_t)l * D * DFF; }
        transpose_item(W, K, N, nblk, WT, ksc, mode, scr, r, lane);
    }
    for (int row0 = gw; row0 < M; row0 += 4 * NGW) {
        f32x4 v[4][4];
#pragma unroll
        for (int r = 0; r < 4; ++r) { const int row = row0 + r * NGW;
            if (row < M) { const float* src = row < MP ? F.in[0] + (size_t)row * D : F.in[1] + (size_t)(row - MP) * D;
#pragma unroll
                for (int j = 0; j < 4; ++j) v[r][j] = *(const f32x4*)(src + 4 * lane + 256 * j); } }
#pragma unroll
        for (int r = 0; r < 4; ++r) { const int row = row0 + r * NGW;
            if (row < M) { float ss = 0.f;
#pragma unroll
                for (int j = 0; j < 4; ++j) ss += (v[r][j][0] * v[r][j][0] + v[r][j][1] * v[r][j][1]) + (v[r][j][2] * v[r][j][2] + v[r][j][3] * v[r][j][3]);
                ss = wave_sum(ss);
                if (lane == 0) V_RS[row] = ss;
#pragma unroll
                for (int j = 0; j < 4; ++j) { u32x2 w; w.x = cvt_pk_bf16(v[r][j][0], v[r][j][1]); w.y = cvt_pk_bf16(v[r][j][2], v[r][j][3]); *(u32x2*)(V_XBA + (size_t)row * D + 4 * lane + 256 * j) = w; } } }
    }
    const int gt = F.bid * NTHREADS + F.tid, NGT = F.G * NTHREADS;
    for (int i = gt; i < 3 * M; i += NGT) V_RS[M + i] = 0.f;
    {
        const int i64 = gt & 63; const double invA = exp(-(double)i64 * (9.210340371976184 / 64.0));
        for (int e = gt; e < NPOS * 64; e += NGT) { const int pi = e >> 6; const double pos = pi < SEQ ? (double)pi : (double)(PAST + pi - SEQ);
            double a = pos * invA; a -= floor(a * 0.15915494309189535) * 6.283185307179586; float sn, cs; sincosf((float)a, &sn, &cs); *(f32x2*)(V_ROPEA + 2 * e) = (f32x2){cs, sn}; }
        const int i32 = gt & 31; const double invC = exp(-(double)i32 * (9.210340371976184 / 32.0));
        for (int e = gt; e < NPOS * 32; e += NGT) { const int pi = e >> 5; const double pos = pi < SEQ ? (double)pi : (double)(PAST + pi - SEQ);
            double a = pos * invC; a -= floor(a * 0.15915494309189535) * 6.283185307179586; float sn, cs; sincosf((float)a, &sn, &cs); *(f32x2*)(V_ROPEC + 2 * e) = (f32x2){cs, sn}; }
    }
}

__device__ __forceinline__ float* kv_out_ptr(float* out, int g, int l, bool sample, int b, int tt) {
    if (sample) { const size_t base = g == 0 ? O_KV0S : (g == 1 ? O_KV1S : O_KV2S); return out + base + ((size_t)(l * DB + b) * DS + tt) * 1024; }
    const int keep = 128 << (2 * g); const size_t base = g == 0 ? O_KV0P : (g == 1 ? O_KV1P : O_KV2P);
    return out + base + ((size_t)(l * BATCH + b) * keep + tt) * 1024;
}
template <int NR>
__device__ __forceinline__ void e1_partA(Ctx& F, int l, const int (&rows)[NR], bool store_qk) {
    const int lane = F.lane, jj = lane & 15, hq = lane >> 4;
    u32x2 xlo[NR][6], xhi[NR][6]; f32x4 cc[NR], sn[NR]; unsigned vv[NR][12];
    bool sample[NR]; int bb[NR], tt0[NR];
#pragma unroll
    for (int r = 0; r < NR; ++r) {
        const int row = rows[r];
        sample[r] = row >= MP; bb[r] = sample[r] ? (row - MP) >> 3 : row >> 12; tt0[r] = sample[r] ? (row - MP) & 7 : row & 4095;
        const int pidx = sample[r] ? SEQ + tt0[r] : tt0[r];
        const bf16_t* prow = V_PROJ + (size_t)row * NPROJ;
#pragma unroll
        for (int sl = 0; sl < 6; ++sl) { const bf16_t* p = prow + (4 * sl + hq) * 128; xlo[r][sl] = *(const u32x2*)(p + 4 * jj); xhi[r][sl] = *(const u32x2*)(p + 64 + 4 * jj); }
        const float* cs = V_ROPEA + ((size_t)pidx * 64 + 4 * jj) * 2;
        const f32x4 c01 = *(const f32x4*)cs, c23 = *(const f32x4*)(cs + 4);
        cc[r] = (f32x4){c01[0], c01[2], c23[0], c23[2]}; sn[r] = (f32x4){c01[1], c01[3], c23[1], c23[3]};
#pragma unroll
        for (int q = 0; q < 12; ++q) vv[r][q] = *(const unsigned*)(prow + PC_AV + q * 128 + 2 * lane);
    }
    const f32x4 gq_lo = *(const f32x4*)(F.in[10] + l * 128 + 4 * jj), gq_hi = *(const f32x4*)(F.in[10] + l * 128 + 64 + 4 * jj);
    const f32x4 gk_lo = *(const f32x4*)(F.in[11] + l * 128 + 4 * jj), gk_hi = *(const f32x4*)(F.in[11] + l * 128 + 64 + 4 * jj);
#pragma unroll
    for (int r = 0; r < NR; ++r) {
        const int row = rows[r], t = tt0[r], b = bb[r]; const bool smp = sample[r];
        bf16_t* prow = V_PROJ + (size_t)row * NPROJ;
#pragma unroll
        for (int sl = 0; sl < 6; ++sl) {
            const int hs = 4 * sl + hq, which = sl >= 3 ? 1 : 0, gh = hs - 12 * which, g = gh >> 2, h = gh & 3;
            f32x4 lo = (f32x4){bf_lo(xlo[r][sl].x), bf_hi(xlo[r][sl].x), bf_lo(xlo[r][sl].y), bf_hi(xlo[r][sl].y)}, hi = (f32x4){bf_lo(xhi[r][sl].x), bf_hi(xhi[r][sl].x), bf_lo(xhi[r][sl].y), bf_hi(xhi[r][sl].y)};
            float ss = (lo[0] * lo[0] + lo[1] * lo[1]) + (lo[2] * lo[2] + lo[3] * lo[3]) + (hi[0] * hi[0] + hi[1] * hi[1]) + (hi[2] * hi[2] + hi[3] * hi[3]);
            ss = row_sum16(ss);
            const float rstd = rsqrtf(ss * (1.f / 128.f) + EPS);
            lo = lo * rstd * (which ? gk_lo : gq_lo); hi = hi * rstd * (which ? gk_hi : gq_hi);
            const f32x4 olo = lo * cc[r] - hi * sn[r], ohi = hi * cc[r] + lo * sn[r];
            bf16_t* p = prow + hs * 128;
            if (store_qk) { u32x2 w0, w1; w0.x = cvt_pk_bf16(olo[0], olo[1]); w0.y = cvt_pk_bf16(olo[2], olo[3]); w1.x = cvt_pk_bf16(ohi[0], ohi[1]); w1.y = cvt_pk_bf16(ohi[2], ohi[3]);
                *(u32x2*)(p + 4 * jj) = w0; *(u32x2*)(p + 64 + 4 * jj) = w1; }
            if (which == 1) {
                const int keep = 128 << (2 * g); const int tt = smp ? t : t - (SEQ - keep);
                if (tt >= 0) { float* dst = kv_out_ptr(F.out, g, l, smp, b, tt) + h * 128; *(f32x4*)(dst + 4 * jj) = olo; *(f32x4*)(dst + 64 + 4 * jj) = ohi; }
            }
        }
#pragma unroll
        for (int g = 0; g < 3; ++g) {
            const int keep = 128 << (2 * g); const int tt = smp ? t : t - (SEQ - keep);
            if (tt >= 0) { float* dst = kv_out_ptr(F.out, g, l, smp, b, tt) + 512;
#pragma unroll
                for (int q = 0; q < 4; ++q) { const unsigned v = vv[r][4 * g + q]; *(f32x2*)(dst + q * 128 + 2 * lane) = (f32x2){bf_lo(v), bf_hi(v)}; } }
        }
    }
}
__device__ __forceinline__ void e1_row(Ctx& F, int l, int row) {
    const int lane = F.lane, j = lane & 31, hh = lane >> 5;
    const bool sample = row >= MP;
    const int b = sample ? (row - MP) >> 3 : row >> 12, t = sample ? (row - MP) & 7 : row & 4095;
    const int pidx = sample ? SEQ + t : t;
    bf16_t* prow = V_PROJ + (size_t)row * NPROJ;
    if (!sample && t < SEQ - 3) return;
#pragma unroll 1
    for (int it = 0; it < 6; ++it) {
        const int slot = 2 * it + hh, typ = slot >> 2, c = slot * 128 + 4 * j;
        f32x4 a = (f32x4){0.f, 0.f, 0.f, 0.f}, xcur = a;
#pragma unroll
        for (int i = 0; i < 4; ++i) {
            const int tp = t - 3 + i; f32x4 x;
            if (tp >= 0) { const u32x2 u = *(const u32x2*)(V_PROJ + (size_t)(row - 3 + i) * NPROJ + PC_BQKV + c); x = (f32x4){bf_lo(u.x), bf_hi(u.x), bf_lo(u.y), bf_hi(u.y)}; }
            else if (sample) x = *(const f32x4*)(F.in[5] + ((size_t)(l * DB + b) * 3 + (tp + 3)) * 1536 + c);
            else x = (f32x4){0.f, 0.f, 0.f, 0.f};
            const f32x4 w = *(const f32x4*)(F.in[12] + (size_t)(l * 4 + i) * 1536 + c);
            a += w * x; if (i == 3) xcur = x;
        }
#pragma unroll
        for (int q = 0; q < 4; ++q) a[q] = a[q] * sigmoidf_(a[q]);
        if (typ < 2) {
            const float ss = half_sum((a[0] * a[0] + a[1] * a[1]) + (a[2] * a[2] + a[3] * a[3]));
            const float sc = rsqrtf(ss + EPS) * (typ == 0 ? 0.08838834764831845f : 1.f);
            a *= sc;
        }
        *(f32x4*)(V_BQKV + (size_t)row * 1536 + c) = a;
        const int tc = sample ? t - 5 : t - (SEQ - 3);
        if (tc >= 0) { float* dst = F.out + (sample ? O_BCS + ((size_t)(l * DB + b) * 3 + tc) * 1536 : O_BCP + ((size_t)(l * BATCH + b) * 3 + tc) * 1536); *(f32x4*)(dst + c) = xcur; }
    }
    if (lane < 8) {
        const int h = lane & 3; const float x = bf1(prow[PC_BETA + lane]);
        float r;
        if (lane < 4) r = 1.f / (1.f + expf(-x));
        else { const float y = x + F.in[14][l * 4 + h]; const float sp = y > 20.f ? y : log1pf(expf(y)); r = -expf(F.in[13][l * 4 + h]) * sp; }
        V_BG[(size_t)row * 8 + lane] = r;
    }
    {
        const int hs = lane >> 3, i0 = 4 * (lane & 7);
        const bf16_t* p = prow + PC_CQ + hs * 64;
        const u32x2 ulo = *(const u32x2*)(p + i0), uhi = *(const u32x2*)(p + 32 + i0);
        const f32x4 lo = (f32x4){bf_lo(ulo.x), bf_hi(ulo.x), bf_lo(ulo.y), bf_hi(ulo.y)}, hi = (f32x4){bf_lo(uhi.x), bf_hi(uhi.x), bf_lo(uhi.y), bf_hi(uhi.y)};
        const float* cs = V_ROPEC + ((size_t)pidx * 32 + i0) * 2;
        const f32x4 c01 = *(const f32x4*)cs, c23 = *(const f32x4*)(cs + 4);
        const f32x4 cc = (f32x4){c01[0], c01[2], c23[0], c23[2]}, sn = (f32x4){c01[1], c01[3], c23[1], c23[3]};
        const float sc = hs >= 4 ? 0.125f : 1.f;
        const f32x4 olo = (lo * cc - hi * sn) * sc, ohi = (hi * cc + lo * sn) * sc;
        *(f32x4*)(V_CQK + (size_t)row * 512 + hs * 64 + i0) = olo; *(f32x4*)(V_CQK + (size_t)row * 512 + hs * 64 + 32 + i0) = ohi;
    }
}

__device__ __forceinline__ float dot8(const u32x4 q, const u32x4 k) {
    return (bf_lo(q.x) * bf_lo(k.x) + bf_hi(q.x) * bf_hi(k.x)) + (bf_lo(q.y) * bf_lo(k.y) + bf_hi(q.y) * bf_hi(k.y)) + (bf_lo(q.z) * bf_lo(k.z) + bf_hi(q.z) * bf_hi(k.z)) + (bf_lo(q.w) * bf_lo(k.w) + bf_hi(q.w) * bf_hi(k.w));
}
#define WAVE_LDS_SYNC() do { asm volatile("s_waitcnt lgkmcnt(0)" ::: "memory"); __builtin_amdgcn_wave_barrier(); } while (0)
__device__ __forceinline__ void attn_prompt_task(Ctx& F, int row, int h) {
    const int lane = F.lane, t = row & 4095;
    const bf16_t* proj = V_PROJ;
    LAS float* ps = (LAS float*)F.lds + F.wave * 256;
    float mrun = -INFINITY, lsum = 0.f, o0 = 0.f, o1 = 0.f;
#pragma unroll 1
    for (int g = 0; g < 3; ++g) {
        const int sh = 2 * g, nk = min(128, t >> sh) + 1;
        const bf16_t* qrow = proj + (size_t)row * NPROJ + PC_AQ + g * 512 + h * 128;
        u32x4 q[16];
#pragma unroll
        for (int i = 0; i < 16; ++i) q[i] = *(const u32x4*)(qrow + 8 * i);
        WAVE_LDS_SYNC();
#pragma unroll 1
        for (int r = 0; r < 3; ++r) {
            const int jk = r * 64 + lane; const bool valid = jk < nk; const int jj = valid ? jk : 0;
            const bf16_t* krow = proj + (size_t)(row - (jj << sh)) * NPROJ + PC_AK + g * 512 + h * 128;
            float a = 0.f;
#pragma unroll
            for (int i = 0; i < 16; ++i) a += dot8(q[i], *(const u32x4*)(krow + 8 * i));
            ps[jk] = valid ? a * 0.08838834764831845f : -INFINITY;
        }
        WAVE_LDS_SYNC();
        const float s0 = ps[lane], s1 = ps[64 + lane], s2 = ps[128 + lane];
        const float mg = wave_max(fmaxf(fmaxf(s0, s1), s2)), mnew = fmaxf(mrun, mg), alpha = __expf(mrun - mnew);
        const float p0 = __expf(s0 - mnew), p1 = __expf(s1 - mnew), p2 = __expf(s2 - mnew);
        WAVE_LDS_SYNC();
        ps[lane] = p0; ps[64 + lane] = p1; ps[128 + lane] = p2;
        lsum = lsum * alpha + wave_sum(p0 + p1 + p2); o0 *= alpha; o1 *= alpha; mrun = mnew;
        WAVE_LDS_SYNC();
        const bf16_t* vbase = proj + (size_t)row * NPROJ + PC_AV + g * 512 + h * 128 + 2 * lane;
#pragma unroll 4
        for (int jk = 0; jk < nk; ++jk) {
            const float pj = ps[jk];
            const unsigned vv = *(const unsigned*)(vbase - (size_t)(jk << sh) * NPROJ);
            o0 += pj * bf_lo(vv); o1 += pj * bf_hi(vv);
        }
    }
    const float inv = 1.f / lsum;
    *(unsigned*)(V_OABC + (size_t)row * 512 + h * 128 + 2 * lane) = cvt_pk_bf16(o0 * inv, o1 * inv);
}
__device__ __forceinline__ void attn_sample_unit(Ctx& F, int l, int bs, int h, int g) {
    const int lane = F.lane, b = bs >> 3, s = bs & 7, row = MP + bs;
    LAS float* ps = (LAS float*)F.lds + F.wave * 256;
    const int sh = 2 * g, L = 128 << sh;
    const float* cache = F.in[2 + g] + (size_t)(l * DB + b) * L * 1024;
    const float* newkv = kv_out_ptr(F.out, g, l, true, b, 0);
    const bf16_t* qrow = V_PROJ + (size_t)row * NPROJ + PC_AQ + g * 512 + h * 128;
    const int hl = lane & 31, hf = lane >> 5;
    const u32x2 qq = *(const u32x2*)(qrow + 4 * hl);
    const float q0 = bf_lo(qq.x) * 0.08838834764831845f, q1 = bf_hi(qq.x) * 0.08838834764831845f, q2 = bf_lo(qq.y) * 0.08838834764831845f, q3 = bf_hi(qq.y) * 0.08838834764831845f;
    WAVE_LDS_SYNC();
#pragma unroll 1
    for (int j0 = 0; j0 < 130; j0 += 26) {
        f32x4 kk[13];
#pragma unroll
        for (int u = 0; u < 13; ++u) { int jk = j0 + 2 * u + hf; jk = jk > 128 ? 128 : jk; const int idx = L + s - (jk << sh);
            kk[u] = *(const f32x4*)((idx < L ? cache + (size_t)idx * 1024 : newkv + (size_t)(idx - L) * 1024) + h * 128 + 4 * hl); }
#pragma unroll
        for (int u = 0; u < 13; ++u) { float a = (q0 * kk[u][0] + q1 * kk[u][1]) + (q2 * kk[u][2] + q3 * kk[u][3]);
            a = row_sum16(a); a += __shfl_xor(a, 16);
            const int jk = j0 + 2 * u + hf; if (hl == 0 && jk <= 128) ps[jk] = a; }
    }
    if (lane >= 1) ps[128 + lane] = -INFINITY;
    WAVE_LDS_SYNC();
    const float s0 = ps[lane], s1 = ps[64 + lane], s2 = ps[128 + lane];
    const float mx = wave_max(fmaxf(fmaxf(s0, s1), s2));
    const float p0 = __expf(s0 - mx), p1 = __expf(s1 - mx), p2 = __expf(s2 - mx);
    WAVE_LDS_SYNC();
    ps[lane] = p0; ps[64 + lane] = p1; ps[128 + lane] = p2;
    const float lsum = wave_sum(p0 + p1 + p2);
    WAVE_LDS_SYNC();
    float o0 = 0.f, o1 = 0.f, o2 = 0.f, o3 = 0.f;
    const float* vc = cache + 512 + h * 128 + 2 * lane; const float* vn2 = newkv + 512 + h * 128 + 2 * lane;
#pragma unroll 1
    for (int j0 = 0; j0 < 128; j0 += 16) {
        f32x2 vv[16];
#pragma unroll
        for (int u = 0; u < 16; ++u) { const int idx = L + s - ((j0 + u) << sh); vv[u] = *(const f32x2*)(idx < L ? vc + (size_t)idx * 1024 : vn2 + (size_t)(idx - L) * 1024); }
#pragma unroll
        for (int u = 0; u < 16; u += 2) { const float pa = ps[j0 + u], pb = ps[j0 + u + 1]; o0 += pa * vv[u][0]; o1 += pa * vv[u][1]; o2 += pb * vv[u + 1][0]; o3 += pb * vv[u + 1][1]; }
    }
    { const int idx = L + s - (128 << sh); const f32x2 vv = *(const f32x2*)(idx < L ? vc + (size_t)idx * 1024 : vn2 + (size_t)(idx - L) * 1024); const float pa = ps[128]; o0 += pa * vv[0]; o1 += pa * vv[1]; }
    const float inv = 1.f / lsum;
    *(unsigned*)(V_AO + ((size_t)g * M + row) * 512 + h * 128 + 2 * lane) = cvt_pk_bf16((o0 + o2) * inv, (o1 + o3) * inv);
    if (lane == 0) V_LSE[((size_t)g * M + row) * 4 + h] = mx + __logf(lsum);
}
constexpr int AT_KSTR = 272, AT_VSTR = 528, AT_VOFF = 256 * AT_KSTR;
template <int NP>
__device__ __forceinline__ void attn_ld(const bf16_t* proj, int b, int sh, int r, int g, int h, int npk0, int tid, u32x4 (&kv)[NP], u32x4 (&vv)[NP]) {
#pragma unroll
    for (int p = 0; p < NP; ++p) {
        const int kl = p * 32 + (tid >> 4), ch = tid & 15, np = npk0 + kl;
        if (np >= 0) { const bf16_t* src = proj + (size_t)(b * SEQ + (np << sh) + r) * NPROJ + g * 512 + h * 128 + ch * 8;
            kv[p] = *(const u32x4*)(src + PC_AK); vv[p] = *(const u32x4*)(src + PC_AV); }
        else { kv[p] = (u32x4){0u, 0u, 0u, 0u}; vv[p] = kv[p]; }
    }
}
template <int NP>
__device__ __forceinline__ void attn_st(LAS unsigned char* Ks, LAS unsigned char* Vt, int row0, int tid, const u32x4 (&kv)[NP], const u32x4 (&vv)[NP]) {
#pragma unroll
    for (int p = 0; p < NP; ++p) {
        const int kl = row0 + p * 32 + (tid >> 4), ch = tid & 15;
        *(LAS u32x4*)(Ks + kl * AT_KSTR + ch * 16) = kv[p];
        LAS unsigned short* vt = (LAS unsigned short*)(Vt + (ch * 8) * AT_VSTR + kl * 2);
        vt[0 * (AT_VSTR / 2)] = (unsigned short)(vv[p].x & 0xffffu); vt[1 * (AT_VSTR / 2)] = (unsigned short)(vv[p].x >> 16);
        vt[2 * (AT_VSTR / 2)] = (unsigned short)(vv[p].y & 0xffffu); vt[3 * (AT_VSTR / 2)] = (unsigned short)(vv[p].y >> 16);
        vt[4 * (AT_VSTR / 2)] = (unsigned short)(vv[p].z & 0xffffu); vt[5 * (AT_VSTR / 2)] = (unsigned short)(vv[p].z >> 16);
        vt[6 * (AT_VSTR / 2)] = (unsigned short)(vv[p].w & 0xffffu); vt[7 * (AT_VSTR / 2)] = (unsigned short)(vv[p].w >> 16);
    }
}
__device__ __forceinline__ void attn_blk(Ctx& F, const LAS unsigned char* Ks, const LAS unsigned char* Vt, int tb, int kmin, size_t rowq, int g, int h, const bf16x8 (&qf)[4]) {
    const int lane = F.lane, w = F.wave, li = lane & 15, q4 = lane >> 4;
    f32x4 st[9];
#pragma unroll
    for (int kt = 0; kt < 9; ++kt) {
        f32x4 acc = (f32x4){0.f, 0.f, 0.f, 0.f};
        const LAS unsigned char* kp = Ks + (((w + kt + tb) & 15) * 16 + li) * AT_KSTR + 16 * q4;
#pragma unroll
        for (int s = 0; s < 4; ++s) acc = __builtin_amdgcn_mfma_f32_16x16x32_bf16(*(const LAS bf16x8*)(kp + 64 * s), qf[s], acc, 0, 0, 0);
        st[kt] = acc;
    }
    float mx = -INFINITY;
#pragma unroll
    for (int kt = 0; kt < 9; ++kt)
#pragma unroll
        for (int rg = 0; rg < 4; ++rg) {
            const int a = 4 * q4 + rg, kl = (w + kt) * 16 + a;
            bool ok = kl >= kmin;
            if (kt == 0) ok = ok && (a >= li);
            if (kt == 8) ok = ok && (a <= li);
            st[kt][rg] = ok ? st[kt][rg] : -INFINITY;
            mx = fmaxf(mx, st[kt][rg]);
        }
    mx = fmaxf(mx, __shfl_xor(mx, 16)); mx = fmaxf(mx, __shfl_xor(mx, 32));
    const float c2 = 0.08838834764831845f * 1.4426950408889634f;
    float lsum = 0.f;
#pragma unroll
    for (int kt = 0; kt < 9; ++kt)
#pragma unroll
        for (int rg = 0; rg < 4; ++rg) { const float p = exp2f((st[kt][rg] - mx) * c2); st[kt][rg] = p; lsum += p; }
    lsum += __shfl_xor(lsum, 16); lsum += __shfl_xor(lsum, 32);
    f32x4 o[8];
#pragma unroll
    for (int db = 0; db < 8; ++db) o[db] = (f32x4){0.f, 0.f, 0.f, 0.f};
#pragma unroll
    for (int ks = 0; ks < 5; ++ks) {
        u32x4 pw;
        pw.x = cvt_pk_bf16(st[2 * ks][0], st[2 * ks][1]); pw.y = cvt_pk_bf16(st[2 * ks][2], st[2 * ks][3]);
        if (ks < 4) { pw.z = cvt_pk_bf16(st[2 * ks + 1][0], st[2 * ks + 1][1]); pw.w = cvt_pk_bf16(st[2 * ks + 1][2], st[2 * ks + 1][3]); }
        else { pw.z = 0u; pw.w = 0u; }
        const bf16x8 pf = __builtin_bit_cast(bf16x8, pw);
        const int t0 = (w + 2 * ks + tb) & 15, t1 = (w + 2 * ks + 1 + tb) & 15;
#pragma unroll
        for (int db = 0; db < 8; ++db) {
            const LAS unsigned char* vp = Vt + (16 * db + li) * AT_VSTR + 8 * q4;
            u32x4 av; const u32x2 a0 = *(const LAS u32x2*)(vp + t0 * 32), a1 = *(const LAS u32x2*)(vp + t1 * 32);
            av.x = a0.x; av.y = a0.y; av.z = a1.x; av.w = a1.y;
            o[db] = __builtin_amdgcn_mfma_f32_16x16x32_bf16(__builtin_bit_cast(bf16x8, av), pf, o[db], 0, 0, 0);
        }
    }
    const float inv = 1.f / lsum;
    bf16_t* dst = V_AO + ((size_t)g * M + rowq) * 512 + h * 128 + 4 * q4;
#pragma unroll
    for (int db = 0; db < 8; ++db) { u32x2 wv; wv.x = cvt_pk_bf16(o[db][0] * inv, o[db][1] * inv); wv.y = cvt_pk_bf16(o[db][2] * inv, o[db][3] * inv); *(u32x2*)(dst + 16 * db) = wv; }
    if (q4 == 0) V_LSE[((size_t)g * M + rowq) * 4 + h] = mx * 0.08838834764831845f + __logf(lsum);
}
__device__ __forceinline__ void attn_mfma_item(Ctx& F, int item) {
    const int tid = F.tid, lane = F.lane, w = F.wave, li = lane & 15, q4 = lane >> 4;
    const int nbr = item & 15; int rest = item >> 4; const int h = rest & 3; rest >>= 2; const int g = rest % 3, b = rest / 3;
    const int sh = 2 * g, psh = 4 - sh, r = nbr >> psh, nbp = nbr & ((1 << psh) - 1), n0 = nbp * 256;
    const bf16_t* proj = V_PROJ;
    LAS unsigned char* Ks = F.lds; LAS unsigned char* Vt = F.lds + AT_VOFF;
    u32x4 k2[4], v2[4];
    {
        u32x4 kv[8], vv[8];
        attn_ld<8>(proj, b, sh, r, g, h, n0 - 128, tid, kv, vv);
        attn_ld<4>(proj, b, sh, r, g, h, n0 + 128, tid, k2, v2);
        attn_st<8>(Ks, Vt, 0, tid, kv, vv);
    }
    const int ql = 16 * w + li;
#pragma unroll 1
    for (int j = 0; j < 2; ++j) {
        const size_t rowq = (size_t)(b * SEQ + ((n0 + 128 * j + ql) << sh) + r);
        bf16x8 qf[4];
#pragma unroll
        for (int s = 0; s < 4; ++s) qf[s] = *(const bf16x8*)(proj + rowq * NPROJ + PC_AQ + g * 512 + h * 128 + 32 * s + 8 * q4);
        __syncthreads();
        attn_blk(F, Ks, Vt, 8 * j, j == 0 ? 128 - n0 : 0, rowq, g, h, qf);
        __syncthreads();
        if (j == 0) attn_st<4>(Ks, Vt, 0, tid, k2, v2);
    }
}
constexpr int DP_Q = 0, DP_K = 17408, DP_V = 34816, DP_AM = 52224, DP_TM = 68608, DP_RTV = 77824, DP_RTK = 96256, DP_GC = 114688, DP_BT = 114944;
__device__ __forceinline__ f32x4 mfma16(const bf16x8 a, const bf16x8 b, const f32x4 c) { return __builtin_amdgcn_mfma_f32_16x16x32_bf16(a, b, c, 0, 0, 0); }
__device__ __forceinline__ void delta_prep_item(Ctx& F, int l, int ch) {
    const int tid = F.tid, lane = F.lane, w = F.wave, li = lane & 15, q4 = lane >> 4;
    const int c = ch & 63, h = (ch >> 6) & 3, b = ch >> 8;
    const int row0 = b * SEQ + 64 * c;
    const bf16_t* proj = V_PROJ;
    LAS unsigned char* L = F.lds;
    LAS float* gcs = (LAS float*)(L + DP_GC); LAS float* bts = (LAS float*)(L + DP_BT);
    float b_x = 0.f, b_y = 0.f;
    if (tid < 64) { const bf16_t* pr = proj + (size_t)(row0 + tid) * NPROJ; b_x = bf1(pr[PC_BETA + h]); b_y = bf1(pr[PC_BA + h]); }
    {
        f32x2 wg[3][4]; unsigned xr[3][11];
#pragma unroll
        for (int typ = 0; typ < 3; ++typ) {
            const int cc = typ * 512 + h * 128 + 2 * lane;
#pragma unroll
            for (int i = 0; i < 4; ++i) wg[typ][i] = *(const f32x2*)(F.in[12] + (size_t)(l * 4 + i) * 1536 + cc);
#pragma unroll
            for (int rr = 0; rr < 11; ++rr) { const int tl = 64 * c + 8 * w + rr - 3; xr[typ][rr] = tl >= 0 ? *(const unsigned*)(proj + (size_t)(b * SEQ + tl) * NPROJ + PC_BQKV + cc) : 0u; }
        }
#pragma unroll
        for (int typ = 0; typ < 3; ++typ) {
#pragma unroll
            for (int rr = 0; rr < 8; ++rr) {
                float a0 = 0.f, a1 = 0.f;
#pragma unroll
                for (int i = 0; i < 4; ++i) { a0 += wg[typ][i][0] * bf_lo(xr[typ][rr + i]); a1 += wg[typ][i][1] * bf_hi(xr[typ][rr + i]); }
                a0 = a0 * sigmoidf_(a0); a1 = a1 * sigmoidf_(a1);
                if (typ < 2) { const float ss = wave_sum(a0 * a0 + a1 * a1); const float sc = rsqrtf(ss + EPS) * (typ == 0 ? 0.08838834764831845f : 1.f); a0 *= sc; a1 *= sc; }
                *(LAS unsigned*)(L + typ * 17408 + (8 * w + rr) * 272 + 4 * lane) = cvt_pk_bf16(a0, a1);
            }
        }
    }
    if (tid < 64) {
        const float be = 1.f / (1.f + expf(-b_x));
        const float y = b_y + F.in[14][l * 4 + h]; const float sp = y > 20.f ? y : log1pf(expf(y));
        float g = -expf(F.in[13][l * 4 + h]) * sp;
#pragma unroll
        for (int o = 1; o < 64; o <<= 1) { const float v = __shfl_up(g, o); if (lane >= o) g += v; }
        gcs[tid] = g; bts[tid] = be;
    }
    __syncthreads();
    const size_t chs = (size_t)ch;
    {
        const int mi = w >> 1;
#pragma unroll
        for (int t2 = 0; t2 < 2; ++t2) {
            const int nj = 2 * (w & 1) + t2;
            bf16_t* ad = V_DAT + chs * 4096 + (size_t)(16 * mi + li) * 64 + 32 * (nj >> 1) + 8 * q4 + 4 * (nj & 1);
            if (nj <= mi) {
                f32x4 akk = (f32x4){0.f, 0.f, 0.f, 0.f}, aqk = akk;
                const LAS unsigned char* ki = L + DP_K + (16 * mi + li) * 272 + 16 * q4; const LAS unsigned char* kj = L + DP_K + (16 * nj + li) * 272 + 16 * q4;
                const LAS unsigned char* qi = L + DP_Q + (16 * mi + li) * 272 + 16 * q4;
#pragma unroll
                for (int s2 = 0; s2 < 4; ++s2) { const bf16x8 fkj = *(const LAS bf16x8*)(kj + 64 * s2);
                    akk = mfma16(*(const LAS bf16x8*)(ki + 64 * s2), fkj, akk);
                    aqk = mfma16(fkj, *(const LAS bf16x8*)(qi + 64 * s2), aqk); }
                const float gj = gcs[16 * nj + li], gi2 = gcs[16 * mi + li];
                float ov[4];
#pragma unroll
                for (int rg = 0; rg < 4; ++rg) {
                    const int i = 16 * mi + 4 * q4 + rg, j = 16 * nj + li;
                    ((LAS float*)(L + DP_AM))[i * 64 + j] = (i > j) ? bts[i] * akk[rg] * __expf(gcs[i] - gj) : 0.f;
                    const int j2 = 16 * nj + 4 * q4 + rg, i2 = 16 * mi + li;
                    ov[rg] = (i2 >= j2) ? aqk[rg] * __expf(gi2 - gcs[j2]) : 0.f;
                }
                u32x2 pk; pk.x = cvt_pk_bf16(ov[0], ov[1]); pk.y = cvt_pk_bf16(ov[2], ov[3]); *(u32x2*)ad = pk;
            } else { *(u32x2*)ad = (u32x2){0u, 0u}; }
        }
    }
    __syncthreads();
    if (w == 0) {
        const LAS float* Am = (const LAS float*)(L + DP_AM);
        float t[64];
#pragma unroll
        for (int i = 0; i < 64; ++i) {
            float a0 = (lane == i) ? 1.f : 0.f, a1 = 0.f;
#pragma unroll
            for (int j = 0; j < i; j += 4) {
                const f32x4 av = *(const LAS f32x4*)(Am + i * 64 + j);
                a0 -= av[0] * t[j];
                if (j + 1 < i) a1 -= av[1] * t[j + 1];
                if (j + 2 < i) a0 -= av[2] * t[j + 2];
                if (j + 3 < i) a1 -= av[3] * t[j + 3];
            }
            t[i] = a0 + a1;
            *(LAS unsigned short*)(L + DP_TM + i * 144 + 2 * lane) = (unsigned short)(cvt_pk_bf16(t[i], 0.f) & 0xffffu);
        }
    } else {
        const int e0 = tid - 64;
        const float gl = gcs[63];
        for (int e = e0; e < 8192; e += 448) {
            const int kk = e >> 12, t = e & 63, dp = (e >> 6) & 63;
            const unsigned u = *(const LAS unsigned*)(L + (kk ? DP_K : DP_V) + t * 272 + 4 * dp);
            const float sc = kk ? bts[t] * __expf(gcs[t]) : bts[t];
            const unsigned pk = cvt_pk_bf16(bf_lo(u) * sc, bf_hi(u) * sc);
            LAS unsigned short* d0 = (LAS unsigned short*)(L + (kk ? DP_RTK : DP_RTV) + (2 * dp) * 144 + 2 * t);
            d0[0] = (unsigned short)(pk & 0xffffu); d0[72] = (unsigned short)(pk >> 16);
        }
        for (int e = e0; e < 1024; e += 448) {
            const int t = e >> 4, c16 = e & 15; const float sc = __expf(gcs[t]);
            const u32x4 u = *(const LAS u32x4*)(L + DP_Q + t * 272 + 16 * c16);
            u32x4 o; o.x = cvt_pk_bf16(bf_lo(u.x) * sc, bf_hi(u.x) * sc); o.y = cvt_pk_bf16(bf_lo(u.y) * sc, bf_hi(u.y) * sc); o.z = cvt_pk_bf16(bf_lo(u.z) * sc, bf_hi(u.z) * sc); o.w = cvt_pk_bf16(bf_lo(u.w) * sc, bf_hi(u.w) * sc);
            { bf16_t* qd = V_DQG + chs * 8192 + (size_t)t * 128 + 32 * (c16 >> 2) + 16 * (c16 & 1) + 4 * ((c16 >> 1) & 1); *(u32x2*)qd = (u32x2){o.x, o.y}; *(u32x2*)(qd + 8) = (u32x2){o.z, o.w}; }
        }
        for (int e = e0; e < 1024; e += 448) {
            const int dk = e >> 3, t8 = (e & 7) * 8;
            float v[8];
#pragma unroll
            for (int q = 0; q < 8; ++q) v[q] = bf1(*(const LAS unsigned short*)(L + DP_K + (t8 + q) * 272 + 2 * dk)) * __expf(gl - gcs[t8 + q]);
            u32x4 o; o.x = cvt_pk_bf16(v[0], v[1]); o.y = cvt_pk_bf16(v[2], v[3]); o.z = cvt_pk_bf16(v[4], v[5]); o.w = cvt_pk_bf16(v[6], v[7]);
            { bf16_t* kd = V_DKT + chs * 8192 + (size_t)dk * 64 + 32 * (t8 >> 5) + 16 * ((t8 >> 3) & 1) + 4 * ((t8 >> 4) & 1); *(u32x2*)kd = (u32x2){o.x, o.y}; *(u32x2*)(kd + 8) = (u32x2){o.z, o.w}; }
        }
        if (tid == 64) V_DDL[ch] = __expf(gl);
    }
    __syncthreads();
#pragma unroll
    for (int q = 0; q < 4; ++q) {
        const int id = 4 * w + q;
        { const int m = id >> 2, n = id & 3;
          const LAS unsigned char* ap = L + DP_RTK + (16 * m + li) * 144 + 16 * q4; const LAS unsigned char* bp = L + DP_TM + (16 * n + li) * 144 + 16 * q4;
          f32x4 acc = (f32x4){0.f, 0.f, 0.f, 0.f};
#pragma unroll
          for (int s2 = 0; s2 < 2; ++s2) acc = mfma16(*(const LAS bf16x8*)(ap + 64 * s2), *(const LAS bf16x8*)(bp + 64 * s2), acc);
          u32x2 pk; pk.x = cvt_pk_bf16(acc[0], acc[1]); pk.y = cvt_pk_bf16(acc[2], acc[3]);
          *(u32x2*)(V_DW + chs * 8192 + (size_t)(16 * n + li) * 128 + 32 * (m >> 1) + 8 * q4 + 4 * (m & 1)) = pk; }
        { const int mb = id & 3, nj = id >> 2;
          const LAS unsigned char* ap = L + DP_TM + (16 * mb + li) * 144 + 16 * q4; const LAS unsigned char* bp = L + DP_RTV + (16 * nj + li) * 144 + 16 * q4;
          f32x4 acc = (f32x4){0.f, 0.f, 0.f, 0.f};
#pragma unroll
          for (int s2 = 0; s2 < 2; ++s2) acc = mfma16(*(const LAS bf16x8*)(ap + 64 * s2), *(const LAS bf16x8*)(bp + 64 * s2), acc);
          *(f32x4*)(V_DU + ((chs * 8 + nj) * 64 + lane) * 16 + 4 * mb) = acc; }
    }
    __syncthreads();
}
__device__ __forceinline__ bf16x8 ld_perm(const LAS unsigned char* p) { const u32x2 a = *(const LAS u32x2*)p, b = *(const LAS u32x2*)(p + 32); u32x4 r; r.x = a.x; r.y = a.y; r.z = b.x; r.w = b.y; return __builtin_bit_cast(bf16x8, r); }
__device__ __forceinline__ bf16x8 pack_b(const f32x4 lo, const f32x4 hi) { u32x4 r; r.x = cvt_pk_bf16(lo[0], lo[1]); r.y = cvt_pk_bf16(lo[2], lo[3]); r.z = cvt_pk_bf16(hi[0], hi[1]); r.w = cvt_pk_bf16(hi[2], hi[3]); return __builtin_bit_cast(bf16x8, r); }
template <int DK, bool HAS_W>
__device__ __forceinline__ void chunk_scan_item(Ctx& F, const bf16_t* gW, const bf16_t* gQG, const bf16_t* gKT, const bf16_t* gAT, const float* gU, const bf16_t* vrow  , const float* gDL, float dl_const,
                                                float* obase  , float* Sout  ) {
    constexpr int RS_ = DK * 2 + 16;
    constexpr int OFF_QG = HAS_W ? 64 * RS_ : 0, OFF_KT = OFF_QG + 64 * RS_, OFF_AT = OFF_KT + DK * 144, BUF = OFF_AT + 64 * 144;
    constexpr int NWQ = (64 * DK / 8) / 512;
    constexpr int MT = DK / 16, KS = DK / 32;
    const int tid = F.tid, lane = F.lane, w = F.wave, li = lane & 15, q4 = lane >> 4;
    LAS unsigned char* L = F.lds;
    f32x4 S[MT];
#pragma unroll
    for (int m = 0; m < MT; ++m) S[m] = (f32x4){0.f, 0.f, 0.f, 0.f};
    u32x4 pfw[NWQ], pfq[NWQ], pfk[NWQ], pfa; f32x4 un[4];
#define CS_LOAD(cv) do { const size_t c_ = (cv); \
        _Pragma("unroll") for (int i_ = 0; i_ < NWQ; ++i_) { if (HAS_W) pfw[i_] = *(const u32x4*)(gW + c_ * (64 * DK) + (size_t)(tid + 512 * i_) * 8); \
            pfq[i_] = *(const u32x4*)(gQG + c_ * (64 * DK) + (size_t)(tid + 512 * i_) * 8); pfk[i_] = *(const u32x4*)(gKT + c_ * (64 * DK) + (size_t)(tid + 512 * i_) * 8); } \
        pfa = *(const u32x4*)(gAT + c_ * 4096 + (size_t)tid * 8); \
        if (HAS_W) { _Pragma("unroll") for (int m_ = 0; m_ < 4; ++m_) un[m_] = *(const f32x4*)(gU + ((c_ * 8 + w) * 64 + lane) * 16 + 4 * m_); } \
        else { const bf16_t* vp_ = vrow + (size_t)(64 * c_ + 4 * q4) * NPROJ + 16 * w + li; _Pragma("unroll") for (int m_ = 0; m_ < 4; ++m_) _Pragma("unroll") for (int r_ = 0; r_ < 4; ++r_) un[m_][r_] = bf1(vp_[(size_t)(16 * m_ + r_) * NPROJ]); } } while (0)
#define CS_STORE(bufv) do { LAS unsigned char* B_ = L + (bufv) * BUF; \
        _Pragma("unroll") for (int i_ = 0; i_ < NWQ; ++i_) { const int u_ = tid + 512 * i_; \
            if (HAS_W) *(LAS u32x4*)(B_ + (u_ / (DK / 8)) * RS_ + (u_ % (DK / 8)) * 16) = pfw[i_]; \
            *(LAS u32x4*)(B_ + OFF_QG + (u_ / (DK / 8)) * RS_ + (u_ % (DK / 8)) * 16) = pfq[i_]; \
            *(LAS u32x4*)(B_ + OFF_KT + (u_ >> 3) * 144 + (u_ & 7) * 16) = pfk[i_]; } \
        *(LAS u32x4*)(B_ + OFF_AT + (tid >> 3) * 144 + (tid & 7) * 16) = pfa; } while (0)
    CS_LOAD(0);
    CS_STORE(0);
    f32x4 uc[4];
#pragma unroll
    for (int m = 0; m < 4; ++m) uc[m] = un[m];
    float dl = gDL ? gDL[0] : dl_const;
    __syncthreads();
#pragma unroll 1
    for (int c = 0; c < 64; ++c) {
        const LAS unsigned char* Bf = L + (c & 1) * BUF;
        float dln = dl_const;
        if (c + 1 < 64) { CS_LOAD(c + 1); if (gDL) dln = gDL[c + 1]; }
        bf16x8 Sb[KS];
#pragma unroll
        for (int s2 = 0; s2 < KS; ++s2) Sb[s2] = pack_b(S[2 * s2], S[2 * s2 + 1]);
        const LAS unsigned char* fb = Bf + li * RS_ + 16 * q4;
        const LAS unsigned char* fb2 = Bf + li * 144 + 16 * q4;
        f32x4 vn[4];
        if (HAS_W) {
            bf16x8 fw[4][KS];
#pragma unroll
            for (int mb = 0; mb < 4; ++mb)
#pragma unroll
                for (int s2 = 0; s2 < KS; ++s2) fw[mb][s2] = *(const LAS bf16x8*)(fb + mb * 16 * RS_ + 64 * s2);
#pragma unroll
            for (int mb = 0; mb < 4; ++mb) vn[mb] = (f32x4){0.f, 0.f, 0.f, 0.f};
#pragma unroll
            for (int s2 = 0; s2 < KS; ++s2)
#pragma unroll
                for (int mb = 0; mb < 4; ++mb) vn[mb] = mfma16(fw[mb][s2], Sb[s2], vn[mb]);
#pragma unroll
            for (int mb = 0; mb < 4; ++mb) vn[mb] = uc[mb] - vn[mb];
        } else {
#pragma unroll
            for (int mb = 0; mb < 4; ++mb) vn[mb] = uc[mb];
        }
        bf16x8 Vb[2];
        Vb[0] = pack_b(vn[0], vn[1]); Vb[1] = pack_b(vn[2], vn[3]);
        {
            bf16x8 fq[4][KS], fa[4][2];
#pragma unroll
            for (int mb = 0; mb < 4; ++mb) {
#pragma unroll
                for (int s2 = 0; s2 < KS; ++s2) fq[mb][s2] = *(const LAS bf16x8*)(fb + OFF_QG + mb * 16 * RS_ + 64 * s2);
#pragma unroll
                for (int s2 = 0; s2 < 2; ++s2) fa[mb][s2] = *(const LAS bf16x8*)(fb2 + OFF_AT + mb * 16 * 144 + 64 * s2);
            }
            f32x4 oa[4];
#pragma unroll
            for (int mb = 0; mb < 4; ++mb) oa[mb] = (f32x4){0.f, 0.f, 0.f, 0.f};
#pragma unroll
            for (int s2 = 0; s2 < KS; ++s2)
#pragma unroll
                for (int mb = 0; mb < 4; ++mb) oa[mb] = mfma16(fq[mb][s2], Sb[s2], oa[mb]);
#pragma unroll
            for (int s2 = 0; s2 < 2; ++s2)
#pragma unroll
                for (int mb = 0; mb < 4; ++mb) oa[mb] = mfma16(fa[mb][s2], Vb[s2], oa[mb]);
            float* od = obase + (size_t)(64 * c + 4 * q4) * 512 + 16 * w + li;
#pragma unroll
            for (int mb = 0; mb < 4; ++mb)
#pragma unroll
                for (int rg = 0; rg < 4; ++rg) od[(size_t)(16 * mb + rg) * 512] = oa[mb][rg];
        }
        {
            bf16x8 fk[MT][2];
#pragma unroll
            for (int m = 0; m < MT; ++m)
#pragma unroll
                for (int s2 = 0; s2 < 2; ++s2) fk[m][s2] = *(const LAS bf16x8*)(fb2 + OFF_KT + m * 16 * 144 + 64 * s2);
#pragma unroll
            for (int m = 0; m < MT; ++m) S[m] = S[m] * dl;
#pragma unroll
            for (int s2 = 0; s2 < 2; ++s2)
#pragma unroll
                for (int m = 0; m < MT; ++m) S[m] = mfma16(fk[m][s2], Vb[s2], S[m]);
        }
        if (c + 1 < 64) { CS_STORE((c + 1) & 1);
#pragma unroll
            for (int m = 0; m < 4; ++m) uc[m] = un[m];
            dl = dln; }
        __syncthreads();
    }
#undef CS_LOAD
#undef CS_STORE
    float* So = Sout + 16 * w + li;
#pragma unroll
    for (int m = 0; m < MT; ++m)
#pragma unroll
        for (int rg = 0; rg < 4; ++rg) So[(size_t)(16 * m + 4 * q4 + rg) * 128] = S[m][rg];
    __syncthreads();
}

constexpr int D2_BUF = 35840, D2_KT = 17408;
__device__ __forceinline__ void delta_scan2_item(Ctx& F, int l, int b, int h) {
    const int tid = F.tid, lane = F.lane, w = F.wave, li = lane & 15, q4 = lane >> 4;
    LAS unsigned char* L = F.lds;
    const size_t ch0 = (size_t)(b * 4 + h) * 64;
    const bf16_t* gW = V_DW + ch0 * 8192; const bf16_t* gKT = V_DKT + ch0 * 8192; const float* gU = V_DU + ch0 * 8192; const float* gDL = V_DDL + ch0;
    bf16_t* gSB = V_SB + ch0 * 16384; bf16_t* gVB = V_VB + ch0 * 8192;
    f32x4 S[8];
#pragma unroll
    for (int m = 0; m < 8; ++m) S[m] = (f32x4){0.f, 0.f, 0.f, 0.f};
    u32x4 pa[4], pb[4]; f32x4 ua[4], ub[4], uc[4]; float dla = 0.f, dlb = 0.f, dl;
#define D2_LOAD(P, U_, DL_, cv) do { const size_t c_ = (cv); \
        P[0] = *(const u32x4*)(gW + c_ * 8192 + (size_t)tid * 8); P[1] = *(const u32x4*)(gW + c_ * 8192 + (size_t)(tid + 512) * 8); \
        P[2] = *(const u32x4*)(gKT + c_ * 8192 + (size_t)tid * 8); P[3] = *(const u32x4*)(gKT + c_ * 8192 + (size_t)(tid + 512) * 8); \
        _Pragma("unroll") for (int m_ = 0; m_ < 4; ++m_) U_[m_] = *(const f32x4*)(gU + ((c_ * 8 + w) * 64 + lane) * 16 + 4 * m_); DL_ = gDL[c_]; } while (0)
#define D2_STORE(P, bufv) do { LAS unsigned char* B_ = L + (bufv) * D2_BUF; \
        *(LAS u32x4*)(B_ + (tid >> 4) * 272 + (tid & 15) * 16) = P[0]; *(LAS u32x4*)(B_ + ((tid >> 4) + 32) * 272 + (tid & 15) * 16) = P[1]; \
        *(LAS u32x4*)(B_ + D2_KT + (tid >> 3) * 144 + (tid & 7) * 16) = P[2]; *(LAS u32x4*)(B_ + D2_KT + ((tid >> 3) + 64) * 144 + (tid & 7) * 16) = P[3]; } while (0)
#define D2_COMPUTE(bufv, cv) do { const LAS unsigned char* Bf = L + (bufv) * D2_BUF; const size_t c_ = (cv); \
        bf16x8 Sb[4]; \
        _Pragma("unroll") for (int s2 = 0; s2 < 4; ++s2) { Sb[s2] = pack_b(S[2 * s2], S[2 * s2 + 1]); *(bf16x8*)(gSB + (((c_ * 8 + w) * 4 + s2) * 64 + lane) * 8) = Sb[s2]; } \
        const LAS unsigned char* fb = Bf + li * 272 + 16 * q4; const LAS unsigned char* fb2 = Bf + D2_KT + li * 144 + 16 * q4; \
        f32x4 vn[4]; \
        { bf16x8 fw[4][4]; \
          _Pragma("unroll") for (int mb = 0; mb < 4; ++mb) _Pragma("unroll") for (int s2 = 0; s2 < 4; ++s2) fw[mb][s2] = *(const LAS bf16x8*)(fb + mb * 16 * 272 + 64 * s2); \
          _Pragma("unroll") for (int mb = 0; mb < 4; ++mb) vn[mb] = (f32x4){0.f, 0.f, 0.f, 0.f}; \
          _Pragma("unroll") for (int s2 = 0; s2 < 4; ++s2) _Pragma("unroll") for (int mb = 0; mb < 4; ++mb) vn[mb] = mfma16(fw[mb][s2], Sb[s2], vn[mb]); } \
        _Pragma("unroll") for (int mb = 0; mb < 4; ++mb) vn[mb] = uc[mb] - vn[mb]; \
        bf16x8 Vb[2]; Vb[0] = pack_b(vn[0], vn[1]); Vb[1] = pack_b(vn[2], vn[3]); \
        _Pragma("unroll") for (int s2 = 0; s2 < 2; ++s2) *(bf16x8*)(gVB + (((c_ * 8 + w) * 2 + s2) * 64 + lane) * 8) = Vb[s2]; \
        { bf16x8 fk[8][2]; \
          _Pragma("unroll") for (int m = 0; m < 8; ++m) _Pragma("unroll") for (int s2 = 0; s2 < 2; ++s2) fk[m][s2] = *(const LAS bf16x8*)(fb2 + m * 16 * 144 + 64 * s2); \
          _Pragma("unroll") for (int m = 0; m < 8; ++m) S[m] = S[m] * dl; \
          _Pragma("unroll") for (int s2 = 0; s2 < 2; ++s2) _Pragma("unroll") for (int m = 0; m < 8; ++m) S[m] = mfma16(fk[m][s2], Vb[s2], S[m]); } } while (0)
    D2_LOAD(pa, ua, dla, 0);
    D2_LOAD(pb, ub, dlb, 1);
    D2_STORE(pa, 0);
#pragma unroll
    for (int m = 0; m < 4; ++m) uc[m] = ua[m];
    dl = dla;
    __syncthreads();
#pragma unroll 1
    for (int c = 0; c < 64; c += 2) {
        if (c + 2 < 64) D2_LOAD(pa, ua, dla, c + 2);
        D2_COMPUTE(0, c);
        D2_STORE(pb, 1);
#pragma unroll
        for (int m = 0; m < 4; ++m) uc[m] = ub[m];
        dl = dlb;
        __syncthreads();
        if (c + 3 < 64) D2_LOAD(pb, ub, dlb, c + 3);
        D2_COMPUTE(1, c + 1);
        if (c + 2 < 64) { D2_STORE(pa, 0);
#pragma unroll
            for (int m = 0; m < 4; ++m) uc[m] = ua[m];
            dl = dla; }
        __syncthreads();
    }
#undef D2_LOAD
#undef D2_STORE
#undef D2_COMPUTE
    float* So = F.out + O_BSP + ((size_t)(l * BATCH + b) * 4 + h) * 16384 + 16 * w + li;
#pragma unroll
    for (int m = 0; m < 8; ++m)
#pragma unroll
        for (int rg = 0; rg < 4; ++rg) So[(size_t)(16 * m + 4 * q4 + rg) * 128] = S[m][rg];
    __syncthreads();
}
__device__ __forceinline__ void delta_out_item(Ctx& F, int l, int ch) {
    const int tid = F.tid, lane = F.lane, w = F.wave, li = lane & 15, q4 = lane >> 4;
    const int c = ch & 63, h = (ch >> 6) & 3, b = ch >> 8;
    const int row0 = b * SEQ + 64 * c;
    LAS unsigned char* L = F.lds;
    const size_t chs = (size_t)ch;
    const u32x4 q0 = *(const u32x4*)(V_DQG + chs * 8192 + (size_t)tid * 8), q1 = *(const u32x4*)(V_DQG + chs * 8192 + (size_t)(tid + 512) * 8), a0 = *(const u32x4*)(V_DAT + chs * 4096 + (size_t)tid * 8);
    bf16x8 Sb[4], Vb[2];
#pragma unroll
    for (int s2 = 0; s2 < 4; ++s2) Sb[s2] = *(const bf16x8*)(V_SB + (((chs * 8 + w) * 4 + s2) * 64 + lane) * 8);
#pragma unroll
    for (int s2 = 0; s2 < 2; ++s2) Vb[s2] = *(const bf16x8*)(V_VB + (((chs * 8 + w) * 2 + s2) * 64 + lane) * 8);
    const float gn = F.in[15][l * 128 + 16 * w + li];
    const bf16_t* zp = V_PROJ + (size_t)(row0 + 4 * q4) * NPROJ + PC_BZ + h * 128 + 16 * w + li;
    float zz[16];
#pragma unroll
    for (int i = 0; i < 16; ++i) zz[i] = bf1(zp[(size_t)(16 * (i >> 2) + (i & 3)) * NPROJ]);
    *(LAS u32x4*)(L + (tid >> 4) * 272 + (tid & 15) * 16) = q0; *(LAS u32x4*)(L + ((tid >> 4) + 32) * 272 + (tid & 15) * 16) = q1;
    *(LAS u32x4*)(L + 17408 + (tid >> 3) * 144 + (tid & 7) * 16) = a0;
    __syncthreads();
    f32x4 oa[4];
    {
        const LAS unsigned char* fb = L + li * 272 + 16 * q4; const LAS unsigned char* fb2 = L + 17408 + li * 144 + 16 * q4;
        bf16x8 fq[4][4], fa[4][2];
#pragma unroll
        for (int mb = 0; mb < 4; ++mb) {
#pragma unroll
            for (int s2 = 0; s2 < 4; ++s2) fq[mb][s2] = *(const LAS bf16x8*)(fb + mb * 16 * 272 + 64 * s2);
#pragma unroll
            for (int s2 = 0; s2 < 2; ++s2) fa[mb][s2] = *(const LAS bf16x8*)(fb2 + mb * 16 * 144 + 64 * s2);
        }
#pragma unroll
        for (int mb = 0; mb < 4; ++mb) oa[mb] = (f32x4){0.f, 0.f, 0.f, 0.f};
#pragma unroll
        for (int s2 = 0; s2 < 4; ++s2)
#pragma unroll
            for (int mb = 0; mb < 4; ++mb) oa[mb] = mfma16(fq[mb][s2], Sb[s2], oa[mb]);
#pragma unroll
        for (int s2 = 0; s2 < 2; ++s2)
#pragma unroll
            for (int mb = 0; mb < 4; ++mb) oa[mb] = mfma16(fa[mb][s2], Vb[s2], oa[mb]);
    }
    LAS float* part = (LAS float*)(L + 32768);
#pragma unroll
    for (int mb = 0; mb < 4; ++mb)
#pragma unroll
        for (int rg = 0; rg < 4; ++rg) { float ss = oa[mb][rg] * oa[mb][rg];
            ss = row_sum16(ss);
            if (li == 0) part[(16 * mb + 4 * q4 + rg) * 8 + w] = ss; }
    __syncthreads();
    bf16_t* od = V_OABC + (size_t)M * 512 + (size_t)(row0 + 4 * q4) * 512 + h * 128 + 16 * w + li;
#pragma unroll
    for (int mb = 0; mb < 4; ++mb)
#pragma unroll
        for (int rg = 0; rg < 4; ++rg) { const int tk = 16 * mb + 4 * q4 + rg;
            const f32x4 p0 = *(const LAS f32x4*)(part + tk * 8), p1 = *(const LAS f32x4*)(part + tk * 8 + 4);
            const float rstd = rsqrtf(((p0[0] + p0[1]) + (p0[2] + p0[3]) + (p1[0] + p1[1]) + (p1[2] + p1[3])) * (1.f / 128.f) + EPS);
            const float z = zz[4 * mb + rg];
            od[(size_t)(16 * mb + rg) * 512] = (bf16_t)(cvt_pk_bf16(oa[mb][rg] * rstd * gn * z * sigmoidf_(z), 0.f) & 0xffffu); }
    __syncthreads();
}
__device__ __forceinline__ void delta_scan_item(Ctx& F, int l, int b, int h) {
    const size_t ch0 = (size_t)(b * 4 + h) * 64;
    chunk_scan_item<128, true>(F, V_DW + ch0 * 8192, V_DQG + ch0 * 8192, V_DKT + ch0 * 8192, V_DAT + ch0 * 4096, V_DU + ch0 * 8192, nullptr, V_DDL + ch0, 0.f,
                               V_OBR + (size_t)(b * SEQ) * 512 + h * 128, F.out + O_BSP + ((size_t)(l * BATCH + b) * 4 + h) * 16384);
}
__device__ __forceinline__ void ret_scan_item(Ctx& F, int l, int b, int h) {
    const size_t ch0 = (size_t)(b * 4 + h) * 64;
    const float lg2 = log2f(1.f - exp2f(-5.f - (float)h));
    chunk_scan_item<64, false>(F, nullptr, V_RQG + ch0 * 4096, V_RKT + ch0 * 4096, V_RAT + ch0 * 4096, nullptr, V_PROJ + (size_t)(b * SEQ) * NPROJ + PC_CV + h * 128, nullptr, exp2f(64.f * lg2),
                               V_OCR + (size_t)(b * SEQ) * 512 + h * 128, F.out + O_CRP + ((size_t)(l * BATCH + b) * 4 + h) * 8192);
}
__device__ __forceinline__ void ret_prep_item(Ctx& F, int l, int item) {
    const int tid = F.tid, lane = F.lane, w = F.wave, li = lane & 15, q4 = lane >> 4;
    const int pj = w >> 1, t2 = tid & 127, w2 = w & 1;
    const int ch = 4 * item + pj, c = ch & 63, h = (ch >> 6) & 3, b = ch >> 8;
    const int row0 = b * SEQ + 64 * c;
    const bf16_t* proj = V_PROJ;
    LAS unsigned char* L = F.lds + pj * 18432;
    const float lg2 = log2f(1.f - exp2f(-5.f - (float)h));
    const size_t chs = (size_t)ch;
#pragma unroll
    for (int k8 = 0; k8 < 8; ++k8) {
        const int task = t2 + 128 * k8, qk = task >> 9, t = (task >> 3) & 63, i0 = 4 * (task & 7);
        const float* cs = V_ROPEC + ((size_t)(64 * c + t) * 32 + i0) * 2;
        const f32x4 c01 = *(const f32x4*)cs, c23 = *(const f32x4*)(cs + 4);
        const f32x4 cc = (f32x4){c01[0], c01[2], c23[0], c23[2]}, sn = (f32x4){c01[1], c01[3], c23[1], c23[3]};
        const bf16_t* p = proj + (size_t)(row0 + t) * NPROJ + (qk ? PC_CK : PC_CQ) + h * 64;
        const u32x2 ulo = *(const u32x2*)(p + i0), uhi = *(const u32x2*)(p + 32 + i0);
        const f32x4 lo = (f32x4){bf_lo(ulo.x), bf_hi(ulo.x), bf_lo(ulo.y), bf_hi(ulo.y)}, hi = (f32x4){bf_lo(uhi.x), bf_hi(uhi.x), bf_lo(uhi.y), bf_hi(uhi.y)};
        const float sc = qk ? 0.125f : 1.f;
        const f32x4 olo = (lo * cc - hi * sn) * sc, ohi = (hi * cc + lo * sn) * sc;
        u32x2 plo, phi; plo.x = cvt_pk_bf16(olo[0], olo[1]); plo.y = cvt_pk_bf16(olo[2], olo[3]); phi.x = cvt_pk_bf16(ohi[0], ohi[1]); phi.y = cvt_pk_bf16(ohi[2], ohi[3]);
        *(LAS u32x2*)(L + qk * 9216 + t * 144 + 2 * i0) = plo; *(LAS u32x2*)(L + qk * 9216 + t * 144 + 64 + 2 * i0) = phi;
    }
    __syncthreads();
#pragma unroll
    for (int t8 = 0; t8 < 8; ++t8) {
        const int tile = 8 * w2 + t8, mi = tile >> 2, nj = tile & 3;
        bf16_t* ad = V_RAT + chs * 4096 + (size_t)(16 * mi + li) * 64 + 32 * (nj >> 1) + 8 * q4 + 4 * (nj & 1);
        if (nj <= mi) {
            f32x4 aqk = (f32x4){0.f, 0.f, 0.f, 0.f};
            const LAS unsigned char* kj = L + 9216 + (16 * nj + li) * 144 + 16 * q4; const LAS unsigned char* qi = L + (16 * mi + li) * 144 + 16 * q4;
#pragma unroll
            for (int s2 = 0; s2 < 2; ++s2) aqk = mfma16(*(const LAS bf16x8*)(kj + 64 * s2), *(const LAS bf16x8*)(qi + 64 * s2), aqk);
            float ov[4];
#pragma unroll
            for (int rg = 0; rg < 4; ++rg) { const int j2 = 16 * nj + 4 * q4 + rg, i2 = 16 * mi + li; ov[rg] = (i2 >= j2) ? aqk[rg] * exp2f((float)(i2 - j2) * lg2) : 0.f; }
            u32x2 pk; pk.x = cvt_pk_bf16(ov[0], ov[1]); pk.y = cvt_pk_bf16(ov[2], ov[3]); *(u32x2*)ad = pk;
        } else { *(u32x2*)ad = (u32x2){0u, 0u}; }
    }
#pragma unroll
    for (int k4 = 0; k4 < 4; ++k4) {
        const int u_ = t2 + 128 * k4;
        { const int t = u_ >> 3, c8 = u_ & 7; const float sc = exp2f((float)(t + 1) * lg2);
          const u32x4 u = *(const LAS u32x4*)(L + t * 144 + 16 * c8);
          u32x4 o; o.x = cvt_pk_bf16(bf_lo(u.x) * sc, bf_hi(u.x) * sc); o.y = cvt_pk_bf16(bf_lo(u.y) * sc, bf_hi(u.y) * sc); o.z = cvt_pk_bf16(bf_lo(u.z) * sc, bf_hi(u.z) * sc); o.w = cvt_pk_bf16(bf_lo(u.w) * sc, bf_hi(u.w) * sc);
          bf16_t* qd = V_RQG + chs * 4096 + (size_t)t * 64 + 32 * (c8 >> 2) + 16 * (c8 & 1) + 4 * ((c8 >> 1) & 1); *(u32x2*)qd = (u32x2){o.x, o.y}; *(u32x2*)(qd + 8) = (u32x2){o.z, o.w}; }
        { const int dk = u_ >> 3, t8 = (u_ & 7) * 8;
          float v[8];
#pragma unroll
          for (int q = 0; q < 8; ++q) v[q] = bf1(*(const LAS unsigned short*)(L + 9216 + (t8 + q) * 144 + 2 * dk)) * exp2f((float)(63 - t8 - q) * lg2);
          u32x4 o2; o2.x = cvt_pk_bf16(v[0], v[1]); o2.y = cvt_pk_bf16(v[2], v[3]); o2.z = cvt_pk_bf16(v[4], v[5]); o2.w = cvt_pk_bf16(v[6], v[7]);
          bf16_t* kd = V_RKT + chs * 4096 + (size_t)dk * 64 + 32 * (t8 >> 5) + 16 * ((t8 >> 3) & 1) + 4 * ((t8 >> 4) & 1); *(u32x2*)kd = (u32x2){o2.x, o2.y}; *(u32x2*)(kd + 8) = (u32x2){o2.z, o2.w}; }
    }
    __syncthreads();
}
__device__ __forceinline__ void delta_item(Ctx& F, int l, bool sample, int b, int h) {
    LAS float* sm = (LAS float*)F.lds;
    LAS float* qs = sm, *ks = sm + 2048, *vs = sm + 4096, *bgs = sm + 6144, *pa = sm + 6400, *pb = sm + 6912;
    const int tid = F.tid, c = tid & 127, qr = tid >> 7;
    float s[32];
    if (sample) { const float* S0 = F.in[6] + ((size_t)(l * DB + b) * 4 + h) * 16384;
#pragma unroll
        for (int i = 0; i < 32; ++i) s[i] = S0[(32 * qr + i) * 128 + c]; }
    else {
#pragma unroll
        for (int i = 0; i < 32; ++i) s[i] = 0.f; }
    const int T = sample ? DS : SEQ, row0 = sample ? MP + b * DS : b * SEQ;
    for (int t0 = 0; t0 < T; t0 += 16) {
        const int nt = min(16, T - t0);
        __syncthreads();
#pragma unroll
        for (int r = 0; r < 12; ++r) { const int e = tid + 512 * r, tok = e / 384, w = e - tok * 384, typ = w >> 7, d = w & 127;
            if (tok < nt) sm[typ * 2048 + tok * 128 + d] = V_BQKV[(size_t)(row0 + t0 + tok) * 1536 + typ * 512 + h * 128 + d]; }
        if (tid < 32) { const int tok = tid >> 1, wh = tid & 1; if (tok < nt) bgs[tok * 2 + wh] = V_BG[(size_t)(row0 + t0 + tok) * 8 + wh * 4 + h]; }
        __syncthreads();
        for (int tt = 0; tt < nt; ++tt) {
            const LAS float* kk = ks + tt * 128 + 32 * qr; const LAS float* qq = qs + tt * 128 + 32 * qr;
            float a = 0.f;
#pragma unroll
            for (int i = 0; i < 32; ++i) a += kk[i] * s[i];
            pa[qr * 128 + c] = a;
            __syncthreads();
            const float kS = (pa[c] + pa[128 + c]) + (pa[256 + c] + pa[384 + c]);
            const float e = __expf(bgs[tt * 2 + 1]), be = bgs[tt * 2];
            const float vn = be * (vs[tt * 128 + c] - e * kS);
            float o = 0.f;
#pragma unroll
            for (int i = 0; i < 32; ++i) { s[i] = e * s[i] + kk[i] * vn; o += qq[i] * s[i]; }
            pb[qr * 128 + c] = o;
            __syncthreads();
            if (qr == 0) V_OBR[(size_t)(row0 + t0 + tt) * 512 + h * 128 + c] = (pb[c] + pb[128 + c]) + (pb[256 + c] + pb[384 + c]);
        }
    }
    float* So = F.out + (sample ? O_BSS + ((size_t)(l * DB + b) * 4 + h) * 16384 : O_BSP + ((size_t)(l * BATCH + b) * 4 + h) * 16384);
#pragma unroll
    for (int i = 0; i < 32; ++i) So[(32 * qr + i) * 128 + c] = s[i];
    __syncthreads();
}
__device__ __forceinline__ void ret_item(Ctx& F, int l, bool sample, int b, int h) {
    LAS float* sm = (LAS float*)F.lds;
    LAS float* qs = sm, *ks = sm + 1024, *vs = sm + 2048, *pp = sm + 4096;
    const int tid = F.tid, c = tid & 127, qr = tid >> 7;
    const float gam = 1.f - exp2f(-5.f - (float)h);
    float r[16];
    if (sample) { const float* R0 = F.in[7] + ((size_t)(l * DB + b) * 4 + h) * 8192;
#pragma unroll
        for (int i = 0; i < 16; ++i) r[i] = R0[(16 * qr + i) * 128 + c]; }
    else {
#pragma unroll
        for (int i = 0; i < 16; ++i) r[i] = 0.f; }
    const int T = sample ? DS : SEQ, row0 = sample ? MP + b * DS : b * SEQ;
    for (int t0 = 0; t0 < T; t0 += 16) {
        const int nt = min(16, T - t0);
        __syncthreads();
#pragma unroll
        for (int rr = 0; rr < 4; ++rr) { const int e = tid + 512 * rr, tok = e >> 7, w = e & 127, typ = w >> 6, d = w & 63;
            if (tok < nt) sm[typ * 1024 + tok * 64 + d] = V_CQK[(size_t)(row0 + t0 + tok) * 512 + typ * 256 + h * 64 + d]; }
#pragma unroll
        for (int rr = 0; rr < 4; ++rr) { const int e = tid + 512 * rr, tok = e >> 7, d = e & 127;
            if (tok < nt) vs[tok * 128 + d] = bf1(V_PROJ[(size_t)(row0 + t0 + tok) * NPROJ + PC_CV + h * 128 + d]); }
        __syncthreads();
        for (int tt = 0; tt < nt; ++tt) {
            const LAS float* kk = ks + tt * 64 + 16 * qr; const LAS float* qq = qs + tt * 64 + 16 * qr;
            const float v = vs[tt * 128 + c];
            float o = 0.f;
#pragma unroll
            for (int i = 0; i < 16; ++i) { r[i] = gam * r[i] + kk[i] * v; o += qq[i] * r[i]; }
            LAS float* pq = pp + (tt & 1) * 512;
            pq[qr * 128 + c] = o;
            __syncthreads();
            if (qr == 0) V_OCR[(size_t)(row0 + t0 + tt) * 512 + h * 128 + c] = (pq[c] + pq[128 + c]) + (pq[256 + c] + pq[384 + c]);
        }
    }
    float* Ro = F.out + (sample ? O_CRS + ((size_t)(l * DB + b) * 4 + h) * 8192 : O_CRP + ((size_t)(l * BATCH + b) * 4 + h) * 8192);
#pragma unroll
    for (int i = 0; i < 16; ++i) Ro[(16 * qr + i) * 128 + c] = r[i];
    __syncthreads();
}
constexpr int IT_DP = 0, IT_RP = 16, IT_ATS = 32, IT_DS = IT_ATS + 384, IT_RS = IT_DS + 128, IT_AT = IT_RS + 128, IT_END = IT_AT + 768;
__device__ __forceinline__ void phase_mix(Ctx& F, int l, int rep) {
    volatile LAS int* slot = (volatile LAS int*)(F.lds + LDS_BYTES - 64);
    unsigned* ctr = V_CTL + (l == 0 ? CW_MIX0 : CW_MIX1) + 256 * rep;
    for (;;) {
        __syncthreads();
        if (F.tid == 0) *slot = (int)atomicAdd(ctr, 1u);
        __syncthreads();
        const int it = __builtin_amdgcn_readfirstlane(*slot);
        { int t_ = F.tid; asm volatile("" : "+v"(t_)); F.tid = t_; F.lane = t_ & 63; }
        if (it >= IT_END) break;
#ifndef MIXSEL
#define MIXSEL 15
#endif
        if (it < IT_RP) delta_scan2_item(F, l, it >> 2, it & 3);
        else if (it < IT_ATS) ret_scan_item(F, l, (it - IT_RP) >> 2, (it - IT_RP) & 3);
        else if (it < IT_DS) { const int u = (it - IT_ATS) * 8 + F.wave; attn_sample_unit(F, l, u / 12, (u % 12) & 3, (u % 12) >> 2); }
        else if (it < IT_RS) delta_item(F, l, true, (it - IT_DS) >> 2, (it - IT_DS) & 3);
        else if (it < IT_AT) ret_item(F, l, true, (it - IT_RS) >> 2, (it - IT_RS) & 3);
        else attn_mfma_item(F, it - IT_AT);
    }
}
__device__ __forceinline__ void fin_row(Ctx& F, int l, int row) {
    const int lane = F.lane, h = lane >> 4, j8 = 8 * (lane & 15);
    {
        const float l0 = V_LSE[((size_t)0 * M + row) * 4 + h], l1 = V_LSE[((size_t)1 * M + row) * 4 + h], l2 = V_LSE[((size_t)2 * M + row) * 4 + h];
        const u32x4 a0 = *(const u32x4*)(V_AO + ((size_t)0 * M + row) * 512 + h * 128 + j8), a1 = *(const u32x4*)(V_AO + ((size_t)1 * M + row) * 512 + h * 128 + j8), a2 = *(const u32x4*)(V_AO + ((size_t)2 * M + row) * 512 + h * 128 + j8);
        const float mm = fmaxf(l0, fmaxf(l1, l2)); float e0 = __expf(l0 - mm), e1 = __expf(l1 - mm), e2 = __expf(l2 - mm); const float iv = 1.f / (e0 + e1 + e2); e0 *= iv; e1 *= iv; e2 *= iv;
        u32x4 o;
        o.x = cvt_pk_bf16(e0 * bf_lo(a0.x) + e1 * bf_lo(a1.x) + e2 * bf_lo(a2.x), e0 * bf_hi(a0.x) + e1 * bf_hi(a1.x) + e2 * bf_hi(a2.x));
        o.y = cvt_pk_bf16(e0 * bf_lo(a0.y) + e1 * bf_lo(a1.y) + e2 * bf_lo(a2.y), e0 * bf_hi(a0.y) + e1 * bf_hi(a1.y) + e2 * bf_hi(a2.y));
        o.z = cvt_pk_bf16(e0 * bf_lo(a0.z) + e1 * bf_lo(a1.z) + e2 * bf_lo(a2.z), e0 * bf_hi(a0.z) + e1 * bf_hi(a1.z) + e2 * bf_hi(a2.z));
        o.w = cvt_pk_bf16(e0 * bf_lo(a0.w) + e1 * bf_lo(a1.w) + e2 * bf_lo(a2.w), e0 * bf_hi(a0.w) + e1 * bf_hi(a1.w) + e2 * bf_hi(a2.w));
        *(u32x4*)(V_OABC + (size_t)row * 512 + h * 128 + j8) = o;
    }
#pragma unroll
    for (int br = 0; br < 2; ++br) {
        if (br == 0 && row < MP) continue;
        const float* src = (br == 0 ? V_OBR : V_OCR) + (size_t)row * 512 + h * 128 + j8;
        const f32x4 x0 = *(const f32x4*)src, x1 = *(const f32x4*)(src + 4);
        const float* gn = F.in[15 + br] + l * 128 + j8;
        const f32x4 g0 = *(const f32x4*)gn, g1 = *(const f32x4*)(gn + 4);
        const u32x4 zz = *(const u32x4*)(V_PROJ + (size_t)row * NPROJ + (br == 0 ? PC_BZ : PC_CZ) + h * 128 + j8);
        const float ss = row_sum16((x0[0] * x0[0] + x0[1] * x0[1]) + (x0[2] * x0[2] + x0[3] * x0[3]) + (x1[0] * x1[0] + x1[1] * x1[1]) + (x1[2] * x1[2] + x1[3] * x1[3]));
        const float rstd = rsqrtf(ss * (1.f / 128.f) + EPS);
        const float z0 = bf_lo(zz.x), z1 = bf_hi(zz.x), z2 = bf_lo(zz.y), z3 = bf_hi(zz.y), z4 = bf_lo(zz.z), z5 = bf_hi(zz.z), z6 = bf_lo(zz.w), z7 = bf_hi(zz.w);
        u32x4 o;
        o.x = cvt_pk_bf16(x0[0] * rstd * g0[0] * z0 * sigmoidf_(z0), x0[1] * rstd * g0[1] * z1 * sigmoidf_(z1));
        o.y = cvt_pk_bf16(x0[2] * rstd * g0[2] * z2 * sigmoidf_(z2), x0[3] * rstd * g0[3] * z3 * sigmoidf_(z3));
        o.z = cvt_pk_bf16(x1[0] * rstd * g1[0] * z4 * sigmoidf_(z4), x1[1] * rstd * g1[1] * z5 * sigmoidf_(z5));
        o.w = cvt_pk_bf16(x1[2] * rstd * g1[2] * z6 * sigmoidf_(z6), x1[3] * rstd * g1[3] * z7 * sigmoidf_(z7));
        *(u32x4*)(V_OABC + (size_t)(1 + br) * M * 512 + (size_t)row * 512 + h * 128 + j8) = o;
    }
}

template <int NR>
__device__ __forceinline__ void fin_rows(Ctx& F, int l, const int (&rows)[NR]) {
    const int lane = F.lane, h = lane >> 4, j8 = 8 * (lane & 15);
    float ls[NR][3]; u32x4 ao[NR][3]; f32x4 xc[NR][2]; u32x4 zc[NR];
#pragma unroll
    for (int r = 0; r < NR; ++r) { const int row = rows[r];
#pragma unroll
        for (int g = 0; g < 3; ++g) { ls[r][g] = V_LSE[((size_t)g * M + row) * 4 + h]; ao[r][g] = *(const u32x4*)(V_AO + ((size_t)g * M + row) * 512 + h * 128 + j8); }
        const float* src = V_OCR + (size_t)row * 512 + h * 128 + j8; xc[r][0] = *(const f32x4*)src; xc[r][1] = *(const f32x4*)(src + 4);
        zc[r] = *(const u32x4*)(V_PROJ + (size_t)row * NPROJ + PC_CZ + h * 128 + j8);
    }
    const f32x4 gc0 = *(const f32x4*)(F.in[16] + l * 128 + j8), gc1 = *(const f32x4*)(F.in[16] + l * 128 + j8 + 4);
#pragma unroll
    for (int r = 0; r < NR; ++r) { const int row = rows[r];
        {
            const float mm = fmaxf(ls[r][0], fmaxf(ls[r][1], ls[r][2])); float e0 = __expf(ls[r][0] - mm), e1 = __expf(ls[r][1] - mm), e2 = __expf(ls[r][2] - mm); const float iv = 1.f / (e0 + e1 + e2); e0 *= iv; e1 *= iv; e2 *= iv;
            const u32x4 a0 = ao[r][0], a1 = ao[r][1], a2 = ao[r][2]; u32x4 o;
            o.x = cvt_pk_bf16(e0 * bf_lo(a0.x) + e1 * bf_lo(a1.x) + e2 * bf_lo(a2.x), e0 * bf_hi(a0.x) + e1 * bf_hi(a1.x) + e2 * bf_hi(a2.x));
            o.y = cvt_pk_bf16(e0 * bf_lo(a0.y) + e1 * bf_lo(a1.y) + e2 * bf_lo(a2.y), e0 * bf_hi(a0.y) + e1 * bf_hi(a1.y) + e2 * bf_hi(a2.y));
            o.z = cvt_pk_bf16(e0 * bf_lo(a0.z) + e1 * bf_lo(a1.z) + e2 * bf_lo(a2.z), e0 * bf_hi(a0.z) + e1 * bf_hi(a1.z) + e2 * bf_hi(a2.z));
            o.w = cvt_pk_bf16(e0 * bf_lo(a0.w) + e1 * bf_lo(a1.w) + e2 * bf_lo(a2.w), e0 * bf_hi(a0.w) + e1 * bf_hi(a1.w) + e2 * bf_hi(a2.w));
            *(u32x4*)(V_OABC + (size_t)row * 512 + h * 128 + j8) = o;
        }
        {
            const f32x4 x0 = xc[r][0], x1 = xc[r][1]; const u32x4 zz = zc[r]; const f32x4 g0 = gc0, g1 = gc1; const int br = 1;
            const float ss = row_sum16((x0[0] * x0[0] + x0[1] * x0[1]) + (x0[2] * x0[2] + x0[3] * x0[3]) + (x1[0] * x1[0] + x1[1] * x1[1]) + (x1[2] * x1[2] + x1[3] * x1[3]));
            const float rstd = rsqrtf(ss * (1.f / 128.f) + EPS);
            const float z0 = bf_lo(zz.x), z1 = bf_hi(zz.x), z2 = bf_lo(zz.y), z3 = bf_hi(zz.y), z4 = bf_lo(zz.z), z5 = bf_hi(zz.z), z6 = bf_lo(zz.w), z7 = bf_hi(zz.w);
            u32x4 o;
            o.x = cvt_pk_bf16(x0[0] * rstd * g0[0] * z0 * sigmoidf_(z0), x0[1] * rstd * g0[1] * z1 * sigmoidf_(z1));
            o.y = cvt_pk_bf16(x0[2] * rstd * g0[2] * z2 * sigmoidf_(z2), x0[3] * rstd * g0[3] * z3 * sigmoidf_(z3));
            o.z = cvt_pk_bf16(x1[0] * rstd * g1[0] * z4 * sigmoidf_(z4), x1[1] * rstd * g1[1] * z5 * sigmoidf_(z5));
            o.w = cvt_pk_bf16(x1[2] * rstd * g1[2] * z6 * sigmoidf_(z6), x1[3] * rstd * g1[3] * z7 * sigmoidf_(z7));
            *(u32x4*)(V_OABC + (size_t)(1 + br) * M * 512 + (size_t)row * 512 + h * 128 + j8) = o;
        }
    }
}

__device__ __forceinline__ void fin_b_row(Ctx& F, int l, int row) {
    const int lane = F.lane, h = lane >> 4, j8 = 8 * (lane & 15);
    const float* src = V_OBR + (size_t)row * 512 + h * 128 + j8; const f32x4 x0 = *(const f32x4*)src, x1 = *(const f32x4*)(src + 4);
    const u32x4 zz = *(const u32x4*)(V_PROJ + (size_t)row * NPROJ + PC_BZ + h * 128 + j8);
    const f32x4 g0 = *(const f32x4*)(F.in[15] + l * 128 + j8), g1 = *(const f32x4*)(F.in[15] + l * 128 + j8 + 4);
    const float ss = row_sum16((x0[0] * x0[0] + x0[1] * x0[1]) + (x0[2] * x0[2] + x0[3] * x0[3]) + (x1[0] * x1[0] + x1[1] * x1[1]) + (x1[2] * x1[2] + x1[3] * x1[3]));
    const float rstd = rsqrtf(ss * (1.f / 128.f) + EPS);
    const float z0 = bf_lo(zz.x), z1 = bf_hi(zz.x), z2 = bf_lo(zz.y), z3 = bf_hi(zz.y), z4 = bf_lo(zz.z), z5 = bf_hi(zz.z), z6 = bf_lo(zz.w), z7 = bf_hi(zz.w);
    u32x4 o;
    o.x = cvt_pk_bf16(x0[0] * rstd * g0[0] * z0 * sigmoidf_(z0), x0[1] * rstd * g0[1] * z1 * sigmoidf_(z1));
    o.y = cvt_pk_bf16(x0[2] * rstd * g0[2] * z2 * sigmoidf_(z2), x0[3] * rstd * g0[3] * z3 * sigmoidf_(z3));
    o.z = cvt_pk_bf16(x1[0] * rstd * g1[0] * z4 * sigmoidf_(z4), x1[1] * rstd * g1[1] * z5 * sigmoidf_(z5));
    o.w = cvt_pk_bf16(x1[2] * rstd * g1[2] * z6 * sigmoidf_(z6), x1[3] * rstd * g1[3] * z7 * sigmoidf_(z7));
    *(u32x4*)(V_OABC + (size_t)M * 512 + (size_t)row * 512 + h * 128 + j8) = o;
}
typedef float f32x16 __attribute__((ext_vector_type(16)));
template <int NSUB, bool GATED>
__device__ __forceinline__ void mini_gemm_core(Ctx& F, int tile, const bf16_t* A, size_t a_sub, const bf16_t* Bt, size_t b_sub, int K, float (&res)[2], int& orow, int& ocol, int (&oreg)[2]) {
    const int lane = F.lane, w = F.wave, r = lane & 31, hh = lane >> 5;
    const int rb = tile & 7, cb = tile >> 3;
    const int kw = K >> 3, k0 = w * kw;
    f32x16 tot;
#pragma unroll
    for (int i = 0; i < 16; ++i) tot[i] = 0.f;
#pragma unroll 1
    for (int sub = 0; sub < NSUB; ++sub) {
        const bf16_t* ap = A + sub * a_sub + (size_t)(MP + rb * 32 + r) * K + k0 + 8 * hh;
        const bf16_t* bp = Bt + sub * b_sub + (size_t)(cb * 32 + r) * K + k0 + 8 * hh;
        f32x16 acc;
#pragma unroll
        for (int i = 0; i < 16; ++i) acc[i] = 0.f;
#pragma unroll 2
        for (int s2 = 0; s2 < kw; s2 += 16) acc = __builtin_amdgcn_mfma_f32_32x32x16_bf16(*(const bf16x8*)(ap + s2), *(const bf16x8*)(bp + s2), acc, 0, 0, 0);
        if (GATED) {
            const bf16_t* gp = V_PROJ + (size_t)(MP + rb * 32 + 4 * hh) * NPROJ + PC_GATE + sub * 1024 + cb * 32 + r;
#pragma unroll
            for (int i = 0; i < 16; ++i) tot[i] += bf1(gp[(size_t)((i & 3) + 8 * (i >> 2)) * NPROJ]) * acc[i];
        } else tot = acc;
    }
    LAS float* red = (LAS float*)F.lds;
#pragma unroll
    for (int i = 0; i < 16; ++i) red[(w * 16 + i) * 64 + lane] = tot[i];
    __syncthreads();
    const int g = F.tid >> 6;
#pragma unroll
    for (int q = 0; q < 2; ++q) { const int rg = 2 * g + q; float v = 0.f;
#pragma unroll
        for (int ww = 0; ww < 8; ++ww) v += red[(ww * 16 + rg) * 64 + lane];
        res[q] = v; oreg[q] = rg; }
    orow = MP + rb * 32 + 4 * hh; ocol = cb * 32 + r;
    __syncthreads();
}
__device__ __forceinline__ void mini_abc(Ctx& F, int l) {
    for (int tile = F.bid; tile < 256; tile += F.G) {
    float res[2]; int orow, ocol, oreg[2];
    mini_gemm_core<3, true>(F, tile, V_OABC, (size_t)M * 512, V_WABC + (size_t)l * 3 * D * 512, (size_t)D * 512, 512, res, orow, ocol, oreg);
#pragma unroll
    for (int q = 0; q < 2; ++q) { const int row = orow + (oreg[q] & 3) + 8 * (oreg[q] >> 2);
        V_MRG[(size_t)row * D + ocol] = (bf16_t)(cvt_pk_bf16(res[q], 0.f) & 0xffffu); }
    }
}
__device__ __forceinline__ void mini_res(Ctx& F, const bf16_t* A, const bf16_t* Bt, int K, const float* resid  , const bf16_t* resb  , float* out, bf16_t* xb, float* rowss) {
    for (int tile = F.bid; tile < 256; tile += F.G) {
    float res[2]; int orow, ocol, oreg[2];
    mini_gemm_core<1, false>(F, tile, A, 0, Bt, 0, K, res, orow, ocol, oreg);
#pragma unroll
    for (int q = 0; q < 2; ++q) { const int row = orow + (oreg[q] & 3) + 8 * (oreg[q] >> 2);
        const float o = (resb ? bf1(resb[(size_t)row * D + ocol]) : resid[(size_t)(row - MP) * D + ocol]) + res[q];
        if (out) out[(size_t)row * D + ocol] = o; else xb[(size_t)row * D + ocol] = (bf16_t)(cvt_pk_bf16(o, 0.f) & 0xffffu);
        float ss = o * o;
        ss = row_sum16(ss); ss += __shfl_xor(ss, 16);
        if ((F.lane & 31) == 0) atomicAdd(rowss + row, ss); }
    }
}
constexpr int N_PHASES = 1 + 8 * DEPTH;
__global__ void __launch_bounds__(NTHREADS, 2) mega_fwd(Args args) {
    extern __shared__ __attribute__((aligned(16))) unsigned char lds_raw[];
    Ctx F;
    F.in = nullptr; F.out = nullptr; F.ws = nullptr; F.tid = 0; F.lane = 0; F.wave = 0;
    F.lds = (LAS unsigned char*)lds_raw;
    F.G = gridDim.x; F.bid = blockIdx.x;
    volatile LAS unsigned* bst = (volatile LAS unsigned*)(F.lds + LDS_BYTES - 128);
    if (threadIdx.x < 2) bst[threadIdx.x] = 0u;
    __syncthreads();
    (void)xcd_barrier_post((unsigned*)(args.ws + WS_CTL) + CW_BAR, bst);
#define XBAR() do { XcdBarrier xb_; xb_.bar = (unsigned*)(F.ws + WS_CTL) + CW_BAR; xb_.x = xb_xcc_id(); xb_.st = (volatile LAS unsigned*)(F.lds + LDS_BYTES - 128); xcd_barrier(xb_, F.tid); } while (0)
    int ph0 = args.ph_lo;
    if (ph0 == 0) {
        { int tid_ = threadIdx.x; asm volatile("" : "+v"(tid_)); F.tid = tid_; F.lane = tid_ & 63; F.wave = __builtin_amdgcn_readfirstlane(tid_ >> 6);
          { int bid_ = blockIdx.x, g_ = gridDim.x; asm volatile("" : "+s"(bid_), "+s"(g_)); F.bid = bid_; F.G = g_; }
          const __attribute__((address_space(4))) char* ka = (const __attribute__((address_space(4))) char*)__builtin_amdgcn_kernarg_segment_ptr(); asm volatile("" : "+s"(ka));
          F.in = (const float* const __attribute__((address_space(4)))*)ka; F.out = *(float* const __attribute__((address_space(4)))*)(ka + 192); F.ws = *(unsigned char* const __attribute__((address_space(4)))*)(ka + 200); }
        const int gw = F.bid * NWAVES + F.wave, NGW = F.G * NWAVES;
        if (PH_MASK & 1) phase_prep(F);
        if (DUP_K == 8) { cg::this_grid().sync(); phase_prep(F); }
        if (DUP_K == 9) { for (int q_ = 0; q_ < 32; ++q_) XBAR(); }
        ph0 = 1;
        if (args.ph_hi > 1000000) cg::this_grid().sync();
        if (ph0 < args.ph_hi) XBAR();
    }
    for (int ph = ph0, rep = 0; ph < args.ph_hi; ++ph) {
        { int tid_ = threadIdx.x; asm volatile("" : "+v"(tid_)); F.tid = tid_; F.lane = tid_ & 63; F.wave = __builtin_amdgcn_readfirstlane(tid_ >> 6);
          { int bid_ = blockIdx.x, g_ = gridDim.x; asm volatile("" : "+s"(bid_), "+s"(g_)); F.bid = bid_; F.G = g_; }
          const __attribute__((address_space(4))) char* ka = (const __attribute__((address_space(4))) char*)__builtin_amdgcn_kernarg_segment_ptr(); asm volatile("" : "+s"(ka));
          F.in = (const float* const __attribute__((address_space(4)))*)ka; F.out = *(float* const __attribute__((address_space(4)))*)(ka + 192); F.ws = *(unsigned char* const __attribute__((address_space(4)))*)(ka + 200); }
        const int gw = F.bid * NWAVES + F.wave, NGW = F.G * NWAVES;
        {
            const int l = (ph - 1) >> 3, k = (ph - 1) & 7;
            if (k == 0 && (PH_MASK & 2)) {
                pg8::Gemm g{V_XBA, V_WIN + (size_t)l * NPROJ * D, D}; pg8::Order<1> S; S.init(M / 256, NPROJ / 256, F.G, F.bid);
                EpiProj E{V_PROJ, V_RS + (size_t)(2 * l) * M};
                pg8::gemm_phase(F.lds, F.tid, g, S, E);
            } else if (k == 1 && (PH_MASK & 4)) {
                {
                    const bool sq = !(DUP_K == 1 && rep == 0);
                    int row = gw;
                    for (; row + 2 * NGW < M; row += 3 * NGW) { const int rr[3] = {row, row + NGW, row + 2 * NGW}; e1_partA<3>(F, l, rr, sq); }
                    for (; row < M; row += NGW) { const int rr[1] = {row}; e1_partA<1>(F, l, rr, sq); }
                    for (int r2 = gw; r2 < M; r2 += NGW) if (r2 >= MP || (r2 & 4095) >= SEQ - 3) e1_row(F, l, r2);
                }
                __syncthreads();
                for (int it = F.bid; it < NCH; it += F.G) delta_prep_item(F, l, it);
                for (int it = F.bid; it < NCH / 4; it += F.G) ret_prep_item(F, l, it);
            } else if (k == 2 && (PH_MASK & 8)) {
                phase_mix(F, l, rep);
            } else if (k == 3 && (PH_MASK & 16)) {
                for (int row = gw; row < M; row += 2 * NGW) { if (row + NGW < M) { const int rr[2] = {row, row + NGW}; fin_rows<2>(F, l, rr); } else { const int rr[1] = {row}; fin_rows<1>(F, l, rr); } }
                for (int row = MP + gw; row < M; row += NGW) fin_b_row(F, l, row);
                __syncthreads();
                for (int it = F.bid; it < NCH; it += F.G) delta_out_item(F, l, it);
            } else if (k == 4 && (PH_MASK & 32)) {
                mini_abc(F, l);
                pg8::Gemm g{V_OABC, V_WABC + (size_t)l * 3 * D * 512, 512}; pg8::Order<3> S; S.init(MP / 256, D / 256, F.G, F.bid); S.sub_m = M / 256;
                EpiAbc E{V_PROJ, V_MRG};
                pg8::gemm_phase(F.lds, F.tid, g, S, E);
            } else if (k == 5 && (PH_MASK & 64)) {
                mini_res(F, V_MRG, V_WOUT + (size_t)l * D * D, D, l == 0 ? F.in[1] : nullptr, l == 0 ? nullptr : V_XBA, nullptr, V_XBB, V_RS + (size_t)(2 * l + 1) * M);
                pg8::Gemm g{V_MRG, V_WOUT + (size_t)l * D * D, D}; pg8::Order<1> S; S.init(MP / 256, D / 256, F.G, F.bid);
                EpiRes E{F.in[0], F.in[1], l == 0 ? nullptr : V_XBA, nullptr, V_XBB, V_RS + (size_t)(2 * l + 1) * M};
                pg8::gemm_phase(F.lds, F.tid, g, S, E);
            } else if (k == 6 && (PH_MASK & 128)) {
                pg8::Gemm g{V_XBB, V_WFI + (size_t)l * 2 * DFF * D, D}; pg8::Order<1> S; S.init(M / 256, 2 * DFF / 256, F.G, F.bid);
                EpiFfn E{V_ACT, V_RS + (size_t)(2 * l + 1) * M};
                pg8::gemm_phase(F.lds, F.tid, g, S, E);
            } else if (k == 7 && (PH_MASK & 256)) {
                mini_res(F, V_ACT, V_WFO + (size_t)l * D * DFF, DFF, nullptr, V_XBB, l == DEPTH - 1 ? F.out : nullptr, V_XBA, V_RS + (size_t)(l == DEPTH - 1 ? 3 : 2) * M);
                pg8::Gemm g{V_ACT, V_WFO + (size_t)l * D * DFF, DFF}; pg8::Order<1> S; S.init(MP / 256, D / 256, F.G, F.bid);
                EpiRes E{nullptr, nullptr, V_XBB, l == DEPTH - 1 ? F.out : nullptr, V_XBA, V_RS + (size_t)(l == DEPTH - 1 ? 3 : 2) * M};
                pg8::gemm_phase(F.lds, F.tid, g, S, E);
            }
        }
        if (DUP_K >= 0 && ((ph - 1) & 7) == DUP_K && rep == 0) { rep = 1; --ph; XBAR(); continue; }
        rep = 0;
        if (ph + 1 < args.ph_hi) XBAR();
    }
}

extern "C" void kernel_launch(void* const* d_in, const int* in_sizes, int n_in, void* d_out, int out_size, void* d_ws, size_t ws_size, hipStream_t stream) {
    static int grid = 0;
    if (grid == 0) {
        if (n_in != 24 || (size_t)out_size != O_END || ws_size < WS_END) { fprintf(stderr, "kernel_launch: unexpected shapes (n_in %d out %d ws %zu, need %zu / %zu)\n", n_in, out_size, ws_size, (size_t)O_END, (size_t)WS_END); grid = -1; return; }
        int dev = 0, cus = 0, per_cu = 0;
        if (hipGetDevice(&dev) != hipSuccess || hipDeviceGetAttribute(&cus, hipDeviceAttributeMultiprocessorCount, dev) != hipSuccess) { grid = -1; return; }
        if (hipFuncSetAttribute((const void*)mega_fwd, hipFuncAttributeMaxDynamicSharedMemorySize, LDS_BYTES) != hipSuccess) { fprintf(stderr, "kernel_launch: hipFuncSetAttribute failed\n"); grid = -1; return; }
        if (hipOccupancyMaxActiveBlocksPerMultiprocessor(&per_cu, (const void*)mega_fwd, NTHREADS, LDS_BYTES) != hipSuccess || per_cu < 1) { fprintf(stderr, "kernel_launch: occupancy query says %d\n", per_cu); per_cu = 1; }
        (void)hipGetLastError();
        grid = cus;
    }
    if (grid < 0) return;
    (void)hipMemsetAsync((char*)d_ws + WS_CTL, 0, 32768, stream);
    Args a{};
    for (int i = 0; i < 24; ++i) a.in[i] = (const float*)d_in[i];
    a.out = (float*)d_out; a.ws = (unsigned char*)d_ws;
#if MK_ONE_LAUNCH
    a.ph_lo = 0; a.ph_hi = N_PHASES;
    void* kargs[] = {&a};
    hipError_t e = hipLaunchCooperativeKernel((const void*)mega_fwd, dim3(grid), dim3(NTHREADS), kargs, LDS_BYTES, stream);
    if (e != hipSuccess) fprintf(stderr, "cooperative launch failed: %s (grid %d)\n", hipGetErrorString(e), grid);
#else
    for (int ph = 0; ph < N_PHASES; ++ph) {
        a.ph_lo = ph; a.ph_hi = ph + 1;
        hipLaunchKernelGGL(mega_fwd, dim3(grid), dim3(NTHREADS), LDS_BYTES, stream, a);
    }
#endif
}
```

```cpp
#include <hip/hip_runtime.h>
#include <hip/hip_cooperative_groups.h>
#include <cstdio>
#include <cstdint>
namespace cg = cooperative_groups;

#ifndef DUP_K
#define DUP_K -1
#endif
#ifndef PH_MASK
#define PH_MASK 0x1ff
#endif
#ifndef MK_ONE_LAUNCH
#define MK_ONE_LAUNCH 1
#endif

#define LAS __attribute__((address_space(3)))
typedef unsigned short bf16_t;
typedef short bf16x8 __attribute__((ext_vector_type(8)));
typedef float f32x4 __attribute__((ext_vector_type(4)));
typedef float f32x2 __attribute__((ext_vector_type(2)));
typedef unsigned u32x4 __attribute__((ext_vector_type(4)));
typedef unsigned u32x2 __attribute__((ext_vector_type(2)));

constexpr int D = 1024, BATCH = 4, SEQ = 4096, DEPTH = 2, DB = 32, DS = 8, PAST = 8192;
constexpr int MP = BATCH * SEQ, MS = DB * DS, M = MP + MS;
constexpr int NIN = 11272, NPROJ = 11520, DFF = 2816;
constexpr int PC_AQ = 0, PC_AK = 1536, PC_AV = 3072, PC_BQKV = 4608, PC_BZ = 6144, PC_CQ = 6656, PC_CK = 6912, PC_CV = 7168, PC_CZ = 7680, PC_GATE = 8192, PC_BETA = 11264, PC_BA = 11268;
constexpr float EPS = 1e-6f;
constexpr int NPOS = SEQ + DS;

constexpr size_t O_YP = 0;
constexpr size_t O_YS = O_YP + (size_t)MP * D;
constexpr size_t O_KV0P = O_YS + (size_t)MS * D;
constexpr size_t O_KV1P = O_KV0P + (size_t)DEPTH * BATCH * 128 * 1024;
constexpr size_t O_KV2P = O_KV1P + (size_t)DEPTH * BATCH * 512 * 1024;
constexpr size_t O_BCP = O_KV2P + (size_t)DEPTH * BATCH * 2048 * 1024;
constexpr size_t O_BSP = O_BCP + (size_t)DEPTH * BATCH * 3 * 1536;
constexpr size_t O_CRP = O_BSP + (size_t)DEPTH * BATCH * 4 * 128 * 128;
constexpr size_t O_KV0S = O_CRP + (size_t)DEPTH * BATCH * 4 * 64 * 128;
constexpr size_t O_KV1S = O_KV0S + (size_t)DEPTH * DB * DS * 1024;
constexpr size_t O_KV2S = O_KV1S + (size_t)DEPTH * DB * DS * 1024;
constexpr size_t O_BCS = O_KV2S + (size_t)DEPTH * DB * DS * 1024;
constexpr size_t O_BSS = O_BCS + (size_t)DEPTH * DB * 3 * 1536;
constexpr size_t O_CRS = O_BSS + (size_t)DEPTH * DB * 4 * 128 * 128;
constexpr size_t O_END = O_CRS + (size_t)DEPTH * DB * 4 * 64 * 128;

constexpr size_t al256(size_t x) { return (x + 255) & ~(size_t)255; }
constexpr size_t WS_CTL = 0, CTL_BYTES = 1u << 20;
constexpr size_t WS_WIN = WS_CTL + CTL_BYTES;
constexpr size_t WS_WABC = WS_WIN + al256((size_t)DEPTH * NPROJ * D * 2);
constexpr size_t WS_WOUT = WS_WABC + al256((size_t)DEPTH * 3 * D * 512 * 2);
constexpr size_t WS_WFI = WS_WOUT + al256((size_t)DEPTH * D * D * 2);
constexpr size_t WS_WFO = WS_WFI + al256((size_t)DEPTH * 2 * DFF * D * 2);
constexpr size_t WS_XBA = WS_WFO + al256((size_t)DEPTH * D * DFF * 2);
constexpr size_t WS_XBB = WS_XBA + al256((size_t)M * D * 2);
constexpr size_t WS_X1 = WS_XBB + al256((size_t)M * D * 2);
constexpr size_t WS_X2 = WS_X1 + al256((size_t)M * D * 4);
constexpr size_t WS_RS = WS_X2 + al256((size_t)M * D * 4);
constexpr size_t WS_PROJ = WS_RS + al256((size_t)4 * M * 4);
constexpr size_t WS_BQKV = WS_PROJ + al256((size_t)M * NPROJ * 2);
constexpr size_t WS_BG = WS_BQKV + al256((size_t)M * 1536 * 4);
constexpr size_t WS_CQK = WS_BG + al256((size_t)M * 8 * 4);
constexpr size_t WS_OBR = WS_CQK + al256((size_t)M * 512 * 4);
constexpr size_t WS_OCR = WS_OBR + al256((size_t)M * 512 * 4);
constexpr size_t WS_OABC = WS_OCR + al256((size_t)M * 512 * 4);
constexpr size_t WS_MRG = WS_OABC + al256((size_t)3 * M * 512 * 2);
constexpr size_t WS_ACT = WS_MRG + al256((size_t)M * D * 2);
constexpr size_t WS_ROPEA = WS_ACT + al256((size_t)M * DFF * 2);
constexpr size_t WS_ROPEC = WS_ROPEA + al256((size_t)NPOS * 64 * 2 * 4);
constexpr size_t WS_AO = WS_ROPEC + al256((size_t)NPOS * 32 * 2 * 4);
constexpr size_t WS_LSE = WS_AO + al256((size_t)3 * M * 512 * 2);
constexpr int NCH = BATCH * 4 * 64;
constexpr size_t WS_DW = WS_LSE + al256((size_t)3 * M * 4 * 4);
constexpr size_t WS_DQG = WS_DW + al256((size_t)NCH * 64 * 128 * 2);
constexpr size_t WS_DKT = WS_DQG + al256((size_t)NCH * 64 * 128 * 2);
constexpr size_t WS_DAT = WS_DKT + al256((size_t)NCH * 64 * 128 * 2);
constexpr size_t WS_DU = WS_DAT + al256((size_t)NCH * 64 * 64 * 2);
constexpr size_t WS_DDL = WS_DU + al256((size_t)NCH * 64 * 128 * 4);
constexpr size_t WS_RQG = WS_DDL + al256((size_t)NCH * 4);
constexpr size_t WS_RKT = WS_RQG + al256((size_t)NCH * 64 * 64 * 2);
constexpr size_t WS_RAT = WS_RKT + al256((size_t)NCH * 64 * 64 * 2);
constexpr size_t WS_RU = WS_RAT + al256((size_t)NCH * 64 * 64 * 2);
constexpr size_t WS_SB = WS_RU + al256((size_t)NCH * 64 * 128 * 4);
constexpr size_t WS_VB = WS_SB + al256((size_t)NCH * 16384 * 2);
constexpr size_t WS_END = WS_VB + al256((size_t)NCH * 8192 * 2);
constexpr int CW_MIX0 = 64, CW_MIX1 = 128, CW_BAR = 1024;

constexpr int NWAVES = 8, NTHREADS = 512;
constexpr int RING_BYTES = 131072, LDS_BYTES = 147456;

__device__ __forceinline__ float bf_lo(unsigned u) { return __uint_as_float(u << 16); }
__device__ __forceinline__ float bf_hi(unsigned u) { return __uint_as_float(u & 0xffff0000u); }
__device__ __forceinline__ float bf1(bf16_t u) { return __uint_as_float(((unsigned)u) << 16); }
typedef __bf16 bf16x2_t __attribute__((ext_vector_type(2)));
__device__ __forceinline__ unsigned cvt_pk_bf16(float lo, float hi) { const f32x2 f = {lo, hi}; const bf16x2_t v = __builtin_convertvector(f, bf16x2_t); return __builtin_bit_cast(unsigned, v); }
template <int CTRL> __device__ __forceinline__ float dpp_mov(float v) { return __int_as_float(__builtin_amdgcn_update_dpp(0, __float_as_int(v), CTRL, 0xf, 0xf, true)); }
__device__ __forceinline__ float rdlane(float v, int l) { return __int_as_float(__builtin_amdgcn_readlane(__float_as_int(v), l)); }
__device__ __forceinline__ float row_sum16(float v) { v += dpp_mov<0xB1>(v); v += dpp_mov<0x4E>(v); v += dpp_mov<0x141>(v); v += dpp_mov<0x140>(v); return v; }
__device__ __forceinline__ float row_max16(float v) { v = fmaxf(v, dpp_mov<0xB1>(v)); v = fmaxf(v, dpp_mov<0x4E>(v)); v = fmaxf(v, dpp_mov<0x141>(v)); v = fmaxf(v, dpp_mov<0x140>(v)); return v; }
__device__ __forceinline__ float wave_sum(float v) { v = row_sum16(v); return (rdlane(v, 0) + rdlane(v, 16)) + (rdlane(v, 32) + rdlane(v, 48)); }
__device__ __forceinline__ float wave_max(float v) { v = row_max16(v); return fmaxf(fmaxf(rdlane(v, 0), rdlane(v, 16)), fmaxf(rdlane(v, 32), rdlane(v, 48))); }
__device__ __forceinline__ float half_sum(float v) { v = row_sum16(v); return v + __shfl_xor(v, 16); }
__device__ __forceinline__ float sigmoidf_(float x) { return __builtin_amdgcn_rcpf(1.f + __expf(-x)); }

namespace pg8 {
constexpr int BM = 256, BK = 64, HALF = 128, HTB = HALF * BK * 2, NXCD = 8, WGM = 2;
__host__ __device__ __forceinline__ int lds_byte(int r, int c) { const int st = (r >> 4) * 2 + (c >> 5), rr = r & 15, cc = c & 31, ob = rr * 64 + cc * 2; return st * 1024 + (ob ^ (((ob >> 9) & 1) << 5)); }
__host__ __device__ __forceinline__ void stage_rc(int b, int& R, int& C) { const int st = b / 1024, sb = b % 1024, swz = sb ^ (((sb >> 9) & 1) << 5); R = (st >> 1) * 16 + swz / 64; C = (st & 1) * 32 + (swz % 64) / 2; }
__host__ __device__ __forceinline__ int perm32(int rho) { const int n = rho >> 4, i = rho & 15; return 8 * (i >> 2) + 4 * n + (i & 3); }

struct Unit { int pm, pn; };
struct Gemm { const bf16_t* A; const bf16_t* Bt; int K; };

template <int TRIP> struct Order {
    int nM, nN, nwg, G, c, sub_m;
    __device__ void init(int nM_, int nN_, int G_, int c_) { nM = nM_; nN = nN_; nwg = nM * nN; G = G_; c = c_; sub_m = nM_; }
    __device__ bool next(int i, Unit& u) const {
        const int ii = i / TRIP, sub = i - ii * TRIP;
        const long L = (long)ii * G + c; if (L >= nwg) return false;
        int wgid = (int)L; { const int q = nwg / NXCD, r = nwg % NXCD, xcd = wgid % NXCD, off = wgid / NXCD; wgid = (xcd < r ? xcd * (q + 1) : r * (q + 1) + (xcd - r) * q) + off; }
        const int nig = WGM * nN, gid = wgid / nig, fm = gid * WGM, gsz = (nM - fm) < WGM ? (nM - fm) : WGM;
        u.pm = fm + ((wgid % nig) % gsz) + sub * sub_m; u.pn = (wgid % nig) / gsz + sub * nN; return true;
    }
};

template <class Epi, class Sched>
__device__ __forceinline__ void gemm_phase(LAS unsigned char* lds, const int tid, const Gemm g, const Sched& S, const Epi& E) {
    const int wid = __builtin_amdgcn_readfirstlane(tid >> 6), lane = tid & 63, wr = wid >> 2, wc = wid & 3, fr = lane & 15, fq = lane >> 4;
    const int K = g.K, nt = K / BK;
    unsigned voffA[2], voffB[2];
#pragma unroll
    for (int i = 0; i < 2; ++i) { int R, C; stage_rc(tid * 16 + i * 8192, R, C); const int Rb = Epi::PERM ? ((R & ~31) + perm32(R & 31)) : R;
        voffA[i] = (unsigned)(R * K + C) * 2u; voffB[i] = (unsigned)(Rb * K + C) * 2u; }
    const size_t kstep = (size_t)(BK * 2);
    const size_t hstep = (size_t)HALF * K * 2;
    const size_t tstep = 2 * hstep;
    const unsigned ldsw = (unsigned)wid * 1024u;
    const int aoff = lds_byte(wr * 64 + fr, fq * 8), boff = lds_byte(wc * 32 + fr, fq * 8);
#define PG8_SA(b, h) (((b) * 2 + (h)) * HTB)
#define PG8_SB(b, h) ((4 + (b) * 2 + (h)) * HTB)
#define PG8_STAGE(bufoff, gbase, voff) do { _Pragma("unroll") for (int _i = 0; _i < 2; ++_i) \
        __builtin_amdgcn_global_load_lds((const unsigned*)((const char*)(gbase) + (voff)[_i]), (LAS unsigned*)(lds + (bufoff) + ldsw + _i * 8192), 16, 0, 0); } while (0)
#define PG8_LDA(dst, b, h) do { _Pragma("unroll") for (int m = 0; m < 4; ++m) _Pragma("unroll") for (int k = 0; k < 2; ++k) dst[m][k] = *(const LAS bf16x8*)(lds + PG8_SA(b, h) + aoff + m * 2048 + k * 1024); } while (0)
#define PG8_LDB(dst, b, h) do { _Pragma("unroll") for (int n = 0; n < 2; ++n) _Pragma("unroll") for (int k = 0; k < 2; ++k) dst[n][k] = *(const LAS bf16x8*)(lds + PG8_SB(b, h) + boff + n * 2048 + k * 1024); } while (0)
#define PG8_MMA(ai, bj, At, Bt) do { __builtin_amdgcn_s_setprio(1); _Pragma("unroll") for (int m = 0; m < 4; ++m) _Pragma("unroll") for (int n = 0; n < 2; ++n) _Pragma("unroll") for (int k = 0; k < 2; ++k) \
        acc[ai][bj][m][n] = __builtin_amdgcn_mfma_f32_16x16x32_bf16(Bt[n][k], At[m][k], acc[ai][bj][m][n], 0, 0, 0); __builtin_amdgcn_s_setprio(0); } while (0)
#define PG8_WAIT_V(n) asm volatile("s_waitcnt vmcnt(" #n ")" ::: "memory")
#define PG8_WAIT_L(n) asm volatile("s_waitcnt lgkmcnt(" #n ")" ::: "memory")
#define PG8_BAR __builtin_amdgcn_s_barrier()
#define PG8_SCHED __builtin_amdgcn_sched_barrier(0)
    Unit cur, nxt; int ui = 0;
    if (!S.next(0, cur)) return;
    f32x4 acc[2][2][4][2];
#pragma unroll
    for (int a = 0; a < 2; ++a)
#pragma unroll
        for (int b = 0; b < 2; ++b)
#pragma unroll
            for (int m = 0; m < 4; ++m)
#pragma unroll
                for (int n = 0; n < 2; ++n) acc[a][b][m][n] = (f32x4){0.f, 0.f, 0.f, 0.f};
    bf16x8 At[4][2], B0[2][2], B1[2][2];
    const char* cA = (const char*)g.A + (size_t)cur.pm * tstep; const char* cB = (const char*)g.Bt + (size_t)cur.pn * tstep;
    PG8_STAGE(PG8_SB(0, 0), cB, voffB); PG8_STAGE(PG8_SB(0, 1), cB + hstep, voffB); PG8_STAGE(PG8_SA(0, 0), cA, voffA); PG8_STAGE(PG8_SA(0, 1), cA + hstep, voffA);
    if (wr == 1) PG8_BAR;
    PG8_WAIT_V(2); PG8_BAR;
    PG8_STAGE(PG8_SB(1, 0), cB + kstep, voffB); PG8_STAGE(PG8_SA(1, 0), cA + kstep, voffA); PG8_STAGE(PG8_SB(1, 1), cB + hstep + kstep, voffB);
    PG8_WAIT_V(6); PG8_BAR;
    for (;;) {
        const bool has_next = S.next(ui + 1, nxt);
        const char* nA = has_next ? (const char*)g.A + (size_t)nxt.pm * tstep : cA; const char* nB = has_next ? (const char*)g.Bt + (size_t)nxt.pn * tstep : cB;
        for (int t = 0; t < nt; t += 2) {
            const bool last = (t == nt - 2);
            const char* a1 = cA + (size_t)(t + 1) * kstep;
            const char* a2 = last ? nA : cA + (size_t)(t + 2) * kstep; const char* b2 = last ? nB : cB + (size_t)(t + 2) * kstep;
            const char* a3 = a2 + kstep; const char* b3 = b2 + kstep;
            PG8_LDB(B0, 0, 0); PG8_LDB(B1, 0, 1); PG8_SCHED; PG8_LDA(At, 0, 0); PG8_STAGE(PG8_SA(1, 1), a1 + hstep, voffA);
            PG8_WAIT_V(8); PG8_WAIT_L(0); PG8_BAR; PG8_MMA(0, 0, At, B0); PG8_MMA(0, 1, At, B1); PG8_BAR; PG8_SCHED;
            PG8_LDA(At, 0, 1); PG8_STAGE(PG8_SB(0, 0), b2, voffB); PG8_STAGE(PG8_SB(0, 1), b2 + hstep, voffB); PG8_STAGE(PG8_SA(0, 0), a2, voffA);
            PG8_WAIT_V(8); PG8_WAIT_L(0); PG8_BAR; PG8_MMA(1, 0, At, B0); PG8_MMA(1, 1, At, B1); PG8_BAR; PG8_SCHED;
            PG8_LDB(B0, 1, 0); PG8_LDB(B1, 1, 1); PG8_SCHED; PG8_LDA(At, 1, 0); PG8_STAGE(PG8_SA(0, 1), a2 + hstep, voffA);
            PG8_WAIT_V(8); PG8_WAIT_L(0); PG8_BAR; PG8_MMA(0, 0, At, B0); PG8_MMA(0, 1, At, B1); PG8_BAR; PG8_SCHED;
            PG8_LDA(At, 1, 1); PG8_STAGE(PG8_SB(1, 0), b3, voffB); PG8_STAGE(PG8_SB(1, 1), b3 + hstep, voffB); PG8_STAGE(PG8_SA(1, 0), a3, voffA);
            PG8_WAIT_V(8); PG8_WAIT_L(0); PG8_BAR; PG8_MMA(1, 0, At, B0); PG8_MMA(1, 1, At, B1); PG8_BAR; PG8_SCHED;
        }
        if (wr == 0) PG8_BAR;
        E(acc, cur, wr, wc, fr, fq);
        if (!has_next) break;
        if (E.reset_after(cur)) {
#pragma unroll
            for (int a = 0; a < 2; ++a)
#pragma unroll
                for (int b = 0; b < 2; ++b)
#pragma unroll
                    for (int m = 0; m < 4; ++m)
#pragma unroll
                        for (int n = 0; n < 2; ++n) acc[a][b][m][n] = (f32x4){0.f, 0.f, 0.f, 0.f};
        }
        cur = nxt; cA = nA; cB = nB; ++ui;
        if (wr == 1) PG8_BAR;
    }
    PG8_WAIT_V(0);
    PG8_BAR;
#undef PG8_SA
#undef PG8_SB
#undef PG8_STAGE
#undef PG8_LDA
#undef PG8_LDB
#undef PG8_MMA
#undef PG8_WAIT_V
#undef PG8_WAIT_L
#undef PG8_BAR
#undef PG8_SCHED
}
}
using pg8::Unit;

struct EpiProj {
    static constexpr bool PERM = true;
    bf16_t* O; const float* rowss;
    __device__ __forceinline__ bool reset_after(const Unit&) const { return true; }
    __device__ __forceinline__ void operator()(f32x4 (&acc)[2][2][4][2], const Unit& u, int wr, int wc, int fr, int fq) const {
        const int row0 = u.pm * 256 + wr * 64 + fr, col0 = u.pn * 256 + wc * 32 + 8 * fq;
        const bool gate = (u.pn >= 32 && u.pn < 44);
#pragma unroll
        for (int ai = 0; ai < 2; ++ai)
#pragma unroll
            for (int m = 0; m < 4; ++m) {
                const int row = row0 + ai * 128 + m * 16;
                const float rs = rsqrtf(rowss[row] * (1.f / 1024.f) + EPS);
                bf16_t* rowp = O + (size_t)row * NPROJ + col0;
#pragma unroll
                for (int bj = 0; bj < 2; ++bj) {
                    f32x4 v0 = acc[ai][bj][m][0] * rs, v1 = acc[ai][bj][m][1] * rs;
                    if (gate) {
#pragma unroll
                        for (int j = 0; j < 4; ++j) { v0[j] = sigmoidf_(v0[j]); v1[j] = sigmoidf_(v1[j]); }
                    }
                    u32x4 w; w.x = cvt_pk_bf16(v0[0], v0[1]); w.y = cvt_pk_bf16(v0[2], v0[3]); w.z = cvt_pk_bf16(v1[0], v1[1]); w.w = cvt_pk_bf16(v1[2], v1[3]);
                    *(u32x4*)(rowp + bj * 128) = w;
                }
            }
    }
};
struct EpiAbc {
    static constexpr bool PERM = true;
    const bf16_t* G; bf16_t* O;
    __device__ __forceinline__ bool reset_after(const Unit& u) const { return (u.pn >> 2) == 2; }
    __device__ __forceinline__ void operator()(f32x4 (&acc)[2][2][4][2], const Unit& u, int wr, int wc, int fr, int fq) const {
        const int sub = u.pn >> 2, pn = u.pn & 3, pm = u.pm - sub * 65;
        const int row0 = pm * 256 + wr * 64 + fr, col0 = pn * 256 + wc * 32 + 8 * fq;
#pragma unroll
        for (int ai = 0; ai < 2; ++ai)
#pragma unroll
            for (int m = 0; m < 4; ++m) {
                const int row = row0 + ai * 128 + m * 16;
                const bf16_t* gp = G + (size_t)row * NPROJ + PC_GATE + sub * 1024 + col0;
#pragma unroll
                for (int bj = 0; bj < 2; ++bj) {
                    const u32x4 ga = *(const u32x4*)(gp + bj * 128);
                    f32x4 g0 = (f32x4){bf_lo(ga.x), bf_hi(ga.x), bf_lo(ga.y), bf_hi(ga.y)}, g1 = (f32x4){bf_lo(ga.z), bf_hi(ga.z), bf_lo(ga.w), bf_hi(ga.w)};
                    if (sub < 2) {
                        const u32x4 gb = *(const u32x4*)(gp + 1024 + bj * 128);
                        const f32x4 h0 = (f32x4){bf_lo(gb.x), bf_hi(gb.x), bf_lo(gb.y), bf_hi(gb.y)}, h1 = (f32x4){bf_lo(gb.z), bf_hi(gb.z), bf_lo(gb.w), bf_hi(gb.w)};
#pragma unroll
                        for (int j = 0; j < 4; ++j) { acc[ai][bj][m][0][j] *= g0[j] * __builtin_amdgcn_rcpf(fmaxf(h0[j], 1e-30f)); acc[ai][bj][m][1][j] *= g1[j] * __builtin_amdgcn_rcpf(fmaxf(h1[j], 1e-30f)); }
                    } else {
                        const f32x4 v0 = acc[ai][bj][m][0] * g0, v1 = acc[ai][bj][m][1] * g1;
                        u32x4 w; w.x = cvt_pk_bf16(v0[0], v0[1]); w.y = cvt_pk_bf16(v0[2], v0[3]); w.z = cvt_pk_bf16(v1[0], v1[1]); w.w = cvt_pk_bf16(v1[2], v1[3]);
                        *(u32x4*)(O + (size_t)row * D + col0 + bj * 128) = w;
                    }
                }
            }
    }
};
struct EpiRes {
    static constexpr bool PERM = false;
    const float* res0; const float* res1; const bf16_t* resb; float* out; bf16_t* xb; float* rowss;
    __device__ __forceinline__ bool reset_after(const Unit&) const { return true; }
    __device__ __forceinline__ void operator()(f32x4 (&acc)[2][2][4][2], const Unit& u, int wr, int wc, int fr, int fq) const {
        const int col0 = u.pn * 256 + wc * 32 + 4 * fq;
        const float* rbase = (u.pm < 64) ? res0 + (size_t)u.pm * 256 * D : res1;
#pragma unroll
        for (int ai = 0; ai < 2; ++ai)
#pragma unroll
            for (int m = 0; m < 4; ++m) {
                const int lrow = ai * 128 + wr * 64 + m * 16 + fr; const size_t grow = (size_t)u.pm * 256 + lrow;
                float ss = 0.f;
#pragma unroll
                for (int bj = 0; bj < 2; ++bj)
#pragma unroll
                    for (int n = 0; n < 2; ++n) {
                        const int c = col0 + bj * 128 + n * 16;
                        f32x4 r4;
                        if (resb) { const u32x2 rb = *(const u32x2*)(resb + grow * D + c); r4 = (f32x4){bf_lo(rb.x), bf_hi(rb.x), bf_lo(rb.y), bf_hi(rb.y)}; }
                        else r4 = *(const f32x4*)(rbase + (size_t)lrow * D + c);
                        const f32x4 o = r4 + acc[ai][bj][m][n];
                        if (out) *(f32x4*)(out + grow * D + c) = o;
                        else { u32x2 w; w.x = cvt_pk_bf16(o[0], o[1]); w.y = cvt_pk_bf16(o[2], o[3]); *(u32x2*)(xb + grow * D + c) = w; }
                        ss += (o[0] * o[0] + o[1] * o[1]) + (o[2] * o[2] + o[3] * o[3]);
                    }
                ss += __shfl_xor(ss, 16); ss += __shfl_xor(ss, 32);
                if (fq == 0) atomicAdd(rowss + grow, ss);
                asm volatile("" ::: "memory");
            }
    }
};
struct EpiFfn {
    static constexpr bool PERM = true;
    bf16_t* O; const float* rowss;
    __device__ __forceinline__ bool reset_after(const Unit&) const { return true; }
    __device__ __forceinline__ void operator()(f32x4 (&acc)[2][2][4][2], const Unit& u, int wr, int wc, int fr, int fq) const {
        const int row0 = u.pm * 256 + wr * 64 + fr, f0 = u.pn * 128 + 16 * wc + 4 * fq;
#pragma unroll
        for (int ai = 0; ai < 2; ++ai)
#pragma unroll
            for (int m = 0; m < 4; ++m) {
                const int row = row0 + ai * 128 + m * 16;
                const float rs = rsqrtf(rowss[row] * (1.f / 1024.f) + EPS);
#pragma unroll
                for (int bj = 0; bj < 2; ++bj) {
                    const f32x4 gg = acc[ai][bj][m][0] * rs, uu = acc[ai][bj][m][1] * rs;
                    f32x4 hh;
#pragma unroll
                    for (int j = 0; j < 4; ++j) hh[j] = gg[j] * sigmoidf_(gg[j]) * uu[j];
                    u32x2 w; w.x = cvt_pk_bf16(hh[0], hh[1]); w.y = cvt_pk_bf16(hh[2], hh[3]);
                    *(u32x2*)(O + (size_t)row * DFF + f0 + bj * 64) = w;
                }
            }
    }
};

#define XB_TMO      128
#define XB_XCNT(j)  (256  + 64 * (j))
#define XB_XSUB(j)  (1280 + 64 * (j))
#define XB_XGEN(j)  (2304 + 64 * (j))
#define XB_TOP      3328
#define XB_TOPGEN   3392
#define XCD_BAR_WORDS 3456
#define XB_SPIN_CAP (1u << 18)

__device__ __forceinline__ unsigned xb_ld(unsigned* p)              { return __hip_atomic_load(p, __ATOMIC_RELAXED, __HIP_MEMORY_SCOPE_AGENT); }
__device__ __forceinline__ unsigned xb_add(unsigned* p, unsigned v) { return __hip_atomic_fetch_add(p, v, __ATOMIC_RELAXED, __HIP_MEMORY_SCOPE_AGENT); }
__device__ __forceinline__ unsigned xb_xcc_id() { return (unsigned)__builtin_amdgcn_s_getreg((3 << 11) | 20) & 0xFu; }
#define XB_SPIN(cond, bar) do { unsigned _sp = 0; while (cond) { __builtin_amdgcn_s_sleep(1); \
    if ((++_sp & 255u) == 0u) { if (xb_ld(&(bar)[XB_TMO])) break; if (_sp > XB_SPIN_CAP) { atomicAdd(&(bar)[XB_TMO], 1u); break; } } } } while (0)

struct XcdBarrier {
    unsigned* bar; unsigned x;
    volatile LAS unsigned* st;
};

__device__ __forceinline__ XcdBarrier xcd_barrier_post(unsigned* bar, volatile LAS unsigned* st) {
    XcdBarrier b; b.bar = bar; b.x = xb_xcc_id(); b.st = st;
    if (threadIdx.x == 0) (void)xb_add(&bar[XB_XCNT(b.x)], 1u);
    return b;
}
__device__ __forceinline__ void xcd_barrier_complete(unsigned* bar, unsigned x, unsigned& nloc, unsigned& nx) {
    const unsigned G = gridDim.x * gridDim.y * gridDim.z;
    unsigned sum, cnt, mine, sp = 0u;
    for (;;) {
        sum = 0u; cnt = 0u; mine = 0u;
#pragma unroll
        for (unsigned j = 0; j < 16; ++j) { const unsigned c = xb_ld(&bar[XB_XCNT(j)]); sum += c; cnt += (c > 0u) ? 1u : 0u; mine = (j == x) ? c : mine; }
        if (sum == G) break;
        __builtin_amdgcn_s_sleep(1);
        if ((++sp & 255u) == 0u) { if (xb_ld(&bar[XB_TMO])) break; if (sp > XB_SPIN_CAP) { atomicAdd(&bar[XB_TMO], 1u); break; } }
    }
    nloc = mine > 0u ? mine : 1u; nx = cnt > 0u ? cnt : 1u;
}

__device__ __forceinline__ void xcd_barrier(const XcdBarrier& b, int tid_l) {
    asm volatile("s_waitcnt vmcnt(0)" ::: "memory");
    __syncthreads();
    if (tid_l == 0) {
        unsigned* bar = b.bar;
        __builtin_amdgcn_s_waitcnt(0);
        unsigned nloc = b.st[0], nx = b.st[1];
        if (nloc == 0u) { xcd_barrier_complete(bar, b.x, nloc, nx); b.st[0] = nloc; b.st[1] = nx; }
        const unsigned old = xb_add(&bar[XB_XSUB(b.x)], 1u);
        const unsigned gen = old / nloc;
        if (old + 1u == (gen + 1u) * nloc) {
            __builtin_amdgcn_fence(__ATOMIC_RELEASE, "agent");
            asm volatile("s_waitcnt vmcnt(0)" ::: "memory");
            const unsigned og = xb_add(&bar[XB_TOP], 1u);
            const unsigned tg = og / nx;
            if (og + 1u == (tg + 1u) * nx) xb_add(&bar[XB_TOPGEN], 1u);
            else XB_SPIN(xb_ld(&bar[XB_TOPGEN]) == tg, bar);
            __builtin_amdgcn_fence(__ATOMIC_ACQUIRE, "agent");
            xb_add(&bar[XB_XGEN(b.x)], 1u);
            asm volatile("s_waitcnt vmcnt(0)" ::: "memory");
        } else {
            XB_SPIN(xb_ld(&bar[XB_XGEN(b.x)]) == gen, bar);
            __builtin_amdgcn_fence(__ATOMIC_ACQUIRE, "agent");
            asm volatile("s_waitcnt vmcnt(0)" ::: "memory");
        }
    }
    __syncthreads();
}


struct Args { const float* in[24]; float* out; unsigned char* ws; int ph_lo, ph_hi; };
static_assert(sizeof(Args) == 216, "Args layout");
struct Ctx {
    const float* const __attribute__((address_space(4)))* in; float* out; unsigned char* ws;
    LAS unsigned char* lds; int tid, lane, wave, G, bid;
};
#define WSV(T, off) ((T*)(F.ws + (off)))
#define V_WIN WSV(bf16_t, WS_WIN)
#define V_WABC WSV(bf16_t, WS_WABC)
#define V_WOUT WSV(bf16_t, WS_WOUT)
#define V_WFI WSV(bf16_t, WS_WFI)
#define V_WFO WSV(bf16_t, WS_WFO)
#define V_XBA WSV(bf16_t, WS_XBA)
#define V_XBB WSV(bf16_t, WS_XBB)
#define V_PROJ WSV(bf16_t, WS_PROJ)
#define V_OABC WSV(bf16_t, WS_OABC)
#define V_MRG WSV(bf16_t, WS_MRG)
#define V_ACT WSV(bf16_t, WS_ACT)
#define V_X1 WSV(float, WS_X1)
#define V_X2 WSV(float, WS_X2)
#define V_RS WSV(float, WS_RS)
#define V_BQKV WSV(float, WS_BQKV)
#define V_BG WSV(float, WS_BG)
#define V_CQK WSV(float, WS_CQK)
#define V_OBR WSV(float, WS_OBR)
#define V_OCR WSV(float, WS_OCR)
#define V_ROPEA WSV(float, WS_ROPEA)
#define V_ROPEC WSV(float, WS_ROPEC)
#define V_CTL WSV(unsigned, WS_CTL)
#define V_AO WSV(bf16_t, WS_AO)
#define V_LSE WSV(float, WS_LSE)
#define V_DW WSV(bf16_t, WS_DW)
#define V_DQG WSV(bf16_t, WS_DQG)
#define V_DKT WSV(bf16_t, WS_DKT)
#define V_DAT WSV(bf16_t, WS_DAT)
#define V_DU WSV(float, WS_DU)
#define V_DDL WSV(float, WS_DDL)
#define V_RQG WSV(bf16_t, WS_RQG)
#define V_RKT WSV(bf16_t, WS_RKT)
#define V_RAT WSV(bf16_t, WS_RAT)
#define V_RU WSV(float, WS_RU)
#define V_SB WSV(bf16_t, WS_SB)
#define V_VB WSV(bf16_t, WS_VB)

__device__ __forceinline__ int src_col(int mode, int n) {
    if (mode == 1) { if (n < 6656) return n; if (n < 11264) return n + 8; if (n < 11272) return n - 11264 + 6656; return -1; }
    if (mode == 2) { const int pn = n >> 8, c = n & 255; const int f = pn * 128 + (c >> 3) * 4 + (c & 3); return ((c >> 2) & 1) * DFF + f; }
    return n;
}
__device__ __forceinline__ void transpose_item(const float* W, int K, int N, int nblk, bf16_t* WT, const float* kscale, int mode, LAS float* scr, int item, int lane) {
    const int kb = item / nblk, nb = item - kb * nblk, k0 = 32 * kb, n0 = 128 * nb;
    const int sc = src_col(mode, n0 + 4 * (lane & 31));
    f32x4 v[16];
#pragma unroll
    for (int i = 0; i < 16; ++i) { const int kk = 2 * i + (lane >> 5);
        v[i] = (f32x4){0.f, 0.f, 0.f, 0.f};
        if (sc >= 0) { v[i] = *(const f32x4*)(W + (size_t)(k0 + kk) * N + sc); if (kscale) v[i] *= kscale[k0 + kk]; } }
#pragma unroll
    for (int i = 0; i < 16; ++i) { const int kk = 2 * i + (lane >> 5); *(LAS f32x4*)(scr + kk * 132 + 4 * (lane & 31)) = v[i]; }
    asm volatile("s_waitcnt lgkmcnt(0)" ::: "memory");
#pragma unroll
    for (int h2 = 0; h2 < 2; ++h2) { const int n = lane + 64 * h2; const LAS float* sp = scr + n;
        bf16_t* dst = WT + (size_t)(n0 + n) * K + k0;
#pragma unroll
        for (int q = 0; q < 4; ++q) { u32x4 o; o.x = cvt_pk_bf16(sp[(8 * q + 0) * 132], sp[(8 * q + 1) * 132]); o.y = cvt_pk_bf16(sp[(8 * q + 2) * 132], sp[(8 * q + 3) * 132]);
            o.z = cvt_pk_bf16(sp[(8 * q + 4) * 132], sp[(8 * q + 5) * 132]); o.w = cvt_pk_bf16(sp[(8 * q + 6) * 132], sp[(8 * q + 7) * 132]); *(u32x4*)(dst + 8 * q) = o; } }
    asm volatile("s_waitcnt lgkmcnt(0)" ::: "memory");
}
constexpr int I_IN = 32 * (NPROJ / 128), I_ABC = 16 * 8, I_OUT = 32 * 8, I_FI = 32 * (2 * DFF / 128), I_FO = (DFF / 32) * 8;
constexpr int I_LAYER = I_IN + 3 * I_ABC + I_OUT + I_FI + I_FO;
__device__ __forceinline__ void prep_weight_item(Ctx& F, int it, LAS float* scr, int lane) {
    const int l = it / I_LAYER; int r = it - l * I_LAYER;
    const float* W; const float* ksc = nullptr; bf16_t* WT; int K = D, N = D, nblk = D / 128, mode = 0;
    if (r < I_IN) { W = F.in[9] + (size_t)l * D * NIN; N = NIN; nblk = NPROJ / 128; WT = V_WIN + (size_t)l * NPROJ * D; ksc = F.in[8] + l * D; mode = 1; }
    else if ((r -= I_IN) < 3 * I_ABC) { const int i = r / I_ABC; r -= i * I_ABC; W = F.in[17 + i] + (size_t)l * 512 * D; K = 512; WT = V_WABC + (size_t)(l * 3 + i) * D * 512; }
    else if ((r -= 3 * I_ABC) < I_OUT) { W = F.in[20] + (size_t)l * D * D; WT = V_WOUT + (size_t)l * D * D; }
    else if ((r -= I_OUT) < I_FI) { W = F.in[22] + (size_t)l * D * 2 * DFF; N = 2 * DFF; nblk = 2 * DFF / 128; WT = V_WFI + (size_t)l * 2 * DFF * D; ksc = F.in[21] + l * D; mode = 2; }
    else { r -= I_FI; W = F.in[23] + (size_t)l * DFF * D; K = DFF; WT = V_WFO + (size_t)l * D * DFF; }
    transpose_item(W, K, N, nblk, WT, ksc, mode, scr, r, lane);
}
__device__ __forceinline__ void phase_prep(Ctx& F) {
    LAS float* scr = (LAS float*)(F.lds + F.wave * 16896);
    const int gw = F.bid * NWAVES + F.wave, NGW = F.G * NWAVES, lane = F.lane;
    for (int it = gw; it < I_IN; it += NGW) prep_weight_item(F, it, scr, lane);
    for (int row0 = gw; row0 < M; row0 += 4 * NGW) {
        f32x4 v[4][4];
#pragma unroll
        for (int r = 0; r < 4; ++r) { const int row = row0 + r * NGW;
            if (row < M) { const float* src = row < MP ? F.in[0] + (size_t)row * D : F.in[1] + (size_t)(row - MP) * D;
#pragma unroll
                for (int j = 0; j < 4; ++j) v[r][j] = *(const f32x4*)(src + 4 * lane + 256 * j); } }
#pragma unroll
        for (int r = 0; r < 4; ++r) { const int row = row0 + r * NGW;
            if (row < M) { float ss = 0.f;
#pragma unroll
                for (int j = 0; j < 4; ++j) ss += (v[r][j][0] * v[r][j][0] + v[r][j][1] * v[r][j][1]) + (v[r][j][2] * v[r][j][2] + v[r][j][3] * v[r][j][3]);
                ss = wave_sum(ss);
                if (lane == 0) V_RS[row] = ss;
#pragma unroll
                for (int j = 0; j < 4; ++j) { u32x2 w; w.x = cvt_pk_bf16(v[r][j][0], v[r][j][1]); w.y = cvt_pk_bf16(v[r][j][2], v[r][j][3]); *(u32x2*)(V_XBA + (size_t)row * D + 4 * lane + 256 * j) = w; } } }
    }
    const int gt = F.bid * NTHREADS + F.tid, NGT = F.G * NTHREADS;
    for (int i = gt; i < 3 * M; i += NGT) V_RS[M + i] = 0.f;
    {
        const int i64 = gt & 63; const double invA = exp(-(double)i64 * (9.210340371976184 / 64.0));
        for (int e = gt; e < NPOS * 64; e += NGT) { const int pi = e >> 6; const double pos = pi < SEQ ? (double)pi : (double)(PAST + pi - SEQ);
            double a = pos * invA; a -= floor(a * 0.15915494309189535) * 6.283185307179586; float sn, cs; sincosf((float)a, &sn, &cs); *(f32x2*)(V_ROPEA + 2 * e) = (f32x2){cs, sn}; }
        const int i32 = gt & 31; const double invC = exp(-(double)i32 * (9.210340371976184 / 32.0));
        for (int e = gt; e < NPOS * 32; e += NGT) { const int pi = e >> 5; const double pos = pi < SEQ ? (double)pi : (double)(PAST + pi - SEQ);
            double a = pos * invC; a -= floor(a * 0.15915494309189535) * 6.283185307179586; float sn, cs; sincosf((float)a, &sn, &cs); *(f32x2*)(V_ROPEC + 2 * e) = (f32x2){cs, sn}; }
    }
}

__device__ __forceinline__ float* kv_out_ptr(float* out, int g, int l, bool sample, int b, int tt) {
    if (sample) { const size_t base = g == 0 ? O_KV0S : (g == 1 ? O_KV1S : O_KV2S); return out + base + ((size_t)(l * DB + b) * DS + tt) * 1024; }
    const int keep = 128 << (2 * g); const size_t base = g == 0 ? O_KV0P : (g == 1 ? O_KV1P : O_KV2P);
    return out + base + ((size_t)(l * BATCH + b) * keep + tt) * 1024;
}
template <int NR>
__device__ __forceinline__ void e1_partA(Ctx& F, int l, const int (&rows)[NR], bool store_qk) {
    const int lane = F.lane, jj = lane & 15, hq = lane >> 4;
    u32x2 xlo[NR][6], xhi[NR][6]; f32x4 cc[NR], sn[NR]; unsigned vv[NR][12];
    bool sample[NR]; int bb[NR], tt0[NR];
#pragma unroll
    for (int r = 0; r < NR; ++r) {
        const int row = rows[r];
        sample[r] = row >= MP; bb[r] = sample[r] ? (row - MP) >> 3 : row >> 12; tt0[r] = sample[r] ? (row - MP) & 7 : row & 4095;
        const int pidx = sample[r] ? SEQ + tt0[r] : tt0[r];
        const bf16_t* prow = V_PROJ + (size_t)row * NPROJ;
#pragma unroll
        for (int sl = 0; sl < 6; ++sl) { const bf16_t* p = prow + (4 * sl + hq) * 128; xlo[r][sl] = *(const u32x2*)(p + 4 * jj); xhi[r][sl] = *(const u32x2*)(p + 64 + 4 * jj); }
        const float* cs = V_ROPEA + ((size_t)pidx * 64 + 4 * jj) * 2;
        const f32x4 c01 = *(const f32x4*)cs, c23 = *(const f32x4*)(cs + 4);
        cc[r] = (f32x4){c01[0], c01[2], c23[0], c23[2]}; sn[r] = (f32x4){c01[1], c01[3], c23[1], c23[3]};
#pragma unroll
        for (int q = 0; q < 12; ++q) vv[r][q] = *(const unsigned*)(prow + PC_AV + q * 128 + 2 * lane);
    }
    const f32x4 gq_lo = *(const f32x4*)(F.in[10] + l * 128 + 4 * jj), gq_hi = *(const f32x4*)(F.in[10] + l * 128 + 64 + 4 * jj);
    const f32x4 gk_lo = *(const f32x4*)(F.in[11] + l * 128 + 4 * jj), gk_hi = *(const f32x4*)(F.in[11] + l * 128 + 64 + 4 * jj);
#pragma unroll
    for (int r = 0; r < NR; ++r) {
        const int row = rows[r], t = tt0[r], b = bb[r]; const bool smp = sample[r];
        bf16_t* prow = V_PROJ + (size_t)row * NPROJ;
#pragma unroll
        for (int sl = 0; sl < 6; ++sl) {
            const int hs = 4 * sl + hq, which = sl >= 3 ? 1 : 0, gh = hs - 12 * which, g = gh >> 2, h = gh & 3;
            f32x4 lo = (f32x4){bf_lo(xlo[r][sl].x), bf_hi(xlo[r][sl].x), bf_lo(xlo[r][sl].y), bf_hi(xlo[r][sl].y)}, hi = (f32x4){bf_lo(xhi[r][sl].x), bf_hi(xhi[r][sl].x), bf_lo(xhi[r][sl].y), bf_hi(xhi[r][sl].y)};
            float ss = (lo[0] * lo[0] + lo[1] * lo[1]) + (lo[2] * lo[2] + lo[3] * lo[3]) + (hi[0] * hi[0] + hi[1] * hi[1]) + (hi[2] * hi[2] + hi[3] * hi[3]);
            ss = row_sum16(ss);
            const float rstd = rsqrtf(ss * (1.f / 128.f) + EPS);
            lo = lo * rstd * (which ? gk_lo : gq_lo); hi = hi * rstd * (which ? gk_hi : gq_hi);
            const f32x4 olo = lo * cc[r] - hi * sn[r], ohi = hi * cc[r] + lo * sn[r];
            bf16_t* p = prow + hs * 128;
            if (store_qk) { u32x2 w0, w1; w0.x = cvt_pk_bf16(olo[0], olo[1]); w0.y = cvt_pk_bf16(olo[2], olo[3]); w1.x = cvt_pk_bf16(ohi[0], ohi[1]); w1.y = cvt_pk_bf16(ohi[2], ohi[3]);
                *(u32x2*)(p + 4 * jj) = w0; *(u32x2*)(p + 64 + 4 * jj) = w1; }
            if (which == 1) {
                const int keep = 128 << (2 * g); const int tt = smp ? t : t - (SEQ - keep);
                if (tt >= 0) { float* dst = kv_out_ptr(F.out, g, l, smp, b, tt) + h * 128; *(f32x4*)(dst + 4 * jj) = olo; *(f32x4*)(dst + 64 + 4 * jj) = ohi; }
            }
        }
#pragma unroll
        for (int g = 0; g < 3; ++g) {
            const int keep = 128 << (2 * g); const int tt = smp ? t : t - (SEQ - keep);
            if (tt >= 0) { float* dst = kv_out_ptr(F.out, g, l, smp, b, tt) + 512;
#pragma unroll
                for (int q = 0; q < 4; ++q) { const unsigned v = vv[r][4 * g + q]; *(f32x2*)(dst + q * 128 + 2 * lane) = (f32x2){bf_lo(v), bf_hi(v)}; } }
        }
    }
}
__device__ __forceinline__ void e1_row(Ctx& F, int l, int row) {
    const int lane = F.lane, j = lane & 31, hh = lane >> 5;
    const bool sample = row >= MP;
    const int b = sample ? (row - MP) >> 3 : row >> 12, t = sample ? (row - MP) & 7 : row & 4095;
    const int pidx = sample ? SEQ + t : t;
    bf16_t* prow = V_PROJ + (size_t)row * NPROJ;
    if (!sample && t < SEQ - 3) return;
#pragma unroll 1
    for (int it = 0; it < 6; ++it) {
        const int slot = 2 * it + hh, typ = slot >> 2, c = slot * 128 + 4 * j;
        f32x4 a = (f32x4){0.f, 0.f, 0.f, 0.f}, xcur = a;
#pragma unroll
        for (int i = 0; i < 4; ++i) {
            const int tp = t - 3 + i; f32x4 x;
            if (tp >= 0) { const u32x2 u = *(const u32x2*)(V_PROJ + (size_t)(row - 3 + i) * NPROJ + PC_BQKV + c); x = (f32x4){bf_lo(u.x), bf_hi(u.x), bf_lo(u.y), bf_hi(u.y)}; }
            else if (sample) x = *(const f32x4*)(F.in[5] + ((size_t)(l * DB + b) * 3 + (tp + 3)) * 1536 + c);
            else x = (f32x4){0.f, 0.f, 0.f, 0.f};
            const f32x4 w = *(const f32x4*)(F.in[12] + (size_t)(l * 4 + i) * 1536 + c);
            a += w * x; if (i == 3) xcur = x;
        }
#pragma unroll
        for (int q = 0; q < 4; ++q) a[q] = a[q] * sigmoidf_(a[q]);
        if (typ < 2) {
            const float ss = half_sum((a[0] * a[0] + a[1] * a[1]) + (a[2] * a[2] + a[3] * a[3]));
            const float sc = rsqrtf(ss + EPS) * (typ == 0 ? 0.08838834764831845f : 1.f);
            a *= sc;
        }
        *(f32x4*)(V_BQKV + (size_t)row * 1536 + c) = a;
        const int tc = sample ? t - 5 : t - (SEQ - 3);
        if (tc >= 0) { float* dst = F.out + (sample ? O_BCS + ((size_t)(l * DB + b) * 3 + tc) * 1536 : O_BCP + ((size_t)(l * BATCH + b) * 3 + tc) * 1536); *(f32x4*)(dst + c) = xcur; }
    }
    if (lane < 8) {
        const int h = lane & 3; const float x = bf1(prow[PC_BETA + lane]);
        float r;
        if (lane < 4) r = 1.f / (1.f + expf(-x));
        else { const float y = x + F.in[14][l * 4 + h]; const float sp = y > 20.f ? y : log1pf(expf(y)); r = -expf(F.in[13][l * 4 + h]) * sp; }
        V_BG[(size_t)row * 8 + lane] = r;
    }
    {
        const int hs = lane >> 3, i0 = 4 * (lane & 7);
        const bf16_t* p = prow + PC_CQ + hs * 64;
        const u32x2 ulo = *(const u32x2*)(p + i0), uhi = *(const u32x2*)(p + 32 + i0);
        const f32x4 lo = (f32x4){bf_lo(ulo.x), bf_hi(ulo.x), bf_lo(ulo.y), bf_hi(ulo.y)}, hi = (f32x4){bf_lo(uhi.x), bf_hi(uhi.x), bf_lo(uhi.y), bf_hi(uhi.y)};
        const float* cs = V_ROPEC + ((size_t)pidx * 32 + i0) * 2;
        const f32x4 c01 = *(const f32x4*)cs, c23 = *(const f32x4*)(cs + 4);
        const f32x4 cc = (f32x4){c01[0], c01[2], c23[0], c23[2]}, sn = (f32x4){c01[1], c01[3], c23[1], c23[3]};
        const float sc = hs >= 4 ? 0.125f : 1.f;
        const f32x4 olo = (lo * cc - hi * sn) * sc, ohi = (hi * cc + lo * sn) * sc;
        *(f32x4*)(V_CQK + (size_t)row * 512 + hs * 64 + i0) = olo; *(f32x4*)(V_CQK + (size_t)row * 512 + hs * 64 + 32 + i0) = ohi;
    }
}

__device__ __forceinline__ float dot8(const u32x4 q, const u32x4 k) {
    return (bf_lo(q.x) * bf_lo(k.x) + bf_hi(q.x) * bf_hi(k.x)) + (bf_lo(q.y) * bf_lo(k.y) + bf_hi(q.y) * bf_hi(k.y)) + (bf_lo(q.z) * bf_lo(k.z) + bf_hi(q.z) * bf_hi(k.z)) + (bf_lo(q.w) * bf_lo(k.w) + bf_hi(q.w) * bf_hi(k.w));
}
#define WAVE_LDS_SYNC() do { asm volatile("s_waitcnt lgkmcnt(0)" ::: "memory"); __builtin_amdgcn_wave_barrier(); } while (0)
__device__ __forceinline__ void attn_prompt_task(Ctx& F, int row, int h) {
    const int lane = F.lane, t = row & 4095;
    const bf16_t* proj = V_PROJ;
    LAS float* ps = (LAS float*)F.lds + F.wave * 256;
    float mrun = -INFINITY, lsum = 0.f, o0 = 0.f, o1 = 0.f;
#pragma unroll 1
    for (int g = 0; g < 3; ++g) {
        const int sh = 2 * g, nk = min(128, t >> sh) + 1;
        const bf16_t* qrow = proj + (size_t)row * NPROJ + PC_AQ + g * 512 + h * 128;
        u32x4 q[16];
#pragma unroll
        for (int i = 0; i < 16; ++i) q[i] = *(const u32x4*)(qrow + 8 * i);
        WAVE_LDS_SYNC();
#pragma unroll 1
        for (int r = 0; r < 3; ++r) {
            const int jk = r * 64 + lane; const bool valid = jk < nk; const int jj = valid ? jk : 0;
            const bf16_t* krow = proj + (size_t)(row - (jj << sh)) * NPROJ + PC_AK + g * 512 + h * 128;
            float a = 0.f;
#pragma unroll
            for (int i = 0; i < 16; ++i) a += dot8(q[i], *(const u32x4*)(krow + 8 * i));
            ps[jk] = valid ? a * 0.08838834764831845f : -INFINITY;
        }
        WAVE_LDS_SYNC();
        const float s0 = ps[lane], s1 = ps[64 + lane], s2 = ps[128 + lane];
        const float mg = wave_max(fmaxf(fmaxf(s0, s1), s2)), mnew = fmaxf(mrun, mg), alpha = __expf(mrun - mnew);
        const float p0 = __expf(s0 - mnew), p1 = __expf(s1 - mnew), p2 = __expf(s2 - mnew);
        WAVE_LDS_SYNC();
        ps[lane] = p0; ps[64 + lane] = p1; ps[128 + lane] = p2;
        lsum = lsum * alpha + wave_sum(p0 + p1 + p2); o0 *= alpha; o1 *= alpha; mrun = mnew;
        WAVE_LDS_SYNC();
        const bf16_t* vbase = proj + (size_t)row * NPROJ + PC_AV + g * 512 + h * 128 + 2 * lane;
#pragma unroll 4
        for (int jk = 0; jk < nk; ++jk) {
            const float pj = ps[jk];
            const unsigned vv = *(const unsigned*)(vbase - (size_t)(jk << sh) * NPROJ);
            o0 += pj * bf_lo(vv); o1 += pj * bf_hi(vv);
        }
    }
    const float inv = 1.f / lsum;
    *(unsigned*)(V_OABC + (size_t)row * 512 + h * 128 + 2 * lane) = cvt_pk_bf16(o0 * inv, o1 * inv);
}
__device__ __forceinline__ void attn_sample_unit(Ctx& F, int l, int bs, int h, int g) {
    const int lane = F.lane, b = bs >> 3, s = bs & 7, row = MP + bs;
    LAS float* ps = (LAS float*)F.lds + F.wave * 256;
    const int sh = 2 * g, L = 128 << sh;
    const float* cache = F.in[2 + g] + (size_t)(l * DB + b) * L * 1024;
    const float* newkv = kv_out_ptr(F.out, g, l, true, b, 0);
    const bf16_t* qrow = V_PROJ + (size_t)row * NPROJ + PC_AQ + g * 512 + h * 128;
    const int hl = lane & 31, hf = lane >> 5;
    const u32x2 qq = *(const u32x2*)(qrow + 4 * hl);
    const float q0 = bf_lo(qq.x) * 0.08838834764831845f, q1 = bf_hi(qq.x) * 0.08838834764831845f, q2 = bf_lo(qq.y) * 0.08838834764831845f, q3 = bf_hi(qq.y) * 0.08838834764831845f;
    WAVE_LDS_SYNC();
#pragma unroll 1
    for (int j0 = 0; j0 < 130; j0 += 26) {
        f32x4 kk[13];
#pragma unroll
        for (int u = 0; u < 13; ++u) { int jk = j0 + 2 * u + hf; jk = jk > 128 ? 128 : jk; const int idx = L + s - (jk << sh);
            kk[u] = *(const f32x4*)((idx < L ? cache + (size_t)idx * 1024 : newkv + (size_t)(idx - L) * 1024) + h * 128 + 4 * hl); }
#pragma unroll
        for (int u = 0; u < 13; ++u) { float a = (q0 * kk[u][0] + q1 * kk[u][1]) + (q2 * kk[u][2] + q3 * kk[u][3]);
            a = row_sum16(a); a += __shfl_xor(a, 16);
            const int jk = j0 + 2 * u + hf; if (hl == 0 && jk <= 128) ps[jk] = a; }
    }
    if (lane >= 1) ps[128 + lane] = -INFINITY;
    WAVE_LDS_SYNC();
    const float s0 = ps[lane], s1 = ps[64 + lane], s2 = ps[128 + lane];
    const float mx = wave_max(fmaxf(fmaxf(s0, s1), s2));
    const float p0 = __expf(s0 - mx), p1 = __expf(s1 - mx), p2 = __expf(s2 - mx);
    WAVE_LDS_SYNC();
    ps[lane] = p0; ps[64 + lane] = p1; ps[128 + lane] = p2;
    const float lsum = wave_sum(p0 + p1 + p2);
    WAVE_LDS_SYNC();
    float o0 = 0.f, o1 = 0.f, o2 = 0.f, o3 = 0.f;
    const float* vc = cache + 512 + h * 128 + 2 * lane; const float* vn2 = newkv + 512 + h * 128 + 2 * lane;
#pragma unroll 1
    for (int j0 = 0; j0 < 128; j0 += 16) {
        f32x2 vv[16];
#pragma unroll
        for (int u = 0; u < 16; ++u) { const int idx = L + s - ((j0 + u) << sh); vv[u] = *(const f32x2*)(idx < L ? vc + (size_t)idx * 1024 : vn2 + (size_t)(idx - L) * 1024); }
#pragma unroll
        for (int u = 0; u < 16; u += 2) { const float pa = ps[j0 + u], pb = ps[j0 + u + 1]; o0 += pa * vv[u][0]; o1 += pa * vv[u][1]; o2 += pb * vv[u + 1][0]; o3 += pb * vv[u + 1][1]; }
    }
    { const int idx = L + s - (128 << sh); const f32x2 vv = *(const f32x2*)(idx < L ? vc + (size_t)idx * 1024 : vn2 + (size_t)(idx - L) * 1024); const float pa = ps[128]; o0 += pa * vv[0]; o1 += pa * vv[1]; }
    const float inv = 1.f / lsum;
    *(unsigned*)(V_AO + ((size_t)g * M + row) * 512 + h * 128 + 2 * lane) = cvt_pk_bf16((o0 + o2) * inv, (o1 + o3) * inv);
    if (lane == 0) V_LSE[((size_t)g * M + row) * 4 + h] = mx + __logf(lsum);
}
constexpr int AT_KSTR = 272, AT_VSTR = 528, AT_VOFF = 256 * AT_KSTR;
template <int NP>
__device__ __forceinline__ void attn_ld(const bf16_t* proj, int b, int sh, int r, int g, int h, int npk0, int tid, u32x4 (&kv)[NP], u32x4 (&vv)[NP]) {
#pragma unroll
    for (int p = 0; p < NP; ++p) {
        const int kl = p * 32 + (tid >> 4), ch = tid & 15, np = npk0 + kl;
        if (np >= 0) { const bf16_t* src = proj + (size_t)(b * SEQ + (np << sh) + r) * NPROJ + g * 512 + h * 128 + ch * 8;
            kv[p] = *(const u32x4*)(src + PC_AK); vv[p] = *(const u32x4*)(src + PC_AV); }
        else { kv[p] = (u32x4){0u, 0u, 0u, 0u}; vv[p] = kv[p]; }
    }
}
template <int NP>
__device__ __forceinline__ void attn_st(LAS unsigned char* Ks, LAS unsigned char* Vt, int row0, int tid, const u32x4 (&kv)[NP], const u32x4 (&vv)[NP]) {
#pragma unroll
    for (int p = 0; p < NP; ++p) {
        const int kl = row0 + p * 32 + (tid >> 4), ch = tid & 15;
        *(LAS u32x4*)(Ks + kl * AT_KSTR + ch * 16) = kv[p];
        LAS unsigned short* vt = (LAS unsigned short*)(Vt + (ch * 8) * AT_VSTR + kl * 2);
        vt[0 * (AT_VSTR / 2)] = (unsigned short)(vv[p].x & 0xffffu); vt[1 * (AT_VSTR / 2)] = (unsigned short)(vv[p].x >> 16);
        vt[2 * (AT_VSTR / 2)] = (unsigned short)(vv[p].y & 0xffffu); vt[3 * (AT_VSTR / 2)] = (unsigned short)(vv[p].y >> 16);
        vt[4 * (AT_VSTR / 2)] = (unsigned short)(vv[p].z & 0xffffu); vt[5 * (AT_VSTR / 2)] = (unsigned short)(vv[p].z >> 16);
        vt[6 * (AT_VSTR / 2)] = (unsigned short)(vv[p].w & 0xffffu); vt[7 * (AT_VSTR / 2)] = (unsigned short)(vv[p].w >> 16);
    }
}
__device__ __forceinline__ void attn_blk(Ctx& F, const LAS unsigned char* Ks, const LAS unsigned char* Vt, int tb, int kmin, size_t rowq, int g, int h, const bf16x8 (&qf)[4]) {
    const int lane = F.lane, w = F.wave, li = lane & 15, q4 = lane >> 4;
    f32x4 st[9];
#pragma unroll
    for (int kt = 0; kt < 9; ++kt) {
        f32x4 acc = (f32x4){0.f, 0.f, 0.f, 0.f};
        const LAS unsigned char* kp = Ks + (((w + kt + tb) & 15) * 16 + li) * AT_KSTR + 16 * q4;
#pragma unroll
        for (int s = 0; s < 4; ++s) acc = __builtin_amdgcn_mfma_f32_16x16x32_bf16(*(const LAS bf16x8*)(kp + 64 * s), qf[s], acc, 0, 0, 0);
        st[kt] = acc;
    }
    float mx = -INFINITY;
#pragma unroll
    for (int kt = 0; kt < 9; ++kt)
#pragma unroll
        for (int rg = 0; rg < 4; ++rg) {
            const int a = 4 * q4 + rg, kl = (w + kt) * 16 + a;
            bool ok = kl >= kmin;
            if (kt == 0) ok = ok && (a >= li);
            if (kt == 8) ok = ok && (a <= li);
            st[kt][rg] = ok ? st[kt][rg] : -INFINITY;
            mx = fmaxf(mx, st[kt][rg]);
        }
    mx = fmaxf(mx, __shfl_xor(mx, 16)); mx = fmaxf(mx, __shfl_xor(mx, 32));
    const float c2 = 0.08838834764831845f * 1.4426950408889634f;
    float lsum = 0.f;
#pragma unroll
    for (int kt = 0; kt < 9; ++kt)
#pragma unroll
        for (int rg = 0; rg < 4; ++rg) { const float p = exp2f((st[kt][rg] - mx) * c2); st[kt][rg] = p; lsum += p; }
    lsum += __shfl_xor(lsum, 16); lsum += __shfl_xor(lsum, 32);
    f32x4 o[8];
#pragma unroll
    for (int db = 0; db < 8; ++db) o[db] = (f32x4){0.f, 0.f, 0.f, 0.f};
#pragma unroll
    for (int ks = 0; ks < 5; ++ks) {
        u32x4 pw;
        pw.x = cvt_pk_bf16(st[2 * ks][0], st[2 * ks][1]); pw.y = cvt_pk_bf16(st[2 * ks][2], st[2 * ks][3]);
        if (ks < 4) { pw.z = cvt_pk_bf16(st[2 * ks + 1][0], st[2 * ks + 1][1]); pw.w = cvt_pk_bf16(st[2 * ks + 1][2], st[2 * ks + 1][3]); }
        else { pw.z = 0u; pw.w = 0u; }
        const bf16x8 pf = __builtin_bit_cast(bf16x8, pw);
        const int t0 = (w + 2 * ks + tb) & 15, t1 = (w + 2 * ks + 1 + tb) & 15;
#pragma unroll
        for (int db = 0; db < 8; ++db) {
            const LAS unsigned char* vp = Vt + (16 * db + li) * AT_VSTR + 8 * q4;
            u32x4 av; const u32x2 a0 = *(const LAS u32x2*)(vp + t0 * 32), a1 = *(const LAS u32x2*)(vp + t1 * 32);
            av.x = a0.x; av.y = a0.y; av.z = a1.x; av.w = a1.y;
            o[db] = __builtin_amdgcn_mfma_f32_16x16x32_bf16(__builtin_bit_cast(bf16x8, av), pf, o[db], 0, 0, 0);
        }
    }
    const float inv = 1.f / lsum;
    bf16_t* dst = V_AO + ((size_t)g * M + rowq) * 512 + h * 128 + 4 * q4;
#pragma unroll
    for (int db = 0; db < 8; ++db) { u32x2 wv; wv.x = cvt_pk_bf16(o[db][0] * inv, o[db][1] * inv); wv.y = cvt_pk_bf16(o[db][2] * inv, o[db][3] * inv); *(u32x2*)(dst + 16 * db) = wv; }
    if (q4 == 0) V_LSE[((size_t)g * M + rowq) * 4 + h] = mx * 0.08838834764831845f + __logf(lsum);
}
__device__ __forceinline__ void attn_mfma_item(Ctx& F, int item) {
    const int tid = F.tid, lane = F.lane, w = F.wave, li = lane & 15, q4 = lane >> 4;
    const int nbr = item & 15; int rest = item >> 4; const int h = rest & 3; rest >>= 2; const int g = rest % 3, b = rest / 3;
    const int sh = 2 * g, psh = 4 - sh, r = nbr >> psh, nbp = nbr & ((1 << psh) - 1), n0 = nbp * 256;
    const bf16_t* proj = V_PROJ;
    LAS unsigned char* Ks = F.lds; LAS unsigned char* Vt = F.lds + AT_VOFF;
    u32x4 k2[4], v2[4];
    {
        u32x4 kv[8], vv[8];
        attn_ld<8>(proj, b, sh, r, g, h, n0 - 128, tid, kv, vv);
        attn_ld<4>(proj, b, sh, r, g, h, n0 + 128, tid, k2, v2);
        attn_st<8>(Ks, Vt, 0, tid, kv, vv);
    }
    const int ql = 16 * w + li;
#pragma unroll 1
    for (int j = 0; j < 2; ++j) {
        const size_t rowq = (size_t)(b * SEQ + ((n0 + 128 * j + ql) << sh) + r);
        bf16x8 qf[4];
#pragma unroll
        for (int s = 0; s < 4; ++s) qf[s] = *(const bf16x8*)(proj + rowq * NPROJ + PC_AQ + g * 512 + h * 128 + 32 * s + 8 * q4);
        __syncthreads();
        attn_blk(F, Ks, Vt, 8 * j, j == 0 ? 128 - n0 : 0, rowq, g, h, qf);
        __syncthreads();
        if (j == 0) attn_st<4>(Ks, Vt, 0, tid, k2, v2);
    }
}
constexpr int DP_Q = 0, DP_K = 17408, DP_V = 34816, DP_AM = 52224, DP_TM = 68608, DP_RTV = 77824, DP_RTK = 96256, DP_GC = 114688, DP_BT = 114944;
__device__ __forceinline__ f32x4 mfma16(const bf16x8 a, const bf16x8 b, const f32x4 c) { return __builtin_amdgcn_mfma_f32_16x16x32_bf16(a, b, c, 0, 0, 0); }
__device__ __forceinline__ void delta_prep_item(Ctx& F, int l, int ch) {
    const int tid = F.tid, lane = F.lane, w = F.wave, li = lane & 15, q4 = lane >> 4;
    const int c = ch & 63, h = (ch >> 6) & 3, b = ch >> 8;
    const int row0 = b * SEQ + 64 * c;
    const bf16_t* proj = V_PROJ;
    LAS unsigned char* L = F.lds;
    LAS float* gcs = (LAS float*)(L + DP_GC); LAS float* bts = (LAS float*)(L + DP_BT);
    float b_x = 0.f, b_y = 0.f;
    if (tid < 64) { const bf16_t* pr = proj + (size_t)(row0 + tid) * NPROJ; b_x = bf1(pr[PC_BETA + h]); b_y = bf1(pr[PC_BA + h]); }
    {
        f32x2 wg[3][4]; unsigned xr[3][11];
#pragma unroll
        for (int typ = 0; typ < 3; ++typ) {
            const int cc = typ * 512 + h * 128 + 2 * lane;
#pragma unroll
            for (int i = 0; i < 4; ++i) wg[typ][i] = *(const f32x2*)(F.in[12] + (size_t)(l * 4 + i) * 1536 + cc);
#pragma unroll
            for (int rr = 0; rr < 11; ++rr) { const int tl = 64 * c + 8 * w + rr - 3; xr[typ][rr] = tl >= 0 ? *(const unsigned*)(proj + (size_t)(b * SEQ + tl) * NPROJ + PC_BQKV + cc) : 0u; }
        }
#pragma unroll
        for (int typ = 0; typ < 3; ++typ) {
#pragma unroll
            for (int rr = 0; rr < 8; ++rr) {
                float a0 = 0.f, a1 = 0.f;
#pragma unroll
                for (int i = 0; i < 4; ++i) { a0 += wg[typ][i][0] * bf_lo(xr[typ][rr + i]); a1 += wg[typ][i][1] * bf_hi(xr[typ][rr + i]); }
                a0 = a0 * sigmoidf_(a0); a1 = a1 * sigmoidf_(a1);
                if (typ < 2) { const float ss = wave_sum(a0 * a0 + a1 * a1); const float sc = rsqrtf(ss + EPS) * (typ == 0 ? 0.08838834764831845f : 1.f); a0 *= sc; a1 *= sc; }
                *(LAS unsigned*)(L + typ * 17408 + (8 * w + rr) * 272 + 4 * lane) = cvt_pk_bf16(a0, a1);
            }
        }
    }
    if (tid < 64) {
        const float be = 1.f / (1.f + expf(-b_x));
        const float y = b_y + F.in[14][l * 4 + h]; const float sp = y > 20.f ? y : log1pf(expf(y));
        float g = -expf(F.in[13][l * 4 + h]) * sp;
#pragma unroll
        for (int o = 1; o < 64; o <<= 1) { const float v = __shfl_up(g, o); if (lane >= o) g += v; }
        gcs[tid] = g; bts[tid] = be;
    }
    __syncthreads();
    const size_t chs = (size_t)ch;
    {
        const int mi = w >> 1;
#pragma unroll
        for (int t2 = 0; t2 < 2; ++t2) {
            const int nj = 2 * (w & 1) + t2;
            bf16_t* ad = V_DAT + chs * 4096 + (size_t)(16 * mi + li) * 64 + 32 * (nj >> 1) + 8 * q4 + 4 * (nj & 1);
            if (nj <= mi) {
                f32x4 akk = (f32x4){0.f, 0.f, 0.f, 0.f}, aqk = akk;
                const LAS unsigned char* ki = L + DP_K + (16 * mi + li) * 272 + 16 * q4; const LAS unsigned char* kj = L + DP_K + (16 * nj + li) * 272 + 16 * q4;
                const LAS unsigned char* qi = L + DP_Q + (16 * mi + li) * 272 + 16 * q4;
#pragma unroll
                for (int s2 = 0; s2 < 4; ++s2) { const bf16x8 fkj = *(const LAS bf16x8*)(kj + 64 * s2);
                    akk = mfma16(*(const LAS bf16x8*)(ki + 64 * s2), fkj, akk);
                    aqk = mfma16(fkj, *(const LAS bf16x8*)(qi + 64 * s2), aqk); }
                const float gj = gcs[16 * nj + li], gi2 = gcs[16 * mi + li];
                float ov[4];
#pragma unroll
                for (int rg = 0; rg < 4; ++rg) {
                    const int i = 16 * mi + 4 * q4 + rg, j = 16 * nj + li;
                    ((LAS float*)(L + DP_AM))[i * 64 + j] = (i > j) ? bts[i] * akk[rg] * __expf(gcs[i] - gj) : 0.f;
                    const int j2 = 16 * nj + 4 * q4 + rg, i2 = 16 * mi + li;
                    ov[rg] = (i2 >= j2) ? aqk[rg] * __expf(gi2 - gcs[j2]) : 0.f;
                }
                u32x2 pk; pk.x = cvt_pk_bf16(ov[0], ov[1]); pk.y = cvt_pk_bf16(ov[2], ov[3]); *(u32x2*)ad = pk;
            } else { *(u32x2*)ad = (u32x2){0u, 0u}; }
        }
    }
    __syncthreads();
    if (w == 0) {
        const LAS float* Am = (const LAS float*)(L + DP_AM);
        float t[64];
#pragma unroll
        for (int i = 0; i < 64; ++i) {
            float a0 = (lane == i) ? 1.f : 0.f, a1 = 0.f;
#pragma unroll
            for (int j = 0; j < i; j += 4) {
                const f32x4 av = *(const LAS f32x4*)(Am + i * 64 + j);
                a0 -= av[0] * t[j];
                if (j + 1 < i) a1 -= av[1] * t[j + 1];
                if (j + 2 < i) a0 -= av[2] * t[j + 2];
                if (j + 3 < i) a1 -= av[3] * t[j + 3];
            }
            t[i] = a0 + a1;
            *(LAS unsigned short*)(L + DP_TM + i * 144 + 2 * lane) = (unsigned short)(cvt_pk_bf16(t[i], 0.f) & 0xffffu);
        }
    } else {
        const int e0 = tid - 64;
        const float gl = gcs[63];
        for (int e = e0; e < 8192; e += 448) {
            const int kk = e >> 12, t = e & 63, dp = (e >> 6) & 63;
            const unsigned u = *(const LAS unsigned*)(L + (kk ? DP_K : DP_V) + t * 272 + 4 * dp);
            const float sc = kk ? bts[t] * __expf(gcs[t]) : bts[t];
            const unsigned pk = cvt_pk_bf16(bf_lo(u) * sc, bf_hi(u) * sc);
            LAS unsigned short* d0 = (LAS unsigned short*)(L + (kk ? DP_RTK : DP_RTV) + (2 * dp) * 144 + 2 * t);
            d0[0] = (unsigned short)(pk & 0xffffu); d0[72] = (unsigned short)(pk >> 16);
        }
        for (int e = e0; e < 1024; e += 448) {
            const int t = e >> 4, c16 = e & 15; const float sc = __expf(gcs[t]);
            const u32x4 u = *(const LAS u32x4*)(L + DP_Q + t * 272 + 16 * c16);
            u32x4 o; o.x = cvt_pk_bf16(bf_lo(u.x) * sc, bf_hi(u.x) * sc); o.y = cvt_pk_bf16(bf_lo(u.y) * sc, bf_hi(u.y) * sc); o.z = cvt_pk_bf16(bf_lo(u.z) * sc, bf_hi(u.z) * sc); o.w = cvt_pk_bf16(bf_lo(u.w) * sc, bf_hi(u.w) * sc);
            { bf16_t* qd = V_DQG + chs * 8192 + (size_t)t * 128 + 32 * (c16 >> 2) + 16 * (c16 & 1) + 4 * ((c16 >> 1) & 1); *(u32x2*)qd = (u32x2){o.x, o.y}; *(u32x2*)(qd + 8) = (u32x2){o.z, o.w}; }
        }
        for (int e = e0; e < 1024; e += 448) {
            const int dk = e >> 3, t8 = (e & 7) * 8;
            float v[8];
#pragma unroll
            for (int q = 0; q < 8; ++q) v[q] = bf1(*(const LAS unsigned short*)(L + DP_K + (t8 + q) * 272 + 2 * dk)) * __expf(gl - gcs[t8 + q]);
            u32x4 o; o.x = cvt_pk_bf16(v[0], v[1]); o.y = cvt_pk_bf16(v[2], v[3]); o.z = cvt_pk_bf16(v[4], v[5]); o.w = cvt_pk_bf16(v[6], v[7]);
            { bf16_t* kd = V_DKT + chs * 8192 + (size_t)dk * 64 + 32 * (t8 >> 5) + 16 * ((t8 >> 3) & 1) + 4 * ((t8 >> 4) & 1); *(u32x2*)kd = (u32x2){o.x, o.y}; *(u32x2*)(kd + 8) = (u32x2){o.z, o.w}; }
        }
        if (tid == 64) V_DDL[ch] = __expf(gl);
    }
    __syncthreads();
#pragma unroll
    for (int q = 0; q < 4; ++q) {
        const int id = 4 * w + q;
        { const int m = id >> 2, n = id & 3;
          const LAS unsigned char* ap = L + DP_RTK + (16 * m + li) * 144 + 16 * q4; const LAS unsigned char* bp = L + DP_TM + (16 * n + li) * 144 + 16 * q4;
          f32x4 acc = (f32x4){0.f, 0.f, 0.f, 0.f};
#pragma unroll
          for (int s2 = 0; s2 < 2; ++s2) acc = mfma16(*(const LAS bf16x8*)(ap + 64 * s2), *(const LAS bf16x8*)(bp + 64 * s2), acc);
          u32x2 pk; pk.x = cvt_pk_bf16(acc[0], acc[1]); pk.y = cvt_pk_bf16(acc[2], acc[3]);
          *(u32x2*)(V_DW + chs * 8192 + (size_t)(16 * n + li) * 128 + 32 * (m >> 1) + 8 * q4 + 4 * (m & 1)) = pk; }
        { const int mb = id & 3, nj = id >> 2;
          const LAS unsigned char* ap = L + DP_TM + (16 * mb + li) * 144 + 16 * q4; const LAS unsigned char* bp = L + DP_RTV + (16 * nj + li) * 144 + 16 * q4;
          f32x4 acc = (f32x4){0.f, 0.f, 0.f, 0.f};
#pragma unroll
          for (int s2 = 0; s2 < 2; ++s2) acc = mfma16(*(const LAS bf16x8*)(ap + 64 * s2), *(const LAS bf16x8*)(bp + 64 * s2), acc);
          *(f32x4*)(V_DU + ((chs * 8 + nj) * 64 + lane) * 16 + 4 * mb) = acc; }
    }
    __syncthreads();
}
__device__ __forceinline__ bf16x8 ld_perm(const LAS unsigned char* p) { const u32x2 a = *(const LAS u32x2*)p, b = *(const LAS u32x2*)(p + 32); u32x4 r; r.x = a.x; r.y = a.y; r.z = b.x; r.w = b.y; return __builtin_bit_cast(bf16x8, r); }
__device__ __forceinline__ bf16x8 pack_b(const f32x4 lo, const f32x4 hi) { u32x4 r; r.x = cvt_pk_bf16(lo[0], lo[1]); r.y = cvt_pk_bf16(lo[2], lo[3]); r.z = cvt_pk_bf16(hi[0], hi[1]); r.w = cvt_pk_bf16(hi[2], hi[3]); return __builtin_bit_cast(bf16x8, r); }
template <int DK, bool HAS_W>
__device__ __forceinline__ void chunk_scan_item(Ctx& F, const bf16_t* gW, const bf16_t* gQG, const bf16_t* gKT, const bf16_t* gAT, const float* gU, const bf16_t* vrow  , const float* gDL, float dl_const,
                                                float* obase  , float* Sout  ) {
    constexpr int RS_ = DK * 2 + 16;
    constexpr int OFF_QG = HAS_W ? 64 * RS_ : 0, OFF_KT = OFF_QG + 64 * RS_, OFF_AT = OFF_KT + DK * 144, BUF = OFF_AT + 64 * 144;
    constexpr int NWQ = (64 * DK / 8) / 512;
    constexpr int MT = DK / 16, KS = DK / 32;
    const int tid = F.tid, lane = F.lane, w = F.wave, li = lane & 15, q4 = lane >> 4;
    LAS unsigned char* L = F.lds;
    f32x4 S[MT];
#pragma unroll
    for (int m = 0; m < MT; ++m) S[m] = (f32x4){0.f, 0.f, 0.f, 0.f};
    u32x4 pfw[NWQ], pfq[NWQ], pfk[NWQ], pfa; f32x4 un[4];
#define CS_LOAD(cv) do { const size_t c_ = (cv); \
        _Pragma("unroll") for (int i_ = 0; i_ < NWQ; ++i_) { if (HAS_W) pfw[i_] = *(const u32x4*)(gW + c_ * (64 * DK) + (size_t)(tid + 512 * i_) * 8); \
            pfq[i_] = *(const u32x4*)(gQG + c_ * (64 * DK) + (size_t)(tid + 512 * i_) * 8); pfk[i_] = *(const u32x4*)(gKT + c_ * (64 * DK) + (size_t)(tid + 512 * i_) * 8); } \
        pfa = *(const u32x4*)(gAT + c_ * 4096 + (size_t)tid * 8); \
        if (HAS_W) { _Pragma("unroll") for (int m_ = 0; m_ < 4; ++m_) un[m_] = *(const f32x4*)(gU + ((c_ * 8 + w) * 64 + lane) * 16 + 4 * m_); } \
        else { const bf16_t* vp_ = vrow + (size_t)(64 * c_ + 4 * q4) * NPROJ + 16 * w + li; _Pragma("unroll") for (int m_ = 0; m_ < 4; ++m_) _Pragma("unroll") for (int r_ = 0; r_ < 4; ++r_) un[m_][r_] = bf1(vp_[(size_t)(16 * m_ + r_) * NPROJ]); } } while (0)
#define CS_STORE(bufv) do { LAS unsigned char* B_ = L + (bufv) * BUF; \
        _Pragma("unroll") for (int i_ = 0; i_ < NWQ; ++i_) { const int u_ = tid + 512 * i_; \
            if (HAS_W) *(LAS u32x4*)(B_ + (u_ / (DK / 8)) * RS_ + (u_ % (DK / 8)) * 16) = pfw[i_]; \
            *(LAS u32x4*)(B_ + OFF_QG + (u_ / (DK / 8)) * RS_ + (u_ % (DK / 8)) * 16) = pfq[i_]; \
            *(LAS u32x4*)(B_ + OFF_KT + (u_ >> 3) * 144 + (u_ & 7) * 16) = pfk[i_]; } \
        *(LAS u32x4*)(B_ + OFF_AT + (tid >> 3) * 144 + (tid & 7) * 16) = pfa; } while (0)
    CS_LOAD(0);
    CS_STORE(0);
    f32x4 uc[4];
#pragma unroll
    for (int m = 0; m < 4; ++m) uc[m] = un[m];
    float dl = gDL ? gDL[0] : dl_const;
    __syncthreads();
#pragma unroll 1
    for (int c = 0; c < 64; ++c) {
        const LAS unsigned char* Bf = L + (c & 1) * BUF;
        float dln = dl_const;
        if (c + 1 < 64) { CS_LOAD(c + 1); if (gDL) dln = gDL[c + 1]; }
        bf16x8 Sb[KS];
#pragma unroll
        for (int s2 = 0; s2 < KS; ++s2) Sb[s2] = pack_b(S[2 * s2], S[2 * s2 + 1]);
        const LAS unsigned char* fb = Bf + li * RS_ + 16 * q4;
        const LAS unsigned char* fb2 = Bf + li * 144 + 16 * q4;
        f32x4 vn[4];
        if (HAS_W) {
            bf16x8 fw[4][KS];
#pragma unroll
            for (int mb = 0; mb < 4; ++mb)
#pragma unroll
                for (int s2 = 0; s2 < KS; ++s2) fw[mb][s2] = *(const LAS bf16x8*)(fb + mb * 16 * RS_ + 64 * s2);
#pragma unroll
            for (int mb = 0; mb < 4; ++mb) vn[mb] = (f32x4){0.f, 0.f, 0.f, 0.f};
#pragma unroll
            for (int s2 = 0; s2 < KS; ++s2)
#pragma unroll
                for (int mb = 0; mb < 4; ++mb) vn[mb] = mfma16(fw[mb][s2], Sb[s2], vn[mb]);
#pragma unroll
            for (int mb = 0; mb < 4; ++mb) vn[mb] = uc[mb] - vn[mb];
        } else {
#pragma unroll
            for (int mb = 0; mb < 4; ++mb) vn[mb] = uc[mb];
        }
        bf16x8 Vb[2];
        Vb[0] = pack_b(vn[0], vn[1]); Vb[1] = pack_b(vn[2], vn[3]);
        {
            bf16x8 fq[4][KS], fa[4][2];
#pragma unroll
            for (int mb = 0; mb < 4; ++mb) {
#pragma unroll
                for (int s2 = 0; s2 < KS; ++s2) fq[mb][s2] = *(const LAS bf16x8*)(fb + OFF_QG + mb * 16 * RS_ + 64 * s2);
#pragma unroll
                for (int s2 = 0; s2 < 2; ++s2) fa[mb][s2] = *(const LAS bf16x8*)(fb2 + OFF_AT + mb * 16 * 144 + 64 * s2);
            }
            f32x4 oa[4];
#pragma unroll
            for (int mb = 0; mb < 4; ++mb) oa[mb] = (f32x4){0.f, 0.f, 0.f, 0.f};
#pragma unroll
            for (int s2 = 0; s2 < KS; ++s2)
#pragma unroll
                for (int mb = 0; mb < 4; ++mb) oa[mb] = mfma16(fq[mb][s2], Sb[s2], oa[mb]);
#pragma unroll
            for (int s2 = 0; s2 < 2; ++s2)
#pragma unroll
                for (int mb = 0; mb < 4; ++mb) oa[mb] = mfma16(fa[mb][s2], Vb[s2], oa[mb]);
            float* od = obase + (size_t)(64 * c + 4 * q4) * 512 + 16 * w + li;
#pragma unroll
            for (int mb = 0; mb < 4; ++mb)
#pragma unroll
                for (int rg = 0; rg < 4; ++rg) od[(size_t)(16 * mb + rg) * 512] = oa[mb][rg];
        }
        {
            bf16x8 fk[MT][2];
#pragma unroll
            for (int m = 0; m < MT; ++m)
#pragma unroll
                for (int s2 = 0; s2 < 2; ++s2) fk[m][s2] = *(const LAS bf16x8*)(fb2 + OFF_KT + m * 16 * 144 + 64 * s2);
#pragma unroll
            for (int m = 0; m < MT; ++m) S[m] = S[m] * dl;
#pragma unroll
            for (int s2 = 0; s2 < 2; ++s2)
#pragma unroll
                for (int m = 0; m < MT; ++m) S[m] = mfma16(fk[m][s2], Vb[s2], S[m]);
        }
        if (c + 1 < 64) { CS_STORE((c + 1) & 1);
#pragma unroll
            for (int m = 0; m < 4; ++m) uc[m] = un[m];
            dl = dln; }
        __syncthreads();
    }
#undef CS_LOAD
#undef CS_STORE
    float* So = Sout + 16 * w + li;
#pragma unroll
    for (int m = 0; m < MT; ++m)
#pragma unroll
        for (int rg = 0; rg < 4; ++rg) So[(size_t)(16 * m + 4 * q4 + rg) * 128] = S[m][rg];
    __syncthreads();
}

constexpr int D2_BUF = 35840, D2_KT = 17408;
__device__ __forceinline__ void delta_scan2_item(Ctx& F, int l, int b, int h) {
    const int tid = F.tid, lane = F.lane, w = F.wave, li = lane & 15, q4 = lane >> 4;
    LAS unsigned char* L = F.lds;
    const size_t ch0 = (size_t)(b * 4 + h) * 64;
    const bf16_t* gW = V_DW + ch0 * 8192; const bf16_t* gKT = V_DKT + ch0 * 8192; const float* gU = V_DU + ch0 * 8192; const float* gDL = V_DDL + ch0;
    bf16_t* gSB = V_SB + ch0 * 16384; bf16_t* gVB = V_VB + ch0 * 8192;
    f32x4 S[8];
#pragma unroll
    for (int m = 0; m < 8; ++m) S[m] = (f32x4){0.f, 0.f, 0.f, 0.f};
    u32x4 pa[4], pb[4]; f32x4 ua[4], ub[4], uc[4]; float dla = 0.f, dlb = 0.f, dl;
#define D2_LOAD(P, U_, DL_, cv) do { const size_t c_ = (cv); \
        P[0] = *(const u32x4*)(gW + c_ * 8192 + (size_t)tid * 8); P[1] = *(const u32x4*)(gW + c_ * 8192 + (size_t)(tid + 512) * 8); \
        P[2] = *(const u32x4*)(gKT + c_ * 8192 + (size_t)tid * 8); P[3] = *(const u32x4*)(gKT + c_ * 8192 + (size_t)(tid + 512) * 8); \
        _Pragma("unroll") for (int m_ = 0; m_ < 4; ++m_) U_[m_] = *(const f32x4*)(gU + ((c_ * 8 + w) * 64 + lane) * 16 + 4 * m_); DL_ = gDL[c_]; } while (0)
#define D2_STORE(P, bufv) do { LAS unsigned char* B_ = L + (bufv) * D2_BUF; \
        *(LAS u32x4*)(B_ + (tid >> 4) * 272 + (tid & 15) * 16) = P[0]; *(LAS u32x4*)(B_ + ((tid >> 4) + 32) * 272 + (tid & 15) * 16) = P[1]; \
        *(LAS u32x4*)(B_ + D2_KT + (tid >> 3) * 144 + (tid & 7) * 16) = P[2]; *(LAS u32x4*)(B_ + D2_KT + ((tid >> 3) + 64) * 144 + (tid & 7) * 16) = P[3]; } while (0)
#define D2_COMPUTE(bufv, cv) do { const LAS unsigned char* Bf = L + (bufv) * D2_BUF; const size_t c_ = (cv); \
        bf16x8 Sb[4]; \
        _Pragma("unroll") for (int s2 = 0; s2 < 4; ++s2) { Sb[s2] = pack_b(S[2 * s2], S[2 * s2 + 1]); *(bf16x8*)(gSB + (((c_ * 8 + w) * 4 + s2) * 64 + lane) * 8) = Sb[s2]; } \
        const LAS unsigned char* fb = Bf + li * 272 + 16 * q4; const LAS unsigned char* fb2 = Bf + D2_KT + li * 144 + 16 * q4; \
        f32x4 vn[4]; \
        { bf16x8 fw[4][4]; \
          _Pragma("unroll") for (int mb = 0; mb < 4; ++mb) _Pragma("unroll") for (int s2 = 0; s2 < 4; ++s2) fw[mb][s2] = *(const LAS bf16x8*)(fb + mb * 16 * 272 + 64 * s2); \
          _Pragma("unroll") for (int mb = 0; mb < 4; ++mb) vn[mb] = (f32x4){0.f, 0.f, 0.f, 0.f}; \
          _Pragma("unroll") for (int s2 = 0; s2 < 4; ++s2) _Pragma("unroll") for (int mb = 0; mb < 4; ++mb) vn[mb] = mfma16(fw[mb][s2], Sb[s2], vn[mb]); } \
        _Pragma("unroll") for (int mb = 0; mb < 4; ++mb) vn[mb] = uc[mb] - vn[mb]; \
        bf16x8 Vb[2]; Vb[0] = pack_b(vn[0], vn[1]); Vb[1] = pack_b(vn[2], vn[3]); \
        _Pragma("unroll") for (int s2 = 0; s2 < 2; ++s2) *(bf16x8*)(gVB + (((c_ * 8 + w) * 2 + s2) * 64 + lane) * 8) = Vb[s2]; \
        { bf16x8 fk[8][2]; \
          _Pragma("unroll") for (int m = 0; m < 8; ++m) _Pragma("unroll") for (int s2 = 0; s2 < 2; ++s2) fk[m][s2] = *(const LAS bf16x8*)(fb2 + m * 16 * 144 + 64 * s2); \
          _Pragma("unroll") for (int m = 0; m < 8; ++m) S[m] = S[m] * dl; \
          _Pragma("unroll") for (int s2 = 0; s2 < 2; ++s2) _Pragma("unroll") for (int m = 0; m < 8; ++m) S[m] = mfma16(fk[m][s2], Vb[s2], S[m]); } } while (0)
    D2_LOAD(pa, ua, dla, 0);
    D2_LOAD(pb, ub, dlb, 1);
    D2_STORE(pa, 0);
#pragma unroll
    for (int m = 0; m < 4; ++m) uc[m] = ua[m];
    dl = dla;
    __syncthreads();
#pragma unroll 1
    for (int c = 0; c < 64; c += 2) {
        if (c + 2 < 64) D2_LOAD(pa, ua, dla, c + 2);
        D2_COMPUTE(0, c);
        D2_STORE(pb, 1);
#pragma unroll
        for (int m = 0; m < 4; ++m) uc[m] = ub[m];
        dl = dlb;
        __syncthreads();
        if (c + 3 < 64) D2_LOAD(pb, ub, dlb, c + 3);
        D2_COMPUTE(1, c + 1);
        if (c + 2 < 64) { D2_STORE(pa, 0);
#pragma unroll
            for (int m = 0; m < 4; ++m) uc[m] = ua[m];
            dl = dla; }
        __syncthreads();
    }
#undef D2_LOAD
#undef D2_STORE
#undef D2_COMPUTE
    float* So = F.out + O_BSP + ((size_t)(l * BATCH + b) * 4 + h) * 16384 + 16 * w + li;
#pragma unroll
    for (int m = 0; m < 8; ++m)
#pragma unroll
        for (int rg = 0; rg < 4; ++rg) So[(size_t)(16 * m + 4 * q4 + rg) * 128] = S[m][rg];
    __syncthreads();
}
__device__ __forceinline__ void delta_out_item(Ctx& F, int l, int ch) {
    const int tid = F.tid, lane = F.lane, w = F.wave, li = lane & 15, q4 = lane >> 4;
    const int c = ch & 63, h = (ch >> 6) & 3, b = ch >> 8;
    const int row0 = b * SEQ + 64 * c;
    LAS unsigned char* L = F.lds;
    const size_t chs = (size_t)ch;
    const u32x4 q0 = *(const u32x4*)(V_DQG + chs * 8192 + (size_t)tid * 8), q1 = *(const u32x4*)(V_DQG + chs * 8192 + (size_t)(tid + 512) * 8), a0 = *(const u32x4*)(V_DAT + chs * 4096 + (size_t)tid * 8);
    bf16x8 Sb[4], Vb[2];
#pragma unroll
    for (int s2 = 0; s2 < 4; ++s2) Sb[s2] = *(const bf16x8*)(V_SB + (((chs * 8 + w) * 4 + s2) * 64 + lane) * 8);
#pragma unroll
    for (int s2 = 0; s2 < 2; ++s2) Vb[s2] = *(const bf16x8*)(V_VB + (((chs * 8 + w) * 2 + s2) * 64 + lane) * 8);
    const float gn = F.in[15][l * 128 + 16 * w + li];
    const bf16_t* zp = V_PROJ + (size_t)(row0 + 4 * q4) * NPROJ + PC_BZ + h * 128 + 16 * w + li;
    float zz[16];
#pragma unroll
    for (int i = 0; i < 16; ++i) zz[i] = bf1(zp[(size_t)(16 * (i >> 2) + (i & 3)) * NPROJ]);
    *(LAS u32x4*)(L + (tid >> 4) * 272 + (tid & 15) * 16) = q0; *(LAS u32x4*)(L + ((tid >> 4) + 32) * 272 + (tid & 15) * 16) = q1;
    *(LAS u32x4*)(L + 17408 + (tid >> 3) * 144 + (tid & 7) * 16) = a0;
    __syncthreads();
    f32x4 oa[4];
    {
        const LAS unsigned char* fb = L + li * 272 + 16 * q4; const LAS unsigned char* fb2 = L + 17408 + li * 144 + 16 * q4;
        bf16x8 fq[4][4], fa[4][2];
#pragma unroll
        for (int mb = 0; mb < 4; ++mb) {
#pragma unroll
            for (int s2 = 0; s2 < 4; ++s2) fq[mb][s2] = *(const LAS bf16x8*)(fb + mb * 16 * 272 + 64 * s2);
#pragma unroll
            for (int s2 = 0; s2 < 2; ++s2) fa[mb][s2] = *(const LAS bf16x8*)(fb2 + mb * 16 * 144 + 64 * s2);
        }
#pragma unroll
        for (int mb = 0; mb < 4; ++mb) oa[mb] = (f32x4){0.f, 0.f, 0.f, 0.f};
#pragma unroll
        for (int s2 = 0; s2 < 4; ++s2)
#pragma unroll
            for (int mb = 0; mb < 4; ++mb) oa[mb] = mfma16(fq[mb][s2], Sb[s2], oa[mb]);
#pragma unroll
        for (int s2 = 0; s2 < 2; ++s2)
#pragma unroll
            for (int mb = 0; mb < 4; ++mb) oa[mb] = mfma16(fa[mb][s2], Vb[s2], oa[mb]);
    }
    LAS float* part = (LAS float*)(L + 32768);
#pragma unroll
    for (int mb = 0; mb < 4; ++mb)
#pragma unroll
        for (int rg = 0; rg < 4; ++rg) { float ss = oa[mb][rg] * oa[mb][rg];
            ss = row_sum16(ss);
            if (li == 0) part[(16 * mb + 4 * q4 + rg) * 8 + w] = ss; }
    __syncthreads();
    bf16_t* od = V_OABC + (size_t)M * 512 + (size_t)(row0 + 4 * q4) * 512 + h * 128 + 16 * w + li;
#pragma unroll
    for (int mb = 0; mb < 4; ++mb)
#pragma unroll
        for (int rg = 0; rg < 4; ++rg) { const int tk = 16 * mb + 4 * q4 + rg;
            const f32x4 p0 = *(const LAS f32x4*)(part + tk * 8), p1 = *(const LAS f32x4*)(part + tk * 8 + 4);
            const float rstd = rsqrtf(((p0[0] + p0[1]) + (p0[2] + p0[3]) + (p1[0] + p1[1]) + (p1[2] + p1[3])) * (1.f / 128.f) + EPS);
            const float z = zz[4 * mb + rg];
            od[(size_t)(16 * mb + rg) * 512] = (bf16_t)(cvt_pk_bf16(oa[mb][rg] * rstd * gn * z * sigmoidf_(z), 0.f) & 0xffffu); }
    __syncthreads();
}
__device__ __forceinline__ void delta_scan_item(Ctx& F, int l, int b, int h) {
    const size_t ch0 = (size_t)(b * 4 + h) * 64;
    chunk_scan_item<128, true>(F, V_DW + ch0 * 8192, V_DQG + ch0 * 8192, V_DKT + ch0 * 8192, V_DAT + ch0 * 4096, V_DU + ch0 * 8192, nullptr, V_DDL + ch0, 0.f,
                               V_OBR + (size_t)(b * SEQ) * 512 + h * 128, F.out + O_BSP + ((size_t)(l * BATCH + b) * 4 + h) * 16384);
}
__device__ __forceinline__ void ret_scan_item(Ctx& F, int l, int b, int h) {
    const size_t ch0 = (size_t)(b * 4 + h) * 64;
    const float lg2 = log2f(1.f - exp2f(-5.f - (float)h));
    chunk_scan_item<64, false>(F, nullptr, V_RQG + ch0 * 4096, V_RKT + ch0 * 4096, V_RAT + ch0 * 4096, nullptr, V_PROJ + (size_t)(b * SEQ) * NPROJ + PC_CV + h * 128, nullptr, exp2f(64.f * lg2),
                               V_OCR + (size_t)(b * SEQ) * 512 + h * 128, F.out + O_CRP + ((size_t)(l * BATCH + b) * 4 + h) * 8192);
}
__device__ __forceinline__ void ret_prep_item(Ctx& F, int l, int item) {
    const int tid = F.tid, lane = F.lane, w = F.wave, li = lane & 15, q4 = lane >> 4;
    const int pj = w >> 1, t2 = tid & 127, w2 = w & 1;
    const int ch = 4 * item + pj, c = ch & 63, h = (ch >> 6) & 3, b = ch >> 8;
    const int row0 = b * SEQ + 64 * c;
    const bf16_t* proj = V_PROJ;
    LAS unsigned char* L = F.lds + pj * 18432;
    const float lg2 = log2f(1.f - exp2f(-5.f - (float)h));
    const size_t chs = (size_t)ch;
#pragma unroll
    for (int k8 = 0; k8 < 8; ++k8) {
        const int task = t2 + 128 * k8, qk = task >> 9, t = (task >> 3) & 63, i0 = 4 * (task & 7);
        const float* cs = V_ROPEC + ((size_t)(64 * c + t) * 32 + i0) * 2;
        const f32x4 c01 = *(const f32x4*)cs, c23 = *(const f32x4*)(cs + 4);
        const f32x4 cc = (f32x4){c01[0], c01[2], c23[0], c23[2]}, sn = (f32x4){c01[1], c01[3], c23[1], c23[3]};
        const bf16_t* p = proj + (size_t)(row0 + t) * NPROJ + (qk ? PC_CK : PC_CQ) + h * 64;
        const u32x2 ulo = *(const u32x2*)(p + i0), uhi = *(const u32x2*)(p + 32 + i0);
        const f32x4 lo = (f32x4){bf_lo(ulo.x), bf_hi(ulo.x), bf_lo(ulo.y), bf_hi(ulo.y)}, hi = (f32x4){bf_lo(uhi.x), bf_hi(uhi.x), bf_lo(uhi.y), bf_hi(uhi.y)};
        const float sc = qk ? 0.125f : 1.f;
        const f32x4 olo = (lo * cc - hi * sn) * sc, ohi = (hi * cc + lo * sn) * sc;
        u32x2 plo, phi; plo.x = cvt_pk_bf16(olo[0], olo[1]); plo.y = cvt_pk_bf16(olo[2], olo[3]); phi.x = cvt_pk_bf16(ohi[0], ohi[1]); phi.y = cvt_pk_bf16(ohi[2], ohi[3]);
        *(LAS u32x2*)(L + qk * 9216 + t * 144 + 2 * i0) = plo; *(LAS u32x2*)(L + qk * 9216 + t * 144 + 64 + 2 * i0) = phi;
    }
    __syncthreads();
#pragma unroll
    for (int t8 = 0; t8 < 8; ++t8) {
        const int tile = 8 * w2 + t8, mi = tile >> 2, nj = tile & 3;
        bf16_t* ad = V_RAT + chs * 4096 + (size_t)(16 * mi + li) * 64 + 32 * (nj >> 1) + 8 * q4 + 4 * (nj & 1);
        if (nj <= mi) {
            f32x4 aqk = (f32x4){0.f, 0.f, 0.f, 0.f};
            const LAS unsigned char* kj = L + 9216 + (16 * nj + li) * 144 + 16 * q4; const LAS unsigned char* qi = L + (16 * mi + li) * 144 + 16 * q4;
#pragma unroll
            for (int s2 = 0; s2 < 2; ++s2) aqk = mfma16(*(const LAS bf16x8*)(kj + 64 * s2), *(const LAS bf16x8*)(qi + 64 * s2), aqk);
            float ov[4];
#pragma unroll
            for (int rg = 0; rg < 4; ++rg) { const int j2 = 16 * nj + 4 * q4 + rg, i2 = 16 * mi + li; ov[rg] = (i2 >= j2) ? aqk[rg] * exp2f((float)(i2 - j2) * lg2) : 0.f; }
            u32x2 pk; pk.x = cvt_pk_bf16(ov[0], ov[1]); pk.y = cvt_pk_bf16(ov[2], ov[3]); *(u32x2*)ad = pk;
        } else { *(u32x2*)ad = (u32x2){0u, 0u}; }
    }
#pragma unroll
    for (int k4 = 0; k4 < 4; ++k4) {
        const int u_ = t2 + 128 * k4;
        { const int t = u_ >> 3, c8 = u_ & 7; const float sc = exp2f((float)(t + 1) * lg2);
          const u32x4 u = *(const LAS u32x4*)(L + t * 144 + 16 * c8);
          u32x4 o; o.x = cvt_pk_bf16(bf_lo(u.x) * sc, bf_hi(u.x) * sc); o.y = cvt_pk_bf16(bf_lo(u.y) * sc, bf_hi(u.y) * sc); o.z = cvt_pk_bf16(bf_lo(u.z) * sc, bf_hi(u.z) * sc); o.w = cvt_pk_bf16(bf_lo(u.w) * sc, bf_hi(u.w) * sc);
          bf16_t* qd = V_RQG + chs * 4096 + (size_t)t * 64 + 32 * (c8 >> 2) + 16 * (c8 & 1) + 4 * ((c8 >> 1) & 1); *(u32x2*)qd = (u32x2){o.x, o.y}; *(u32x2*)(qd + 8) = (u32x2){o.z, o.w}; }
        { const int dk = u_ >> 3, t8 = (u_ & 7) * 8;
          float v[8];
#pragma unroll
          for (int q = 0; q < 8; ++q) v[q] = bf1(*(const LAS unsigned short*)(L + 9216 + (t8 + q) * 144 + 2 * dk)) * exp2f((float)(63 - t8 - q) * lg2);
          u32x4 o2; o2.x = cvt_pk_bf16(v[0], v[1]); o2.y = cvt_pk_bf16(v[2], v[3]); o2.z = cvt_pk_bf16(v[4], v[5]); o2.w = cvt_pk_bf16(v[6], v[7]);
          bf16_t* kd = V_RKT + chs * 4096 + (size_t)dk * 64 + 32 * (t8 >> 5) + 16 * ((t8 >> 3) & 1) + 4 * ((t8 >> 4) & 1); *(u32x2*)kd = (u32x2){o2.x, o2.y}; *(u32x2*)(kd + 8) = (u32x2){o2.z, o2.w}; }
    }
    __syncthreads();
}
__device__ __forceinline__ void delta_item(Ctx& F, int l, bool sample, int b, int h) {
    LAS float* sm = (LAS float*)F.lds;
    LAS float* qs = sm, *ks = sm + 2048, *vs = sm + 4096, *bgs = sm + 6144, *pa = sm + 6400, *pb = sm + 6912;
    const int tid = F.tid, c = tid & 127, qr = tid >> 7;
    float s[32];
    if (sample) { const float* S0 = F.in[6] + ((size_t)(l * DB + b) * 4 + h) * 16384;
#pragma unroll
        for (int i = 0; i < 32; ++i) s[i] = S0[(32 * qr + i) * 128 + c]; }
    else {
#pragma unroll
        for (int i = 0; i < 32; ++i) s[i] = 0.f; }
    const int T = sample ? DS : SEQ, row0 = sample ? MP + b * DS : b * SEQ;
    for (int t0 = 0; t0 < T; t0 += 16) {
        const int nt = min(16, T - t0);
        __syncthreads();
#pragma unroll
        for (int r = 0; r < 12; ++r) { const int e = tid + 512 * r, tok = e / 384, w = e - tok * 384, typ = w >> 7, d = w & 127;
            if (tok < nt) sm[typ * 2048 + tok * 128 + d] = V_BQKV[(size_t)(row0 + t0 + tok) * 1536 + typ * 512 + h * 128 + d]; }
        if (tid < 32) { const int tok = tid >> 1, wh = tid & 1; if (tok < nt) bgs[tok * 2 + wh] = V_BG[(size_t)(row0 + t0 + tok) * 8 + wh * 4 + h]; }
        __syncthreads();
        for (int tt = 0; tt < nt; ++tt) {
            const LAS float* kk = ks + tt * 128 + 32 * qr; const LAS float* qq = qs + tt * 128 + 32 * qr;
            float a = 0.f;
#pragma unroll
            for (int i = 0; i < 32; ++i) a += kk[i] * s[i];
            pa[qr * 128 + c] = a;
            __syncthreads();
            const float kS = (pa[c] + pa[128 + c]) + (pa[256 + c] + pa[384 + c]);
            const float e = __expf(bgs[tt * 2 + 1]), be = bgs[tt * 2];
            const float vn = be * (vs[tt * 128 + c] - e * kS);
            float o = 0.f;
#pragma unroll
            for (int i = 0; i < 32; ++i) { s[i] = e * s[i] + kk[i] * vn; o += qq[i] * s[i]; }
            pb[qr * 128 + c] = o;
            __syncthreads();
            if (qr == 0) V_OBR[(size_t)(row0 + t0 + tt) * 512 + h * 128 + c] = (pb[c] + pb[128 + c]) + (pb[256 + c] + pb[384 + c]);
        }
    }
    float* So = F.out + (sample ? O_BSS + ((size_t)(l * DB + b) * 4 + h) * 16384 : O_BSP + ((size_t)(l * BATCH + b) * 4 + h) * 16384);
#pragma unroll
    for (int i = 0; i < 32; ++i) So[(32 * qr + i) * 128 + c] = s[i];
    __syncthreads();
}
__device__ __forceinline__ void ret_item(Ctx& F, int l, bool sample, int b, int h) {
    LAS float* sm = (LAS float*)F.lds;
    LAS float* qs = sm, *ks = sm + 1024, *vs = sm + 2048, *pp = sm + 4096;
    const int tid = F.tid, c = tid & 127, qr = tid >> 7;
    const float gam = 1.f - exp2f(-5.f - (float)h);
    float r[16];
    if (sample) { const float* R0 = F.in[7] + ((size_t)(l * DB + b) * 4 + h) * 8192;
#pragma unroll
        for (int i = 0; i < 16; ++i) r[i] = R0[(16 * qr + i) * 128 + c]; }
    else {
#pragma unroll
        for (int i = 0; i < 16; ++i) r[i] = 0.f; }
    const int T = sample ? DS : SEQ, row0 = sample ? MP + b * DS : b * SEQ;
    for (int t0 = 0; t0 < T; t0 += 16) {
        const int nt = min(16, T - t0);
        __syncthreads();
#pragma unroll
        for (int rr = 0; rr < 4; ++rr) { const int e = tid + 512 * rr, tok = e >> 7, w = e & 127, typ = w >> 6, d = w & 63;
            if (tok < nt) sm[typ * 1024 + tok * 64 + d] = V_CQK[(size_t)(row0 + t0 + tok) * 512 + typ * 256 + h * 64 + d]; }
#pragma unroll
        for (int rr = 0; rr < 4; ++rr) { const int e = tid + 512 * rr, tok = e >> 7, d = e & 127;
            if (tok < nt) vs[tok * 128 + d] = bf1(V_PROJ[(size_t)(row0 + t0 + tok) * NPROJ + PC_CV + h * 128 + d]); }
        __syncthreads();
        for (int tt = 0; tt < nt; ++tt) {
            const LAS float* kk = ks + tt * 64 + 16 * qr; const LAS float* qq = qs + tt * 64 + 16 * qr;
            const float v = vs[tt * 128 + c];
            float o = 0.f;
#pragma unroll
            for (int i = 0; i < 16; ++i) { r[i] = gam * r[i] + kk[i] * v; o += qq[i] * r[i]; }
            LAS float* pq = pp + (tt & 1) * 512;
            pq[qr * 128 + c] = o;
            __syncthreads();
            if (qr == 0) V_OCR[(size_t)(row0 + t0 + tt) * 512 + h * 128 + c] = (pq[c] + pq[128 + c]) + (pq[256 + c] + pq[384 + c]);
        }
    }
    float* Ro = F.out + (sample ? O_CRS + ((size_t)(l * DB + b) * 4 + h) * 8192 : O_CRP + ((size_t)(l * BATCH + b) * 4 + h) * 8192);
#pragma unroll
    for (int i = 0; i < 16; ++i) Ro[(16 * qr + i) * 128 + c] = r[i];
    __syncthreads();
}
constexpr int IT_DP = 0, IT_RP = 16, IT_ATS = 32, IT_DS = IT_ATS + 384, IT_RS = IT_DS + 128, IT_AT = IT_RS + 128, IT_END = IT_AT + 768;
__device__ __forceinline__ void phase_mix(Ctx& F, int l, int rep) {
    volatile LAS int* slot = (volatile LAS int*)(F.lds + LDS_BYTES - 64);
    unsigned* ctr = V_CTL + (l == 0 ? CW_MIX0 : CW_MIX1) + 256 * rep;
    for (;;) {
        __syncthreads();
        if (F.tid == 0) *slot = (int)atomicAdd(ctr, 1u);
        __syncthreads();
        const int it = __builtin_amdgcn_readfirstlane(*slot);
        { int t_ = F.tid; asm volatile("" : "+v"(t_)); F.tid = t_; F.lane = t_ & 63; }
        if (it >= IT_END + (l == 0 ? (DEPTH * I_LAYER - I_IN) / 8 : 0)) break;
#ifndef MIXSEL
#define MIXSEL 15
#endif
        if (it < IT_RP) delta_scan2_item(F, l, it >> 2, it & 3);
        else if (it < IT_ATS) ret_scan_item(F, l, (it - IT_RP) >> 2, (it - IT_RP) & 3);
        else if (it < IT_DS) { const int u = (it - IT_ATS) * 8 + F.wave; attn_sample_unit(F, l, u / 12, (u % 12) & 3, (u % 12) >> 2); }
        else if (it < IT_RS) delta_item(F, l, true, (it - IT_DS) >> 2, (it - IT_DS) & 3);
        else if (it < IT_AT) ret_item(F, l, true, (it - IT_RS) >> 2, (it - IT_RS) & 3);
        else if (it < IT_END) attn_mfma_item(F, it - IT_AT);
        else { const int wi = I_IN + (it - IT_END) * 8 + F.wave; prep_weight_item(F, wi, (LAS float*)(F.lds + F.wave * 16896), F.lane); }
    }
}
__device__ __forceinline__ void fin_row(Ctx& F, int l, int row) {
    const int lane = F.lane, h = lane >> 4, j8 = 8 * (lane & 15);
    {
        const float l0 = V_LSE[((size_t)0 * M + row) * 4 + h], l1 = V_LSE[((size_t)1 * M + row) * 4 + h], l2 = V_LSE[((size_t)2 * M + row) * 4 + h];
        const u32x4 a0 = *(const u32x4*)(V_AO + ((size_t)0 * M + row) * 512 + h * 128 + j8), a1 = *(const u32x4*)(V_AO + ((size_t)1 * M + row) * 512 + h * 128 + j8), a2 = *(const u32x4*)(V_AO + ((size_t)2 * M + row) * 512 + h * 128 + j8);
        const float mm = fmaxf(l0, fmaxf(l1, l2)); float e0 = __expf(l0 - mm), e1 = __expf(l1 - mm), e2 = __expf(l2 - mm); const float iv = 1.f / (e0 + e1 + e2); e0 *= iv; e1 *= iv; e2 *= iv;
        u32x4 o;
        o.x = cvt_pk_bf16(e0 * bf_lo(a0.x) + e1 * bf_lo(a1.x) + e2 * bf_lo(a2.x), e0 * bf_hi(a0.x) + e1 * bf_hi(a1.x) + e2 * bf_hi(a2.x));
        o.y = cvt_pk_bf16(e0 * bf_lo(a0.y) + e1 * bf_lo(a1.y) + e2 * bf_lo(a2.y), e0 * bf_hi(a0.y) + e1 * bf_hi(a1.y) + e2 * bf_hi(a2.y));
        o.z = cvt_pk_bf16(e0 * bf_lo(a0.z) + e1 * bf_lo(a1.z) + e2 * bf_lo(a2.z), e0 * bf_hi(a0.z) + e1 * bf_hi(a1.z) + e2 * bf_hi(a2.z));
        o.w = cvt_pk_bf16(e0 * bf_lo(a0.w) + e1 * bf_lo(a1.w) + e2 * bf_lo(a2.w), e0 * bf_hi(a0.w) + e1 * bf_hi(a1.w) + e2 * bf_hi(a2.w));
        *(u32x4*)(V_OABC + (size_t)row * 512 + h * 128 + j8) = o;
    }
#pragma unroll
    for (int br = 0; br < 2; ++br) {
        if (br == 0 && row < MP) continue;
        const float* src = (br == 0 ? V_OBR : V_OCR) + (size_t)row * 512 + h * 128 + j8;
        const f32x4 x0 = *(const f32x4*)src, x1 = *(const f32x4*)(src + 4);
        const float* gn = F.in[15 + br] + l * 128 + j8;
        const f32x4 g0 = *(const f32x4*)gn, g1 = *(const f32x4*)(gn + 4);
        const u32x4 zz = *(const u32x4*)(V_PROJ + (size_t)row * NPROJ + (br == 0 ? PC_BZ : PC_CZ) + h * 128 + j8);
        const float ss = row_sum16((x0[0] * x0[0] + x0[1] * x0[1]) + (x0[2] * x0[2] + x0[3] * x0[3]) + (x1[0] * x1[0] + x1[1] * x1[1]) + (x1[2] * x1[2] + x1[3] * x1[3]));
        const float rstd = rsqrtf(ss * (1.f / 128.f) + EPS);
        const float z0 = bf_lo(zz.x), z1 = bf_hi(zz.x), z2 = bf_lo(zz.y), z3 = bf_hi(zz.y), z4 = bf_lo(zz.z), z5 = bf_hi(zz.z), z6 = bf_lo(zz.w), z7 = bf_hi(zz.w);
        u32x4 o;
        o.x = cvt_pk_bf16(x0[0] * rstd * g0[0] * z0 * sigmoidf_(z0), x0[1] * rstd * g0[1] * z1 * sigmoidf_(z1));
        o.y = cvt_pk_bf16(x0[2] * rstd * g0[2] * z2 * sigmoidf_(z2), x0[3] * rstd * g0[3] * z3 * sigmoidf_(z3));
        o.z = cvt_pk_bf16(x1[0] * rstd * g1[0] * z4 * sigmoidf_(z4), x1[1] * rstd * g1[1] * z5 * sigmoidf_(z5));
        o.w = cvt_pk_bf16(x1[2] * rstd * g1[2] * z6 * sigmoidf_(z6), x1[3] * rstd * g1[3] * z7 * sigmoidf_(z7));
        *(u32x4*)(V_OABC + (size_t)(1 + br) * M * 512 + (size_t)row * 512 + h * 128 + j8) = o;
    }
}

template <int NR>
__device__ __forceinline__ void fin_rows(Ctx& F, int l, const int (&rows)[NR]) {
    const int lane = F.lane, h = lane >> 4, j8 = 8 * (lane & 15);
    float ls[NR][3]; u32x4 ao[NR][3]; f32x4 xc[NR][2]; u32x4 zc[NR];
#pragma unroll
    for (int r = 0; r < NR; ++r) { const int row = rows[r];
#pragma unroll
        for (int g = 0; g < 3; ++g) { ls[r][g] = V_LSE[((size_t)g * M + row) * 4 + h]; ao[r][g] = *(const u32x4*)(V_AO + ((size_t)g * M + row) * 512 + h * 128 + j8); }
        const float* src = V_OCR + (size_t)row * 512 + h * 128 + j8; xc[r][0] = *(const f32x4*)src; xc[r][1] = *(const f32x4*)(src + 4);
        zc[r] = *(const u32x4*)(V_PROJ + (size_t)row * NPROJ + PC_CZ + h * 128 + j8);
    }
    const f32x4 gc0 = *(const f32x4*)(F.in[16] + l * 128 + j8), gc1 = *(const f32x4*)(F.in[16] + l * 128 + j8 + 4);
#pragma unroll
    for (int r = 0; r < NR; ++r) { const int row = rows[r];
        {
            const float mm = fmaxf(ls[r][0], fmaxf(ls[r][1], ls[r][2])); float e0 = __expf(ls[r][0] - mm), e1 = __expf(ls[r][1] - mm), e2 = __expf(ls[r][2] - mm); const float iv = 1.f / (e0 + e1 + e2); e0 *= iv; e1 *= iv; e2 *= iv;
            const u32x4 a0 = ao[r][0], a1 = ao[r][1], a2 = ao[r][2]; u32x4 o;
            o.x = cvt_pk_bf16(e0 * bf_lo(a0.x) + e1 * bf_lo(a1.x) + e2 * bf_lo(a2.x), e0 * bf_hi(a0.x) + e1 * bf_hi(a1.x) + e2 * bf_hi(a2.x));
            o.y = cvt_pk_bf16(e0 * bf_lo(a0.y) + e1 * bf_lo(a1.y) + e2 * bf_lo(a2.y), e0 * bf_hi(a0.y) + e1 * bf_hi(a1.y) + e2 * bf_hi(a2.y));
            o.z = cvt_pk_bf16(e0 * bf_lo(a0.z) + e1 * bf_lo(a1.z) + e2 * bf_lo(a2.z), e0 * bf_hi(a0.z) + e1 * bf_hi(a1.z) + e2 * bf_hi(a2.z));
            o.w = cvt_pk_bf16(e0 * bf_lo(a0.w) + e1 * bf_lo(a1.w) + e2 * bf_lo(a2.w), e0 * bf_hi(a0.w) + e1 * bf_hi(a1.w) + e2 * bf_hi(a2.w));
            *(u32x4*)(V_OABC + (size_t)row * 512 + h * 128 + j8) = o;
        }
        {
            const f32x4 x0 = xc[r][0], x1 = xc[r][1]; const u32x4 zz = zc[r]; const f32x4 g0 = gc0, g1 = gc1; const int br = 1;
            const float ss = row_sum16((x0[0] * x0[0] + x0[1] * x0[1]) + (x0[2] * x0[2] + x0[3] * x0[3]) + (x1[0] * x1[0] + x1[1] * x1[1]) + (x1[2] * x1[2] + x1[3] * x1[3]));
            const float rstd = rsqrtf(ss * (1.f / 128.f) + EPS);
            const float z0 = bf_lo(zz.x), z1 = bf_hi(zz.x), z2 = bf_lo(zz.y), z3 = bf_hi(zz.y), z4 = bf_lo(zz.z), z5 = bf_hi(zz.z), z6 = bf_lo(zz.w), z7 = bf_hi(zz.w);
            u32x4 o;
            o.x = cvt_pk_bf16(x0[0] * rstd * g0[0] * z0 * sigmoidf_(z0), x0[1] * rstd * g0[1] * z1 * sigmoidf_(z1));
            o.y = cvt_pk_bf16(x0[2] * rstd * g0[2] * z2 * sigmoidf_(z2), x0[3] * rstd * g0[3] * z3 * sigmoidf_(z3));
            o.z = cvt_pk_bf16(x1[0] * rstd * g1[0] * z4 * sigmoidf_(z4), x1[1] * rstd * g1[1] * z5 * sigmoidf_(z5));
            o.w = cvt_pk_bf16(x1[2] * rstd * g1[2] * z6 * sigmoidf_(z6), x1[3] * rstd * g1[3] * z7 * sigmoidf_(z7));
            *(u32x4*)(V_OABC + (size_t)(1 + br) * M * 512 + (size_t)row * 512 + h * 128 + j8) = o;
        }
    }
}

__device__ __forceinline__ void fin_b_row(Ctx& F, int l, int row) {
    const int lane = F.lane, h = lane >> 4, j8 = 8 * (lane & 15);
    const float* src = V_OBR + (size_t)row * 512 + h * 128 + j8; const f32x4 x0 = *(const f32x4*)src, x1 = *(const f32x4*)(src + 4);
    const u32x4 zz = *(const u32x4*)(V_PROJ + (size_t)row * NPROJ + PC_BZ + h * 128 + j8);
    const f32x4 g0 = *(const f32x4*)(F.in[15] + l * 128 + j8), g1 = *(const f32x4*)(F.in[15] + l * 128 + j8 + 4);
    const float ss = row_sum16((x0[0] * x0[0] + x0[1] * x0[1]) + (x0[2] * x0[2] + x0[3] * x0[3]) + (x1[0] * x1[0] + x1[1] * x1[1]) + (x1[2] * x1[2] + x1[3] * x1[3]));
    const float rstd = rsqrtf(ss * (1.f / 128.f) + EPS);
    const float z0 = bf_lo(zz.x), z1 = bf_hi(zz.x), z2 = bf_lo(zz.y), z3 = bf_hi(zz.y), z4 = bf_lo(zz.z), z5 = bf_hi(zz.z), z6 = bf_lo(zz.w), z7 = bf_hi(zz.w);
    u32x4 o;
    o.x = cvt_pk_bf16(x0[0] * rstd * g0[0] * z0 * sigmoidf_(z0), x0[1] * rstd * g0[1] * z1 * sigmoidf_(z1));
    o.y = cvt_pk_bf16(x0[2] * rstd * g0[2] * z2 * sigmoidf_(z2), x0[3] * rstd * g0[3] * z3 * sigmoidf_(z3));
    o.z = cvt_pk_bf16(x1[0] * rstd * g1[0] * z4 * sigmoidf_(z4), x1[1] * rstd * g1[1] * z5 * sigmoidf_(z5));
    o.w = cvt_pk_bf16(x1[2] * rstd * g1[2] * z6 * sigmoidf_(z6), x1[3] * rstd * g1[3] * z7 * sigmoidf_(z7));
    *(u32x4*)(V_OABC + (size_t)M * 512 + (size_t)row * 512 + h * 128 + j8) = o;
}
typedef float f32x16 __attribute__((ext_vector_type(16)));
template <int NSUB, bool GATED>
__device__ __forceinline__ void mini_gemm_core(Ctx& F, int tile, const bf16_t* A, size_t a_sub, const bf16_t* Bt, size_t b_sub, int K, float (&res)[2], int& orow, int& ocol, int (&oreg)[2]) {
    const int lane = F.lane, w = F.wave, r = lane & 31, hh = lane >> 5;
    const int rb = tile & 7, cb = tile >> 3;
    const int kw = K >> 3, k0 = w * kw;
    f32x16 tot;
#pragma unroll
    for (int i = 0; i < 16; ++i) tot[i] = 0.f;
#pragma unroll 1
    for (int sub = 0; sub < NSUB; ++sub) {
        const bf16_t* ap = A + sub * a_sub + (size_t)(MP + rb * 32 + r) * K + k0 + 8 * hh;
        const bf16_t* bp = Bt + sub * b_sub + (size_t)(cb * 32 + r) * K + k0 + 8 * hh;
        f32x16 acc;
#pragma unroll
        for (int i = 0; i < 16; ++i) acc[i] = 0.f;
#pragma unroll 2
        for (int s2 = 0; s2 < kw; s2 += 16) acc = __builtin_amdgcn_mfma_f32_32x32x16_bf16(*(const bf16x8*)(ap + s2), *(const bf16x8*)(bp + s2), acc, 0, 0, 0);
        if (GATED) {
            const bf16_t* gp = V_PROJ + (size_t)(MP + rb * 32 + 4 * hh) * NPROJ + PC_GATE + sub * 1024 + cb * 32 + r;
#pragma unroll
            for (int i = 0; i < 16; ++i) tot[i] += bf1(gp[(size_t)((i & 3) + 8 * (i >> 2)) * NPROJ]) * acc[i];
        } else tot = acc;
    }
    LAS float* red = (LAS float*)F.lds;
#pragma unroll
    for (int i = 0; i < 16; ++i) red[(w * 16 + i) * 64 + lane] = tot[i];
    __syncthreads();
    const int g = F.tid >> 6;
#pragma unroll
    for (int q = 0; q < 2; ++q) { const int rg = 2 * g + q; float v = 0.f;
#pragma unroll
        for (int ww = 0; ww < 8; ++ww) v += red[(ww * 16 + rg) * 64 + lane];
        res[q] = v; oreg[q] = rg; }
    orow = MP + rb * 32 + 4 * hh; ocol = cb * 32 + r;
    __syncthreads();
}
__device__ __forceinline__ void mini_abc(Ctx& F, int l) {
    for (int tile = F.bid; tile < 256; tile += F.G) {
    float res[2]; int orow, ocol, oreg[2];
    mini_gemm_core<3, true>(F, tile, V_OABC, (size_t)M * 512, V_WABC + (size_t)l * 3 * D * 512, (size_t)D * 512, 512, res, orow, ocol, oreg);
#pragma unroll
    for (int q = 0; q < 2; ++q) { const int row = orow + (oreg[q] & 3) + 8 * (oreg[q] >> 2);
        V_MRG[(size_t)row * D + ocol] = (bf16_t)(cvt_pk_bf16(res[q], 0.f) & 0xffffu); }
    }
}
__device__ __forceinline__ void mini_res(Ctx& F, const bf16_t* A, const bf16_t* Bt, int K, const float* resid  , const bf16_t* resb  , float* out, bf16_t* xb, float* rowss) {
    for (int tile = F.bid; tile < 256; tile += F.G) {
    float res[2]; int orow, ocol, oreg[2];
    mini_gemm_core<1, false>(F, tile, A, 0, Bt, 0, K, res, orow, ocol, oreg);
#pragma unroll
    for (int q = 0; q < 2; ++q) { const int row = orow + (oreg[q] & 3) + 8 * (oreg[q] >> 2);
        const float o = (resb ? bf1(resb[(size_t)row * D + ocol]) : resid[(size_t)(row - MP) * D + ocol]) + res[q];
        if (out) out[(size_t)row * D + ocol] = o; else xb[(size_t)row * D + ocol] = (bf16_t)(cvt_pk_bf16(o, 0.f) & 0xffffu);
        float ss = o * o;
        ss = row_sum16(ss); ss += __shfl_xor(ss, 16);
        if ((F.lane & 31) == 0) atomicAdd(rowss + row, ss); }
    }
}
constexpr int N_PHASES = 1 + 8 * DEPTH;
__global__ void __launch_bounds__(NTHREADS, 2) mega_fwd(Args args) {
    extern __shared__ __attribute__((aligned(16))) unsigned char lds_raw[];
    Ctx F;
    F.in = nullptr; F.out = nullptr; F.ws = nullptr; F.tid = 0; F.lane = 0; F.wave = 0;
    F.lds = (LAS unsigned char*)lds_raw;
    F.G = gridDim.x; F.bid = blockIdx.x;
    volatile LAS unsigned* bst = (volatile LAS unsigned*)(F.lds + LDS_BYTES - 128);
    if (threadIdx.x < 2) bst[threadIdx.x] = 0u;
    __syncthreads();
    (void)xcd_barrier_post((unsigned*)(args.ws + WS_CTL) + CW_BAR, bst);
#define XBAR() do { XcdBarrier xb_; xb_.bar = (unsigned*)(F.ws + WS_CTL) + CW_BAR; xb_.x = xb_xcc_id(); xb_.st = (volatile LAS unsigned*)(F.lds + LDS_BYTES - 128); xcd_barrier(xb_, F.tid); } while (0)
    int ph0 = args.ph_lo;
    if (ph0 == 0) {
        { int tid_ = threadIdx.x; asm volatile("" : "+v"(tid_)); F.tid = tid_; F.lane = tid_ & 63; F.wave = __builtin_amdgcn_readfirstlane(tid_ >> 6);
          { int bid_ = blockIdx.x, g_ = gridDim.x; asm volatile("" : "+s"(bid_), "+s"(g_)); F.bid = bid_; F.G = g_; }
          const __attribute__((address_space(4))) char* ka = (const __attribute__((address_space(4))) char*)__builtin_amdgcn_kernarg_segment_ptr(); asm volatile("" : "+s"(ka));
          F.in = (const float* const __attribute__((address_space(4)))*)ka; F.out = *(float* const __attribute__((address_space(4)))*)(ka + 192); F.ws = *(unsigned char* const __attribute__((address_space(4)))*)(ka + 200); }
        const int gw = F.bid * NWAVES + F.wave, NGW = F.G * NWAVES;
        if (PH_MASK & 1) phase_prep(F);
        if (DUP_K == 8) { cg::this_grid().sync(); phase_prep(F); }
        if (DUP_K == 9) { for (int q_ = 0; q_ < 32; ++q_) XBAR(); }
        ph0 = 1;
        if (args.ph_hi > 1000000) cg::this_grid().sync();
        if (ph0 < args.ph_hi) XBAR();
    }
    for (int ph = ph0, rep = 0; ph < args.ph_hi; ++ph) {
        { int tid_ = threadIdx.x; asm volatile("" : "+v"(tid_)); F.tid = tid_; F.lane = tid_ & 63; F.wave = __builtin_amdgcn_readfirstlane(tid_ >> 6);
          { int bid_ = blockIdx.x, g_ = gridDim.x; asm volatile("" : "+s"(bid_), "+s"(g_)); F.bid = bid_; F.G = g_; }
          const __attribute__((address_space(4))) char* ka = (const __attribute__((address_space(4))) char*)__builtin_amdgcn_kernarg_segment_ptr(); asm volatile("" : "+s"(ka));
          F.in = (const float* const __attribute__((address_space(4)))*)ka; F.out = *(float* const __attribute__((address_space(4)))*)(ka + 192); F.ws = *(unsigned char* const __attribute__((address_space(4)))*)(ka + 200); }
        const int gw = F.bid * NWAVES + F.wave, NGW = F.G * NWAVES;
        {
            const int l = (ph - 1) >> 3, k = (ph - 1) & 7;
            if (k == 0 && (PH_MASK & 2)) {
                pg8::Gemm g{V_XBA, V_WIN + (size_t)l * NPROJ * D, D}; pg8::Order<1> S; S.init(M / 256, NPROJ / 256, F.G, F.bid);
                EpiProj E{V_PROJ, V_RS + (size_t)(2 * l) * M};
                pg8::gemm_phase(F.lds, F.tid, g, S, E);
            } else if (k == 1 && (PH_MASK & 4)) {
                {
                    const bool sq = !(DUP_K == 1 && rep == 0);
                    int row = gw;
                    for (; row + 2 * NGW < M; row += 3 * NGW) { const int rr[3] = {row, row + NGW, row + 2 * NGW}; e1_partA<3>(F, l, rr, sq); }
                    for (; row < M; row += NGW) { const int rr[1] = {row}; e1_partA<1>(F, l, rr, sq); }
                    for (int r2 = gw; r2 < M; r2 += NGW) if (r2 >= MP || (r2 & 4095) >= SEQ - 3) e1_row(F, l, r2);
                }
                __syncthreads();
                for (int it = F.bid; it < NCH; it += F.G) delta_prep_item(F, l, it);
                for (int it = F.bid; it < NCH / 4; it += F.G) ret_prep_item(F, l, it);
            } else if (k == 2 && (PH_MASK & 8)) {
                phase_mix(F, l, rep);
            } else if (k == 3 && (PH_MASK & 16)) {
                for (int row = gw; row < M; row += 2 * NGW) { if (row + NGW < M) { const int rr[2] = {row, row + NGW}; fin_rows<2>(F, l, rr); } else { const int rr[1] = {row}; fin_rows<1>(F, l, rr); } }
                for (int row = MP + gw; row < M; row += NGW) fin_b_row(F, l, row);
                __syncthreads();
                for (int it = F.bid; it < NCH; it += F.G) delta_out_item(F, l, it);
            } else if (k == 4 && (PH_MASK & 32)) {
                mini_abc(F, l);
                pg8::Gemm g{V_OABC, V_WABC + (size_t)l * 3 * D * 512, 512}; pg8::Order<3> S; S.init(MP / 256, D / 256, F.G, F.bid); S.sub_m = M / 256;
                EpiAbc E{V_PROJ, V_MRG};
                pg8::gemm_phase(F.lds, F.tid, g, S, E);
            } else if (k == 5 && (PH_MASK & 64)) {
                mini_res(F, V_MRG, V_WOUT + (size_t)l * D * D, D, l == 0 ? F.in[1] : nullptr, l == 0 ? nullptr : V_XBA, nullptr, V_XBB, V_RS + (size_t)(2 * l + 1) * M);
                pg8::Gemm g{V_MRG, V_WOUT + (size_t)l * D * D, D}; pg8::Order<1> S; S.init(MP / 256, D / 256, F.G, F.bid);
                EpiRes E{F.in[0], F.in[1], l == 0 ? nullptr : V_XBA, nullptr, V_XBB, V_RS + (size_t)(2 * l + 1) * M};
                pg8::gemm_phase(F.lds, F.tid, g, S, E);
            } else if (k == 6 && (PH_MASK & 128)) {
                pg8::Gemm g{V_XBB, V_WFI + (size_t)l * 2 * DFF * D, D}; pg8::Order<1> S; S.init(M / 256, 2 * DFF / 256, F.G, F.bid);
                EpiFfn E{V_ACT, V_RS + (size_t)(2 * l + 1) * M};
                pg8::gemm_phase(F.lds, F.tid, g, S, E);
            } else if (k == 7 && (PH_MASK & 256)) {
                mini_res(F, V_ACT, V_WFO + (size_t)l * D * DFF, DFF, nullptr, V_XBB, l == DEPTH - 1 ? F.out : nullptr, V_XBA, V_RS + (size_t)(l == DEPTH - 1 ? 3 : 2) * M);
                pg8::Gemm g{V_ACT, V_WFO + (size_t)l * D * DFF, DFF}; pg8::Order<1> S; S.init(MP / 256, D / 256, F.G, F.bid);
                EpiRes E{nullptr, nullptr, V_XBB, l == DEPTH - 1 ? F.out : nullptr, V_XBA, V_RS + (size_t)(l == DEPTH - 1 ? 3 : 2) * M};
                pg8::gemm_phase(F.lds, F.tid, g, S, E);
            }
        }
        if (DUP_K >= 0 && ((ph - 1) & 7) == DUP_K && rep == 0) { rep = 1; --ph; XBAR(); continue; }
        rep = 0;
        if (ph + 1 < args.ph_hi) XBAR();
    }
}

extern "C" void kernel_launch(void* const* d_in, const int* in_sizes, int n_in, void* d_out, int out_size, void* d_ws, size_t ws_size, hipStream_t stream) {
    static int grid = 0;
    if (grid == 0) {
        if (n_in != 24 || (size_t)out_size != O_END || ws_size < WS_END) { fprintf(stderr, "kernel_launch: unexpected shapes (n_in %d out %d ws %zu, need %zu / %zu)\n", n_in, out_size, ws_size, (size_t)O_END, (size_t)WS_END); grid = -1; return; }
        int dev = 0, cus = 0, per_cu = 0;
        if (hipGetDevice(&dev) != hipSuccess || hipDeviceGetAttribute(&cus, hipDeviceAttributeMultiprocessorCount, dev) != hipSuccess) { grid = -1; return; }
        if (hipFuncSetAttribute((const void*)mega_fwd, hipFuncAttributeMaxDynamicSharedMemorySize, LDS_BYTES) != hipSuccess) { fprintf(stderr, "kernel_launch: hipFuncSetAttribute failed\n"); grid = -1; return; }
        if (hipOccupancyMaxActiveBlocksPerMultiprocessor(&per_cu, (const void*)mega_fwd, NTHREADS, LDS_BYTES) != hipSuccess || per_cu < 1) { fprintf(stderr, "kernel_launch: occupancy query says %d\n", per_cu); per_cu = 1; }
        (void)hipGetLastError();
        grid = cus;
    }
    if (grid < 0) return;
    (void)hipMemsetAsync((char*)d_ws + WS_CTL, 0, 32768, stream);
    Args a{};
    for (int i = 0; i < 24; ++i) a.in[i] = (const float*)d_in[i];
    a.out = (float*)d_out; a.ws = (unsigned char*)d_ws;
#if MK_ONE_LAUNCH
    a.ph_lo = 0; a.ph_hi = N_PHASES;
    void* kargs[] = {&a};
    hipError_t e = hipLaunchCooperativeKernel((const void*)mega_fwd, dim3(grid), dim3(NTHREADS), kargs, LDS_BYTES, stream);
    if (e != hipSuccess) fprintf(stderr, "cooperative launch failed: %s (grid %d)\n", hipGetErrorString(e), grid);
#else
    for (int ph = 0; ph < N_PHASES; ++ph) {
        a.ph_lo = ph; a.ph_hi = ph + 1;
        hipLaunchKernelGGL(mega_fwd, dim3(grid), dim3(NTHREADS), LDS_BYTES, stream, a);
    }
#endif
}
```

```cpp
#include <hip/hip_runtime.h>
#include <hip/hip_cooperative_groups.h>
#include <cstdio>
#include <cstdint>
namespace cg = cooperative_groups;

#ifndef DUP_K
#define DUP_K -1
#endif
#ifndef PH_MASK
#define PH_MASK 0x1ff
#endif
#ifndef MK_ONE_LAUNCH
#define MK_ONE_LAUNCH 1
#endif

#define LAS __attribute__((address_space(3)))
typedef unsigned short bf16_t;
typedef short bf16x8 __attribute__((ext_vector_type(8)));
typedef float f32x4 __attribute__((ext_vector_type(4)));
typedef float f32x2 __attribute__((ext_vector_type(2)));
typedef unsigned u32x4 __attribute__((ext_vector_type(4)));
typedef unsigned u32x2 __attribute__((ext_vector_type(2)));

constexpr int D = 1024, BATCH = 4, SEQ = 4096, DEPTH = 2, DB = 32, DS = 8, PAST = 8192;
constexpr int MP = BATCH * SEQ, MS = DB * DS, M = MP + MS;
constexpr int NIN = 11272, NPROJ = 11520, DFF = 2816;
constexpr int PC_AQ = 0, PC_AK = 1536, PC_AV = 3072, PC_BQKV = 4608, PC_BZ = 6144, PC_CQ = 6656, PC_CK = 6912, PC_CV = 7168, PC_CZ = 7680, PC_GATE = 8192, PC_BETA = 11264, PC_BA = 11268;
constexpr float EPS = 1e-6f;
constexpr int NPOS = SEQ + DS;

constexpr size_t O_YP = 0;
constexpr size_t O_YS = O_YP + (size_t)MP * D;
constexpr size_t O_KV0P = O_YS + (size_t)MS * D;
constexpr size_t O_KV1P = O_KV0P + (size_t)DEPTH * BATCH * 128 * 1024;
constexpr size_t O_KV2P = O_KV1P + (size_t)DEPTH * BATCH * 512 * 1024;
constexpr size_t O_BCP = O_KV2P + (size_t)DEPTH * BATCH * 2048 * 1024;
constexpr size_t O_BSP = O_BCP + (size_t)DEPTH * BATCH * 3 * 1536;
constexpr size_t O_CRP = O_BSP + (size_t)DEPTH * BATCH * 4 * 128 * 128;
constexpr size_t O_KV0S = O_CRP + (size_t)DEPTH * BATCH * 4 * 64 * 128;
constexpr size_t O_KV1S = O_KV0S + (size_t)DEPTH * DB * DS * 1024;
constexpr size_t O_KV2S = O_KV1S + (size_t)DEPTH * DB * DS * 1024;
constexpr size_t O_BCS = O_KV2S + (size_t)DEPTH * DB * DS * 1024;
constexpr size_t O_BSS = O_BCS + (size_t)DEPTH * DB * 3 * 1536;
constexpr size_t O_CRS = O_BSS + (size_t)DEPTH * DB * 4 * 128 * 128;
constexpr size_t O_END = O_CRS + (size_t)DEPTH * DB * 4 * 64 * 128;

constexpr size_t al256(size_t x) { return (x + 255) & ~(size_t)255; }
constexpr size_t WS_CTL = 0, CTL_BYTES = 1u << 20;
constexpr size_t WS_WIN = WS_CTL + CTL_BYTES;
constexpr size_t WS_WABC = WS_WIN + al256((size_t)DEPTH * NPROJ * D * 2);
constexpr size_t WS_WOUT = WS_WABC + al256((size_t)DEPTH * 3 * D * 512 * 2);
constexpr size_t WS_WFI = WS_WOUT + al256((size_t)DEPTH * D * D * 2);
constexpr size_t WS_WFO = WS_WFI + al256((size_t)DEPTH * 2 * DFF * D * 2);
constexpr size_t WS_XBA = WS_WFO + al256((size_t)DEPTH * D * DFF * 2);
constexpr size_t WS_XBB = WS_XBA + al256((size_t)M * D * 2);
constexpr size_t WS_X1 = WS_XBB + al256((size_t)M * D * 2);
constexpr size_t WS_X2 = WS_X1 + al256((size_t)M * D * 4);
constexpr size_t WS_RS = WS_X2 + al256((size_t)M * D * 4);
constexpr size_t WS_PROJ = WS_RS + al256((size_t)4 * M * 4);
constexpr size_t WS_BQKV = WS_PROJ + al256((size_t)M * NPROJ * 2);
constexpr size_t WS_BG = WS_BQKV + al256((size_t)M * 1536 * 4);
constexpr size_t WS_CQK = WS_BG + al256((size_t)M * 8 * 4);
constexpr size_t WS_OBR = WS_CQK + al256((size_t)M * 512 * 4);
constexpr size_t WS_OCR = WS_OBR + al256((size_t)M * 512 * 4);
constexpr size_t WS_OABC = WS_OCR + al256((size_t)M * 512 * 4);
constexpr size_t WS_MRG = WS_OABC + al256((size_t)3 * M * 512 * 2);
constexpr size_t WS_ACT = WS_MRG + al256((size_t)M * D * 2);
constexpr size_t WS_ROPEA = WS_ACT + al256((size_t)M * DFF * 2);
constexpr size_t WS_ROPEC = WS_ROPEA + al256((size_t)NPOS * 64 * 2 * 4);
constexpr size_t WS_AO = WS_ROPEC + al256((size_t)NPOS * 32 * 2 * 4);
constexpr size_t WS_LSE = WS_AO + al256((size_t)3 * M * 512 * 2);
constexpr int NCH = BATCH * 4 * 64;
constexpr size_t WS_DW = WS_LSE + al256((size_t)3 * M * 4 * 4);
constexpr size_t WS_DQG = WS_DW + al256((size_t)NCH * 64 * 128 * 2);
constexpr size_t WS_DKT = WS_DQG + al256((size_t)NCH * 64 * 128 * 2);
constexpr size_t WS_DAT = WS_DKT + al256((size_t)NCH * 64 * 128 * 2);
constexpr size_t WS_DU = WS_DAT + al256((size_t)NCH * 64 * 64 * 2);
constexpr size_t WS_DDL = WS_DU + al256((size_t)NCH * 64 * 128 * 4);
constexpr size_t WS_RQG = WS_DDL + al256((size_t)NCH * 4);
constexpr size_t WS_RKT = WS_RQG + al256((size_t)NCH * 64 * 64 * 2);
constexpr size_t WS_RAT = WS_RKT + al256((size_t)NCH * 64 * 64 * 2);
constexpr size_t WS_RU = WS_RAT + al256((size_t)NCH * 64 * 64 * 2);
constexpr size_t WS_SB = WS_RU + al256((size_t)NCH * 64 * 128 * 4);
constexpr size_t WS_VB = WS_SB + al256((size_t)NCH * 16384 * 2);
constexpr size_t WS_END = WS_VB + al256((size_t)NCH * 8192 * 2);
constexpr int CW_MIX0 = 64, CW_MIX1 = 128, CW_BAR = 1024;

constexpr int NWAVES = 8, NTHREADS = 512;
constexpr int RING_BYTES = 131072, LDS_BYTES = 147456;

__device__ __forceinline__ float bf_lo(unsigned u) { return __uint_as_float(u << 16); }
__device__ __forceinline__ float bf_hi(unsigned u) { return __uint_as_float(u & 0xffff0000u); }
__device__ __forceinline__ float bf1(bf16_t u) { return __uint_as_float(((unsigned)u) << 16); }
typedef __bf16 bf16x2_t __attribute__((ext_vector_type(2)));
__device__ __forceinline__ unsigned cvt_pk_bf16(float lo, float hi) { const f32x2 f = {lo, hi}; const bf16x2_t v = __builtin_convertvector(f, bf16x2_t); return __builtin_bit_cast(unsigned, v); }
template <int CTRL> __device__ __forceinline__ float dpp_mov(float v) { return __int_as_float(__builtin_amdgcn_update_dpp(0, __float_as_int(v), CTRL, 0xf, 0xf, true)); }
__device__ __forceinline__ float rdlane(float v, int l) { return __int_as_float(__builtin_amdgcn_readlane(__float_as_int(v), l)); }
__device__ __forceinline__ float row_sum16(float v) { v += dpp_mov<0xB1>(v); v += dpp_mov<0x4E>(v); v += dpp_mov<0x141>(v); v += dpp_mov<0x140>(v); return v; }
__device__ __forceinline__ float row_max16(float v) { v = fmaxf(v, dpp_mov<0xB1>(v)); v = fmaxf(v, dpp_mov<0x4E>(v)); v = fmaxf(v, dpp_mov<0x141>(v)); v = fmaxf(v, dpp_mov<0x140>(v)); return v; }
__device__ __forceinline__ float wave_sum(float v) { v = row_sum16(v); return (rdlane(v, 0) + rdlane(v, 16)) + (rdlane(v, 32) + rdlane(v, 48)); }
__device__ __forceinline__ float wave_max(float v) { v = row_max16(v); return fmaxf(fmaxf(rdlane(v, 0), rdlane(v, 16)), fmaxf(rdlane(v, 32), rdlane(v, 48))); }
__device__ __forceinline__ float half_sum(float v) { v = row_sum16(v); return v + __shfl_xor(v, 16); }
__device__ __forceinline__ float sigmoidf_(float x) { return __builtin_amdgcn_rcpf(1.f + __expf(-x)); }

namespace pg8 {
constexpr int BM = 256, BK = 64, HALF = 128, HTB = HALF * BK * 2, NXCD = 8, WGM = 2;
__host__ __device__ __forceinline__ int lds_byte(int r, int c) { const int st = (r >> 4) * 2 + (c >> 5), rr = r & 15, cc = c & 31, ob = rr * 64 + cc * 2; return st * 1024 + (ob ^ (((ob >> 9) & 1) << 5)); }
__host__ __device__ __forceinline__ void stage_rc(int b, int& R, int& C) { const int st = b / 1024, sb = b % 1024, swz = sb ^ (((sb >> 9) & 1) << 5); R = (st >> 1) * 16 + swz / 64; C = (st & 1) * 32 + (swz % 64) / 2; }
__host__ __device__ __forceinline__ int perm32(int rho) { const int n = rho >> 4, i = rho & 15; return 8 * (i >> 2) + 4 * n + (i & 3); }

struct Unit { int pm, pn; };
struct Gemm { const bf16_t* A; const bf16_t* Bt; int K; };

template <int TRIP> struct Order {
    int nM, nN, nwg, G, c, sub_m;
    __device__ void init(int nM_, int nN_, int G_, int c_) { nM = nM_; nN = nN_; nwg = nM * nN; G = G_; c = c_; sub_m = nM_; }
    __device__ bool next(int i, Unit& u) const {
        const int ii = i / TRIP, sub = i - ii * TRIP;
        const long L = (long)ii * G + c; if (L >= nwg) return false;
        int wgid = (int)L; { const int q = nwg / NXCD, r = nwg % NXCD, xcd = wgid % NXCD, off = wgid / NXCD; wgid = (xcd < r ? xcd * (q + 1) : r * (q + 1) + (xcd - r) * q) + off; }
        const int nig = WGM * nN, gid = wgid / nig, fm = gid * WGM, gsz = (nM - fm) < WGM ? (nM - fm) : WGM;
        u.pm = fm + ((wgid % nig) % gsz) + sub * sub_m; u.pn = (wgid % nig) / gsz + sub * nN; return true;
    }
};

template <class Epi, class Sched>
__device__ __forceinline__ void gemm_phase(LAS unsigned char* lds, const int tid, const Gemm g, const Sched& S, const Epi& E) {
    const int wid = __builtin_amdgcn_readfirstlane(tid >> 6), lane = tid & 63, wr = wid >> 2, wc = wid & 3, fr = lane & 15, fq = lane >> 4;
    const int K = g.K, nt = K / BK;
    unsigned voffA[2], voffB[2];
#pragma unroll
    for (int i = 0; i < 2; ++i) { int R, C; stage_rc(tid * 16 + i * 8192, R, C); const int Rb = Epi::PERM ? ((R & ~31) + perm32(R & 31)) : R;
        voffA[i] = (unsigned)(R * K + C) * 2u; voffB[i] = (unsigned)(Rb * K + C) * 2u; }
    const size_t kstep = (size_t)(BK * 2);
    const size_t hstep = (size_t)HALF * K * 2;
    const size_t tstep = 2 * hstep;
    const unsigned ldsw = (unsigned)wid * 1024u;
    const int aoff = lds_byte(wr * 64 + fr, fq * 8), boff = lds_byte(wc * 32 + fr, fq * 8);
#define PG8_SA(b, h) (((b) * 2 + (h)) * HTB)
#define PG8_SB(b, h) ((4 + (b) * 2 + (h)) * HTB)
#define PG8_STAGE(bufoff, gbase, voff) do { _Pragma("unroll") for (int _i = 0; _i < 2; ++_i) \
        __builtin_amdgcn_global_load_lds((const unsigned*)((const char*)(gbase) + (voff)[_i]), (LAS unsigned*)(lds + (bufoff) + ldsw + _i * 8192), 16, 0, 0); } while (0)
#define PG8_LDA(dst, b, h) do { _Pragma("unroll") for (int m = 0; m < 4; ++m) _Pragma("unroll") for (int k = 0; k < 2; ++k) dst[m][k] = *(const LAS bf16x8*)(lds + PG8_SA(b, h) + aoff + m * 2048 + k * 1024); } while (0)
#define PG8_LDB(dst, b, h) do { _Pragma("unroll") for (int n = 0; n < 2; ++n) _Pragma("unroll") for (int k = 0; k < 2; ++k) dst[n][k] = *(const LAS bf16x8*)(lds + PG8_SB(b, h) + boff + n * 2048 + k * 1024); } while (0)
#define PG8_MMA(ai, bj, At, Bt) do { __builtin_amdgcn_s_setprio(1); _Pragma("unroll") for (int m = 0; m < 4; ++m) _Pragma("unroll") for (int n = 0; n < 2; ++n) _Pragma("unroll") for (int k = 0; k < 2; ++k) \
        acc[ai][bj][m][n] = __builtin_amdgcn_mfma_f32_16x16x32_bf16(Bt[n][k], At[m][k], acc[ai][bj][m][n], 0, 0, 0); __builtin_amdgcn_s_setprio(0); } while (0)
#define PG8_WAIT_V(n) asm volatile("s_waitcnt vmcnt(" #n ")" ::: "memory")
#define PG8_WAIT_L(n) asm volatile("s_waitcnt lgkmcnt(" #n ")" ::: "memory")
#define PG8_BAR __builtin_amdgcn_s_barrier()
#define PG8_SCHED __builtin_amdgcn_sched_barrier(0)
    Unit cur, nxt; int ui = 0;
    if (!S.next(0, cur)) return;
    f32x4 acc[2][2][4][2];
#pragma unroll
    for (int a = 0; a < 2; ++a)
#pragma unroll
        for (int b = 0; b < 2; ++b)
#pragma unroll
            for (int m = 0; m < 4; ++m)
#pragma unroll
                for (int n = 0; n < 2; ++n) acc[a][b][m][n] = (f32x4){0.f, 0.f, 0.f, 0.f};
    bf16x8 At[4][2], B0[2][2], B1[2][2];
    const char* cA = (const char*)g.A + (size_t)cur.pm * tstep; const char* cB = (const char*)g.Bt + (size_t)cur.pn * tstep;
    PG8_STAGE(PG8_SB(0, 0), cB, voffB); PG8_STAGE(PG8_SB(0, 1), cB + hstep, voffB); PG8_STAGE(PG8_SA(0, 0), cA, voffA); PG8_STAGE(PG8_SA(0, 1), cA + hstep, voffA);
    if (wr == 1) PG8_BAR;
    PG8_WAIT_V(2); PG8_BAR;
    PG8_STAGE(PG8_SB(1, 0), cB + kstep, voffB); PG8_STAGE(PG8_SA(1, 0), cA + kstep, voffA); PG8_STAGE(PG8_SB(1, 1), cB + hstep + kstep, voffB);
    PG8_WAIT_V(6); PG8_BAR;
    for (;;) {
        const bool has_next = S.next(ui + 1, nxt);
        const char* nA = has_next ? (const char*)g.A + (size_t)nxt.pm * tstep : cA; const char* nB = has_next ? (const char*)g.Bt + (size_t)nxt.pn * tstep : cB;
        for (int t = 0; t < nt; t += 2) {
            const bool last = (t == nt - 2);
            const char* a1 = cA + (size_t)(t + 1) * kstep;
            const char* a2 = last ? nA : cA + (size_t)(t + 2) * kstep; const char* b2 = last ? nB : cB + (size_t)(t + 2) * kstep;
            const char* a3 = a2 + kstep; const char* b3 = b2 + kstep;
            PG8_LDB(B0, 0, 0); PG8_LDB(B1, 0, 1); PG8_SCHED; PG8_LDA(At, 0, 0); PG8_STAGE(PG8_SA(1, 1), a1 + hstep, voffA);
            PG8_WAIT_V(8); PG8_WAIT_L(0); PG8_BAR; PG8_MMA(0, 0, At, B0); PG8_MMA(0, 1, At, B1); PG8_BAR; PG8_SCHED;
            PG8_LDA(At, 0, 1); PG8_STAGE(PG8_SB(0, 0), b2, voffB); PG8_STAGE(PG8_SB(0, 1), b2 + hstep, voffB); PG8_STAGE(PG8_SA(0, 0), a2, voffA);
            PG8_WAIT_V(8); PG8_WAIT_L(0); PG8_BAR; PG8_MMA(1, 0, At, B0); PG8_MMA(1, 1, At, B1); PG8_BAR; PG8_SCHED;
            PG8_LDB(B0, 1, 0); PG8_LDB(B1, 1, 1); PG8_SCHED; PG8_LDA(At, 1, 0); PG8_STAGE(PG8_SA(0, 1), a2 + hstep, voffA);
            PG8_WAIT_V(8); PG8_WAIT_L(0); PG8_BAR; PG8_MMA(0, 0, At, B0); PG8_MMA(0, 1, At, B1); PG8_BAR; PG8_SCHED;
            PG8_LDA(At, 1, 1); PG8_STAGE(PG8_SB(1, 0), b3, voffB); PG8_STAGE(PG8_SB(1, 1), b3 + hstep, voffB); PG8_STAGE(PG8_SA(1, 0), a3, voffA);
            PG8_WAIT_V(8); PG8_WAIT_L(0); PG8_BAR; PG8_MMA(1, 0, At, B0); PG8_MMA(1, 1, At, B1); PG8_BAR; PG8_SCHED;
        }
        if (wr == 0) PG8_BAR;
        E(acc, cur, wr, wc, fr, fq);
        if (!has_next) break;
        if (E.reset_after(cur)) {
#pragma unroll
            for (int a = 0; a < 2; ++a)
#pragma unroll
                for (int b = 0; b < 2; ++b)
#pragma unroll
                    for (int m = 0; m < 4; ++m)
#pragma unroll
                        for (int n = 0; n < 2; ++n) acc[a][b][m][n] = (f32x4){0.f, 0.f, 0.f, 0.f};
        }
        cur = nxt; cA = nA; cB = nB; ++ui;
        if (wr == 1) PG8_BAR;
    }
    PG8_WAIT_V(0);
    PG8_BAR;
#undef PG8_SA
#undef PG8_SB
#undef PG8_STAGE
#undef PG8_LDA
#undef PG8_LDB
#undef PG8_MMA
#undef PG8_WAIT_V
#undef PG8_WAIT_L
#undef PG8_BAR
#undef PG8_SCHED
}
}
using pg8::Unit;

struct EpiProj {
    static constexpr bool PERM = true;
    bf16_t* O; const float* rowss;
    __device__ __forceinline__ bool reset_after(const Unit&) const { return true; }
    __device__ __forceinline__ void operator()(f32x4 (&acc)[2][2][4][2], const Unit& u, int wr, int wc, int fr, int fq) const {
        const int row0 = u.pm * 256 + wr * 64 + fr, col0 = u.pn * 256 + wc * 32 + 8 * fq;
        const bool gate = (u.pn >= 32 && u.pn < 44);
#pragma unroll
        for (int ai = 0; ai < 2; ++ai)
#pragma unroll
            for (int m = 0; m < 4; ++m) {
                const int row = row0 + ai * 128 + m * 16;
                const float rs = rsqrtf(rowss[row] * (1.f / 1024.f) + EPS);
                bf16_t* rowp = O + (size_t)row * NPROJ + col0;
#pragma unroll
                for (int bj = 0; bj < 2; ++bj) {
                    f32x4 v0 = acc[ai][bj][m][0] * rs, v1 = acc[ai][bj][m][1] * rs;
                    if (gate) {
#pragma unroll
                        for (int j = 0; j < 4; ++j) { v0[j] = sigmoidf_(v0[j]); v1[j] = sigmoidf_(v1[j]); }
                    }
                    u32x4 w; w.x = cvt_pk_bf16(v0[0], v0[1]); w.y = cvt_pk_bf16(v0[2], v0[3]); w.z = cvt_pk_bf16(v1[0], v1[1]); w.w = cvt_pk_bf16(v1[2], v1[3]);
                    *(u32x4*)(rowp + bj * 128) = w;
                }
            }
    }
};
struct EpiAbc {
    static constexpr bool PERM = true;
    const bf16_t* G; bf16_t* O;
    __device__ __forceinline__ bool reset_after(const Unit& u) const { return (u.pn >> 2) == 2; }
    __device__ __forceinline__ void operator()(f32x4 (&acc)[2][2][4][2], const Unit& u, int wr, int wc, int fr, int fq) const {
        const int sub = u.pn >> 2, pn = u.pn & 3, pm = u.pm - sub * 65;
        const int row0 = pm * 256 + wr * 64 + fr, col0 = pn * 256 + wc * 32 + 8 * fq;
#pragma unroll
        for (int ai = 0; ai < 2; ++ai)
#pragma unroll
            for (int m = 0; m < 4; ++m) {
                const int row = row0 + ai * 128 + m * 16;
                const bf16_t* gp = G + (size_t)row * NPROJ + PC_GATE + sub * 1024 + col0;
#pragma unroll
                for (int bj = 0; bj < 2; ++bj) {
                    const u32x4 ga = *(const u32x4*)(gp + bj * 128);
                    f32x4 g0 = (f32x4){bf_lo(ga.x), bf_hi(ga.x), bf_lo(ga.y), bf_hi(ga.y)}, g1 = (f32x4){bf_lo(ga.z), bf_hi(ga.z), bf_lo(ga.w), bf_hi(ga.w)};
                    if (sub < 2) {
                        const u32x4 gb = *(const u32x4*)(gp + 1024 + bj * 128);
                        const f32x4 h0 = (f32x4){bf_lo(gb.x), bf_hi(gb.x), bf_lo(gb.y), bf_hi(gb.y)}, h1 = (f32x4){bf_lo(gb.z), bf_hi(gb.z), bf_lo(gb.w), bf_hi(gb.w)};
#pragma unroll
                        for (int j = 0; j < 4; ++j) { acc[ai][bj][m][0][j] *= g0[j] * __builtin_amdgcn_rcpf(fmaxf(h0[j], 1e-30f)); acc[ai][bj][m][1][j] *= g1[j] * __builtin_amdgcn_rcpf(fmaxf(h1[j], 1e-30f)); }
                    } else {
                        const f32x4 v0 = acc[ai][bj][m][0] * g0, v1 = acc[ai][bj][m][1] * g1;
                        u32x4 w; w.x = cvt_pk_bf16(v0[0], v0[1]); w.y = cvt_pk_bf16(v0[2], v0[3]); w.z = cvt_pk_bf16(v1[0], v1[1]); w.w = cvt_pk_bf16(v1[2], v1[3]);
                        *(u32x4*)(O + (size_t)row * D + col0 + bj * 128) = w;
                    }
                }
            }
    }
};
struct EpiRes {
    static constexpr bool PERM = false;
    const float* res0; const float* res1; const bf16_t* resb; float* out; bf16_t* xb; float* rowss;
    __device__ __forceinline__ bool reset_after(const Unit&) const { return true; }
    __device__ __forceinline__ void operator()(f32x4 (&acc)[2][2][4][2], const Unit& u, int wr, int wc, int fr, int fq) const {
        const int col0 = u.pn * 256 + wc * 32 + 4 * fq;
        const float* rbase = (u.pm < 64) ? res0 + (size_t)u.pm * 256 * D : res1;
#pragma unroll
        for (int ai = 0; ai < 2; ++ai)
#pragma unroll
            for (int m = 0; m < 4; ++m) {
                const int lrow = ai * 128 + wr * 64 + m * 16 + fr; const size_t grow = (size_t)u.pm * 256 + lrow;
                float ss = 0.f;
#pragma unroll
                for (int bj = 0; bj < 2; ++bj)
#pragma unroll
                    for (int n = 0; n < 2; ++n) {
                        const int c = col0 + bj * 128 + n * 16;
                        f32x4 r4;
                        if (resb) { const u32x2 rb = *(const u32x2*)(resb + grow * D + c); r4 = (f32x4){bf_lo(rb.x), bf_hi(rb.x), bf_lo(rb.y), bf_hi(rb.y)}; }
                        else r4 = *(const f32x4*)(rbase + (size_t)lrow * D + c);
                        const f32x4 o = r4 + acc[ai][bj][m][n];
                        if (out) *(f32x4*)(out + grow * D + c) = o;
                        else { u32x2 w; w.x = cvt_pk_bf16(o[0], o[1]); w.y = cvt_pk_bf16(o[2], o[3]); *(u32x2*)(xb + grow * D + c) = w; }
                        ss += (o[0] * o[0] + o[1] * o[1]) + (o[2] * o[2] + o[3] * o[3]);
                    }
                ss += __shfl_xor(ss, 16); ss += __shfl_xor(ss, 32);
                if (fq == 0) atomicAdd(rowss + grow, ss);
                asm volatile("" ::: "memory");
            }
    }
};
struct EpiFfn {
    static constexpr bool PERM = true;
    bf16_t* O; const float* rowss;
    __device__ __forceinline__ bool reset_after(const Unit&) const { return true; }
    __device__ __forceinline__ void operator()(f32x4 (&acc)[2][2][4][2], const Unit& u, int wr, int wc, int fr, int fq) const {
        const int row0 = u.pm * 256 + wr * 64 + fr, f0 = u.pn * 128 + 16 * wc + 4 * fq;
#pragma unroll
        for (int ai = 0; ai < 2; ++ai)
#pragma unroll
            for (int m = 0; m < 4; ++m) {
                const int row = row0 + ai * 128 + m * 16;
                const float rs = rsqrtf(rowss[row] * (1.f / 1024.f) + EPS);
#pragma unroll
                for (int bj = 0; bj < 2; ++bj) {
                    const f32x4 gg = acc[ai][bj][m][0] * rs, uu = acc[ai][bj][m][1] * rs;
                    f32x4 hh;
#pragma unroll
                    for (int j = 0; j < 4; ++j) hh[j] = gg[j] * sigmoidf_(gg[j]) * uu[j];
                    u32x2 w; w.x = cvt_pk_bf16(hh[0], hh[1]); w.y = cvt_pk_bf16(hh[2], hh[3]);
                    *(u32x2*)(O + (size_t)row * DFF + f0 + bj * 64) = w;
                }
            }
    }
};

#define XB_TMO      128
#define XB_XCNT(j)  (256  + 64 * (j))
#define XB_XSUB(j)  (1280 + 64 * (j))
#define XB_XGEN(j)  (2304 + 64 * (j))
#define XB_TOP      3328
#define XB_TOPGEN   3392
#define XCD_BAR_WORDS 3456
#define XB_SPIN_CAP (1u << 18)

__device__ __forceinline__ unsigned xb_ld(unsigned* p)              { return __hip_atomic_load(p, __ATOMIC_RELAXED, __HIP_MEMORY_SCOPE_AGENT); }
__device__ __forceinline__ unsigned xb_add(unsigned* p, unsigned v) { return __hip_atomic_fetch_add(p, v, __ATOMIC_RELAXED, __HIP_MEMORY_SCOPE_AGENT); }
__device__ __forceinline__ unsigned xb_xcc_id() { return (unsigned)__builtin_amdgcn_s_getreg((3 << 11) | 20) & 0xFu; }
#define XB_SPIN(cond, bar) do { unsigned _sp = 0; while (cond) { __builtin_amdgcn_s_sleep(1); \
    if ((++_sp & 255u) == 0u) { if (xb_ld(&(bar)[XB_TMO])) break; if (_sp > XB_SPIN_CAP) { atomicAdd(&(bar)[XB_TMO], 1u); break; } } } } while (0)

struct XcdBarrier {
    unsigned* bar; unsigned x;
    volatile LAS unsigned* st;
};

__device__ __forceinline__ XcdBarrier xcd_barrier_post(unsigned* bar, volatile LAS unsigned* st) {
    XcdBarrier b; b.bar = bar; b.x = xb_xcc_id(); b.st = st;
    if (threadIdx.x == 0) (void)xb_add(&bar[XB_XCNT(b.x)], 1u);
    return b;
}
__device__ __forceinline__ void xcd_barrier_complete(unsigned* bar, unsigned x, unsigned& nloc, unsigned& nx) {
    const unsigned G = gridDim.x * gridDim.y * gridDim.z;
    unsigned sum, cnt, mine, sp = 0u;
    for (;;) {
        sum = 0u; cnt = 0u; mine = 0u;
#pragma unroll
        for (unsigned j = 0; j < 16; ++j) { const unsigned c = xb_ld(&bar[XB_XCNT(j)]); sum += c; cnt += (c > 0u) ? 1u : 0u; mine = (j == x) ? c : mine; }
        if (sum == G) break;
        __builtin_amdgcn_s_sleep(1);
        if ((++sp & 255u) == 0u) { if (xb_ld(&bar[XB_TMO])) break; if (sp > XB_SPIN_CAP) { atomicAdd(&bar[XB_TMO], 1u); break; } }
    }
    nloc = mine > 0u ? mine : 1u; nx = cnt > 0u ? cnt : 1u;
}

__device__ __forceinline__ void xcd_barrier(const XcdBarrier& b, int tid_l) {
    asm volatile("s_waitcnt vmcnt(0)" ::: "memory");
    __syncthreads();
    if (tid_l == 0) {
        unsigned* bar = b.bar;
        __builtin_amdgcn_s_waitcnt(0);
        unsigned nloc = b.st[0], nx = b.st[1];
        if (nloc == 0u) { xcd_barrier_complete(bar, b.x, nloc, nx); b.st[0] = nloc; b.st[1] = nx; }
        const unsigned old = xb_add(&bar[XB_XSUB(b.x)], 1u);
        const unsigned gen = old / nloc;
        if (old + 1u == (gen + 1u) * nloc) {
            __builtin_amdgcn_fence(__ATOMIC_RELEASE, "agent");
            asm volatile("s_waitcnt vmcnt(0)" ::: "memory");
            const unsigned og = xb_add(&bar[XB_TOP], 1u);
            const unsigned tg = og / nx;
            if (og + 1u == (tg + 1u) * nx) xb_add(&bar[XB_TOPGEN], 1u);
            else XB_SPIN(xb_ld(&bar[XB_TOPGEN]) == tg, bar);
            __builtin_amdgcn_fence(__ATOMIC_ACQUIRE, "agent");
            xb_add(&bar[XB_XGEN(b.x)], 1u);
            asm volatile("s_waitcnt vmcnt(0)" ::: "memory");
        } else {
            XB_SPIN(xb_ld(&bar[XB_XGEN(b.x)]) == gen, bar);
            __builtin_amdgcn_fence(__ATOMIC_ACQUIRE, "agent");
            asm volatile("s_waitcnt vmcnt(0)" ::: "memory");
        }
    }
    __syncthreads();
}


struct Args { const float* in[24]; float* out; unsigned char* ws; int ph_lo, ph_hi; };
static_assert(sizeof(Args) == 216, "Args layout");
struct Ctx {
    const float* const __attribute__((address_space(4)))* in; float* out; unsigned char* ws;
    LAS unsigned char* lds; int tid, lane, wave, G, bid;
};
#define WSV(T, off) ((T*)(F.ws + (off)))
#define V_WIN WSV(bf16_t, WS_WIN)
#define V_WABC WSV(bf16_t, WS_WABC)
#define V_WOUT WSV(bf16_t, WS_WOUT)
#define V_WFI WSV(bf16_t, WS_WFI)
#define V_WFO WSV(bf16_t, WS_WFO)
#define V_XBA WSV(bf16_t, WS_XBA)
#define V_XBB WSV(bf16_t, WS_XBB)
#define V_PROJ WSV(bf16_t, WS_PROJ)
#define V_OABC WSV(bf16_t, WS_OABC)
#define V_MRG WSV(bf16_t, WS_MRG)
#define V_ACT WSV(bf16_t, WS_ACT)
#define V_X1 WSV(float, WS_X1)
#define V_X2 WSV(float, WS_X2)
#define V_RS WSV(float, WS_RS)
#define V_BQKV WSV(float, WS_BQKV)
#define V_BG WSV(float, WS_BG)
#define V_CQK WSV(float, WS_CQK)
#define V_OBR WSV(float, WS_OBR)
#define V_OCR WSV(float, WS_OCR)
#define V_ROPEA WSV(float, WS_ROPEA)
#define V_ROPEC WSV(float, WS_ROPEC)
#define V_CTL WSV(unsigned, WS_CTL)
#define V_AO WSV(bf16_t, WS_AO)
#define V_LSE WSV(float, WS_LSE)
#define V_DW WSV(bf16_t, WS_DW)
#define V_DQG WSV(bf16_t, WS_DQG)
#define V_DKT WSV(bf16_t, WS_DKT)
#define V_DAT WSV(bf16_t, WS_DAT)
#define V_DU WSV(float, WS_DU)
#define V_DDL WSV(float, WS_DDL)
#define V_RQG WSV(bf16_t, WS_RQG)
#define V_RKT WSV(bf16_t, WS_RKT)
#define V_RAT WSV(bf16_t, WS_RAT)
#define V_RU WSV(float, WS_RU)
#define V_SB WSV(bf16_t, WS_SB)
#define V_VB WSV(bf16_t, WS_VB)

__device__ __forceinline__ int src_col(int mode, int n) {
    if (mode == 1) { if (n < 6656) return n; if (n < 11264) return n + 8; if (n < 11272) return n - 11264 + 6656; return -1; }
    if (mode == 2) { const int pn = n >> 8, c = n & 255; const int f = pn * 128 + (c >> 3) * 4 + (c & 3); return ((c >> 2) & 1) * DFF + f; }
    return n;
}
__device__ __forceinline__ void transpose_item(const float* W, int K, int N, int nblk, bf16_t* WT, const float* kscale, int mode, LAS float* scr, int item, int lane) {
    const int kb = item / nblk, nb = item - kb * nblk, k0 = 32 * kb, n0 = 128 * nb;
    const int sc = src_col(mode, n0 + 4 * (lane & 31));
    f32x4 v[16];
#pragma unroll
    for (int i = 0; i < 16; ++i) { const int kk = 2 * i + (lane >> 5);
        v[i] = (f32x4){0.f, 0.f, 0.f, 0.f};
        if (sc >= 0) { v[i] = *(const f32x4*)(W + (size_t)(k0 + kk) * N + sc); if (kscale) v[i] *= kscale[k0 + kk]; } }
#pragma unroll
    for (int i = 0; i < 16; ++i) { const int kk = 2 * i + (lane >> 5); *(LAS f32x4*)(scr + kk * 132 + 4 * (lane & 31)) = v[i]; }
    asm volatile("s_waitcnt lgkmcnt(0)" ::: "memory");
#pragma unroll
    for (int h2 = 0; h2 < 2; ++h2) { const int n = lane + 64 * h2; const LAS float* sp = scr + n;
        bf16_t* dst = WT + (size_t)(n0 + n) * K + k0;
#pragma unroll
        for (int q = 0; q < 4; ++q) { u32x4 o; o.x = cvt_pk_bf16(sp[(8 * q + 0) * 132], sp[(8 * q + 1) * 132]); o.y = cvt_pk_bf16(sp[(8 * q + 2) * 132], sp[(8 * q + 3) * 132]);
            o.z = cvt_pk_bf16(sp[(8 * q + 4) * 132], sp[(8 * q + 5) * 132]); o.w = cvt_pk_bf16(sp[(8 * q + 6) * 132], sp[(8 * q + 7) * 132]); *(u32x4*)(dst + 8 * q) = o; } }
    asm volatile("s_waitcnt lgkmcnt(0)" ::: "memory");
}
constexpr int I_IN = 32 * (NPROJ / 128), I_ABC = 16 * 8, I_OUT = 32 * 8, I_FI = 32 * (2 * DFF / 128), I_FO = (DFF / 32) * 8;
constexpr int I_LAYER = I_IN + 3 * I_ABC + I_OUT + I_FI + I_FO;
__device__ __forceinline__ void prep_weight_item(Ctx& F, int it, LAS float* scr, int lane) {
    const int l = it / I_LAYER; int r = it - l * I_LAYER;
    const float* W; const float* ksc = nullptr; bf16_t* WT; int K = D, N = D, nblk = D / 128, mode = 0;
    if (r < I_IN) { W = F.in[9] + (size_t)l * D * NIN; N = NIN; nblk = NPROJ / 128; WT = V_WIN + (size_t)l * NPROJ * D; ksc = F.in[8] + l * D; mode = 1; }
    else if ((r -= I_IN) < 3 * I_ABC) { const int i = r / I_ABC; r -= i * I_ABC; W = F.in[17 + i] + (size_t)l * 512 * D; K = 512; WT = V_WABC + (size_t)(l * 3 + i) * D * 512; }
    else if ((r -= 3 * I_ABC) < I_OUT) { W = F.in[20] + (size_t)l * D * D; WT = V_WOUT + (size_t)l * D * D; }
    else if ((r -= I_OUT) < I_FI) { W = F.in[22] + (size_t)l * D * 2 * DFF; N = 2 * DFF; nblk = 2 * DFF / 128; WT = V_WFI + (size_t)l * 2 * DFF * D; ksc = F.in[21] + l * D; mode = 2; }
    else { r -= I_FI; W = F.in[23] + (size_t)l * DFF * D; K = DFF; WT = V_WFO + (size_t)l * D * DFF; }
    transpose_item(W, K, N, nblk, WT, ksc, mode, scr, r, lane);
}
__device__ __forceinline__ void phase_prep(Ctx& F) {
    LAS float* scr = (LAS float*)(F.lds + F.wave * 16896);
    const int gw = F.bid * NWAVES + F.wave, NGW = F.G * NWAVES, lane = F.lane;
    for (int it = gw; it < I_IN; it += NGW) prep_weight_item(F, it, scr, lane);
    for (int row0 = gw; row0 < M; row0 += 4 * NGW) {
        f32x4 v[4][4];
#pragma unroll
        for (int r = 0; r < 4; ++r) { const int row = row0 + r * NGW;
            if (row < M) { const float* src = row < MP ? F.in[0] + (size_t)row * D : F.in[1] + (size_t)(row - MP) * D;
#pragma unroll
                for (int j = 0; j < 4; ++j) v[r][j] = *(const f32x4*)(src + 4 * lane + 256 * j); } }
#pragma unroll
        for (int r = 0; r < 4; ++r) { const int row = row0 + r * NGW;
            if (row < M) { float ss = 0.f;
#pragma unroll
                for (int j = 0; j < 4; ++j) ss += (v[r][j][0] * v[r][j][0] + v[r][j][1] * v[r][j][1]) + (v[r][j][2] * v[r][j][2] + v[r][j][3] * v[r][j][3]);
                ss = wave_sum(ss);
                if (lane == 0) V_RS[row] = ss;
#pragma unroll
                for (int j = 0; j < 4; ++j) { u32x2 w; w.x = cvt_pk_bf16(v[r][j][0], v[r][j][1]); w.y = cvt_pk_bf16(v[r][j][2], v[r][j][3]); *(u32x2*)(V_XBA + (size_t)row * D + 4 * lane + 256 * j) = w; } } }
    }
    const int gt = F.bid * NTHREADS + F.tid, NGT = F.G * NTHREADS;
    for (int i = gt; i < 3 * M; i += NGT) V_RS[M + i] = 0.f;
    {
        const int i64 = gt & 63; const double invA = exp(-(double)i64 * (9.210340371976184 / 64.0));
        for (int e = gt; e < NPOS * 64; e += NGT) { const int pi = e >> 6; const double pos = pi < SEQ ? (double)pi : (double)(PAST + pi - SEQ);
            double a = pos * invA; a -= floor(a * 0.15915494309189535) * 6.283185307179586; float sn, cs; sincosf((float)a, &sn, &cs); *(f32x2*)(V_ROPEA + 2 * e) = (f32x2){cs, sn}; }
        const int i32 = gt & 31; const double invC = exp(-(double)i32 * (9.210340371976184 / 32.0));
        for (int e = gt; e < NPOS * 32; e += NGT) { const int pi = e >> 5; const double pos = pi < SEQ ? (double)pi : (double)(PAST + pi - SEQ);
            double a = pos * invC; a -= floor(a * 0.15915494309189535) * 6.283185307179586; float sn, cs; sincosf((float)a, &sn, &cs); *(f32x2*)(V_ROPEC + 2 * e) = (f32x2){cs, sn}; }
    }
}

__device__ __forceinline__ float* kv_out_ptr(float* out, int g, int l, bool sample, int b, int tt) {
    if (sample) { const size_t base = g == 0 ? O_KV0S : (g == 1 ? O_KV1S : O_KV2S); return out + base + ((size_t)(l * DB + b) * DS + tt) * 1024; }
    const int keep = 128 << (2 * g); const size_t base = g == 0 ? O_KV0P : (g == 1 ? O_KV1P : O_KV2P);
    return out + base + ((size_t)(l * BATCH + b) * keep + tt) * 1024;
}
template <int NR>
__device__ __forceinline__ void e1_partA(Ctx& F, int l, const int (&rows)[NR], bool store_qk) {
    const int lane = F.lane, jj = lane & 15, hq = lane >> 4;
    u32x2 xlo[NR][6], xhi[NR][6]; f32x4 cc[NR], sn[NR]; unsigned vv[NR][12];
    bool sample[NR]; int bb[NR], tt0[NR];
#pragma unroll
    for (int r = 0; r < NR; ++r) {
        const int row = rows[r];
        sample[r] = row >= MP; bb[r] = sample[r] ? (row - MP) >> 3 : row >> 12; tt0[r] = sample[r] ? (row - MP) & 7 : row & 4095;
        const int pidx = sample[r] ? SEQ + tt0[r] : tt0[r];
        const bf16_t* prow = V_PROJ + (size_t)row * NPROJ;
#pragma unroll
        for (int sl = 0; sl < 6; ++sl) { const bf16_t* p = prow + (4 * sl + hq) * 128; xlo[r][sl] = *(const u32x2*)(p + 4 * jj); xhi[r][sl] = *(const u32x2*)(p + 64 + 4 * jj); }
        const float* cs = V_ROPEA + ((size_t)pidx * 64 + 4 * jj) * 2;
        const f32x4 c01 = *(const f32x4*)cs, c23 = *(const f32x4*)(cs + 4);
        cc[r] = (f32x4){c01[0], c01[2], c23[0], c23[2]}; sn[r] = (f32x4){c01[1], c01[3], c23[1], c23[3]};
#pragma unroll
        for (int q = 0; q < 12; ++q) vv[r][q] = *(const unsigned*)(prow + PC_AV + q * 128 + 2 * lane);
    }
    const f32x4 gq_lo = *(const f32x4*)(F.in[10] + l * 128 + 4 * jj), gq_hi = *(const f32x4*)(F.in[10] + l * 128 + 64 + 4 * jj);
    const f32x4 gk_lo = *(const f32x4*)(F.in[11] + l * 128 + 4 * jj), gk_hi = *(const f32x4*)(F.in[11] + l * 128 + 64 + 4 * jj);
#pragma unroll
    for (int r = 0; r < NR; ++r) {
        const int row = rows[r], t = tt0[r], b = bb[r]; const bool smp = sample[r];
        bf16_t* prow = V_PROJ + (size_t)row * NPROJ;
#pragma unroll
        for (int sl = 0; sl < 6; ++sl) {
            const int hs = 4 * sl + hq, which = sl >= 3 ? 1 : 0, gh = hs - 12 * which, g = gh >> 2, h = gh & 3;
            f32x4 lo = (f32x4){bf_lo(xlo[r][sl].x), bf_hi(xlo[r][sl].x), bf_lo(xlo[r][sl].y), bf_hi(xlo[r][sl].y)}, hi = (f32x4){bf_lo(xhi[r][sl].x), bf_hi(xhi[r][sl].x), bf_lo(xhi[r][sl].y), bf_hi(xhi[r][sl].y)};
            float ss = (lo[0] * lo[0] + lo[1] * lo[1]) + (lo[2] * lo[2] + lo[3] * lo[3]) + (hi[0] * hi[0] + hi[1] * hi[1]) + (hi[2] * hi[2] + hi[3] * hi[3]);
            ss = row_sum16(ss);
            const float rstd = rsqrtf(ss * (1.f / 128.f) + EPS);
            lo = lo * rstd * (which ? gk_lo : gq_lo); hi = hi * rstd * (which ? gk_hi : gq_hi);
            const f32x4 olo = lo * cc[r] - hi * sn[r], ohi = hi * cc[r] + lo * sn[r];
            bf16_t* p = prow + hs * 128;
            if (store_qk) { u32x2 w0, w1; w0.x = cvt_pk_bf16(olo[0], olo[1]); w0.y = cvt_pk_bf16(olo[2], olo[3]); w1.x = cvt_pk_bf16(ohi[0], ohi[1]); w1.y = cvt_pk_bf16(ohi[2], ohi[3]);
                *(u32x2*)(p + 4 * jj) = w0; *(u32x2*)(p + 64 + 4 * jj) = w1; }
            if (which == 1) {
                const int keep = 128 << (2 * g); const int tt = smp ? t : t - (SEQ - keep);
                if (tt >= 0) { float* dst = kv_out_ptr(F.out, g, l, smp, b, tt) + h * 128; *(f32x4*)(dst + 4 * jj) = olo; *(f32x4*)(dst + 64 + 4 * jj) = ohi; }
            }
        }
#pragma unroll
        for (int g = 0; g < 3; ++g) {
            const int keep = 128 << (2 * g); const int tt = smp ? t : t - (SEQ - keep);
            if (tt >= 0) { float* dst = kv_out_ptr(F.out, g, l, smp, b, tt) + 512;
#pragma unroll
                for (int q = 0; q < 4; ++q) { const unsigned v = vv[r][4 * g + q]; *(f32x2*)(dst + q * 128 + 2 * lane) = (f32x2){bf_lo(v), bf_hi(v)}; } }
        }
    }
}
__device__ __forceinline__ void e1_row(Ctx& F, int l, int row) {
    const int lane = F.lane, j = lane & 31, hh = lane >> 5;
    const bool sample = row >= MP;
    const int b = sample ? (row - MP) >> 3 : row >> 12, t = sample ? (row - MP) & 7 : row & 4095;
    const int pidx = sample ? SEQ + t : t;
    bf16_t* prow = V_PROJ + (size_t)row * NPROJ;
    if (!sample && t < SEQ - 3) return;
#pragma unroll 1
    for (int it = 0; it < 6; ++it) {
        const int slot = 2 * it + hh, typ = slot >> 2, c = slot * 128 + 4 * j;
        f32x4 a = (f32x4){0.f, 0.f, 0.f, 0.f}, xcur = a;
#pragma unroll
        for (int i = 0; i < 4; ++i) {
            const int tp = t - 3 + i; f32x4 x;
            if (tp >= 0) { const u32x2 u = *(const u32x2*)(V_PROJ + (size_t)(row - 3 + i) * NPROJ + PC_BQKV + c); x = (f32x4){bf_lo(u.x), bf_hi(u.x), bf_lo(u.y), bf_hi(u.y)}; }
            else if (sample) x = *(const f32x4*)(F.in[5] + ((size_t)(l * DB + b) * 3 + (tp + 3)) * 1536 + c);
            else x = (f32x4){0.f, 0.f, 0.f, 0.f};
            const f32x4 w = *(const f32x4*)(F.in[12] + (size_t)(l * 4 + i) * 1536 + c);
            a += w * x; if (i == 3) xcur = x;
        }
#pragma unroll
        for (int q = 0; q < 4; ++q) a[q] = a[q] * sigmoidf_(a[q]);
        if (typ < 2) {
            const float ss = half_sum((a[0] * a[0] + a[1] * a[1]) + (a[2] * a[2] + a[3] * a[3]));
            const float sc = rsqrtf(ss + EPS) * (typ == 0 ? 0.08838834764831845f : 1.f);
            a *= sc;
        }
        *(f32x4*)(V_BQKV + (size_t)row * 1536 + c) = a;
        const int tc = sample ? t - 5 : t - (SEQ - 3);
        if (tc >= 0) { float* dst = F.out + (sample ? O_BCS + ((size_t)(l * DB + b) * 3 + tc) * 1536 : O_BCP + ((size_t)(l * BATCH + b) * 3 + tc) * 1536); *(f32x4*)(dst + c) = xcur; }
    }
    if (lane < 8) {
        const int h = lane & 3; const float x = bf1(prow[PC_BETA + lane]);
        float r;
        if (lane < 4) r = 1.f / (1.f + expf(-x));
        else { const float y = x + F.in[14][l * 4 + h]; const float sp = y > 20.f ? y : log1pf(expf(y)); r = -expf(F.in[13][l * 4 + h]) * sp; }
        V_BG[(size_t)row * 8 + lane] = r;
    }
    {
        const int hs = lane >> 3, i0 = 4 * (lane & 7);
        const bf16_t* p = prow + PC_CQ + hs * 64;
        const u32x2 ulo = *(const u32x2*)(p + i0), uhi = *(const u32x2*)(p + 32 + i0);
        const f32x4 lo = (f32x4){bf_lo(ulo.x), bf_hi(ulo.x), bf_lo(ulo.y), bf_hi(ulo.y)}, hi = (f32x4){bf_lo(uhi.x), bf_hi(uhi.x), bf_lo(uhi.y), bf_hi(uhi.y)};
        const float* cs = V_ROPEC + ((size_t)pidx * 32 + i0) * 2;
        const f32x4 c01 = *(const f32x4*)cs, c23 = *(const f32x4*)(cs + 4);
        const f32x4 cc = (f32x4){c01[0], c01[2], c23[0], c23[2]}, sn = (f32x4){c01[1], c01[3], c23[1], c23[3]};
        const float sc = hs >= 4 ? 0.125f : 1.f;
        const f32x4 olo = (lo * cc - hi * sn) * sc, ohi = (hi * cc + lo * sn) * sc;
        *(f32x4*)(V_CQK + (size_t)row * 512 + hs * 64 + i0) = olo; *(f32x4*)(V_CQK + (size_t)row * 512 + hs * 64 + 32 + i0) = ohi;
    }
}

__device__ __forceinline__ float dot8(const u32x4 q, const u32x4 k) {
    return (bf_lo(q.x) * bf_lo(k.x) + bf_hi(q.x) * bf_hi(k.x)) + (bf_lo(q.y) * bf_lo(k.y) + bf_hi(q.y) * bf_hi(k.y)) + (bf_lo(q.z) * bf_lo(k.z) + bf_hi(q.z) * bf_hi(k.z)) + (bf_lo(q.w) * bf_lo(k.w) + bf_hi(q.w) * bf_hi(k.w));
}
#define WAVE_LDS_SYNC() do { asm volatile("s_waitcnt lgkmcnt(0)" ::: "memory"); __builtin_amdgcn_wave_barrier(); } while (0)
__device__ __forceinline__ void attn_prompt_task(Ctx& F, int row, int h) {
    const int lane = F.lane, t = row & 4095;
    const bf16_t* proj = V_PROJ;
    LAS float* ps = (LAS float*)F.lds + F.wave * 256;
    float mrun = -INFINITY, lsum = 0.f, o0 = 0.f, o1 = 0.f;
#pragma unroll 1
    for (int g = 0; g < 3; ++g) {
        const int sh = 2 * g, nk = min(128, t >> sh) + 1;
        const bf16_t* qrow = proj + (size_t)row * NPROJ + PC_AQ + g * 512 + h * 128;
        u32x4 q[16];
#pragma unroll
        for (int i = 0; i < 16; ++i) q[i] = *(const u32x4*)(qrow + 8 * i);
        WAVE_LDS_SYNC();
#pragma unroll 1
        for (int r = 0; r < 3; ++r) {
            const int jk = r * 64 + lane; const bool valid = jk < nk; const int jj = valid ? jk : 0;
            const bf16_t* krow = proj + (size_t)(row - (jj << sh)) * NPROJ + PC_AK + g * 512 + h * 128;
            float a = 0.f;
#pragma unroll
            for (int i = 0; i < 16; ++i) a += dot8(q[i], *(const u32x4*)(krow + 8 * i));
            ps[jk] = valid ? a * 0.08838834764831845f : -INFINITY;
        }
        WAVE_LDS_SYNC();
        const float s0 = ps[lane], s1 = ps[64 + lane], s2 = ps[128 + lane];
        const float mg = wave_max(fmaxf(fmaxf(s0, s1), s2)), mnew = fmaxf(mrun, mg), alpha = __expf(mrun - mnew);
        const float p0 = __expf(s0 - mnew), p1 = __expf(s1 - mnew), p2 = __expf(s2 - mnew);
        WAVE_LDS_SYNC();
        ps[lane] = p0; ps[64 + lane] = p1; ps[128 + lane] = p2;
        lsum = lsum * alpha + wave_sum(p0 + p1 + p2); o0 *= alpha; o1 *= alpha; mrun = mnew;
        WAVE_LDS_SYNC();
        const bf16_t* vbase = proj + (size_t)row * NPROJ + PC_AV + g * 512 + h * 128 + 2 * lane;
#pragma unroll 4
        for (int jk = 0; jk < nk; ++jk) {
            const float pj = ps[jk];
            const unsigned vv = *(const unsigned*)(vbase - (size_t)(jk << sh) * NPROJ);
            o0 += pj * bf_lo(vv); o1 += pj * bf_hi(vv);
        }
    }
    const float inv = 1.f / lsum;
    *(unsigned*)(V_OABC + (size_t)row * 512 + h * 128 + 2 * lane) = cvt_pk_bf16(o0 * inv, o1 * inv);
}
__device__ __forceinline__ void attn_sample_unit(Ctx& F, int l, int bs, int h, int g) {
    const int lane = F.lane, b = bs >> 3, s = bs & 7, row = MP + bs;
    LAS float* ps = (LAS float*)F.lds + F.wave * 256;
    const int sh = 2 * g, L = 128 << sh;
    const float* cache = F.in[2 + g] + (size_t)(l * DB + b) * L * 1024;
    const float* newkv = kv_out_ptr(F.out, g, l, true, b, 0);
    const bf16_t* qrow = V_PROJ + (size_t)row * NPROJ + PC_AQ + g * 512 + h * 128;
    const int hl = lane & 31, hf = lane >> 5;
    const u32x2 qq = *(const u32x2*)(qrow + 4 * hl);
    const float q0 = bf_lo(qq.x) * 0.08838834764831845f, q1 = bf_hi(qq.x) * 0.08838834764831845f, q2 = bf_lo(qq.y) * 0.08838834764831845f, q3 = bf_hi(qq.y) * 0.08838834764831845f;
    WAVE_LDS_SYNC();
#pragma unroll 1
    for (int j0 = 0; j0 < 130; j0 += 26) {
        f32x4 kk[13];
#pragma unroll
        for (int u = 0; u < 13; ++u) { int jk = j0 + 2 * u + hf; jk = jk > 128 ? 128 : jk; const int idx = L + s - (jk << sh);
            kk[u] = *(const f32x4*)((idx < L ? cache + (size_t)idx * 1024 : newkv + (size_t)(idx - L) * 1024) + h * 128 + 4 * hl); }
#pragma unroll
        for (int u = 0; u < 13; ++u) { float a = (q0 * kk[u][0] + q1 * kk[u][1]) + (q2 * kk[u][2] + q3 * kk[u][3]);
            a = row_sum16(a); a += __shfl_xor(a, 16);
            const int jk = j0 + 2 * u + hf; if (hl == 0 && jk <= 128) ps[jk] = a; }
    }
    if (lane >= 1) ps[128 + lane] = -INFINITY;
    WAVE_LDS_SYNC();
    const float s0 = ps[lane], s1 = ps[64 + lane], s2 = ps[128 + lane];
    const float mx = wave_max(fmaxf(fmaxf(s0, s1), s2));
    const float p0 = __expf(s0 - mx), p1 = __expf(s1 - mx), p2 = __expf(s2 - mx);
    WAVE_LDS_SYNC();
    ps[lane] = p0; ps[64 + lane] = p1; ps[128 + lane] = p2;
    const float lsum = wave_sum(p0 + p1 + p2);
    WAVE_LDS_SYNC();
    float o0 = 0.f, o1 = 0.f, o2 = 0.f, o3 = 0.f;
    const float* vc = cache + 512 + h * 128 + 2 * lane; const float* vn2 = newkv + 512 + h * 128 + 2 * lane;
#pragma unroll 1
    for (int j0 = 0; j0 < 128; j0 += 16) {
        f32x2 vv[16];
#pragma unroll
        for (int u = 0; u < 16; ++u) { const int idx = L + s - ((j0 + u) << sh); vv[u] = *(const f32x2*)(idx < L ? vc + (size_t)idx * 1024 : vn2 + (size_t)(idx - L) * 1024); }
#pragma unroll
        for (int u = 0; u < 16; u += 2) { const float pa = ps[j0 + u], pb = ps[j0 + u + 1]; o0 += pa * vv[u][0]; o1 += pa * vv[u][1]; o2 += pb * vv[u + 1][0]; o3 += pb * vv[u + 1][1]; }
    }
    { const int idx = L + s - (128 << sh); const f32x2 vv = *(const f32x2*)(idx < L ? vc + (size_t)idx * 1024 : vn2 + (size_t)(idx - L) * 1024); const float pa = ps[128]; o0 += pa * vv[0]; o1 += pa * vv[1]; }
    const float inv = 1.f / lsum;
    *(unsigned*)(V_AO + ((size_t)g * M + row) * 512 + h * 128 + 2 * lane) = cvt_pk_bf16((o0 + o2) * inv, (o1 + o3) * inv);
    if (lane == 0) V_LSE[((size_t)g * M + row) * 4 + h] = mx + __logf(lsum);
}
constexpr int AT_KSTR = 272, AT_VSTR = 528, AT_VOFF = 256 * AT_KSTR;
template <int NP>
__device__ __forceinline__ void attn_ld(const bf16_t* proj, int b, int sh, int r, int g, int h, int npk0, int tid, u32x4 (&kv)[NP], u32x4 (&vv)[NP]) {
#pragma unroll
    for (int p = 0; p < NP; ++p) {
        const int kl = p * 32 + (tid >> 4), ch = tid & 15, np = npk0 + kl;
        if (np >= 0) { const bf16_t* src = proj + (size_t)(b * SEQ + (np << sh) + r) * NPROJ + g * 512 + h * 128 + ch * 8;
            kv[p] = *(const u32x4*)(src + PC_AK); vv[p] = *(const u32x4*)(src + PC_AV); }
        else { kv[p] = (u32x4){0u, 0u, 0u, 0u}; vv[p] = kv[p]; }
    }
}
template <int NP>
__device__ __forceinline__ void attn_st(LAS unsigned char* Ks, LAS unsigned char* Vt, int row0, int tid, const u32x4 (&kv)[NP], const u32x4 (&vv)[NP]) {
#pragma unroll
    for (int p = 0; p < NP; ++p) {
        const int kl = row0 + p * 32 + (tid >> 4), ch = tid & 15;
        *(LAS u32x4*)(Ks + kl * AT_KSTR + ch * 16) = kv[p];
        LAS unsigned short* vt = (LAS unsigned short*)(Vt + (ch * 8) * AT_VSTR + kl * 2);
        vt[0 * (AT_VSTR / 2)] = (unsigned short)(vv[p].x & 0xffffu); vt[1 * (AT_VSTR / 2)] = (unsigned short)(vv[p].x >> 16);
        vt[2 * (AT_VSTR / 2)] = (unsigned short)(vv[p].y & 0xffffu); vt[3 * (AT_VSTR / 2)] = (unsigned short)(vv[p].y >> 16);
        vt[4 * (AT_VSTR / 2)] = (unsigned short)(vv[p].z & 0xffffu); vt[5 * (AT_VSTR / 2)] = (unsigned short)(vv[p].z >> 16);
        vt[6 * (AT_VSTR / 2)] = (unsigned short)(vv[p].w & 0xffffu); vt[7 * (AT_VSTR / 2)] = (unsigned short)(vv[p].w >> 16);
    }
}
__device__ __forceinline__ void attn_blk(Ctx& F, const LAS unsigned char* Ks, const LAS unsigned char* Vt, int tb, int kmin, size_t rowq, int g, int h, const bf16x8 (&qf)[4]) {
    const int lane = F.lane, w = F.wave, li = lane & 15, q4 = lane >> 4;
    f32x4 st[9];
#pragma unroll
    for (int kt = 0; kt < 9; ++kt) {
        f32x4 acc = (f32x4){0.f, 0.f, 0.f, 0.f};
        const LAS unsigned char* kp = Ks + (((w + kt + tb) & 15) * 16 + li) * AT_KSTR + 16 * q4;
#pragma unroll
        for (int s = 0; s < 4; ++s) acc = __builtin_amdgcn_mfma_f32_16x16x32_bf16(*(const LAS bf16x8*)(kp + 64 * s), qf[s], acc, 0, 0, 0);
        st[kt] = acc;
    }
    float mx = -INFINITY;
#pragma unroll
    for (int kt = 0; kt < 9; ++kt)
#pragma unroll
        for (int rg = 0; rg < 4; ++rg) {
            const int a = 4 * q4 + rg, kl = (w + kt) * 16 + a;
            bool ok = kl >= kmin;
            if (kt == 0) ok = ok && (a >= li);
            if (kt == 8) ok = ok && (a <= li);
            st[kt][rg] = ok ? st[kt][rg] : -INFINITY;
            mx = fmaxf(mx, st[kt][rg]);
        }
    mx = fmaxf(mx, __shfl_xor(mx, 16)); mx = fmaxf(mx, __shfl_xor(mx, 32));
    const float c2 = 0.08838834764831845f * 1.4426950408889634f;
    float lsum = 0.f;
#pragma unroll
    for (int kt = 0; kt < 9; ++kt)
#pragma unroll
        for (int rg = 0; rg < 4; ++rg) { const float p = exp2f((st[kt][rg] - mx) * c2); st[kt][rg] = p; lsum += p; }
    lsum += __shfl_xor(lsum, 16); lsum += __shfl_xor(lsum, 32);
    f32x4 o[8];
#pragma unroll
    for (int db = 0; db < 8; ++db) o[db] = (f32x4){0.f, 0.f, 0.f, 0.f};
#pragma unroll
    for (int ks = 0; ks < 5; ++ks) {
        u32x4 pw;
        pw.x = cvt_pk_bf16(st[2 * ks][0], st[2 * ks][1]); pw.y = cvt_pk_bf16(st[2 * ks][2], st[2 * ks][3]);
        if (ks < 4) { pw.z = cvt_pk_bf16(st[2 * ks + 1][0], st[2 * ks + 1][1]); pw.w = cvt_pk_bf16(st[2 * ks + 1][2], st[2 * ks + 1][3]); }
        else { pw.z = 0u; pw.w = 0u; }
        const bf16x8 pf = __builtin_bit_cast(bf16x8, pw);
        const int t0 = (w + 2 * ks + tb) & 15, t1 = (w + 2 * ks + 1 + tb) & 15;
#pragma unroll
        for (int db = 0; db < 8; ++db) {
            const LAS unsigned char* vp = Vt + (16 * db + li) * AT_VSTR + 8 * q4;
            u32x4 av; const u32x2 a0 = *(const LAS u32x2*)(vp + t0 * 32), a1 = *(const LAS u32x2*)(vp + t1 * 32);
            av.x = a0.x; av.y = a0.y; av.z = a1.x; av.w = a1.y;
            o[db] = __builtin_amdgcn_mfma_f32_16x16x32_bf16(__builtin_bit_cast(bf16x8, av), pf, o[db], 0, 0, 0);
        }
    }
    const float inv = 1.f / lsum;
    bf16_t* dst = V_AO + ((size_t)g * M + rowq) * 512 + h * 128 + 4 * q4;
#pragma unroll
    for (int db = 0; db < 8; ++db) { u32x2 wv; wv.x = cvt_pk_bf16(o[db][0] * inv, o[db][1] * inv); wv.y = cvt_pk_bf16(o[db][2] * inv, o[db][3] * inv); *(u32x2*)(dst + 16 * db) = wv; }
    if (q4 == 0) V_LSE[((size_t)g * M + rowq) * 4 + h] = mx * 0.08838834764831845f + __logf(lsum);
}
__device__ __forceinline__ void attn_mfma_item(Ctx& F, int item) {
    const int tid = F.tid, lane = F.lane, w = F.wave, li = lane & 15, q4 = lane >> 4;
    const int nbr = item & 15; int rest = item >> 4; const int h = rest & 3; rest >>= 2; const int g = rest % 3, b = rest / 3;
    const int sh = 2 * g, psh = 4 - sh, r = nbr >> psh, nbp = nbr & ((1 << psh) - 1), n0 = nbp * 256;
    const bf16_t* proj = V_PROJ;
    LAS unsigned char* Ks = F.lds; LAS unsigned char* Vt = F.lds + AT_VOFF;
    u32x4 k2[4], v2[4];
    {
        u32x4 kv[8], vv[8];
        attn_ld<8>(proj, b, sh, r, g, h, n0 - 128, tid, kv, vv);
        attn_ld<4>(proj, b, sh, r, g, h, n0 + 128, tid, k2, v2);
        attn_st<8>(Ks, Vt, 0, tid, kv, vv);
    }
    const int ql = 16 * w + li;
#pragma unroll 1
    for (int j = 0; j < 2; ++j) {
        const size_t rowq = (size_t)(b * SEQ + ((n0 + 128 * j + ql) << sh) + r);
        bf16x8 qf[4];
#pragma unroll
        for (int s = 0; s < 4; ++s) qf[s] = *(const bf16x8*)(proj + rowq * NPROJ + PC_AQ + g * 512 + h * 128 + 32 * s + 8 * q4);
        __syncthreads();
        attn_blk(F, Ks, Vt, 8 * j, j == 0 ? 128 - n0 : 0, rowq, g, h, qf);
        __syncthreads();
        if (j == 0) attn_st<4>(Ks, Vt, 0, tid, k2, v2);
    }
}
constexpr int DP_Q = 0, DP_K = 17408, DP_V = 34816, DP_AM = 52224, DP_TM = 68608, DP_RTV = 77824, DP_RTK = 96256, DP_GC = 114688, DP_BT = 114944;
__device__ __forceinline__ f32x4 mfma16(const bf16x8 a, const bf16x8 b, const f32x4 c) { return __builtin_amdgcn_mfma_f32_16x16x32_bf16(a, b, c, 0, 0, 0); }
__device__ __forceinline__ void delta_prep_item(Ctx& F, int l, int ch) {
    const int tid = F.tid, lane = F.lane, w = F.wave, li = lane & 15, q4 = lane >> 4;
    const int c = ch & 63, h = (ch >> 6) & 3, b = ch >> 8;
    const int row0 = b * SEQ + 64 * c;
    const bf16_t* proj = V_PROJ;
    LAS unsigned char* L = F.lds;
    LAS float* gcs = (LAS float*)(L + DP_GC); LAS float* bts = (LAS float*)(L + DP_BT);
    float b_x = 0.f, b_y = 0.f;
    if (tid < 64) { const bf16_t* pr = proj + (size_t)(row0 + tid) * NPROJ; b_x = bf1(pr[PC_BETA + h]); b_y = bf1(pr[PC_BA + h]); }
    {
        f32x2 wg[3][4]; unsigned xr[3][11];
#pragma unroll
        for (int typ = 0; typ < 3; ++typ) {
            const int cc = typ * 512 + h * 128 + 2 * lane;
#pragma unroll
            for (int i = 0; i < 4; ++i) wg[typ][i] = *(const f32x2*)(F.in[12] + (size_t)(l * 4 + i) * 1536 + cc);
#pragma unroll
            for (int rr = 0; rr < 11; ++rr) { const int tl = 64 * c + 8 * w + rr - 3; xr[typ][rr] = tl >= 0 ? *(const unsigned*)(proj + (size_t)(b * SEQ + tl) * NPROJ + PC_BQKV + cc) : 0u; }
        }
#pragma unroll
        for (int typ = 0; typ < 3; ++typ) {
#pragma unroll
            for (int rr = 0; rr < 8; ++rr) {
                float a0 = 0.f, a1 = 0.f;
#pragma unroll
                for (int i = 0; i < 4; ++i) { a0 += wg[typ][i][0] * bf_lo(xr[typ][rr + i]); a1 += wg[typ][i][1] * bf_hi(xr[typ][rr + i]); }
                a0 = a0 * sigmoidf_(a0); a1 = a1 * sigmoidf_(a1);
                if (typ < 2) { const float ss = wave_sum(a0 * a0 + a1 * a1); const float sc = rsqrtf(ss + EPS) * (typ == 0 ? 0.08838834764831845f : 1.f); a0 *= sc; a1 *= sc; }
                *(LAS unsigned*)(L + typ * 17408 + (8 * w + rr) * 272 + 4 * lane) = cvt_pk_bf16(a0, a1);
            }
        }
    }
    if (tid < 64) {
        const float be = 1.f / (1.f + expf(-b_x));
        const float y = b_y + F.in[14][l * 4 + h]; const float sp = y > 20.f ? y : log1pf(expf(y));
        float g = -expf(F.in[13][l * 4 + h]) * sp;
#pragma unroll
        for (int o = 1; o < 64; o <<= 1) { const float v = __shfl_up(g, o); if (lane >= o) g += v; }
        gcs[tid] = g; bts[tid] = be;
    }
    __syncthreads();
    const size_t chs = (size_t)ch;
    {
        const int mi = w >> 1;
#pragma unroll
        for (int t2 = 0; t2 < 2; ++t2) {
            const int nj = 2 * (w & 1) + t2;
            bf16_t* ad = V_DAT + chs * 4096 + (size_t)(16 * mi + li) * 64 + 32 * (nj >> 1) + 8 * q4 + 4 * (nj & 1);
            if (nj <= mi) {
                f32x4 akk = (f32x4){0.f, 0.f, 0.f, 0.f}, aqk = akk;
                const LAS unsigned char* ki = L + DP_K + (16 * mi + li) * 272 + 16 * q4; const LAS unsigned char* kj = L + DP_K + (16 * nj + li) * 272 + 16 * q4;
                const LAS unsigned char* qi = L + DP_Q + (16 * mi + li) * 272 + 16 * q4;
#pragma unroll
                for (int s2 = 0; s2 < 4; ++s2) { const bf16x8 fkj = *(const LAS bf16x8*)(kj + 64 * s2);
                    akk = mfma16(*(const LAS bf16x8*)(ki + 64 * s2), fkj, akk);
                    aqk = mfma16(fkj, *(const LAS bf16x8*)(qi + 64 * s2), aqk); }
                const float gj = gcs[16 * nj + li], gi2 = gcs[16 * mi + li];
                float ov[4];
#pragma unroll
                for (int rg = 0; rg < 4; ++rg) {
                    const int i = 16 * mi + 4 * q4 + rg, j = 16 * nj + li;
                    ((LAS float*)(L + DP_AM))[i * 64 + j] = (i > j) ? bts[i] * akk[rg] * __expf(gcs[i] - gj) : 0.f;
                    const int j2 = 16 * nj + 4 * q4 + rg, i2 = 16 * mi + li;
                    ov[rg] = (i2 >= j2) ? aqk[rg] * __expf(gi2 - gcs[j2]) : 0.f;
                }
                u32x2 pk; pk.x = cvt_pk_bf16(ov[0], ov[1]); pk.y = cvt_pk_bf16(ov[2], ov[3]); *(u32x2*)ad = pk;
            } else { *(u32x2*)ad = (u32x2){0u, 0u}; }
        }
    }
    __syncthreads();
    if (w == 0) {
        const LAS float* Am = (const LAS float*)(L + DP_AM);
        float t[64];
#pragma unroll
        for (int i = 0; i < 64; ++i) {
            float a0 = (lane == i) ? 1.f : 0.f, a1 = 0.f;
#pragma unroll
            for (int j = 0; j < i; j += 4) {
                const f32x4 av = *(const LAS f32x4*)(Am + i * 64 + j);
                a0 -= av[0] * t[j];
                if (j + 1 < i) a1 -= av[1] * t[j + 1];
                if (j + 2 < i) a0 -= av[2] * t[j + 2];
                if (j + 3 < i) a1 -= av[3] * t[j + 3];
            }
            t[i] = a0 + a1;
            *(LAS unsigned short*)(L + DP_TM + i * 144 + 2 * lane) = (unsigned short)(cvt_pk_bf16(t[i], 0.f) & 0xffffu);
        }
    } else {
        const int e0 = tid - 64;
        const float gl = gcs[63];
        for (int e = e0; e < 8192; e += 448) {
            const int kk = e >> 12, t = e & 63, dp = (e >> 6) & 63;
            const unsigned u = *(const LAS unsigned*)(L + (kk ? DP_K : DP_V) + t * 272 + 4 * dp);
            const float sc = kk ? bts[t] * __expf(gcs[t]) : bts[t];
            const unsigned pk = cvt_pk_bf16(bf_lo(u) * sc, bf_hi(u) * sc);
            LAS unsigned short* d0 = (LAS unsigned short*)(L + (kk ? DP_RTK : DP_RTV) + (2 * dp) * 144 + 2 * t);
            d0[0] = (unsigned short)(pk & 0xffffu); d0[72] = (unsigned short)(pk >> 16);
        }
        for (int e = e0; e < 1024; e += 448) {
            const int t = e >> 4, c16 = e & 15; const float sc = __expf(gcs[t]);
            const u32x4 u = *(const LAS u32x4*)(L + DP_Q + t * 272 + 16 * c16);
            u32x4 o; o.x = cvt_pk_bf16(bf_lo(u.x) * sc, bf_hi(u.x) * sc); o.y = cvt_pk_bf16(bf_lo(u.y) * sc, bf_hi(u.y) * sc); o.z = cvt_pk_bf16(bf_lo(u.z) * sc, bf_hi(u.z) * sc); o.w = cvt_pk_bf16(bf_lo(u.w) * sc, bf_hi(u.w) * sc);
            { bf16_t* qd = V_DQG + chs * 8192 + (size_t)t * 128 + 32 * (c16 >> 2) + 16 * (c16 & 1) + 4 * ((c16 >> 1) & 1); *(u32x2*)qd = (u32x2){o.x, o.y}; *(u32x2*)(qd + 8) = (u32x2){o.z, o.w}; }
        }
        for (int e = e0; e < 1024; e += 448) {
            const int dk = e >> 3, t8 = (e & 7) * 8;
            float v[8];
#pragma unroll
            for (int q = 0; q < 8; ++q) v[q] = bf1(*(const LAS unsigned short*)(L + DP_K + (t8 + q) * 272 + 2 * dk)) * __expf(gl - gcs[t8 + q]);
            u32x4 o; o.x = cvt_pk_bf16(v[0], v[1]); o.y = cvt_pk_bf16(v[2], v[3]); o.z = cvt_pk_bf16(v[4], v[5]); o.w = cvt_pk_bf16(v[6], v[7]);
            { bf16_t* kd = V_DKT + chs * 8192 + (size_t)dk * 64 + 32 * (t8 >> 5) + 16 * ((t8 >> 3) & 1) + 4 * ((t8 >> 4) & 1); *(u32x2*)kd = (u32x2){o.x, o.y}; *(u32x2*)(kd + 8) = (u32x2){o.z, o.w}; }
        }
        if (tid == 64) V_DDL[ch] = __expf(gl);
    }
    __syncthreads();
#pragma unroll
    for (int q = 0; q < 4; ++q) {
        const int id = 4 * w + q;
        { const int m = id >> 2, n = id & 3;
          const LAS unsigned char* ap = L + DP_RTK + (16 * m + li) * 144 + 16 * q4; const LAS unsigned char* bp = L + DP_TM + (16 * n + li) * 144 + 16 * q4;
          f32x4 acc = (f32x4){0.f, 0.f, 0.f, 0.f};
#pragma unroll
          for (int s2 = 0; s2 < 2; ++s2) acc = mfma16(*(const LAS bf16x8*)(ap + 64 * s2), *(const LAS bf16x8*)(bp + 64 * s2), acc);
          u32x2 pk; pk.x = cvt_pk_bf16(acc[0], acc[1]); pk.y = cvt_pk_bf16(acc[2], acc[3]);
          *(u32x2*)(V_DW + chs * 8192 + (size_t)(16 * n + li) * 128 + 32 * (m >> 1) + 8 * q4 + 4 * (m & 1)) = pk; }
        { const int mb = id & 3, nj = id >> 2;
          const LAS unsigned char* ap = L + DP_TM + (16 * mb + li) * 144 + 16 * q4; const LAS unsigned char* bp = L + DP_RTV + (16 * nj + li) * 144 + 16 * q4;
          f32x4 acc = (f32x4){0.f, 0.f, 0.f, 0.f};
#pragma unroll
          for (int s2 = 0; s2 < 2; ++s2) acc = mfma16(*(const LAS bf16x8*)(ap + 64 * s2), *(const LAS bf16x8*)(bp + 64 * s2), acc);
          *(f32x4*)(V_DU + ((chs * 8 + nj) * 64 + lane) * 16 + 4 * mb) = acc; }
    }
    __syncthreads();
}
__device__ __forceinline__ bf16x8 ld_perm(const LAS unsigned char* p) { const u32x2 a = *(const LAS u32x2*)p, b = *(const LAS u32x2*)(p + 32); u32x4 r; r.x = a.x; r.y = a.y; r.z = b.x; r.w = b.y; return __builtin_bit_cast(bf16x8, r); }
__device__ __forceinline__ bf16x8 pack_b(const f32x4 lo, const f32x4 hi) { u32x4 r; r.x = cvt_pk_bf16(lo[0], lo[1]); r.y = cvt_pk_bf16(lo[2], lo[3]); r.z = cvt_pk_bf16(hi[0], hi[1]); r.w = cvt_pk_bf16(hi[2], hi[3]); return __builtin_bit_cast(bf16x8, r); }
template <int DK, bool HAS_W>
__device__ __forceinline__ void chunk_scan_item(Ctx& F, const bf16_t* gW, const bf16_t* gQG, const bf16_t* gKT, const bf16_t* gAT, const float* gU, const bf16_t* vrow  , const float* gDL, float dl_const,
                                                float* obase  , float* Sout  ) {
    constexpr int RS_ = DK * 2 + 16;
    constexpr int OFF_QG = HAS_W ? 64 * RS_ : 0, OFF_KT = OFF_QG + 64 * RS_, OFF_AT = OFF_KT + DK * 144, BUF = OFF_AT + 64 * 144;
    constexpr int NWQ = (64 * DK / 8) / 512;
    constexpr int MT = DK / 16, KS = DK / 32;
    const int tid = F.tid, lane = F.lane, w = F.wave, li = lane & 15, q4 = lane >> 4;
    LAS unsigned char* L = F.lds;
    f32x4 S[MT];
#pragma unroll
    for (int m = 0; m < MT; ++m) S[m] = (f32x4){0.f, 0.f, 0.f, 0.f};
    u32x4 pfw[NWQ], pfq[NWQ], pfk[NWQ], pfa; f32x4 un[4];
#define CS_LOAD(cv) do { const size_t c_ = (cv); \
        _Pragma("unroll") for (int i_ = 0; i_ < NWQ; ++i_) { if (HAS_W) pfw[i_] = *(const u32x4*)(gW + c_ * (64 * DK) + (size_t)(tid + 512 * i_) * 8); \
            pfq[i_] = *(const u32x4*)(gQG + c_ * (64 * DK) + (size_t)(tid + 512 * i_) * 8); pfk[i_] = *(const u32x4*)(gKT + c_ * (64 * DK) + (size_t)(tid + 512 * i_) * 8); } \
        pfa = *(const u32x4*)(gAT + c_ * 4096 + (size_t)tid * 8); \
        if (HAS_W) { _Pragma("unroll") for (int m_ = 0; m_ < 4; ++m_) un[m_] = *(const f32x4*)(gU + ((c_ * 8 + w) * 64 + lane) * 16 + 4 * m_); } \
        else { const bf16_t* vp_ = vrow + (size_t)(64 * c_ + 4 * q4) * NPROJ + 16 * w + li; _Pragma("unroll") for (int m_ = 0; m_ < 4; ++m_) _Pragma("unroll") for (int r_ = 0; r_ < 4; ++r_) un[m_][r_] = bf1(vp_[(size_t)(16 * m_ + r_) * NPROJ]); } } while (0)
#define CS_STORE(bufv) do { LAS unsigned char* B_ = L + (bufv) * BUF; \
        _Pragma("unroll") for (int i_ = 0; i_ < NWQ; ++i_) { const int u_ = tid + 512 * i_; \
            if (HAS_W) *(LAS u32x4*)(B_ + (u_ / (DK / 8)) * RS_ + (u_ % (DK / 8)) * 16) = pfw[i_]; \
            *(LAS u32x4*)(B_ + OFF_QG + (u_ / (DK / 8)) * RS_ + (u_ % (DK / 8)) * 16) = pfq[i_]; \
            *(LAS u32x4*)(B_ + OFF_KT + (u_ >> 3) * 144 + (u_ & 7) * 16) = pfk[i_]; } \
        *(LAS u32x4*)(B_ + OFF_AT + (tid >> 3) * 144 + (tid & 7) * 16) = pfa; } while (0)
    CS_LOAD(0);
    CS_STORE(0);
    f32x4 uc[4];
#pragma unroll
    for (int m = 0; m < 4; ++m) uc[m] = un[m];
    float dl = gDL ? gDL[0] : dl_const;
    __syncthreads();
#pragma unroll 1
    for (int c = 0; c < 64; ++c) {
        const LAS unsigned char* Bf = L + (c & 1) * BUF;
        float dln = dl_const;
        if (c + 1 < 64) { CS_LOAD(c + 1); if (gDL) dln = gDL[c + 1]; }
        bf16x8 Sb[KS];
#pragma unroll
        for (int s2 = 0; s2 < KS; ++s2) Sb[s2] = pack_b(S[2 * s2], S[2 * s2 + 1]);
        const LAS unsigned char* fb = Bf + li * RS_ + 16 * q4;
        const LAS unsigned char* fb2 = Bf + li * 144 + 16 * q4;
        f32x4 vn[4];
        if (HAS_W) {
            bf16x8 fw[4][KS];
#pragma unroll
            for (int mb = 0; mb < 4; ++mb)
#pragma unroll
                for (int s2 = 0; s2 < KS; ++s2) fw[mb][s2] = *(const LAS bf16x8*)(fb + mb * 16 * RS_ + 64 * s2);
#pragma unroll
            for (int mb = 0; mb < 4; ++mb) vn[mb] = (f32x4){0.f, 0.f, 0.f, 0.f};
#pragma unroll
            for (int s2 = 0; s2 < KS; ++s2)
#pragma unroll
                for (int mb = 0; mb < 4; ++mb) vn[mb] = mfma16(fw[mb][s2], Sb[s2], vn[mb]);
#pragma unroll
            for (int mb = 0; mb < 4; ++mb) vn[mb] = uc[mb] - vn[mb];
        } else {
#pragma unroll
            for (int mb = 0; mb < 4; ++mb) vn[mb] = uc[mb];
        }
        bf16x8 Vb[2];
        Vb[0] = pack_b(vn[0], vn[1]); Vb[1] = pack_b(vn[2], vn[3]);
        {
            bf16x8 fq[4][KS], fa[4][2];
#pragma unroll
            for (int mb = 0; mb < 4; ++mb) {
#pragma unroll
                for (int s2 = 0; s2 < KS; ++s2) fq[mb][s2] = *(const LAS bf16x8*)(fb + OFF_QG + mb * 16 * RS_ + 64 * s2);
#pragma unroll
                for (int s2 = 0; s2 < 2; ++s2) fa[mb][s2] = *(const LAS bf16x8*)(fb2 + OFF_AT + mb * 16 * 144 + 64 * s2);
            }
            f32x4 oa[4];
#pragma unroll
            for (int mb = 0; mb < 4; ++mb) oa[mb] = (f32x4){0.f, 0.f, 0.f, 0.f};
#pragma unroll
            for (int s2 = 0; s2 < KS; ++s2)
#pragma unroll
                for (int mb = 0; mb < 4; ++mb) oa[mb] = mfma16(fq[mb][s2], Sb[s2], oa[mb]);
#pragma unroll
            for (int s2 = 0; s2 < 2; ++s2)
#pragma unroll
                for (int mb = 0; mb < 4; ++mb) oa[mb] = mfma16(fa[mb][s2], Vb[s2], oa[mb]);
            float* od = obase + (size_t)(64 * c + 4 * q4) * 512 + 16 * w + li;
#pragma unroll
            for (int mb = 0; mb < 4; ++mb)
#pragma unroll
                for (int rg = 0; rg < 4; ++rg) od[(size_t)(16 * mb + rg) * 512] = oa[mb][rg];
        }
        {
            bf16x8 fk[MT][2];
#pragma unroll
            for (int m = 0; m < MT; ++m)
#pragma unroll
                for (int s2 = 0; s2 < 2; ++s2) fk[m][s2] = *(const LAS bf16x8*)(fb2 + OFF_KT + m * 16 * 144 + 64 * s2);
#pragma unroll
            for (int m = 0; m < MT; ++m) S[m] = S[m] * dl;
#pragma unroll
            for (int s2 = 0; s2 < 2; ++s2)
#pragma unroll
                for (int m = 0; m < MT; ++m) S[m] = mfma16(fk[m][s2], Vb[s2], S[m]);
        }
        if (c + 1 < 64) { CS_STORE((c + 1) & 1);
#pragma unroll
            for (int m = 0; m < 4; ++m) uc[m] = un[m];
            dl = dln; }
        __syncthreads();
    }
#undef CS_LOAD
#undef CS_STORE
    float* So = Sout + 16 * w + li;
#pragma unroll
    for (int m = 0; m < MT; ++m)
#pragma unroll
        for (int rg = 0; rg < 4; ++rg) So[(size_t)(16 * m + 4 * q4 + rg) * 128] = S[m][rg];
    __syncthreads();
}


constexpr int D2P_Q = 0, D2P_K = 18432, D2P_RTV = 35840, D2P_AM = 54272, D2P_GC = 70656, D2P_BT = 70912, D2P_HALF = 71168;
__device__ __forceinline__ void delta_prep_item2(Ctx& F, int l, int item) {
    const int tid = F.tid, lane = F.lane, w = F.wave, li = lane & 15, q4 = lane >> 4;
    const int hf = w >> 2, lw = w & 3, lt = tid & 255;
    const int ch = 2 * item + hf, c = ch & 63, h = (ch >> 6) & 3, b = ch >> 8;
    const int row0 = b * SEQ + 64 * c;
    const bf16_t* proj = V_PROJ;
    LAS unsigned char* L = F.lds + hf * D2P_HALF;
    LAS float* gcs = (LAS float*)(L + D2P_GC); LAS float* bts = (LAS float*)(L + D2P_BT);
    const size_t chs = (size_t)ch;
    float b_x = 0.f, b_y = 0.f;
    if (lt < 64) { const bf16_t* pr = proj + (size_t)(row0 + lt) * NPROJ; b_x = bf1(pr[PC_BETA + h]); b_y = bf1(pr[PC_BA + h]); }
    {
        f32x2 wg[3][4];
#pragma unroll
        for (int typ = 0; typ < 3; ++typ)
#pragma unroll
            for (int i = 0; i < 4; ++i) wg[typ][i] = *(const f32x2*)(F.in[12] + (size_t)(l * 4 + i) * 1536 + typ * 512 + h * 128 + 2 * lane);
#pragma unroll 1
        for (int p = 0; p < 2; ++p) {
            const int r8 = 16 * lw + 8 * p;
            unsigned xr[3][11]; float bx[8];
#pragma unroll
            for (int typ = 0; typ < 3; ++typ)
#pragma unroll
                for (int rr = 0; rr < 11; ++rr) { const int tl = 64 * c + r8 + rr - 3; xr[typ][rr] = tl >= 0 ? *(const unsigned*)(proj + (size_t)(b * SEQ + tl) * NPROJ + PC_BQKV + typ * 512 + h * 128 + 2 * lane) : 0u; }
#pragma unroll
            for (int rr = 0; rr < 8; ++rr) bx[rr] = bf1(proj[(size_t)(row0 + r8 + rr) * NPROJ + PC_BETA + h]);
#pragma unroll
            for (int typ = 0; typ < 3; ++typ) {
#pragma unroll
                for (int rr = 0; rr < 8; ++rr) {
                    float a0 = 0.f, a1 = 0.f;
#pragma unroll
                    for (int i = 0; i < 4; ++i) { a0 += wg[typ][i][0] * bf_lo(xr[typ][rr + i]); a1 += wg[typ][i][1] * bf_hi(xr[typ][rr + i]); }
                    a0 = a0 * sigmoidf_(a0); a1 = a1 * sigmoidf_(a1);
                    if (typ < 2) { const float ss = wave_sum(a0 * a0 + a1 * a1); const float sc = rsqrtf(ss + EPS) * (typ == 0 ? 0.08838834764831845f : 1.f); a0 *= sc; a1 *= sc;
                        *(LAS unsigned*)(L + (typ ? D2P_K : D2P_Q) + (r8 + rr) * 272 + 4 * lane) = cvt_pk_bf16(a0, a1); }
                    else { const float be = 1.f / (1.f + __expf(-bx[rr])); const unsigned pk = cvt_pk_bf16(a0 * be, a1 * be);
                        LAS unsigned short* d0 = (LAS unsigned short*)(L + D2P_RTV + (2 * lane) * 144 + 2 * (r8 + rr)); d0[0] = (unsigned short)(pk & 0xffffu); d0[72] = (unsigned short)(pk >> 16); }
                }
            }
        }
    }
    if (lt < 64) {
        const float be = 1.f / (1.f + __expf(-b_x));
        const float y = b_y + F.in[14][l * 4 + h]; const float sp = y > 20.f ? y : log1pf(expf(y));
        float g = -expf(F.in[13][l * 4 + h]) * sp;
#pragma unroll
        for (int o = 1; o < 64; o <<= 1) { const float v = __shfl_up(g, o); if (lane >= o) g += v; }
        gcs[lt] = g; bts[lt] = be;
    }
    __syncthreads();
    {
        const int mi = lw;
#pragma unroll
        for (int nj = 0; nj < 4; ++nj) {
            bf16_t* ad = V_DAT + chs * 4096 + (size_t)(16 * mi + li) * 64 + 32 * (nj >> 1) + 8 * q4 + 4 * (nj & 1);
            if (nj <= mi) {
                f32x4 akk = (f32x4){0.f, 0.f, 0.f, 0.f}, aqk = akk;
                const LAS unsigned char* ki = L + D2P_K + (16 * mi + li) * 272 + 16 * q4; const LAS unsigned char* kj = L + D2P_K + (16 * nj + li) * 272 + 16 * q4;
                const LAS unsigned char* qi = L + D2P_Q + (16 * mi + li) * 272 + 16 * q4;
#pragma unroll
                for (int s2 = 0; s2 < 4; ++s2) { const bf16x8 fkj = *(const LAS bf16x8*)(kj + 64 * s2);
                    akk = mfma16(*(const LAS bf16x8*)(ki + 64 * s2), fkj, akk);
                    aqk = mfma16(fkj, *(const LAS bf16x8*)(qi + 64 * s2), aqk); }
                const float gj = gcs[16 * nj + li], gi2 = gcs[16 * mi + li];
                float ov[4];
#pragma unroll
                for (int rg = 0; rg < 4; ++rg) {
                    const int i = 16 * mi + 4 * q4 + rg, j = 16 * nj + li;
                    ((LAS float*)(L + D2P_AM))[i * 64 + j] = (i > j) ? bts[i] * akk[rg] * __expf(gcs[i] - gj) : 0.f;
                    const int j2 = 16 * nj + 4 * q4 + rg, i2 = 16 * mi + li;
                    ov[rg] = (i2 >= j2) ? aqk[rg] * __expf(gi2 - gcs[j2]) : 0.f;
                }
                u32x2 pk; pk.x = cvt_pk_bf16(ov[0], ov[1]); pk.y = cvt_pk_bf16(ov[2], ov[3]); *(u32x2*)ad = pk;
            } else { *(u32x2*)ad = (u32x2){0u, 0u}; }
        }
#pragma unroll
        for (int k4 = 0; k4 < 4; ++k4) {
            const int e = lt + 256 * k4, t = e >> 4, c16 = e & 15; const float sc = __expf(gcs[t]);
            const u32x4 u = *(const LAS u32x4*)(L + D2P_Q + t * 272 + 16 * c16);
            u32x4 o; o.x = cvt_pk_bf16(bf_lo(u.x) * sc, bf_hi(u.x) * sc); o.y = cvt_pk_bf16(bf_lo(u.y) * sc, bf_hi(u.y) * sc); o.z = cvt_pk_bf16(bf_lo(u.z) * sc, bf_hi(u.z) * sc); o.w = cvt_pk_bf16(bf_lo(u.w) * sc, bf_hi(u.w) * sc);
            bf16_t* qd = V_DQG + chs * 8192 + (size_t)t * 128 + 32 * (c16 >> 2) + 16 * (c16 & 1) + 4 * ((c16 >> 1) & 1); *(u32x2*)qd = (u32x2){o.x, o.y}; *(u32x2*)(qd + 8) = (u32x2){o.z, o.w};
        }
    }
    __syncthreads();
    if (lw == 0) {
        const LAS float* Am = (const LAS float*)(L + D2P_AM);
        float t[64];
#pragma unroll
        for (int i = 0; i < 64; ++i) {
            float a0 = (lane == i) ? 1.f : 0.f, a1 = 0.f;
#pragma unroll
            for (int j = 0; j < i; j += 4) {
                const f32x4 av = *(const LAS f32x4*)(Am + i * 64 + j);
                a0 -= av[0] * t[j];
                if (j + 1 < i) a1 -= av[1] * t[j + 1];
                if (j + 2 < i) a0 -= av[2] * t[j + 2];
                if (j + 3 < i) a1 -= av[3] * t[j + 3];
            }
            t[i] = a0 + a1;
        }
        asm volatile("s_waitcnt lgkmcnt(0)" ::: "memory");
#pragma unroll
        for (int i = 0; i < 64; ++i) *(LAS unsigned short*)(L + D2P_AM + i * 144 + 2 * lane) = (unsigned short)(cvt_pk_bf16(t[i], 0.f) & 0xffffu);
    } else {
        const int e0 = lt - 64;
        const float gl = gcs[63];
        for (int e = e0; e < 4096; e += 192) {
            const int t = e & 63, dp = e >> 6;
            const unsigned u = *(const LAS unsigned*)(L + D2P_K + t * 272 + 4 * dp);
            const float sc = bts[t] * __expf(gcs[t]);
            const unsigned pk = cvt_pk_bf16(bf_lo(u) * sc, bf_hi(u) * sc);
            LAS unsigned short* d0 = (LAS unsigned short*)(L + D2P_Q + (2 * dp) * 144 + 2 * t);
            d0[0] = (unsigned short)(pk & 0xffffu); d0[72] = (unsigned short)(pk >> 16);
        }
        for (int e = e0; e < 1024; e += 192) {
            const int dk = e >> 3, t8 = (e & 7) * 8;
            float v[8];
#pragma unroll
            for (int q = 0; q < 8; ++q) v[q] = bf1(*(const LAS unsigned short*)(L + D2P_K + (t8 + q) * 272 + 2 * dk)) * __expf(gl - gcs[t8 + q]);
            u32x4 o; o.x = cvt_pk_bf16(v[0], v[1]); o.y = cvt_pk_bf16(v[2], v[3]); o.z = cvt_pk_bf16(v[4], v[5]); o.w = cvt_pk_bf16(v[6], v[7]);
            bf16_t* kd = V_DKT + chs * 8192 + (size_t)dk * 64 + 32 * (t8 >> 5) + 16 * ((t8 >> 3) & 1) + 4 * ((t8 >> 4) & 1); *(u32x2*)kd = (u32x2){o.x, o.y}; *(u32x2*)(kd + 8) = (u32x2){o.z, o.w};
        }
        if (lt == 64) V_DDL[ch] = __expf(gl);
    }
    __syncthreads();
#pragma unroll
    for (int q = 0; q < 8; ++q) {
        const int id = 8 * lw + q;
        { const int m = id >> 2, n = id & 3;
          const LAS unsigned char* ap = L + D2P_Q + (16 * m + li) * 144 + 16 * q4; const LAS unsigned char* bp = L + D2P_AM + (16 * n + li) * 144 + 16 * q4;
          f32x4 acc = (f32x4){0.f, 0.f, 0.f, 0.f};
#pragma unroll
          for (int s2 = 0; s2 < 2; ++s2) acc = mfma16(*(const LAS bf16x8*)(ap + 64 * s2), *(const LAS bf16x8*)(bp + 64 * s2), acc);
          u32x2 pk; pk.x = cvt_pk_bf16(acc[0], acc[1]); pk.y = cvt_pk_bf16(acc[2], acc[3]);
          *(u32x2*)(V_DW + chs * 8192 + (size_t)(16 * n + li) * 128 + 32 * (m >> 1) + 8 * q4 + 4 * (m & 1)) = pk; }
        { const int mb = id & 3, nj = id >> 2;
          const LAS unsigned char* ap = L + D2P_AM + (16 * mb + li) * 144 + 16 * q4; const LAS unsigned char* bp = L + D2P_RTV + (16 * nj + li) * 144 + 16 * q4;
          f32x4 acc = (f32x4){0.f, 0.f, 0.f, 0.f};
#pragma unroll
          for (int s2 = 0; s2 < 2; ++s2) acc = mfma16(*(const LAS bf16x8*)(ap + 64 * s2), *(const LAS bf16x8*)(bp + 64 * s2), acc);
          *(f32x4*)(V_DU + ((chs * 8 + nj) * 64 + lane) * 16 + 4 * mb) = acc; }
    }
    __syncthreads();
}
constexpr int D2_BUF = 35840, D2_KT = 17408;
__device__ __forceinline__ void delta_scan2_item(Ctx& F, int l, int b, int h) {
    const int tid = F.tid, lane = F.lane, w = F.wave, li = lane & 15, q4 = lane >> 4;
    LAS unsigned char* L = F.lds;
    const size_t ch0 = (size_t)(b * 4 + h) * 64;
    const bf16_t* gW = V_DW + ch0 * 8192; const bf16_t* gKT = V_DKT + ch0 * 8192; const float* gU = V_DU + ch0 * 8192; const float* gDL = V_DDL + ch0;
    bf16_t* gSB = V_SB + ch0 * 16384; bf16_t* gVB = V_VB + ch0 * 8192;
    f32x4 S[8];
#pragma unroll
    for (int m = 0; m < 8; ++m) S[m] = (f32x4){0.f, 0.f, 0.f, 0.f};
    u32x4 pa[4], pb[4]; f32x4 ua[4], ub[4], uc[4]; float dla = 0.f, dlb = 0.f, dl;
#define D2_LOAD(P, U_, DL_, cv) do { const size_t c_ = (cv); \
        P[0] = *(const u32x4*)(gW + c_ * 8192 + (size_t)tid * 8); P[1] = *(const u32x4*)(gW + c_ * 8192 + (size_t)(tid + 512) * 8); \
        P[2] = *(const u32x4*)(gKT + c_ * 8192 + (size_t)tid * 8); P[3] = *(const u32x4*)(gKT + c_ * 8192 + (size_t)(tid + 512) * 8); \
        _Pragma("unroll") for (int m_ = 0; m_ < 4; ++m_) U_[m_] = *(const f32x4*)(gU + ((c_ * 8 + w) * 64 + lane) * 16 + 4 * m_); DL_ = gDL[c_]; } while (0)
#define D2_STORE(P, bufv) do { LAS unsigned char* B_ = L + (bufv) * D2_BUF; \
        *(LAS u32x4*)(B_ + (tid >> 4) * 272 + (tid & 15) * 16) = P[0]; *(LAS u32x4*)(B_ + ((tid >> 4) + 32) * 272 + (tid & 15) * 16) = P[1]; \
        *(LAS u32x4*)(B_ + D2_KT + (tid >> 3) * 144 + (tid & 7) * 16) = P[2]; *(LAS u32x4*)(B_ + D2_KT + ((tid >> 3) + 64) * 144 + (tid & 7) * 16) = P[3]; } while (0)
#define D2_COMPUTE(bufv, cv) do { const LAS unsigned char* Bf = L + (bufv) * D2_BUF; const size_t c_ = (cv); \
        bf16x8 Sb[4]; \
        _Pragma("unroll") for (int s2 = 0; s2 < 4; ++s2) { Sb[s2] = pack_b(S[2 * s2], S[2 * s2 + 1]); *(bf16x8*)(gSB + (((c_ * 8 + w) * 4 + s2) * 64 + lane) * 8) = Sb[s2]; } \
        const LAS unsigned char* fb = Bf + li * 272 + 16 * q4; const LAS unsigned char* fb2 = Bf + D2_KT + li * 144 + 16 * q4; \
        f32x4 vn[4]; \
        { bf16x8 fw[4][4]; \
          _Pragma("unroll") for (int mb = 0; mb < 4; ++mb) _Pragma("unroll") for (int s2 = 0; s2 < 4; ++s2) fw[mb][s2] = *(const LAS bf16x8*)(fb + mb * 16 * 272 + 64 * s2); \
          _Pragma("unroll") for (int mb = 0; mb < 4; ++mb) vn[mb] = (f32x4){0.f, 0.f, 0.f, 0.f}; \
          _Pragma("unroll") for (int s2 = 0; s2 < 4; ++s2) _Pragma("unroll") for (int mb = 0; mb < 4; ++mb) vn[mb] = mfma16(fw[mb][s2], Sb[s2], vn[mb]); } \
        _Pragma("unroll") for (int mb = 0; mb < 4; ++mb) vn[mb] = uc[mb] - vn[mb]; \
        bf16x8 Vb[2]; Vb[0] = pack_b(vn[0], vn[1]); Vb[1] = pack_b(vn[2], vn[3]); \
        _Pragma("unroll") for (int s2 = 0; s2 < 2; ++s2) *(bf16x8*)(gVB + (((c_ * 8 + w) * 2 + s2) * 64 + lane) * 8) = Vb[s2]; \
        { bf16x8 fk[8][2]; \
          _Pragma("unroll") for (int m = 0; m < 8; ++m) _Pragma("unroll") for (int s2 = 0; s2 < 2; ++s2) fk[m][s2] = *(const LAS bf16x8*)(fb2 + m * 16 * 144 + 64 * s2); \
          _Pragma("unroll") for (int m = 0; m < 8; ++m) S[m] = S[m] * dl; \
          _Pragma("unroll") for (int s2 = 0; s2 < 2; ++s2) _Pragma("unroll") for (int m = 0; m < 8; ++m) S[m] = mfma16(fk[m][s2], Vb[s2], S[m]); } } while (0)
    D2_LOAD(pa, ua, dla, 0);
    D2_LOAD(pb, ub, dlb, 1);
    D2_STORE(pa, 0);
#pragma unroll
    for (int m = 0; m < 4; ++m) uc[m] = ua[m];
    dl = dla;
    __syncthreads();
#pragma unroll 1
    for (int c = 0; c < 64; c += 2) {
        if (c + 2 < 64) D2_LOAD(pa, ua, dla, c + 2);
        D2_COMPUTE(0, c);
        D2_STORE(pb, 1);
#pragma unroll
        for (int m = 0; m < 4; ++m) uc[m] = ub[m];
        dl = dlb;
        __syncthreads();
        if (c + 3 < 64) D2_LOAD(pb, ub, dlb, c + 3);
        D2_COMPUTE(1, c + 1);
        if (c + 2 < 64) { D2_STORE(pa, 0);
#pragma unroll
            for (int m = 0; m < 4; ++m) uc[m] = ua[m];
            dl = dla; }
        __syncthreads();
    }
#undef D2_LOAD
#undef D2_STORE
#undef D2_COMPUTE
    float* So = F.out + O_BSP + ((size_t)(l * BATCH + b) * 4 + h) * 16384 + 16 * w + li;
#pragma unroll
    for (int m = 0; m < 8; ++m)
#pragma unroll
        for (int rg = 0; rg < 4; ++rg) So[(size_t)(16 * m + 4 * q4 + rg) * 128] = S[m][rg];
    __syncthreads();
}
__device__ __forceinline__ void delta_out_item(Ctx& F, int l, int ch) {
    const int tid = F.tid, lane = F.lane, w = F.wave, li = lane & 15, q4 = lane >> 4;
    const int c = ch & 63, h = (ch >> 6) & 3, b = ch >> 8;
    const int row0 = b * SEQ + 64 * c;
    LAS unsigned char* L = F.lds;
    const size_t chs = (size_t)ch;
    const u32x4 q0 = *(const u32x4*)(V_DQG + chs * 8192 + (size_t)tid * 8), q1 = *(const u32x4*)(V_DQG + chs * 8192 + (size_t)(tid + 512) * 8), a0 = *(const u32x4*)(V_DAT + chs * 4096 + (size_t)tid * 8);
    bf16x8 Sb[4], Vb[2];
#pragma unroll
    for (int s2 = 0; s2 < 4; ++s2) Sb[s2] = *(const bf16x8*)(V_SB + (((chs * 8 + w) * 4 + s2) * 64 + lane) * 8);
#pragma unroll
    for (int s2 = 0; s2 < 2; ++s2) Vb[s2] = *(const bf16x8*)(V_VB + (((chs * 8 + w) * 2 + s2) * 64 + lane) * 8);
    const float gn = F.in[15][l * 128 + 16 * w + li];
    const bf16_t* zp = V_PROJ + (size_t)(row0 + 4 * q4) * NPROJ + PC_BZ + h * 128 + 16 * w + li;
    float zz[16];
#pragma unroll
    for (int i = 0; i < 16; ++i) zz[i] = bf1(zp[(size_t)(16 * (i >> 2) + (i & 3)) * NPROJ]);
    *(LAS u32x4*)(L + (tid >> 4) * 272 + (tid & 15) * 16) = q0; *(LAS u32x4*)(L + ((tid >> 4) + 32) * 272 + (tid & 15) * 16) = q1;
    *(LAS u32x4*)(L + 17408 + (tid >> 3) * 144 + (tid & 7) * 16) = a0;
    __syncthreads();
    f32x4 oa[4];
    {
        const LAS unsigned char* fb = L + li * 272 + 16 * q4; const LAS unsigned char* fb2 = L + 17408 + li * 144 + 16 * q4;
        bf16x8 fq[4][4], fa[4][2];
#pragma unroll
        for (int mb = 0; mb < 4; ++mb) {
#pragma unroll
            for (int s2 = 0; s2 < 4; ++s2) fq[mb][s2] = *(const LAS bf16x8*)(fb + mb * 16 * 272 + 64 * s2);
#pragma unroll
            for (int s2 = 0; s2 < 2; ++s2) fa[mb][s2] = *(const LAS bf16x8*)(fb2 + mb * 16 * 144 + 64 * s2);
        }
#pragma unroll
        for (int mb = 0; mb < 4; ++mb) oa[mb] = (f32x4){0.f, 0.f, 0.f, 0.f};
#pragma unroll
        for (int s2 = 0; s2 < 4; ++s2)
#pragma unroll
            for (int mb = 0; mb < 4; ++mb) oa[mb] = mfma16(fq[mb][s2], Sb[s2], oa[mb]);
#pragma unroll
        for (int s2 = 0; s2 < 2; ++s2)
#pragma unroll
            for (int mb = 0; mb < 4; ++mb) oa[mb] = mfma16(fa[mb][s2], Vb[s2], oa[mb]);
    }
    LAS float* part = (LAS float*)(L + 32768);
#pragma unroll
    for (int mb = 0; mb < 4; ++mb)
#pragma unroll
        for (int rg = 0; rg < 4; ++rg) { float ss = oa[mb][rg] * oa[mb][rg];
            ss = row_sum16(ss);
            if (li == 0) part[(16 * mb + 4 * q4 + rg) * 8 + w] = ss; }
    __syncthreads();
    bf16_t* od = V_OABC + (size_t)M * 512 + (size_t)(row0 + 4 * q4) * 512 + h * 128 + 16 * w + li;
#pragma unroll
    for (int mb = 0; mb < 4; ++mb)
#pragma unroll
        for (int rg = 0; rg < 4; ++rg) { const int tk = 16 * mb + 4 * q4 + rg;
            const f32x4 p0 = *(const LAS f32x4*)(part + tk * 8), p1 = *(const LAS f32x4*)(part + tk * 8 + 4);
            const float rstd = rsqrtf(((p0[0] + p0[1]) + (p0[2] + p0[3]) + (p1[0] + p1[1]) + (p1[2] + p1[3])) * (1.f / 128.f) + EPS);
            const float z = zz[4 * mb + rg];
            od[(size_t)(16 * mb + rg) * 512] = (bf16_t)(cvt_pk_bf16(oa[mb][rg] * rstd * gn * z * sigmoidf_(z), 0.f) & 0xffffu); }
    __syncthreads();
}
__device__ __forceinline__ void delta_scan_item(Ctx& F, int l, int b, int h) {
    const size_t ch0 = (size_t)(b * 4 + h) * 64;
    chunk_scan_item<128, true>(F, V_DW + ch0 * 8192, V_DQG + ch0 * 8192, V_DKT + ch0 * 8192, V_DAT + ch0 * 4096, V_DU + ch0 * 8192, nullptr, V_DDL + ch0, 0.f,
                               V_OBR + (size_t)(b * SEQ) * 512 + h * 128, F.out + O_BSP + ((size_t)(l * BATCH + b) * 4 + h) * 16384);
}
__device__ __forceinline__ void ret_scan_item(Ctx& F, int l, int b, int h) {
    const size_t ch0 = (size_t)(b * 4 + h) * 64;
    const float lg2 = log2f(1.f - exp2f(-5.f - (float)h));
    chunk_scan_item<64, false>(F, nullptr, V_RQG + ch0 * 4096, V_RKT + ch0 * 4096, V_RAT + ch0 * 4096, nullptr, V_PROJ + (size_t)(b * SEQ) * NPROJ + PC_CV + h * 128, nullptr, exp2f(64.f * lg2),
                               V_OCR + (size_t)(b * SEQ) * 512 + h * 128, F.out + O_CRP + ((size_t)(l * BATCH + b) * 4 + h) * 8192);
}
__device__ __forceinline__ void ret_prep_item(Ctx& F, int l, int item) {
    const int tid = F.tid, lane = F.lane, w = F.wave, li = lane & 15, q4 = lane >> 4;
    const int pj = w >> 1, t2 = tid & 127, w2 = w & 1;
    const int ch = 4 * item + pj, c = ch & 63, h = (ch >> 6) & 3, b = ch >> 8;
    const int row0 = b * SEQ + 64 * c;
    const bf16_t* proj = V_PROJ;
    LAS unsigned char* L = F.lds + pj * 18432;
    const float lg2 = log2f(1.f - exp2f(-5.f - (float)h));
    const size_t chs = (size_t)ch;
#pragma unroll
    for (int k8 = 0; k8 < 8; ++k8) {
        const int task = t2 + 128 * k8, qk = task >> 9, t = (task >> 3) & 63, i0 = 4 * (task & 7);
        const float* cs = V_ROPEC + ((size_t)(64 * c + t) * 32 + i0) * 2;
        const f32x4 c01 = *(const f32x4*)cs, c23 = *(const f32x4*)(cs + 4);
        const f32x4 cc = (f32x4){c01[0], c01[2], c23[0], c23[2]}, sn = (f32x4){c01[1], c01[3], c23[1], c23[3]};
        const bf16_t* p = proj + (size_t)(row0 + t) * NPROJ + (qk ? PC_CK : PC_CQ) + h * 64;
        const u32x2 ulo = *(const u32x2*)(p + i0), uhi = *(const u32x2*)(p + 32 + i0);
        const f32x4 lo = (f32x4){bf_lo(ulo.x), bf_hi(ulo.x), bf_lo(ulo.y), bf_hi(ulo.y)}, hi = (f32x4){bf_lo(uhi.x), bf_hi(uhi.x), bf_lo(uhi.y), bf_hi(uhi.y)};
        const float sc = qk ? 0.125f : 1.f;
        const f32x4 olo = (lo * cc - hi * sn) * sc, ohi = (hi * cc + lo * sn) * sc;
        u32x2 plo, phi; plo.x = cvt_pk_bf16(olo[0], olo[1]); plo.y = cvt_pk_bf16(olo[2], olo[3]); phi.x = cvt_pk_bf16(ohi[0], ohi[1]); phi.y = cvt_pk_bf16(ohi[2], ohi[3]);
        *(LAS u32x2*)(L + qk * 9216 + t * 144 + 2 * i0) = plo; *(LAS u32x2*)(L + qk * 9216 + t * 144 + 64 + 2 * i0) = phi;
    }
    __syncthreads();
#pragma unroll
    for (int t8 = 0; t8 < 8; ++t8) {
        const int tile = 8 * w2 + t8, mi = tile >> 2, nj = tile & 3;
        bf16_t* ad = V_RAT + chs * 4096 + (size_t)(16 * mi + li) * 64 + 32 * (nj >> 1) + 8 * q4 + 4 * (nj & 1);
        if (nj <= mi) {
            f32x4 aqk = (f32x4){0.f, 0.f, 0.f, 0.f};
            const LAS unsigned char* kj = L + 9216 + (16 * nj + li) * 144 + 16 * q4; const LAS unsigned char* qi = L + (16 * mi + li) * 144 + 16 * q4;
#pragma unroll
            for (int s2 = 0; s2 < 2; ++s2) aqk = mfma16(*(const LAS bf16x8*)(kj + 64 * s2), *(const LAS bf16x8*)(qi + 64 * s2), aqk);
            float ov[4];
#pragma unroll
            for (int rg = 0; rg < 4; ++rg) { const int j2 = 16 * nj + 4 * q4 + rg, i2 = 16 * mi + li; ov[rg] = (i2 >= j2) ? aqk[rg] * exp2f((float)(i2 - j2) * lg2) : 0.f; }
            u32x2 pk; pk.x = cvt_pk_bf16(ov[0], ov[1]); pk.y = cvt_pk_bf16(ov[2], ov[3]); *(u32x2*)ad = pk;
        } else { *(u32x2*)ad = (u32x2){0u, 0u}; }
    }
#pragma unroll
    for (int k4 = 0; k4 < 4; ++k4) {
        const int u_ = t2 + 128 * k4;
        { const int t = u_ >> 3, c8 = u_ & 7; const float sc = exp2f((float)(t + 1) * lg2);
          const u32x4 u = *(const LAS u32x4*)(L + t * 144 + 16 * c8);
          u32x4 o; o.x = cvt_pk_bf16(bf_lo(u.x) * sc, bf_hi(u.x) * sc); o.y = cvt_pk_bf16(bf_lo(u.y) * sc, bf_hi(u.y) * sc); o.z = cvt_pk_bf16(bf_lo(u.z) * sc, bf_hi(u.z) * sc); o.w = cvt_pk_bf16(bf_lo(u.w) * sc, bf_hi(u.w) * sc);
          bf16_t* qd = V_RQG + chs * 4096 + (size_t)t * 64 + 32 * (c8 >> 2) + 16 * (c8 & 1) + 4 * ((c8 >> 1) & 1); *(u32x2*)qd = (u32x2){o.x, o.y}; *(u32x2*)(qd + 8) = (u32x2){o.z, o.w}; }
        { const int dk = u_ >> 3, t8 = (u_ & 7) * 8;
          float v[8];
#pragma unroll
          for (int q = 0; q < 8; ++q) v[q] = bf1(*(const LAS unsigned short*)(L + 9216 + (t8 + q) * 144 + 2 * dk)) * exp2f((float)(63 - t8 - q) * lg2);
          u32x4 o2; o2.x = cvt_pk_bf16(v[0], v[1]); o2.y = cvt_pk_bf16(v[2], v[3]); o2.z = cvt_pk_bf16(v[4], v[5]); o2.w = cvt_pk_bf16(v[6], v[7]);
          bf16_t* kd = V_RKT + chs * 4096 + (size_t)dk * 64 + 32 * (t8 >> 5) + 16 * ((t8 >> 3) & 1) + 4 * ((t8 >> 4) & 1); *(u32x2*)kd = (u32x2){o2.x, o2.y}; *(u32x2*)(kd + 8) = (u32x2){o2.z, o2.w}; }
    }
    __syncthreads();
}
__device__ __forceinline__ void delta_item(Ctx& F, int l, bool sample, int b, int h) {
    LAS float* sm = (LAS float*)F.lds;
    LAS float* qs = sm, *ks = sm + 2048, *vs = sm + 4096, *bgs = sm + 6144, *pa = sm + 6400, *pb = sm + 6912;
    const int tid = F.tid, c = tid & 127, qr = tid >> 7;
    float s[32];
    if (sample) { const float* S0 = F.in[6] + ((size_t)(l * DB + b) * 4 + h) * 16384;
#pragma unroll
        for (int i = 0; i < 32; ++i) s[i] = S0[(32 * qr + i) * 128 + c]; }
    else {
#pragma unroll
        for (int i = 0; i < 32; ++i) s[i] = 0.f; }
    const int T = sample ? DS : SEQ, row0 = sample ? MP + b * DS : b * SEQ;
    for (int t0 = 0; t0 < T; t0 += 16) {
        const int nt = min(16, T - t0);
        __syncthreads();
#pragma unroll
        for (int r = 0; r < 12; ++r) { const int e = tid + 512 * r, tok = e / 384, w = e - tok * 384, typ = w >> 7, d = w & 127;
            if (tok < nt) sm[typ * 2048 + tok * 128 + d] = V_BQKV[(size_t)(row0 + t0 + tok) * 1536 + typ * 512 + h * 128 + d]; }
        if (tid < 32) { const int tok = tid >> 1, wh = tid & 1; if (tok < nt) bgs[tok * 2 + wh] = V_BG[(size_t)(row0 + t0 + tok) * 8 + wh * 4 + h]; }
        __syncthreads();
        for (int tt = 0; tt < nt; ++tt) {
            const LAS float* kk = ks + tt * 128 + 32 * qr; const LAS float* qq = qs + tt * 128 + 32 * qr;
            float a = 0.f;
#pragma unroll
            for (int i = 0; i < 32; ++i) a += kk[i] * s[i];
            pa[qr * 128 + c] = a;
            __syncthreads();
            const float kS = (pa[c] + pa[128 + c]) + (pa[256 + c] + pa[384 + c]);
            const float e = __expf(bgs[tt * 2 + 1]), be = bgs[tt * 2];
            const float vn = be * (vs[tt * 128 + c] - e * kS);
            float o = 0.f;
#pragma unroll
            for (int i = 0; i < 32; ++i) { s[i] = e * s[i] + kk[i] * vn; o += qq[i] * s[i]; }
            pb[qr * 128 + c] = o;
            __syncthreads();
            if (qr == 0) V_OBR[(size_t)(row0 + t0 + tt) * 512 + h * 128 + c] = (pb[c] + pb[128 + c]) + (pb[256 + c] + pb[384 + c]);
        }
    }
    float* So = F.out + (sample ? O_BSS + ((size_t)(l * DB + b) * 4 + h) * 16384 : O_BSP + ((size_t)(l * BATCH + b) * 4 + h) * 16384);
#pragma unroll
    for (int i = 0; i < 32; ++i) So[(32 * qr + i) * 128 + c] = s[i];
    __syncthreads();
}
__device__ __forceinline__ void ret_item(Ctx& F, int l, bool sample, int b, int h) {
    LAS float* sm = (LAS float*)F.lds;
    LAS float* qs = sm, *ks = sm + 1024, *vs = sm + 2048, *pp = sm + 4096;
    const int tid = F.tid, c = tid & 127, qr = tid >> 7;
    const float gam = 1.f - exp2f(-5.f - (float)h);
    float r[16];
    if (sample) { const float* R0 = F.in[7] + ((size_t)(l * DB + b) * 4 + h) * 8192;
#pragma unroll
        for (int i = 0; i < 16; ++i) r[i] = R0[(16 * qr + i) * 128 + c]; }
    else {
#pragma unroll
        for (int i = 0; i < 16; ++i) r[i] = 0.f; }
    const int T = sample ? DS : SEQ, row0 = sample ? MP + b * DS : b * SEQ;
    for (int t0 = 0; t0 < T; t0 += 16) {
        const int nt = min(16, T - t0);
        __syncthreads();
#pragma unroll
        for (int rr = 0; rr < 4; ++rr) { const int e = tid + 512 * rr, tok = e >> 7, w = e & 127, typ = w >> 6, d = w & 63;
            if (tok < nt) sm[typ * 1024 + tok * 64 + d] = V_CQK[(size_t)(row0 + t0 + tok) * 512 + typ * 256 + h * 64 + d]; }
#pragma unroll
        for (int rr = 0; rr < 4; ++rr) { const int e = tid + 512 * rr, tok = e >> 7, d = e & 127;
            if (tok < nt) vs[tok * 128 + d] = bf1(V_PROJ[(size_t)(row0 + t0 + tok) * NPROJ + PC_CV + h * 128 + d]); }
        __syncthreads();
        for (int tt = 0; tt < nt; ++tt) {
            const LAS float* kk = ks + tt * 64 + 16 * qr; const LAS float* qq = qs + tt * 64 + 16 * qr;
            const float v = vs[tt * 128 + c];
            float o = 0.f;
#pragma unroll
            for (int i = 0; i < 16; ++i) { r[i] = gam * r[i] + kk[i] * v; o += qq[i] * r[i]; }
            LAS float* pq = pp + (tt & 1) * 512;
            pq[qr * 128 + c] = o;
            __syncthreads();
            if (qr == 0) V_OCR[(size_t)(row0 + t0 + tt) * 512 + h * 128 + c] = (pq[c] + pq[128 + c]) + (pq[256 + c] + pq[384 + c]);
        }
    }
    float* Ro = F.out + (sample ? O_CRS + ((size_t)(l * DB + b) * 4 + h) * 8192 : O_CRP + ((size_t)(l * BATCH + b) * 4 + h) * 8192);
#pragma unroll
    for (int i = 0; i < 16; ++i) Ro[(16 * qr + i) * 128 + c] = r[i];
    __syncthreads();
}
constexpr int IT_DP = 0, IT_RP = 16, IT_ATS = 32, IT_DS = IT_ATS + 384, IT_RS = IT_DS + 128, IT_AT = IT_RS + 128, IT_END = IT_AT + 768;
__device__ __forceinline__ void phase_mix(Ctx& F, int l, int rep) {
    volatile LAS int* slot = (volatile LAS int*)(F.lds + LDS_BYTES - 64);
    unsigned* ctr = V_CTL + (l == 0 ? CW_MIX0 : CW_MIX1) + 256 * rep;
    for (;;) {
        __syncthreads();
        if (F.tid == 0) *slot = (int)atomicAdd(ctr, 1u);
        __syncthreads();
        const int it = __builtin_amdgcn_readfirstlane(*slot);
        { int t_ = F.tid; asm volatile("" : "+v"(t_)); F.tid = t_; F.lane = t_ & 63; }
        if (it >= IT_END + (l == 0 ? (DEPTH * I_LAYER - I_IN) / 8 : 0)) break;
#ifndef MIXSEL
#define MIXSEL 15
#endif
        if (it < IT_RP) delta_scan2_item(F, l, it >> 2, it & 3);
        else if (it < IT_ATS) ret_scan_item(F, l, (it - IT_RP) >> 2, (it - IT_RP) & 3);
        else if (it < IT_DS) { const int u = (it - IT_ATS) * 8 + F.wave; attn_sample_unit(F, l, u / 12, (u % 12) & 3, (u % 12) >> 2); }
        else if (it < IT_RS) delta_item(F, l, true, (it - IT_DS) >> 2, (it - IT_DS) & 3);
        else if (it < IT_AT) ret_item(F, l, true, (it - IT_RS) >> 2, (it - IT_RS) & 3);
        else if (it < IT_END) attn_mfma_item(F, it - IT_AT);
        else { const int wi = I_IN + (it - IT_END) * 8 + F.wave; prep_weight_item(F, wi, (LAS float*)(F.lds + F.wave * 16896), F.lane); }
    }
}
__device__ __forceinline__ void fin_row(Ctx& F, int l, int row) {
    const int lane = F.lane, h = lane >> 4, j8 = 8 * (lane & 15);
    {
        const float l0 = V_LSE[((size_t)0 * M + row) * 4 + h], l1 = V_LSE[((size_t)1 * M + row) * 4 + h], l2 = V_LSE[((size_t)2 * M + row) * 4 + h];
        const u32x4 a0 = *(const u32x4*)(V_AO + ((size_t)0 * M + row) * 512 + h * 128 + j8), a1 = *(const u32x4*)(V_AO + ((size_t)1 * M + row) * 512 + h * 128 + j8), a2 = *(const u32x4*)(V_AO + ((size_t)2 * M + row) * 512 + h * 128 + j8);
        const float mm = fmaxf(l0, fmaxf(l1, l2)); float e0 = __expf(l0 - mm), e1 = __expf(l1 - mm), e2 = __expf(l2 - mm); const float iv = 1.f / (e0 + e1 + e2); e0 *= iv; e1 *= iv; e2 *= iv;
        u32x4 o;
        o.x = cvt_pk_bf16(e0 * bf_lo(a0.x) + e1 * bf_lo(a1.x) + e2 * bf_lo(a2.x), e0 * bf_hi(a0.x) + e1 * bf_hi(a1.x) + e2 * bf_hi(a2.x));
        o.y = cvt_pk_bf16(e0 * bf_lo(a0.y) + e1 * bf_lo(a1.y) + e2 * bf_lo(a2.y), e0 * bf_hi(a0.y) + e1 * bf_hi(a1.y) + e2 * bf_hi(a2.y));
        o.z = cvt_pk_bf16(e0 * bf_lo(a0.z) + e1 * bf_lo(a1.z) + e2 * bf_lo(a2.z), e0 * bf_hi(a0.z) + e1 * bf_hi(a1.z) + e2 * bf_hi(a2.z));
        o.w = cvt_pk_bf16(e0 * bf_lo(a0.w) + e1 * bf_lo(a1.w) + e2 * bf_lo(a2.w), e0 * bf_hi(a0.w) + e1 * bf_hi(a1.w) + e2 * bf_hi(a2.w));
        *(u32x4*)(V_OABC + (size_t)row * 512 + h * 128 + j8) = o;
    }
#pragma unroll
    for (int br = 0; br < 2; ++br) {
        if (br == 0 && row < MP) continue;
        const float* src = (br == 0 ? V_OBR : V_OCR) + (size_t)row * 512 + h * 128 + j8;
        const f32x4 x0 = *(const f32x4*)src, x1 = *(const f32x4*)(src + 4);
        const float* gn = F.in[15 + br] + l * 128 + j8;
        const f32x4 g0 = *(const f32x4*)gn, g1 = *(const f32x4*)(gn + 4);
        const u32x4 zz = *(const u32x4*)(V_PROJ + (size_t)row * NPROJ + (br == 0 ? PC_BZ : PC_CZ) + h * 128 + j8);
        const float ss = row_sum16((x0[0] * x0[0] + x0[1] * x0[1]) + (x0[2] * x0[2] + x0[3] * x0[3]) + (x1[0] * x1[0] + x1[1] * x1[1]) + (x1[2] * x1[2] + x1[3] * x1[3]));
        const float rstd = rsqrtf(ss * (1.f / 128.f) + EPS);
        const float z0 = bf_lo(zz.x), z1 = bf_hi(zz.x), z2 = bf_lo(zz.y), z3 = bf_hi(zz.y), z4 = bf_lo(zz.z), z5 = bf_hi(zz.z), z6 = bf_lo(zz.w), z7 = bf_hi(zz.w);
        u32x4 o;
        o.x = cvt_pk_bf16(x0[0] * rstd * g0[0] * z0 * sigmoidf_(z0), x0[1] * rstd * g0[1] * z1 * sigmoidf_(z1));
        o.y = cvt_pk_bf16(x0[2] * rstd * g0[2] * z2 * sigmoidf_(z2), x0[3] * rstd * g0[3] * z3 * sigmoidf_(z3));
        o.z = cvt_pk_bf16(x1[0] * rstd * g1[0] * z4 * sigmoidf_(z4), x1[1] * rstd * g1[1] * z5 * sigmoidf_(z5));
        o.w = cvt_pk_bf16(x1[2] * rstd * g1[2] * z6 * sigmoidf_(z6), x1[3] * rstd * g1[3] * z7 * sigmoidf_(z7));
        *(u32x4*)(V_OABC + (size_t)(1 + br) * M * 512 + (size_t)row * 512 + h * 128 + j8) = o;
    }
}

template <int NR>
__device__ __forceinline__ void fin_rows(Ctx& F, int l, const int (&rows)[NR]) {
    const int lane = F.lane, h = lane >> 4, j8 = 8 * (lane & 15);
    float ls[NR][3]; u32x4 ao[NR][3]; f32x4 xc[NR][2]; u32x4 zc[NR];
#pragma unroll
    for (int r = 0; r < NR; ++r) { const int row = rows[r];
#pragma unroll
        for (int g = 0; g < 3; ++g) { ls[r][g] = V_LSE[((size_t)g * M + row) * 4 + h]; ao[r][g] = *(const u32x4*)(V_AO + ((size_t)g * M + row) * 512 + h * 128 + j8); }
        const float* src = V_OCR + (size_t)row * 512 + h * 128 + j8; xc[r][0] = *(const f32x4*)src; xc[r][1] = *(const f32x4*)(src + 4);
        zc[r] = *(const u32x4*)(V_PROJ + (size_t)row * NPROJ + PC_CZ + h * 128 + j8);
    }
    const f32x4 gc0 = *(const f32x4*)(F.in[16] + l * 128 + j8), gc1 = *(const f32x4*)(F.in[16] + l * 128 + j8 + 4);
#pragma unroll
    for (int r = 0; r < NR; ++r) { const int row = rows[r];
        {
            const float mm = fmaxf(ls[r][0], fmaxf(ls[r][1], ls[r][2])); float e0 = __expf(ls[r][0] - mm), e1 = __expf(ls[r][1] - mm), e2 = __expf(ls[r][2] - mm); const float iv = 1.f / (e0 + e1 + e2); e0 *= iv; e1 *= iv; e2 *= iv;
            const u32x4 a0 = ao[r][0], a1 = ao[r][1], a2 = ao[r][2]; u32x4 o;
            o.x = cvt_pk_bf16(e0 * bf_lo(a0.x) + e1 * bf_lo(a1.x) + e2 * bf_lo(a2.x), e0 * bf_hi(a0.x) + e1 * bf_hi(a1.x) + e2 * bf_hi(a2.x));
            o.y = cvt_pk_bf16(e0 * bf_lo(a0.y) + e1 * bf_lo(a1.y) + e2 * bf_lo(a2.y), e0 * bf_hi(a0.y) + e1 * bf_hi(a1.y) + e2 * bf_hi(a2.y));
            o.z = cvt_pk_bf16(e0 * bf_lo(a0.z) + e1 * bf_lo(a1.z) + e2 * bf_lo(a2.z), e0 * bf_hi(a0.z) + e1 * bf_hi(a1.z) + e2 * bf_hi(a2.z));
            o.w = cvt_pk_bf16(e0 * bf_lo(a0.w) + e1 * bf_lo(a1.w) + e2 * bf_lo(a2.w), e0 * bf_hi(a0.w) + e1 * bf_hi(a1.w) + e2 * bf_hi(a2.w));
            *(u32x4*)(V_OABC + (size_t)row * 512 + h * 128 + j8) = o;
        }
        {
            const f32x4 x0 = xc[r][0], x1 = xc[r][1]; const u32x4 zz = zc[r]; const f32x4 g0 = gc0, g1 = gc1; const int br = 1;
            const float ss = row_sum16((x0[0] * x0[0] + x0[1] * x0[1]) + (x0[2] * x0[2] + x0[3] * x0[3]) + (x1[0] * x1[0] + x1[1] * x1[1]) + (x1[2] * x1[2] + x1[3] * x1[3]));
            const float rstd = rsqrtf(ss * (1.f / 128.f) + EPS);
            const float z0 = bf_lo(zz.x), z1 = bf_hi(zz.x), z2 = bf_lo(zz.y), z3 = bf_hi(zz.y), z4 = bf_lo(zz.z), z5 = bf_hi(zz.z), z6 = bf_lo(zz.w), z7 = bf_hi(zz.w);
            u32x4 o;
            o.x = cvt_pk_bf16(x0[0] * rstd * g0[0] * z0 * sigmoidf_(z0), x0[1] * rstd * g0[1] * z1 * sigmoidf_(z1));
            o.y = cvt_pk_bf16(x0[2] * rstd * g0[2] * z2 * sigmoidf_(z2), x0[3] * rstd * g0[3] * z3 * sigmoidf_(z3));
            o.z = cvt_pk_bf16(x1[0] * rstd * g1[0] * z4 * sigmoidf_(z4), x1[1] * rstd * g1[1] * z5 * sigmoidf_(z5));
            o.w = cvt_pk_bf16(x1[2] * rstd * g1[2] * z6 * sigmoidf_(z6), x1[3] * rstd * g1[3] * z7 * sigmoidf_(z7));
            *(u32x4*)(V_OABC + (size_t)(1 + br) * M * 512 + (size_t)row * 512 + h * 128 + j8) = o;
        }
    }
}

__device__ __forceinline__ void fin_b_row(Ctx& F, int l, int row) {
    const int lane = F.lane, h = lane >> 4, j8 = 8 * (lane & 15);
    const float* src = V_OBR + (size_t)row * 512 + h * 128 + j8; const f32x4 x0 = *(const f32x4*)src, x1 = *(const f32x4*)(src + 4);
    const u32x4 zz = *(const u32x4*)(V_PROJ + (size_t)row * NPROJ + PC_BZ + h * 128 + j8);
    const f32x4 g0 = *(const f32x4*)(F.in[15] + l * 128 + j8), g1 = *(const f32x4*)(F.in[15] + l * 128 + j8 + 4);
    const float ss = row_sum16((x0[0] * x0[0] + x0[1] * x0[1]) + (x0[2] * x0[2] + x0[3] * x0[3]) + (x1[0] * x1[0] + x1[1] * x1[1]) + (x1[2] * x1[2] + x1[3] * x1[3]));
    const float rstd = rsqrtf(ss * (1.f / 128.f) + EPS);
    const float z0 = bf_lo(zz.x), z1 = bf_hi(zz.x), z2 = bf_lo(zz.y), z3 = bf_hi(zz.y), z4 = bf_lo(zz.z), z5 = bf_hi(zz.z), z6 = bf_lo(zz.w), z7 = bf_hi(zz.w);
    u32x4 o;
    o.x = cvt_pk_bf16(x0[0] * rstd * g0[0] * z0 * sigmoidf_(z0), x0[1] * rstd * g0[1] * z1 * sigmoidf_(z1));
    o.y = cvt_pk_bf16(x0[2] * rstd * g0[2] * z2 * sigmoidf_(z2), x0[3] * rstd * g0[3] * z3 * sigmoidf_(z3));
    o.z = cvt_pk_bf16(x1[0] * rstd * g1[0] * z4 * sigmoidf_(z4), x1[1] * rstd * g1[1] * z5 * sigmoidf_(z5));
    o.w = cvt_pk_bf16(x1[2] * rstd * g1[2] * z6 * sigmoidf_(z6), x1[3] * rstd * g1[3] * z7 * sigmoidf_(z7));
    *(u32x4*)(V_OABC + (size_t)M * 512 + (size_t)row * 512 + h * 128 + j8) = o;
}
typedef float f32x16 __attribute__((ext_vector_type(16)));
template <int NSUB, bool GATED>
__device__ __forceinline__ void mini_gemm_core(Ctx& F, int tile, const bf16_t* A, size_t a_sub, const bf16_t* Bt, size_t b_sub, int K, float (&res)[2], int& orow, int& ocol, int (&oreg)[2]) {
    const int lane = F.lane, w = F.wave, r = lane & 31, hh = lane >> 5;
    const int rb = tile & 7, cb = tile >> 3;
    const int kw = K >> 3, k0 = w * kw;
    f32x16 tot;
#pragma unroll
    for (int i = 0; i < 16; ++i) tot[i] = 0.f;
#pragma unroll 1
    for (int sub = 0; sub < NSUB; ++sub) {
        const bf16_t* ap = A + sub * a_sub + (size_t)(MP + rb * 32 + r) * K + k0 + 8 * hh;
        const bf16_t* bp = Bt + sub * b_sub + (size_t)(cb * 32 + r) * K + k0 + 8 * hh;
        f32x16 acc;
#pragma unroll
        for (int i = 0; i < 16; ++i) acc[i] = 0.f;
#pragma unroll 2
        for (int s2 = 0; s2 < kw; s2 += 16) acc = __builtin_amdgcn_mfma_f32_32x32x16_bf16(*(const bf16x8*)(ap + s2), *(const bf16x8*)(bp + s2), acc, 0, 0, 0);
        if (GATED) {
            const bf16_t* gp = V_PROJ + (size_t)(MP + rb * 32 + 4 * hh) * NPROJ + PC_GATE + sub * 1024 + cb * 32 + r;
#pragma unroll
            for (int i = 0; i < 16; ++i) tot[i] += bf1(gp[(size_t)((i & 3) + 8 * (i >> 2)) * NPROJ]) * acc[i];
        } else tot = acc;
    }
    LAS float* red = (LAS float*)F.lds;
#pragma unroll
    for (int i = 0; i < 16; ++i) red[(w * 16 + i) * 64 + lane] = tot[i];
    __syncthreads();
    const int g = F.tid >> 6;
#pragma unroll
    for (int q = 0; q < 2; ++q) { const int rg = 2 * g + q; float v = 0.f;
#pragma unroll
        for (int ww = 0; ww < 8; ++ww) v += red[(ww * 16 + rg) * 64 + lane];
        res[q] = v; oreg[q] = rg; }
    orow = MP + rb * 32 + 4 * hh; ocol = cb * 32 + r;
    __syncthreads();
}
__device__ __forceinline__ void mini_abc(Ctx& F, int l) {
    for (int tile = F.bid; tile < 256; tile += F.G) {
    float res[2]; int orow, ocol, oreg[2];
    mini_gemm_core<3, true>(F, tile, V_OABC, (size_t)M * 512, V_WABC + (size_t)l * 3 * D * 512, (size_t)D * 512, 512, res, orow, ocol, oreg);
#pragma unroll
    for (int q = 0; q < 2; ++q) { const int row = orow + (oreg[q] & 3) + 8 * (oreg[q] >> 2);
        V_MRG[(size_t)row * D + ocol] = (bf16_t)(cvt_pk_bf16(res[q], 0.f) & 0xffffu); }
    }
}
__device__ __forceinline__ void mini_res(Ctx& F, const bf16_t* A, const bf16_t* Bt, int K, const float* resid  , const bf16_t* resb  , float* out, bf16_t* xb, float* rowss) {
    for (int tile = F.bid; tile < 256; tile += F.G) {
    float res[2]; int orow, ocol, oreg[2];
    mini_gemm_core<1, false>(F, tile, A, 0, Bt, 0, K, res, orow, ocol, oreg);
#pragma unroll
    for (int q = 0; q < 2; ++q) { const int row = orow + (oreg[q] & 3) + 8 * (oreg[q] >> 2);
        const float o = (resb ? bf1(resb[(size_t)row * D + ocol]) : resid[(size_t)(row - MP) * D + ocol]) + res[q];
        if (out) out[(size_t)row * D + ocol] = o; else xb[(size_t)row * D + ocol] = (bf16_t)(cvt_pk_bf16(o, 0.f) & 0xffffu);
        float ss = o * o;
        ss = row_sum16(ss); ss += __shfl_xor(ss, 16);
        if ((F.lane & 31) == 0) atomicAdd(rowss + row, ss); }
    }
}
constexpr int N_PHASES = 1 + 8 * DEPTH;
__global__ void __launch_bounds__(NTHREADS, 2) mega_fwd(Args args) {
    extern __shared__ __attribute__((aligned(16))) unsigned char lds_raw[];
    Ctx F;
    F.in = nullptr; F.out = nullptr; F.ws = nullptr; F.tid = 0; F.lane = 0; F.wave = 0;
    F.lds = (LAS unsigned char*)lds_raw;
    F.G = gridDim.x; F.bid = blockIdx.x;
    volatile LAS unsigned* bst = (volatile LAS unsigned*)(F.lds + LDS_BYTES - 128);
    if (threadIdx.x < 2) bst[threadIdx.x] = 0u;
    __syncthreads();
    (void)xcd_barrier_post((unsigned*)(args.ws + WS_CTL) + CW_BAR, bst);
#define XBAR() do { XcdBarrier xb_; xb_.bar = (unsigned*)(F.ws + WS_CTL) + CW_BAR; xb_.x = xb_xcc_id(); xb_.st = (volatile LAS unsigned*)(F.lds + LDS_BYTES - 128); xcd_barrier(xb_, F.tid); } while (0)
    int ph0 = args.ph_lo;
    if (ph0 == 0) {
        { int tid_ = threadIdx.x; asm volatile("" : "+v"(tid_)); F.tid = tid_; F.lane = tid_ & 63; F.wave = __builtin_amdgcn_readfirstlane(tid_ >> 6);
          { int bid_ = blockIdx.x, g_ = gridDim.x; asm volatile("" : "+s"(bid_), "+s"(g_)); F.bid = bid_; F.G = g_; }
          const __attribute__((address_space(4))) char* ka = (const __attribute__((address_space(4))) char*)__builtin_amdgcn_kernarg_segment_ptr(); asm volatile("" : "+s"(ka));
          F.in = (const float* const __attribute__((address_space(4)))*)ka; F.out = *(float* const __attribute__((address_space(4)))*)(ka + 192); F.ws = *(unsigned char* const __attribute__((address_space(4)))*)(ka + 200); }
        const int gw = F.bid * NWAVES + F.wave, NGW = F.G * NWAVES;
        if (PH_MASK & 1) phase_prep(F);
        if (DUP_K == 8) { cg::this_grid().sync(); phase_prep(F); }
        if (DUP_K == 9) { for (int q_ = 0; q_ < 32; ++q_) XBAR(); }
        ph0 = 1;
        if (args.ph_hi > 1000000) cg::this_grid().sync();
        if (ph0 < args.ph_hi) XBAR();
    }
    for (int ph = ph0, rep = 0; ph < args.ph_hi; ++ph) {
        { int tid_ = threadIdx.x; asm volatile("" : "+v"(tid_)); F.tid = tid_; F.lane = tid_ & 63; F.wave = __builtin_amdgcn_readfirstlane(tid_ >> 6);
          { int bid_ = blockIdx.x, g_ = gridDim.x; asm volatile("" : "+s"(bid_), "+s"(g_)); F.bid = bid_; F.G = g_; }
          const __attribute__((address_space(4))) char* ka = (const __attribute__((address_space(4))) char*)__builtin_amdgcn_kernarg_segment_ptr(); asm volatile("" : "+s"(ka));
          F.in = (const float* const __attribute__((address_space(4)))*)ka; F.out = *(float* const __attribute__((address_space(4)))*)(ka + 192); F.ws = *(unsigned char* const __attribute__((address_space(4)))*)(ka + 200); }
        const int gw = F.bid * NWAVES + F.wave, NGW = F.G * NWAVES;
        {
            const int l = (ph - 1) >> 3, k = (ph - 1) & 7;
            if (k == 0 && (PH_MASK & 2)) {
                pg8::Gemm g{V_XBA, V_WIN + (size_t)l * NPROJ * D, D}; pg8::Order<1> S; S.init(M / 256, NPROJ / 256, F.G, F.bid);
                EpiProj E{V_PROJ, V_RS + (size_t)(2 * l) * M};
                pg8::gemm_phase(F.lds, F.tid, g, S, E);
            } else if (k == 1 && (PH_MASK & 4)) {
                {
                    const bool sq = !(DUP_K == 1 && rep == 0);
                    int row = gw;
                    for (; row + 2 * NGW < M; row += 3 * NGW) { const int rr[3] = {row, row + NGW, row + 2 * NGW}; e1_partA<3>(F, l, rr, sq); }
                    for (; row < M; row += NGW) { const int rr[1] = {row}; e1_partA<1>(F, l, rr, sq); }
                    for (int r2 = gw; r2 < M; r2 += NGW) if (r2 >= MP || (r2 & 4095) >= SEQ - 3) e1_row(F, l, r2);
                }
                __syncthreads();
                for (int it = F.bid; it < NCH / 2; it += F.G) delta_prep_item2(F, l, it);
                for (int it = F.bid; it < NCH / 4; it += F.G) ret_prep_item(F, l, it);
            } else if (k == 2 && (PH_MASK & 8)) {
                phase_mix(F, l, rep);
            } else if (k == 3 && (PH_MASK & 16)) {
                for (int row = gw; row < M; row += 2 * NGW) { if (row + NGW < M) { const int rr[2] = {row, row + NGW}; fin_rows<2>(F, l, rr); } else { const int rr[1] = {row}; fin_rows<1>(F, l, rr); } }
                for (int row = MP + gw; row < M; row += NGW) fin_b_row(F, l, row);
                __syncthreads();
                for (int it = F.bid; it < NCH; it += F.G) delta_out_item(F, l, it);
            } else if (k == 4 && (PH_MASK & 32)) {
                mini_abc(F, l);
                pg8::Gemm g{V_OABC, V_WABC + (size_t)l * 3 * D * 512, 512}; pg8::Order<3> S; S.init(MP / 256, D / 256, F.G, F.bid); S.sub_m = M / 256;
                EpiAbc E{V_PROJ, V_MRG};
                pg8::gemm_phase(F.lds, F.tid, g, S, E);
            } else if (k == 5 && (PH_MASK & 64)) {
                mini_res(F, V_MRG, V_WOUT + (size_t)l * D * D, D, l == 0 ? F.in[1] : nullptr, l == 0 ? nullptr : V_XBA, nullptr, V_XBB, V_RS + (size_t)(2 * l + 1) * M);
                pg8::Gemm g{V_MRG, V_WOUT + (size_t)l * D * D, D}; pg8::Order<1> S; S.init(MP / 256, D / 256, F.G, F.bid);
                EpiRes E{F.in[0], F.in[1], l == 0 ? nullptr : V_XBA, nullptr, V_XBB, V_RS + (size_t)(2 * l + 1) * M};
                pg8::gemm_phase(F.lds, F.tid, g, S, E);
            } else if (k == 6 && (PH_MASK & 128)) {
                pg8::Gemm g{V_XBB, V_WFI + (size_t)l * 2 * DFF * D, D}; pg8::Order<1> S; S.init(M / 256, 2 * DFF / 256, F.G, F.bid);
                EpiFfn E{V_ACT, V_RS + (size_t)(2 * l + 1) * M};
                pg8::gemm_phase(F.lds, F.tid, g, S, E);
            } else if (k == 7 && (PH_MASK & 256)) {
                mini_res(F, V_ACT, V_WFO + (size_t)l * D * DFF, DFF, nullptr, V_XBB, l == DEPTH - 1 ? F.out : nullptr, V_XBA, V_RS + (size_t)(l == DEPTH - 1 ? 3 : 2) * M);
                pg8::Gemm g{V_ACT, V_WFO + (size_t)l * D * DFF, DFF}; pg8::Order<1> S; S.init(MP / 256, D / 256, F.G, F.bid);
                EpiRes E{nullptr, nullptr, V_XBB, l == DEPTH - 1 ? F.out : nullptr, V_XBA, V_RS + (size_t)(l == DEPTH - 1 ? 3 : 2) * M};
                pg8::gemm_phase(F.lds, F.tid, g, S, E);
            }
        }
        if (DUP_K >= 0 && ((ph - 1) & 7) == DUP_K && rep == 0) { rep = 1; --ph; XBAR(); continue; }
        rep = 0;
        if (ph + 1 < args.ph_hi) XBAR();
    }
}

extern "C" void kernel_launch(void* const* d_in, const int* in_sizes, int n_in, void* d_out, int out_size, void* d_ws, size_t ws_size, hipStream_t stream) {
    static int grid = 0;
    if (grid == 0) {
        if (n_in != 24 || (size_t)out_size != O_END || ws_size < WS_END) { fprintf(stderr, "kernel_launch: unexpected shapes (n_in %d out %d ws %zu, need %zu / %zu)\n", n_in, out_size, ws_size, (size_t)O_END, (size_t)WS_END); grid = -1; return; }
        int dev = 0, cus = 0, per_cu = 0;
        if (hipGetDevice(&dev) != hipSuccess || hipDeviceGetAttribute(&cus, hipDeviceAttributeMultiprocessorCount, dev) != hipSuccess) { grid = -1; return; }
        if (hipFuncSetAttribute((const void*)mega_fwd, hipFuncAttributeMaxDynamicSharedMemorySize, LDS_BYTES) != hipSuccess) { fprintf(stderr, "kernel_launch: hipFuncSetAttribute failed\n"); grid = -1; return; }
        if (hipOccupancyMaxActiveBlocksPerMultiprocessor(&per_cu, (const void*)mega_fwd, NTHREADS, LDS_BYTES) != hipSuccess || per_cu < 1) { fprintf(stderr, "kernel_launch: occupancy query says %d\n", per_cu); per_cu = 1; }
        (void)hipGetLastError();
        grid = cus;
    }
    if (grid < 0) return;
    (void)hipMemsetAsync((char*)d_ws + WS_CTL, 0, 32768, stream);
    Args a{};
    for (int i = 0; i < 24; ++i) a.in[i] = (const float*)d_in[i];
    a.out = (float*)d_out; a.ws = (unsigned char*)d_ws;
#if MK_ONE_LAUNCH
    a.ph_lo = 0; a.ph_hi = N_PHASES;
    void* kargs[] = {&a};
    hipError_t e = hipLaunchCooperativeKernel((const void*)mega_fwd, dim3(grid), dim3(NTHREADS), kargs, LDS_BYTES, stream);
    if (e != hipSuccess) fprintf(stderr, "cooperative launch failed: %s (grid %d)\n", hipGetErrorString(e), grid);
#else
    for (int ph = 0; ph < N_PHASES; ++ph) {
        a.ph_lo = ph; a.ph_hi = ph + 1;
        hipLaunchKernelGGL(mega_fwd, dim3(grid), dim3(NTHREADS), LDS_BYTES, stream, a);
    }
#endif
}
```

```cpp
#include <hip/hip_runtime.h>
#include <hip/hip_cooperative_groups.h>
#include <cstdio>
#include <cstdint>
namespace cg = cooperative_groups;

#ifndef DUP_K
#define DUP_K -1
#endif
#ifndef PH_MASK
#define PH_MASK 0x1ff
#endif
#ifndef MK_ONE_LAUNCH
#define MK_ONE_LAUNCH 1
#endif

#define LAS __attribute__((address_space(3)))
typedef unsigned short bf16_t;
typedef short bf16x8 __attribute__((ext_vector_type(8)));
typedef float f32x4 __attribute__((ext_vector_type(4)));
typedef float f32x2 __attribute__((ext_vector_type(2)));
typedef unsigned u32x4 __attribute__((ext_vector_type(4)));
typedef unsigned u32x2 __attribute__((ext_vector_type(2)));

constexpr int D = 1024, BATCH = 4, SEQ = 4096, DEPTH = 2, DB = 32, DS = 8, PAST = 8192;
constexpr int MP = BATCH * SEQ, MS = DB * DS, M = MP + MS;
constexpr int NIN = 11272, NPROJ = 11520, DFF = 2816;
constexpr int PC_AQ = 0, PC_AK = 1536, PC_AV = 3072, PC_BQKV = 4608, PC_BZ = 6144, PC_CQ = 6656, PC_CK = 6912, PC_CV = 7168, PC_CZ = 7680, PC_GATE = 8192, PC_BETA = 11264, PC_BA = 11268;
constexpr float EPS = 1e-6f;
constexpr int NPOS = SEQ + DS;

constexpr size_t O_YP = 0;
constexpr size_t O_YS = O_YP + (size_t)MP * D;
constexpr size_t O_KV0P = O_YS + (size_t)MS * D;
constexpr size_t O_KV1P = O_KV0P + (size_t)DEPTH * BATCH * 128 * 1024;
constexpr size_t O_KV2P = O_KV1P + (size_t)DEPTH * BATCH * 512 * 1024;
constexpr size_t O_BCP = O_KV2P + (size_t)DEPTH * BATCH * 2048 * 1024;
constexpr size_t O_BSP = O_BCP + (size_t)DEPTH * BATCH * 3 * 1536;
constexpr size_t O_CRP = O_BSP + (size_t)DEPTH * BATCH * 4 * 128 * 128;
constexpr size_t O_KV0S = O_CRP + (size_t)DEPTH * BATCH * 4 * 64 * 128;
constexpr size_t O_KV1S = O_KV0S + (size_t)DEPTH * DB * DS * 1024;
constexpr size_t O_KV2S = O_KV1S + (size_t)DEPTH * DB * DS * 1024;
constexpr size_t O_BCS = O_KV2S + (size_t)DEPTH * DB * DS * 1024;
constexpr size_t O_BSS = O_BCS + (size_t)DEPTH * DB * 3 * 1536;
constexpr size_t O_CRS = O_BSS + (size_t)DEPTH * DB * 4 * 128 * 128;
constexpr size_t O_END = O_CRS + (size_t)DEPTH * DB * 4 * 64 * 128;

constexpr size_t al256(size_t x) { return (x + 255) & ~(size_t)255; }
constexpr size_t WS_CTL = 0, CTL_BYTES = 1u << 20;
constexpr size_t WS_WIN = WS_CTL + CTL_BYTES;
constexpr size_t WS_WABC = WS_WIN + al256((size_t)DEPTH * NPROJ * D * 2);
constexpr size_t WS_WOUT = WS_WABC + al256((size_t)DEPTH * 3 * D * 512 * 2);
constexpr size_t WS_WFI = WS_WOUT + al256((size_t)DEPTH * D * D * 2);
constexpr size_t WS_WFO = WS_WFI + al256((size_t)DEPTH * 2 * DFF * D * 2);
constexpr size_t WS_XBA = WS_WFO + al256((size_t)DEPTH * D * DFF * 2);
constexpr size_t WS_XBB = WS_XBA + al256((size_t)M * D * 2);
constexpr size_t WS_X1 = WS_XBB + al256((size_t)M * D * 2);
constexpr size_t WS_X2 = WS_X1 + al256((size_t)M * D * 4);
constexpr size_t WS_RS = WS_X2 + al256((size_t)M * D * 4);
constexpr size_t WS_PROJ = WS_RS + al256((size_t)4 * M * 4);
constexpr size_t WS_BQKV = WS_PROJ + al256((size_t)M * NPROJ * 2);
constexpr size_t WS_BG = WS_BQKV + al256((size_t)M * 1536 * 4);
constexpr size_t WS_CQK = WS_BG + al256((size_t)M * 8 * 4);
constexpr size_t WS_OBR = WS_CQK + al256((size_t)M * 512 * 4);
constexpr size_t WS_OCR = WS_OBR + al256((size_t)M * 512 * 4);
constexpr size_t WS_OABC = WS_OCR + al256((size_t)M * 512 * 4);
constexpr size_t WS_MRG = WS_OABC + al256((size_t)3 * M * 512 * 2);
constexpr size_t WS_ACT = WS_MRG + al256((size_t)M * D * 2);
constexpr size_t WS_ROPEA = WS_ACT + al256((size_t)M * DFF * 2);
constexpr size_t WS_ROPEC = WS_ROPEA + al256((size_t)NPOS * 64 * 2 * 4);
constexpr size_t WS_AO = WS_ROPEC + al256((size_t)NPOS * 32 * 2 * 4);
constexpr size_t WS_LSE = WS_AO + al256((size_t)3 * M * 512 * 2);
constexpr int NCH = BATCH * 4 * 64;
constexpr size_t WS_DW = WS_LSE + al256((size_t)3 * M * 4 * 4);
constexpr size_t WS_DQG = WS_DW + al256((size_t)NCH * 64 * 128 * 2);
constexpr size_t WS_DKT = WS_DQG + al256((size_t)NCH * 64 * 128 * 2);
constexpr size_t WS_DAT = WS_DKT + al256((size_t)NCH * 64 * 128 * 2);
constexpr size_t WS_DU = WS_DAT + al256((size_t)NCH * 64 * 64 * 2);
constexpr size_t WS_DDL = WS_DU + al256((size_t)NCH * 64 * 128 * 4);
constexpr size_t WS_RQG = WS_DDL + al256((size_t)NCH * 4);
constexpr size_t WS_RKT = WS_RQG + al256((size_t)NCH * 64 * 64 * 2);
constexpr size_t WS_RAT = WS_RKT + al256((size_t)NCH * 64 * 64 * 2);
constexpr size_t WS_RU = WS_RAT + al256((size_t)NCH * 64 * 64 * 2);
constexpr size_t WS_SB = WS_RU + al256((size_t)NCH * 64 * 128 * 4);
constexpr size_t WS_VB = WS_SB + al256((size_t)NCH * 16384 * 2);
constexpr size_t WS_END = WS_VB + al256((size_t)NCH * 8192 * 2);
constexpr int CW_MIX0 = 64, CW_MIX1 = 128, CW_BAR = 1024;

constexpr int NWAVES = 8, NTHREADS = 512;
constexpr int RING_BYTES = 131072, LDS_BYTES = 147456;

__device__ __forceinline__ float bf_lo(unsigned u) { return __uint_as_float(u << 16); }
__device__ __forceinline__ float bf_hi(unsigned u) { return __uint_as_float(u & 0xffff0000u); }
__device__ __forceinline__ float bf1(bf16_t u) { return __uint_as_float(((unsigned)u) << 16); }
typedef __bf16 bf16x2_t __attribute__((ext_vector_type(2)));
__device__ __forceinline__ unsigned cvt_pk_bf16(float lo, float hi) { const f32x2 f = {lo, hi}; const bf16x2_t v = __builtin_convertvector(f, bf16x2_t); return __builtin_bit_cast(unsigned, v); }
template <int CTRL> __device__ __forceinline__ float dpp_mov(float v) { return __int_as_float(__builtin_amdgcn_update_dpp(0, __float_as_int(v), CTRL, 0xf, 0xf, true)); }
__device__ __forceinline__ float rdlane(float v, int l) { return __int_as_float(__builtin_amdgcn_readlane(__float_as_int(v), l)); }
__device__ __forceinline__ float row_sum16(float v) { v += dpp_mov<0xB1>(v); v += dpp_mov<0x4E>(v); v += dpp_mov<0x141>(v); v += dpp_mov<0x140>(v); return v; }
__device__ __forceinline__ float row_max16(float v) { v = fmaxf(v, dpp_mov<0xB1>(v)); v = fmaxf(v, dpp_mov<0x4E>(v)); v = fmaxf(v, dpp_mov<0x141>(v)); v = fmaxf(v, dpp_mov<0x140>(v)); return v; }
__device__ __forceinline__ float wave_sum(float v) { v = row_sum16(v); return (rdlane(v, 0) + rdlane(v, 16)) + (rdlane(v, 32) + rdlane(v, 48)); }
__device__ __forceinline__ float wave_max(float v) { v = row_max16(v); return fmaxf(fmaxf(rdlane(v, 0), rdlane(v, 16)), fmaxf(rdlane(v, 32), rdlane(v, 48))); }
__device__ __forceinline__ float half_sum(float v) { v = row_sum16(v); return v + __shfl_xor(v, 16); }
__device__ __forceinline__ float sigmoidf_(float x) { return __builtin_amdgcn_rcpf(1.f + __expf(-x)); }

namespace pg8 {
constexpr int BM = 256, BK = 64, HALF = 128, HTB = HALF * BK * 2, NXCD = 8, WGM = 2;
__host__ __device__ __forceinline__ int lds_byte(int r, int c) { const int st = (r >> 4) * 2 + (c >> 5), rr = r & 15, cc = c & 31, ob = rr * 64 + cc * 2; return st * 1024 + (ob ^ (((ob >> 9) & 1) << 5)); }
__host__ __device__ __forceinline__ void stage_rc(int b, int& R, int& C) { const int st = b / 1024, sb = b % 1024, swz = sb ^ (((sb >> 9) & 1) << 5); R = (st >> 1) * 16 + swz / 64; C = (st & 1) * 32 + (swz % 64) / 2; }
__host__ __device__ __forceinline__ int perm32(int rho) { const int n = rho >> 4, i = rho & 15; return 8 * (i >> 2) + 4 * n + (i & 3); }

struct Unit { int pm, pn; };
struct Gemm { const bf16_t* A; const bf16_t* Bt; int K; };

template <int TRIP> struct Order {
    int nM, nN, nwg, G, c, sub_m;
    __device__ void init(int nM_, int nN_, int G_, int c_) { nM = nM_; nN = nN_; nwg = nM * nN; G = G_; c = c_; sub_m = nM_; }
    __device__ bool next(int i, Unit& u) const {
        const int ii = i / TRIP, sub = i - ii * TRIP;
        const long L = (long)ii * G + c; if (L >= nwg) return false;
        int wgid = (int)L; { const int q = nwg / NXCD, r = nwg % NXCD, xcd = wgid % NXCD, off = wgid / NXCD; wgid = (xcd < r ? xcd * (q + 1) : r * (q + 1) + (xcd - r) * q) + off; }
        const int nig = WGM * nN, gid = wgid / nig, fm = gid * WGM, gsz = (nM - fm) < WGM ? (nM - fm) : WGM;
        u.pm = fm + ((wgid % nig) % gsz) + sub * sub_m; u.pn = (wgid % nig) / gsz + sub * nN; return true;
    }
};

template <class Epi, class Sched>
__device__ __forceinline__ void gemm_phase(LAS unsigned char* lds, const int tid, const Gemm g, const Sched& S, const Epi& E) {
    const int wid = __builtin_amdgcn_readfirstlane(tid >> 6), lane = tid & 63, wr = wid >> 2, wc = wid & 3, fr = lane & 15, fq = lane >> 4;
    const int K = g.K, nt = K / BK;
    unsigned voffA[2], voffB[2];
#pragma unroll
    for (int i = 0; i < 2; ++i) { int R, C; stage_rc(tid * 16 + i * 8192, R, C); const int Rb = Epi::PERM ? ((R & ~31) + perm32(R & 31)) : R;
        voffA[i] = (unsigned)(R * K + C) * 2u; voffB[i] = (unsigned)(Rb * K + C) * 2u; }
    const size_t kstep = (size_t)(BK * 2);
    const size_t hstep = (size_t)HALF * K * 2;
    const size_t tstep = 2 * hstep;
    const unsigned ldsw = (unsigned)wid * 1024u;
    const int aoff = lds_byte(wr * 64 + fr, fq * 8), boff = lds_byte(wc * 32 + fr, fq * 8);
#define PG8_SA(b, h) (((b) * 2 + (h)) * HTB)
#define PG8_SB(b, h) ((4 + (b) * 2 + (h)) * HTB)
#define PG8_STAGE(bufoff, gbase, voff) do { _Pragma("unroll") for (int _i = 0; _i < 2; ++_i) \
        __builtin_amdgcn_global_load_lds((const unsigned*)((const char*)(gbase) + (voff)[_i]), (LAS unsigned*)(lds + (bufoff) + ldsw + _i * 8192), 16, 0, 0); } while (0)
#define PG8_LDA(dst, b, h) do { _Pragma("unroll") for (int m = 0; m < 4; ++m) _Pragma("unroll") for (int k = 0; k < 2; ++k) dst[m][k] = *(const LAS bf16x8*)(lds + PG8_SA(b, h) + aoff + m * 2048 + k * 1024); } while (0)
#define PG8_LDB(dst, b, h) do { _Pragma("unroll") for (int n = 0; n < 2; ++n) _Pragma("unroll") for (int k = 0; k < 2; ++k) dst[n][k] = *(const LAS bf16x8*)(lds + PG8_SB(b, h) + boff + n * 2048 + k * 1024); } while (0)
#define PG8_MMA(ai, bj, At, Bt) do { __builtin_amdgcn_s_setprio(1); _Pragma("unroll") for (int m = 0; m < 4; ++m) _Pragma("unroll") for (int n = 0; n < 2; ++n) _Pragma("unroll") for (int k = 0; k < 2; ++k) \
        acc[ai][bj][m][n] = __builtin_amdgcn_mfma_f32_16x16x32_bf16(Bt[n][k], At[m][k], acc[ai][bj][m][n], 0, 0, 0); __builtin_amdgcn_s_setprio(0); } while (0)
#define PG8_WAIT_V(n) asm volatile("s_waitcnt vmcnt(" #n ")" ::: "memory")
#define PG8_WAIT_L(n) asm volatile("s_waitcnt lgkmcnt(" #n ")" ::: "memory")
#define PG8_BAR __builtin_amdgcn_s_barrier()
#define PG8_SCHED __builtin_amdgcn_sched_barrier(0)
    Unit cur, nxt; int ui = 0;
    if (!S.next(0, cur)) return;
    f32x4 acc[2][2][4][2];
#pragma unroll
    for (int a = 0; a < 2; ++a)
#pragma unroll
        for (int b = 0; b < 2; ++b)
#pragma unroll
            for (int m = 0; m < 4; ++m)
#pragma unroll
                for (int n = 0; n < 2; ++n) acc[a][b][m][n] = (f32x4){0.f, 0.f, 0.f, 0.f};
    bf16x8 At[4][2], B0[2][2], B1[2][2];
    const char* cA = (const char*)g.A + (size_t)cur.pm * tstep; const char* cB = (const char*)g.Bt + (size_t)cur.pn * tstep;
    PG8_STAGE(PG8_SB(0, 0), cB, voffB); PG8_STAGE(PG8_SB(0, 1), cB + hstep, voffB); PG8_STAGE(PG8_SA(0, 0), cA, voffA); PG8_STAGE(PG8_SA(0, 1), cA + hstep, voffA);
    if (wr == 1) PG8_BAR;
    PG8_WAIT_V(2); PG8_BAR;
    PG8_STAGE(PG8_SB(1, 0), cB + kstep, voffB); PG8_STAGE(PG8_SA(1, 0), cA + kstep, voffA); PG8_STAGE(PG8_SB(1, 1), cB + hstep + kstep, voffB);
    PG8_WAIT_V(6); PG8_BAR;
    for (;;) {
        const bool has_next = S.next(ui + 1, nxt);
        const char* nA = has_next ? (const char*)g.A + (size_t)nxt.pm * tstep : cA; const char* nB = has_next ? (const char*)g.Bt + (size_t)nxt.pn * tstep : cB;
        for (int t = 0; t < nt; t += 2) {
            const bool last = (t == nt - 2);
            const char* a1 = cA + (size_t)(t + 1) * kstep;
            const char* a2 = last ? nA : cA + (size_t)(t + 2) * kstep; const char* b2 = last ? nB : cB + (size_t)(t + 2) * kstep;
            const char* a3 = a2 + kstep; const char* b3 = b2 + kstep;
            PG8_LDB(B0, 0, 0); PG8_LDB(B1, 0, 1); PG8_SCHED; PG8_LDA(At, 0, 0); PG8_STAGE(PG8_SA(1, 1), a1 + hstep, voffA);
            PG8_WAIT_V(8); PG8_WAIT_L(0); PG8_BAR; PG8_MMA(0, 0, At, B0); PG8_MMA(0, 1, At, B1); PG8_BAR; PG8_SCHED;
            PG8_LDA(At, 0, 1); PG8_STAGE(PG8_SB(0, 0), b2, voffB); PG8_STAGE(PG8_SB(0, 1), b2 + hstep, voffB); PG8_STAGE(PG8_SA(0, 0), a2, voffA);
            PG8_WAIT_V(8); PG8_WAIT_L(0); PG8_BAR; PG8_MMA(1, 0, At, B0); PG8_MMA(1, 1, At, B1); PG8_BAR; PG8_SCHED;
            PG8_LDB(B0, 1, 0); PG8_LDB(B1, 1, 1); PG8_SCHED; PG8_LDA(At, 1, 0); PG8_STAGE(PG8_SA(0, 1), a2 + hstep, voffA);
            PG8_WAIT_V(8); PG8_WAIT_L(0); PG8_BAR; PG8_MMA(0, 0, At, B0); PG8_MMA(0, 1, At, B1); PG8_BAR; PG8_SCHED;
            PG8_LDA(At, 1, 1); PG8_STAGE(PG8_SB(1, 0), b3, voffB); PG8_STAGE(PG8_SB(1, 1), b3 + hstep, voffB); PG8_STAGE(PG8_SA(1, 0), a3, voffA);
            PG8_WAIT_V(8); PG8_WAIT_L(0); PG8_BAR; PG8_MMA(1, 0, At, B0); PG8_MMA(1, 1, At, B1); PG8_BAR; PG8_SCHED;
        }
        if (wr == 0) PG8_BAR;
        E(acc, cur, wr, wc, fr, fq);
        if (!has_next) break;
        if (E.reset_after(cur)) {
#pragma unroll
            for (int a = 0; a < 2; ++a)
#pragma unroll
                for (int b = 0; b < 2; ++b)
#pragma unroll
                    for (int m = 0; m < 4; ++m)
#pragma unroll
                        for (int n = 0; n < 2; ++n) acc[a][b][m][n] = (f32x4){0.f, 0.f, 0.f, 0.f};
        }
        cur = nxt; cA = nA; cB = nB; ++ui;
        if (wr == 1) PG8_BAR;
    }
    PG8_WAIT_V(0);
    PG8_BAR;
#undef PG8_SA
#undef PG8_SB
#undef PG8_STAGE
#undef PG8_LDA
#undef PG8_LDB
#undef PG8_MMA
#undef PG8_WAIT_V
#undef PG8_WAIT_L
#undef PG8_BAR
#undef PG8_SCHED
}
}
using pg8::Unit;

struct EpiProj {
    static constexpr bool PERM = true;
    bf16_t* O; const float* rowss;
    __device__ __forceinline__ bool reset_after(const Unit&) const { return true; }
    __device__ __forceinline__ void operator()(f32x4 (&acc)[2][2][4][2], const Unit& u, int wr, int wc, int fr, int fq) const {
        const int row0 = u.pm * 256 + wr * 64 + fr, col0 = u.pn * 256 + wc * 32 + 8 * fq;
        const bool gate = (u.pn >= 32 && u.pn < 44);
#pragma unroll
        for (int ai = 0; ai < 2; ++ai)
#pragma unroll
            for (int m = 0; m < 4; ++m) {
                const int row = row0 + ai * 128 + m * 16;
                const float rs = rsqrtf(rowss[row] * (1.f / 1024.f) + EPS);
                bf16_t* rowp = O + (size_t)row * NPROJ + col0;
#pragma unroll
                for (int bj = 0; bj < 2; ++bj) {
                    f32x4 v0 = acc[ai][bj][m][0] * rs, v1 = acc[ai][bj][m][1] * rs;
                    if (gate) {
#pragma unroll
                        for (int j = 0; j < 4; ++j) { v0[j] = sigmoidf_(v0[j]); v1[j] = sigmoidf_(v1[j]); }
                    }
                    u32x4 w; w.x = cvt_pk_bf16(v0[0], v0[1]); w.y = cvt_pk_bf16(v0[2], v0[3]); w.z = cvt_pk_bf16(v1[0], v1[1]); w.w = cvt_pk_bf16(v1[2], v1[3]);
                    *(u32x4*)(rowp + bj * 128) = w;
                }
            }
    }
};
struct EpiAbc {
    static constexpr bool PERM = true;
    const bf16_t* G; bf16_t* O;
    __device__ __forceinline__ bool reset_after(const Unit& u) const { return (u.pn >> 2) == 2; }
    __device__ __forceinline__ void operator()(f32x4 (&acc)[2][2][4][2], const Unit& u, int wr, int wc, int fr, int fq) const {
        const int sub = u.pn >> 2, pn = u.pn & 3, pm = u.pm - sub * 65;
        const int row0 = pm * 256 + wr * 64 + fr, col0 = pn * 256 + wc * 32 + 8 * fq;
#pragma unroll
        for (int ai = 0; ai < 2; ++ai)
#pragma unroll
            for (int m = 0; m < 4; ++m) {
                const int row = row0 + ai * 128 + m * 16;
                const bf16_t* gp = G + (size_t)row * NPROJ + PC_GATE + sub * 1024 + col0;
#pragma unroll
                for (int bj = 0; bj < 2; ++bj) {
                    const u32x4 ga = *(const u32x4*)(gp + bj * 128);
                    f32x4 g0 = (f32x4){bf_lo(ga.x), bf_hi(ga.x), bf_lo(ga.y), bf_hi(ga.y)}, g1 = (f32x4){bf_lo(ga.z), bf_hi(ga.z), bf_lo(ga.w), bf_hi(ga.w)};
                    if (sub < 2) {
                        const u32x4 gb = *(const u32x4*)(gp + 1024 + bj * 128);
                        const f32x4 h0 = (f32x4){bf_lo(gb.x), bf_hi(gb.x), bf_lo(gb.y), bf_hi(gb.y)}, h1 = (f32x4){bf_lo(gb.z), bf_hi(gb.z), bf_lo(gb.w), bf_hi(gb.w)};
#pragma unroll
                        for (int j = 0; j < 4; ++j) { acc[ai][bj][m][0][j] *= g0[j] * __builtin_amdgcn_rcpf(fmaxf(h0[j], 1e-30f)); acc[ai][bj][m][1][j] *= g1[j] * __builtin_amdgcn_rcpf(fmaxf(h1[j], 1e-30f)); }
                    } else {
                        const f32x4 v0 = acc[ai][bj][m][0] * g0, v1 = acc[ai][bj][m][1] * g1;
                        u32x4 w; w.x = cvt_pk_bf16(v0[0], v0[1]); w.y = cvt_pk_bf16(v0[2], v0[3]); w.z = cvt_pk_bf16(v1[0], v1[1]); w.w = cvt_pk_bf16(v1[2], v1[3]);
                        *(u32x4*)(O + (size_t)row * D + col0 + bj * 128) = w;
                    }
                }
            }
    }
};
struct EpiRes {
    static constexpr bool PERM = false;
    const float* res0; const float* res1; const bf16_t* resb; float* out; bf16_t* xb; float* rowss;
    __device__ __forceinline__ bool reset_after(const Unit&) const { return true; }
    __device__ __forceinline__ void operator()(f32x4 (&acc)[2][2][4][2], const Unit& u, int wr, int wc, int fr, int fq) const {
        const int col0 = u.pn * 256 + wc * 32 + 4 * fq;
        const float* rbase = (u.pm < 64) ? res0 + (size_t)u.pm * 256 * D : res1;
#pragma unroll
        for (int ai = 0; ai < 2; ++ai)
#pragma unroll
            for (int m = 0; m < 4; ++m) {
                const int lrow = ai * 128 + wr * 64 + m * 16 + fr; const size_t grow = (size_t)u.pm * 256 + lrow;
                float ss = 0.f;
#pragma unroll
                for (int bj = 0; bj < 2; ++bj)
#pragma unroll
                    for (int n = 0; n < 2; ++n) {
                        const int c = col0 + bj * 128 + n * 16;
                        f32x4 r4;
                        if (resb) { const u32x2 rb = *(const u32x2*)(resb + grow * D + c); r4 = (f32x4){bf_lo(rb.x), bf_hi(rb.x), bf_lo(rb.y), bf_hi(rb.y)}; }
                        else r4 = *(const f32x4*)(rbase + (size_t)lrow * D + c);
                        const f32x4 o = r4 + acc[ai][bj][m][n];
                        if (out) *(f32x4*)(out + grow * D + c) = o;
                        else { u32x2 w; w.x = cvt_pk_bf16(o[0], o[1]); w.y = cvt_pk_bf16(o[2], o[3]); *(u32x2*)(xb + grow * D + c) = w; }
                        ss += (o[0] * o[0] + o[1] * o[1]) + (o[2] * o[2] + o[3] * o[3]);
                    }
                ss += __shfl_xor(ss, 16); ss += __shfl_xor(ss, 32);
                if (fq == 0) atomicAdd(rowss + grow, ss);
                asm volatile("" ::: "memory");
            }
    }
};
struct EpiFfn {
    static constexpr bool PERM = true;
    bf16_t* O; const float* rowss;
    __device__ __forceinline__ bool reset_after(const Unit&) const { return true; }
    __device__ __forceinline__ void operator()(f32x4 (&acc)[2][2][4][2], const Unit& u, int wr, int wc, int fr, int fq) const {
        const int row0 = u.pm * 256 + wr * 64 + fr, f0 = u.pn * 128 + 16 * wc + 4 * fq;
#pragma unroll
        for (int ai = 0; ai < 2; ++ai)
#pragma unroll
            for (int m = 0; m < 4; ++m) {
                const int row = row0 + ai * 128 + m * 16;
                const float rs = rsqrtf(rowss[row] * (1.f / 1024.f) + EPS);
#pragma unroll
                for (int bj = 0; bj < 2; ++bj) {
                    const f32x4 gg = acc[ai][bj][m][0] * rs, uu = acc[ai][bj][m][1] * rs;
                    f32x4 hh;
#pragma unroll
                    for (int j = 0; j < 4; ++j) hh[j] = gg[j] * sigmoidf_(gg[j]) * uu[j];
                    u32x2 w; w.x = cvt_pk_bf16(hh[0], hh[1]); w.y = cvt_pk_bf16(hh[2], hh[3]);
                    *(u32x2*)(O + (size_t)row * DFF + f0 + bj * 64) = w;
                }
            }
    }
};

#define XB_TMO      128
#define XB_XCNT(j)  (256  + 64 * (j))
#define XB_XSUB(j)  (1280 + 64 * (j))
#define XB_XGEN(j)  (2304 + 64 * (j))
#define XB_TOP      3328
#define XB_TOPGEN   3392
#define XCD_BAR_WORDS 3456
#define XB_SPIN_CAP (1u << 18)

__device__ __forceinline__ unsigned xb_ld(unsigned* p)              { return __hip_atomic_load(p, __ATOMIC_RELAXED, __HIP_MEMORY_SCOPE_AGENT); }
__device__ __forceinline__ unsigned xb_add(unsigned* p, unsigned v) { return __hip_atomic_fetch_add(p, v, __ATOMIC_RELAXED, __HIP_MEMORY_SCOPE_AGENT); }
__device__ __forceinline__ unsigned xb_xcc_id() { return (unsigned)__builtin_amdgcn_s_getreg((3 << 11) | 20) & 0xFu; }
#define XB_SPIN(cond, bar) do { unsigned _sp = 0; while (cond) { __builtin_amdgcn_s_sleep(1); \
    if ((++_sp & 255u) == 0u) { if (xb_ld(&(bar)[XB_TMO])) break; if (_sp > XB_SPIN_CAP) { atomicAdd(&(bar)[XB_TMO], 1u); break; } } } } while (0)

struct XcdBarrier {
    unsigned* bar; unsigned x;
    volatile LAS unsigned* st;
};

__device__ __forceinline__ XcdBarrier xcd_barrier_post(unsigned* bar, volatile LAS unsigned* st) {
    XcdBarrier b; b.bar = bar; b.x = xb_xcc_id(); b.st = st;
    if (threadIdx.x == 0) (void)xb_add(&bar[XB_XCNT(b.x)], 1u);
    return b;
}
__device__ __forceinline__ void xcd_barrier_complete(unsigned* bar, unsigned x, unsigned& nloc, unsigned& nx) {
    const unsigned G = gridDim.x * gridDim.y * gridDim.z;
    unsigned sum, cnt, mine, sp = 0u;
    for (;;) {
        sum = 0u; cnt = 0u; mine = 0u;
#pragma unroll
        for (unsigned j = 0; j < 16; ++j) { const unsigned c = xb_ld(&bar[XB_XCNT(j)]); sum += c; cnt += (c > 0u) ? 1u : 0u; mine = (j == x) ? c : mine; }
        if (sum == G) break;
        __builtin_amdgcn_s_sleep(1);
        if ((++sp & 255u) == 0u) { if (xb_ld(&bar[XB_TMO])) break; if (sp > XB_SPIN_CAP) { atomicAdd(&bar[XB_TMO], 1u); break; } }
    }
    nloc = mine > 0u ? mine : 1u; nx = cnt > 0u ? cnt : 1u;
}

__device__ __forceinline__ void xcd_barrier(const XcdBarrier& b, int tid_l) {
    asm volatile("s_waitcnt vmcnt(0)" ::: "memory");
    __syncthreads();
    if (tid_l == 0) {
        unsigned* bar = b.bar;
        __builtin_amdgcn_s_waitcnt(0);
        unsigned nloc = b.st[0], nx = b.st[1];
        if (nloc == 0u) { xcd_barrier_complete(bar, b.x, nloc, nx); b.st[0] = nloc; b.st[1] = nx; }
        const unsigned old = xb_add(&bar[XB_XSUB(b.x)], 1u);
        const unsigned gen = old / nloc;
        if (old + 1u == (gen + 1u) * nloc) {
            __builtin_amdgcn_fence(__ATOMIC_RELEASE, "agent");
            asm volatile("s_waitcnt vmcnt(0)" ::: "memory");
            const unsigned og = xb_add(&bar[XB_TOP], 1u);
            const unsigned tg = og / nx;
            if (og + 1u == (tg + 1u) * nx) xb_add(&bar[XB_TOPGEN], 1u);
            else XB_SPIN(xb_ld(&bar[XB_TOPGEN]) == tg, bar);
            __builtin_amdgcn_fence(__ATOMIC_ACQUIRE, "agent");
            xb_add(&bar[XB_XGEN(b.x)], 1u);
            asm volatile("s_waitcnt vmcnt(0)" ::: "memory");
        } else {
            XB_SPIN(xb_ld(&bar[XB_XGEN(b.x)]) == gen, bar);
            __builtin_amdgcn_fence(__ATOMIC_ACQUIRE, "agent");
            asm volatile("s_waitcnt vmcnt(0)" ::: "memory");
        }
    }
    __syncthreads();
}


struct Args { const float* in[24]; float* out; unsigned char* ws; int ph_lo, ph_hi; };
static_assert(sizeof(Args) == 216, "Args layout");
struct Ctx {
    const float* const __attribute__((address_space(4)))* in; float* out; unsigned char* ws;
    LAS unsigned char* lds; int tid, lane, wave, G, bid;
};
#define WSV(T, off) ((T*)(F.ws + (off)))
#define V_WIN WSV(bf16_t, WS_WIN)
#define V_WABC WSV(bf16_t, WS_WABC)
#define V_WOUT WSV(bf16_t, WS_WOUT)
#define V_WFI WSV(bf16_t, WS_WFI)
#define V_WFO WSV(bf16_t, WS_WFO)
#define V_XBA WSV(bf16_t, WS_XBA)
#define V_XBB WSV(bf16_t, WS_XBB)
#define V_PROJ WSV(bf16_t, WS_PROJ)
#define V_OABC WSV(bf16_t, WS_OABC)
#define V_MRG WSV(bf16_t, WS_MRG)
#define V_ACT WSV(bf16_t, WS_ACT)
#define V_X1 WSV(float, WS_X1)
#define V_X2 WSV(float, WS_X2)
#define V_RS WSV(float, WS_RS)
#define V_BQKV WSV(float, WS_BQKV)
#define V_BG WSV(float, WS_BG)
#define V_CQK WSV(float, WS_CQK)
#define V_OBR WSV(float, WS_OBR)
#define V_OCR WSV(float, WS_OCR)
#define V_ROPEA WSV(float, WS_ROPEA)
#define V_ROPEC WSV(float, WS_ROPEC)
#define V_CTL WSV(unsigned, WS_CTL)
#define V_AO WSV(bf16_t, WS_AO)
#define V_LSE WSV(float, WS_LSE)
#define V_DW WSV(bf16_t, WS_DW)
#define V_DQG WSV(bf16_t, WS_DQG)
#define V_DKT WSV(bf16_t, WS_DKT)
#define V_DAT WSV(bf16_t, WS_DAT)
#define V_DU WSV(float, WS_DU)
#define V_DDL WSV(float, WS_DDL)
#define V_RQG WSV(bf16_t, WS_RQG)
#define V_RKT WSV(bf16_t, WS_RKT)
#define V_RAT WSV(bf16_t, WS_RAT)
#define V_RU WSV(float, WS_RU)
#define V_SB WSV(bf16_t, WS_SB)
#define V_VB WSV(bf16_t, WS_VB)

__device__ __forceinline__ int src_col(int mode, int n) {
    if (mode == 1) { if (n < 6656) return n; if (n < 11264) return n + 8; if (n < 11272) return n - 11264 + 6656; return -1; }
    if (mode == 2) { const int pn = n >> 8, c = n & 255; const int f = pn * 128 + (c >> 3) * 4 + (c & 3); return ((c >> 2) & 1) * DFF + f; }
    return n;
}
__device__ __forceinline__ void transpose_item(const float* W, int K, int N, int nblk, bf16_t* WT, const float* kscale, int mode, LAS float* scr, int item, int lane) {
    const int kb = item / nblk, nb = item - kb * nblk, k0 = 32 * kb, n0 = 128 * nb;
    const int sc = src_col(mode, n0 + 4 * (lane & 31));
    f32x4 v[16];
#pragma unroll
    for (int i = 0; i < 16; ++i) { const int kk = 2 * i + (lane >> 5);
        v[i] = (f32x4){0.f, 0.f, 0.f, 0.f};
        if (sc >= 0) { v[i] = *(const f32x4*)(W + (size_t)(k0 + kk) * N + sc); if (kscale) v[i] *= kscale[k0 + kk]; } }
#pragma unroll
    for (int i = 0; i < 16; ++i) { const int kk = 2 * i + (lane >> 5); *(LAS f32x4*)(scr + kk * 132 + 4 * (lane & 31)) = v[i]; }
    asm volatile("s_waitcnt lgkmcnt(0)" ::: "memory");
#pragma unroll
    for (int h2 = 0; h2 < 2; ++h2) { const int n = lane + 64 * h2; const LAS float* sp = scr + n;
        bf16_t* dst = WT + (size_t)(n0 + n) * K + k0;
#pragma unroll
        for (int q = 0; q < 4; ++q) { u32x4 o; o.x = cvt_pk_bf16(sp[(8 * q + 0) * 132], sp[(8 * q + 1) * 132]); o.y = cvt_pk_bf16(sp[(8 * q + 2) * 132], sp[(8 * q + 3) * 132]);
            o.z = cvt_pk_bf16(sp[(8 * q + 4) * 132], sp[(8 * q + 5) * 132]); o.w = cvt_pk_bf16(sp[(8 * q + 6) * 132], sp[(8 * q + 7) * 132]); *(u32x4*)(dst + 8 * q) = o; } }
    asm volatile("s_waitcnt lgkmcnt(0)" ::: "memory");
}
constexpr int I_IN = 32 * (NPROJ / 128), I_ABC = 16 * 8, I_OUT = 32 * 8, I_FI = 32 * (2 * DFF / 128), I_FO = (DFF / 32) * 8;
constexpr int I_LAYER = I_IN + 3 * I_ABC + I_OUT + I_FI + I_FO;
__device__ __forceinline__ void prep_weight_item(Ctx& F, int it, LAS float* scr, int lane) {
    const int l = it / I_LAYER; int r = it - l * I_LAYER;
    const float* W; const float* ksc = nullptr; bf16_t* WT; int K = D, N = D, nblk = D / 128, mode = 0;
    if (r < I_IN) { W = F.in[9] + (size_t)l * D * NIN; N = NIN; nblk = NPROJ / 128; WT = V_WIN + (size_t)l * NPROJ * D; ksc = F.in[8] + l * D; mode = 1; }
    else if ((r -= I_IN) < 3 * I_ABC) { const int i = r / I_ABC; r -= i * I_ABC; W = F.in[17 + i] + (size_t)l * 512 * D; K = 512; WT = V_WABC + (size_t)(l * 3 + i) * D * 512; }
    else if ((r -= 3 * I_ABC) < I_OUT) { W = F.in[20] + (size_t)l * D * D; WT = V_WOUT + (size_t)l * D * D; }
    else if ((r -= I_OUT) < I_FI) { W = F.in[22] + (size_t)l * D * 2 * DFF; N = 2 * DFF; nblk = 2 * DFF / 128; WT = V_WFI + (size_t)l * 2 * DFF * D; ksc = F.in[21] + l * D; mode = 2; }
    else { r -= I_FI; W = F.in[23] + (size_t)l * DFF * D; K = DFF; WT = V_WFO + (size_t)l * D * DFF; }
    transpose_item(W, K, N, nblk, WT, ksc, mode, scr, r, lane);
}
__device__ __forceinline__ void phase_prep(Ctx& F) {
    LAS float* scr = (LAS float*)(F.lds + F.wave * 16896);
    const int gw = F.bid * NWAVES + F.wave, NGW = F.G * NWAVES, lane = F.lane;
    for (int it = gw; it < I_IN; it += NGW) prep_weight_item(F, it, scr, lane);
    for (int row0 = gw; row0 < M; row0 += 4 * NGW) {
        f32x4 v[4][4];
#pragma unroll
        for (int r = 0; r < 4; ++r) { const int row = row0 + r * NGW;
            if (row < M) { const float* src = row < MP ? F.in[0] + (size_t)row * D : F.in[1] + (size_t)(row - MP) * D;
#pragma unroll
                for (int j = 0; j < 4; ++j) v[r][j] = *(const f32x4*)(src + 4 * lane + 256 * j); } }
#pragma unroll
        for (int r = 0; r < 4; ++r) { const int row = row0 + r * NGW;
            if (row < M) { float ss = 0.f;
#pragma unroll
                for (int j = 0; j < 4; ++j) ss += (v[r][j][0] * v[r][j][0] + v[r][j][1] * v[r][j][1]) + (v[r][j][2] * v[r][j][2] + v[r][j][3] * v[r][j][3]);
                ss = wave_sum(ss);
                if (lane == 0) V_RS[row] = ss;
#pragma unroll
                for (int j = 0; j < 4; ++j) { u32x2 w; w.x = cvt_pk_bf16(v[r][j][0], v[r][j][1]); w.y = cvt_pk_bf16(v[r][j][2], v[r][j][3]); *(u32x2*)(V_XBA + (size_t)row * D + 4 * lane + 256 * j) = w; } } }
    }
    const int gt = F.bid * NTHREADS + F.tid, NGT = F.G * NTHREADS;
    for (int i = gt; i < 3 * M; i += NGT) V_RS[M + i] = 0.f;
    {
        const int i64 = gt & 63; const double invA = exp(-(double)i64 * (9.210340371976184 / 64.0));
        for (int e = gt; e < NPOS * 64; e += NGT) { const int pi = e >> 6; const double pos = pi < SEQ ? (double)pi : (double)(PAST + pi - SEQ);
            double a = pos * invA; a -= floor(a * 0.15915494309189535) * 6.283185307179586; float sn, cs; sincosf((float)a, &sn, &cs); *(f32x2*)(V_ROPEA + 2 * e) = (f32x2){cs, sn}; }
        const int i32 = gt & 31; const double invC = exp(-(double)i32 * (9.210340371976184 / 32.0));
        for (int e = gt; e < NPOS * 32; e += NGT) { const int pi = e >> 5; const double pos = pi < SEQ ? (double)pi : (double)(PAST + pi - SEQ);
            double a = pos * invC; a -= floor(a * 0.15915494309189535) * 6.283185307179586; float sn, cs; sincosf((float)a, &sn, &cs); *(f32x2*)(V_ROPEC + 2 * e) = (f32x2){cs, sn}; }
    }
}

__device__ __forceinline__ float* kv_out_ptr(float* out, int g, int l, bool sample, int b, int tt) {
    if (sample) { const size_t base = g == 0 ? O_KV0S : (g == 1 ? O_KV1S : O_KV2S); return out + base + ((size_t)(l * DB + b) * DS + tt) * 1024; }
    const int keep = 128 << (2 * g); const size_t base = g == 0 ? O_KV0P : (g == 1 ? O_KV1P : O_KV2P);
    return out + base + ((size_t)(l * BATCH + b) * keep + tt) * 1024;
}
template <int NR>
__device__ __forceinline__ void e1_partA(Ctx& F, int l, const int (&rows)[NR], bool store_qk) {
    const int lane = F.lane, jj = lane & 15, hq = lane >> 4;
    u32x2 xlo[NR][6], xhi[NR][6]; f32x4 cc[NR], sn[NR]; unsigned vv[NR][12];
    bool sample[NR]; int bb[NR], tt0[NR];
#pragma unroll
    for (int r = 0; r < NR; ++r) {
        const int row = rows[r];
        sample[r] = row >= MP; bb[r] = sample[r] ? (row - MP) >> 3 : row >> 12; tt0[r] = sample[r] ? (row - MP) & 7 : row & 4095;
        const int pidx = sample[r] ? SEQ + tt0[r] : tt0[r];
        const bf16_t* prow = V_PROJ + (size_t)row * NPROJ;
#pragma unroll
        for (int sl = 0; sl < 6; ++sl) { const bf16_t* p = prow + (4 * sl + hq) * 128; xlo[r][sl] = *(const u32x2*)(p + 4 * jj); xhi[r][sl] = *(const u32x2*)(p + 64 + 4 * jj); }
        const float* cs = V_ROPEA + ((size_t)pidx * 64 + 4 * jj) * 2;
        const f32x4 c01 = *(const f32x4*)cs, c23 = *(const f32x4*)(cs + 4);
        cc[r] = (f32x4){c01[0], c01[2], c23[0], c23[2]}; sn[r] = (f32x4){c01[1], c01[3], c23[1], c23[3]};
#pragma unroll
        for (int q = 0; q < 12; ++q) vv[r][q] = *(const unsigned*)(prow + PC_AV + q * 128 + 2 * lane);
    }
    const f32x4 gq_lo = *(const f32x4*)(F.in[10] + l * 128 + 4 * jj), gq_hi = *(const f32x4*)(F.in[10] + l * 128 + 64 + 4 * jj);
    const f32x4 gk_lo = *(const f32x4*)(F.in[11] + l * 128 + 4 * jj), gk_hi = *(const f32x4*)(F.in[11] + l * 128 + 64 + 4 * jj);
#pragma unroll
    for (int r = 0; r < NR; ++r) {
        const int row = rows[r], t = tt0[r], b = bb[r]; const bool smp = sample[r];
        bf16_t* prow = V_PROJ + (size_t)row * NPROJ;
#pragma unroll
        for (int sl = 0; sl < 6; ++sl) {
            const int hs = 4 * sl + hq, which = sl >= 3 ? 1 : 0, gh = hs - 12 * which, g = gh >> 2, h = gh & 3;
            f32x4 lo = (f32x4){bf_lo(xlo[r][sl].x), bf_hi(xlo[r][sl].x), bf_lo(xlo[r][sl].y), bf_hi(xlo[r][sl].y)}, hi = (f32x4){bf_lo(xhi[r][sl].x), bf_hi(xhi[r][sl].x), bf_lo(xhi[r][sl].y), bf_hi(xhi[r][sl].y)};
            float ss = (lo[0] * lo[0] + lo[1] * lo[1]) + (lo[2] * lo[2] + lo[3] * lo[3]) + (hi[0] * hi[0] + hi[1] * hi[1]) + (hi[2] * hi[2] + hi[3] * hi[3]);
            ss = row_sum16(ss);
            const float rstd = rsqrtf(ss * (1.f / 128.f) + EPS);
            lo = lo * rstd * (which ? gk_lo : gq_lo); hi = hi * rstd * (which ? gk_hi : gq_hi);
            const f32x4 olo = lo * cc[r] - hi * sn[r], ohi = hi * cc[r] + lo * sn[r];
            bf16_t* p = prow + hs * 128;
            if (store_qk) { u32x2 w0, w1; w0.x = cvt_pk_bf16(olo[0], olo[1]); w0.y = cvt_pk_bf16(olo[2], olo[3]); w1.x = cvt_pk_bf16(ohi[0], ohi[1]); w1.y = cvt_pk_bf16(ohi[2], ohi[3]);
                *(u32x2*)(p + 4 * jj) = w0; *(u32x2*)(p + 64 + 4 * jj) = w1; }
            if (which == 1) {
                const int keep = 128 << (2 * g); const int tt = smp ? t : t - (SEQ - keep);
                if (tt >= 0) { float* dst = kv_out_ptr(F.out, g, l, smp, b, tt) + h * 128; *(f32x4*)(dst + 4 * jj) = olo; *(f32x4*)(dst + 64 + 4 * jj) = ohi; }
            }
        }
#pragma unroll
        for (int g = 0; g < 3; ++g) {
            const int keep = 128 << (2 * g); const int tt = smp ? t : t - (SEQ - keep);
            if (tt >= 0) { float* dst = kv_out_ptr(F.out, g, l, smp, b, tt) + 512;
#pragma unroll
                for (int q = 0; q < 4; ++q) { const unsigned v = vv[r][4 * g + q]; *(f32x2*)(dst + q * 128 + 2 * lane) = (f32x2){bf_lo(v), bf_hi(v)}; } }
        }
    }
}
__device__ __forceinline__ void e1_row(Ctx& F, int l, int row) {
    const int lane = F.lane, j = lane & 31, hh = lane >> 5;
    const bool sample = row >= MP;
    const int b = sample ? (row - MP) >> 3 : row >> 12, t = sample ? (row - MP) & 7 : row & 4095;
    const int pidx = sample ? SEQ + t : t;
    bf16_t* prow = V_PROJ + (size_t)row * NPROJ;
    if (!sample && t < SEQ - 3) return;
#pragma unroll 1
    for (int it = 0; it < 6; ++it) {
        const int slot = 2 * it + hh, typ = slot >> 2, c = slot * 128 + 4 * j;
        f32x4 a = (f32x4){0.f, 0.f, 0.f, 0.f}, xcur = a;
#pragma unroll
        for (int i = 0; i < 4; ++i) {
            const int tp = t - 3 + i; f32x4 x;
            if (tp >= 0) { const u32x2 u = *(const u32x2*)(V_PROJ + (size_t)(row - 3 + i) * NPROJ + PC_BQKV + c); x = (f32x4){bf_lo(u.x), bf_hi(u.x), bf_lo(u.y), bf_hi(u.y)}; }
            else if (sample) x = *(const f32x4*)(F.in[5] + ((size_t)(l * DB + b) * 3 + (tp + 3)) * 1536 + c);
            else x = (f32x4){0.f, 0.f, 0.f, 0.f};
            const f32x4 w = *(const f32x4*)(F.in[12] + (size_t)(l * 4 + i) * 1536 + c);
            a += w * x; if (i == 3) xcur = x;
        }
#pragma unroll
        for (int q = 0; q < 4; ++q) a[q] = a[q] * sigmoidf_(a[q]);
        if (typ < 2) {
            const float ss = half_sum((a[0] * a[0] + a[1] * a[1]) + (a[2] * a[2] + a[3] * a[3]));
            const float sc = rsqrtf(ss + EPS) * (typ == 0 ? 0.08838834764831845f : 1.f);
            a *= sc;
        }
        *(f32x4*)(V_BQKV + (size_t)row * 1536 + c) = a;
        const int tc = sample ? t - 5 : t - (SEQ - 3);
        if (tc >= 0) { float* dst = F.out + (sample ? O_BCS + ((size_t)(l * DB + b) * 3 + tc) * 1536 : O_BCP + ((size_t)(l * BATCH + b) * 3 + tc) * 1536); *(f32x4*)(dst + c) = xcur; }
    }
    if (lane < 8) {
        const int h = lane & 3; const float x = bf1(prow[PC_BETA + lane]);
        float r;
        if (lane < 4) r = 1.f / (1.f + expf(-x));
        else { const float y = x + F.in[14][l * 4 + h]; const float sp = y > 20.f ? y : log1pf(expf(y)); r = -expf(F.in[13][l * 4 + h]) * sp; }
        V_BG[(size_t)row * 8 + lane] = r;
    }
    {
        const int hs = lane >> 3, i0 = 4 * (lane & 7);
        const bf16_t* p = prow + PC_CQ + hs * 64;
        const u32x2 ulo = *(const u32x2*)(p + i0), uhi = *(const u32x2*)(p + 32 + i0);
        const f32x4 lo = (f32x4){bf_lo(ulo.x), bf_hi(ulo.x), bf_lo(ulo.y), bf_hi(ulo.y)}, hi = (f32x4){bf_lo(uhi.x), bf_hi(uhi.x), bf_lo(uhi.y), bf_hi(uhi.y)};
        const float* cs = V_ROPEC + ((size_t)pidx * 32 + i0) * 2;
        const f32x4 c01 = *(const f32x4*)cs, c23 = *(const f32x4*)(cs + 4);
        const f32x4 cc = (f32x4){c01[0], c01[2], c23[0], c23[2]}, sn = (f32x4){c01[1], c01[3], c23[1], c23[3]};
        const float sc = hs >= 4 ? 0.125f : 1.f;
        const f32x4 olo = (lo * cc - hi * sn) * sc, ohi = (hi * cc + lo * sn) * sc;
        *(f32x4*)(V_CQK + (size_t)row * 512 + hs * 64 + i0) = olo; *(f32x4*)(V_CQK + (size_t)row * 512 + hs * 64 + 32 + i0) = ohi;
    }
}

__device__ __forceinline__ float dot8(const u32x4 q, const u32x4 k) {
    return (bf_lo(q.x) * bf_lo(k.x) + bf_hi(q.x) * bf_hi(k.x)) + (bf_lo(q.y) * bf_lo(k.y) + bf_hi(q.y) * bf_hi(k.y)) + (bf_lo(q.z) * bf_lo(k.z) + bf_hi(q.z) * bf_hi(k.z)) + (bf_lo(q.w) * bf_lo(k.w) + bf_hi(q.w) * bf_hi(k.w));
}
#define WAVE_LDS_SYNC() do { asm volatile("s_waitcnt lgkmcnt(0)" ::: "memory"); __builtin_amdgcn_wave_barrier(); } while (0)
__device__ __forceinline__ void attn_prompt_task(Ctx& F, int row, int h) {
    const int lane = F.lane, t = row & 4095;
    const bf16_t* proj = V_PROJ;
    LAS float* ps = (LAS float*)F.lds + F.wave * 256;
    float mrun = -INFINITY, lsum = 0.f, o0 = 0.f, o1 = 0.f;
#pragma unroll 1
    for (int g = 0; g < 3; ++g) {
        const int sh = 2 * g, nk = min(128, t >> sh) + 1;
        const bf16_t* qrow = proj + (size_t)row * NPROJ + PC_AQ + g * 512 + h * 128;
        u32x4 q[16];
#pragma unroll
        for (int i = 0; i < 16; ++i) q[i] = *(const u32x4*)(qrow + 8 * i);
        WAVE_LDS_SYNC();
#pragma unroll 1
        for (int r = 0; r < 3; ++r) {
            const int jk = r * 64 + lane; const bool valid = jk < nk; const int jj = valid ? jk : 0;
            const bf16_t* krow = proj + (size_t)(row - (jj << sh)) * NPROJ + PC_AK + g * 512 + h * 128;
            float a = 0.f;
#pragma unroll
            for (int i = 0; i < 16; ++i) a += dot8(q[i], *(const u32x4*)(krow + 8 * i));
            ps[jk] = valid ? a * 0.08838834764831845f : -INFINITY;
        }
        WAVE_LDS_SYNC();
        const float s0 = ps[lane], s1 = ps[64 + lane], s2 = ps[128 + lane];
        const float mg = wave_max(fmaxf(fmaxf(s0, s1), s2)), mnew = fmaxf(mrun, mg), alpha = __expf(mrun - mnew);
        const float p0 = __expf(s0 - mnew), p1 = __expf(s1 - mnew), p2 = __expf(s2 - mnew);
        WAVE_LDS_SYNC();
        ps[lane] = p0; ps[64 + lane] = p1; ps[128 + lane] = p2;
        lsum = lsum * alpha + wave_sum(p0 + p1 + p2); o0 *= alpha; o1 *= alpha; mrun = mnew;
        WAVE_LDS_SYNC();
        const bf16_t* vbase = proj + (size_t)row * NPROJ + PC_AV + g * 512 + h * 128 + 2 * lane;
#pragma unroll 4
        for (int jk = 0; jk < nk; ++jk) {
            const float pj = ps[jk];
            const unsigned vv = *(const unsigned*)(vbase - (size_t)(jk << sh) * NPROJ);
            o0 += pj * bf_lo(vv); o1 += pj * bf_hi(vv);
        }
    }
    const float inv = 1.f / lsum;
    *(unsigned*)(V_OABC + (size_t)row * 512 + h * 128 + 2 * lane) = cvt_pk_bf16(o0 * inv, o1 * inv);
}
__device__ __forceinline__ void attn_sample_unit(Ctx& F, int l, int bs, int h, int g) {
    const int lane = F.lane, b = bs >> 3, s = bs & 7, row = MP + bs;
    LAS float* ps = (LAS float*)F.lds + F.wave * 256;
    const int sh = 2 * g, L = 128 << sh;
    const float* cache = F.in[2 + g] + (size_t)(l * DB + b) * L * 1024;
    const float* newkv = kv_out_ptr(F.out, g, l, true, b, 0);
    const bf16_t* qrow = V_PROJ + (size_t)row * NPROJ + PC_AQ + g * 512 + h * 128;
    const int hl = lane & 31, hf = lane >> 5;
    const u32x2 qq = *(const u32x2*)(qrow + 4 * hl);
    const float q0 = bf_lo(qq.x) * 0.08838834764831845f, q1 = bf_hi(qq.x) * 0.08838834764831845f, q2 = bf_lo(qq.y) * 0.08838834764831845f, q3 = bf_hi(qq.y) * 0.08838834764831845f;
    WAVE_LDS_SYNC();
#pragma unroll 1
    for (int j0 = 0; j0 < 130; j0 += 26) {
        f32x4 kk[13];
#pragma unroll
        for (int u = 0; u < 13; ++u) { int jk = j0 + 2 * u + hf; jk = jk > 128 ? 128 : jk; const int idx = L + s - (jk << sh);
            kk[u] = *(const f32x4*)((idx < L ? cache + (size_t)idx * 1024 : newkv + (size_t)(idx - L) * 1024) + h * 128 + 4 * hl); }
#pragma unroll
        for (int u = 0; u < 13; ++u) { float a = (q0 * kk[u][0] + q1 * kk[u][1]) + (q2 * kk[u][2] + q3 * kk[u][3]);
            a = row_sum16(a); a += __shfl_xor(a, 16);
            const int jk = j0 + 2 * u + hf; if (hl == 0 && jk <= 128) ps[jk] = a; }
    }
    if (lane >= 1) ps[128 + lane] = -INFINITY;
    WAVE_LDS_SYNC();
    const float s0 = ps[lane], s1 = ps[64 + lane], s2 = ps[128 + lane];
    const float mx = wave_max(fmaxf(fmaxf(s0, s1), s2));
    const float p0 = __expf(s0 - mx), p1 = __expf(s1 - mx), p2 = __expf(s2 - mx);
    WAVE_LDS_SYNC();
    ps[lane] = p0; ps[64 + lane] = p1; ps[128 + lane] = p2;
    const float lsum = wave_sum(p0 + p1 + p2);
    WAVE_LDS_SYNC();
    float o0 = 0.f, o1 = 0.f, o2 = 0.f, o3 = 0.f;
    const float* vc = cache + 512 + h * 128 + 2 * lane; const float* vn2 = newkv + 512 + h * 128 + 2 * lane;
#pragma unroll 1
    for (int j0 = 0; j0 < 128; j0 += 16) {
        f32x2 vv[16];
#pragma unroll
        for (int u = 0; u < 16; ++u) { const int idx = L + s - ((j0 + u) << sh); vv[u] = *(const f32x2*)(idx < L ? vc + (size_t)idx * 1024 : vn2 + (size_t)(idx - L) * 1024); }
#pragma unroll
        for (int u = 0; u < 16; u += 2) { const float pa = ps[j0 + u], pb = ps[j0 + u + 1]; o0 += pa * vv[u][0]; o1 += pa * vv[u][1]; o2 += pb * vv[u + 1][0]; o3 += pb * vv[u + 1][1]; }
    }
    { const int idx = L + s - (128 << sh); const f32x2 vv = *(const f32x2*)(idx < L ? vc + (size_t)idx * 1024 : vn2 + (size_t)(idx - L) * 1024); const float pa = ps[128]; o0 += pa * vv[0]; o1 += pa * vv[1]; }
    const float inv = 1.f / lsum;
    *(unsigned*)(V_AO + ((size_t)g * M + row) * 512 + h * 128 + 2 * lane) = cvt_pk_bf16((o0 + o2) * inv, (o1 + o3) * inv);
    if (lane == 0) V_LSE[((size_t)g * M + row) * 4 + h] = mx + __logf(lsum);
}
constexpr int AT_KSTR = 272, AT_VSTR = 288, AT_VOFF = 256 * AT_KSTR;
typedef short v4i16_t __attribute__((ext_vector_type(4)));
__device__ __forceinline__ u32x2 lds_tr16(const LAS unsigned char* p) { return __builtin_bit_cast(u32x2, __builtin_amdgcn_ds_read_tr16_b64_v4i16((LAS v4i16_t*)p)); }
template <int NP>
__device__ __forceinline__ void attn_ld(const bf16_t* proj, int b, int sh, int r, int g, int h, int npk0, int tid, u32x4 (&kv)[NP], u32x4 (&vv)[NP]) {
#pragma unroll
    for (int p = 0; p < NP; ++p) {
        const int kl = p * 32 + (tid >> 4), ch = tid & 15, np = npk0 + kl;
        if (np >= 0) { const bf16_t* src = proj + (size_t)(b * SEQ + (np << sh) + r) * NPROJ + g * 512 + h * 128 + ch * 8;
            kv[p] = *(const u32x4*)(src + PC_AK); vv[p] = *(const u32x4*)(src + PC_AV); }
        else { kv[p] = (u32x4){0u, 0u, 0u, 0u}; vv[p] = kv[p]; }
    }
}
template <int NP>
__device__ __forceinline__ void attn_st(LAS unsigned char* Ks, LAS unsigned char* Vt, int row0, int tid, const u32x4 (&kv)[NP], const u32x4 (&vv)[NP]) {
#pragma unroll
    for (int p = 0; p < NP; ++p) {
        const int kl = row0 + p * 32 + (tid >> 4), ch = tid & 15;
        *(LAS u32x4*)(Ks + kl * AT_KSTR + ch * 16) = kv[p];
        *(LAS u32x4*)(Vt + kl * AT_VSTR + ch * 16) = vv[p];
    }
}
__device__ __forceinline__ void attn_blk(Ctx& F, const LAS unsigned char* Ks, const LAS unsigned char* Vt, int tb, int kmin, size_t rowq, int g, int h, const bf16x8 (&qf)[4]) {
    const int lane = F.lane, w = F.wave, li = lane & 15, q4 = lane >> 4;
    f32x4 st[9];
#pragma unroll
    for (int kt = 0; kt < 9; ++kt) {
        f32x4 acc = (f32x4){0.f, 0.f, 0.f, 0.f};
        const LAS unsigned char* kp = Ks + (((w + kt + tb) & 15) * 16 + li) * AT_KSTR + 16 * q4;
#pragma unroll
        for (int s = 0; s < 4; ++s) acc = __builtin_amdgcn_mfma_f32_16x16x32_bf16(*(const LAS bf16x8*)(kp + 64 * s), qf[s], acc, 0, 0, 0);
        st[kt] = acc;
    }
    float mx = -INFINITY;
#pragma unroll
    for (int kt = 0; kt < 9; ++kt)
#pragma unroll
        for (int rg = 0; rg < 4; ++rg) {
            const int a = 4 * q4 + rg, kl = (w + kt) * 16 + a;
            bool ok = kl >= kmin;
            if (kt == 0) ok = ok && (a >= li);
            if (kt == 8) ok = ok && (a <= li);
            st[kt][rg] = ok ? st[kt][rg] : -INFINITY;
            mx = fmaxf(mx, st[kt][rg]);
        }
    mx = fmaxf(mx, __shfl_xor(mx, 16)); mx = fmaxf(mx, __shfl_xor(mx, 32));
    const float c2 = 0.08838834764831845f * 1.4426950408889634f;
    float lsum = 0.f;
#pragma unroll
    for (int kt = 0; kt < 9; ++kt)
#pragma unroll
        for (int rg = 0; rg < 4; ++rg) { const float p = exp2f((st[kt][rg] - mx) * c2); st[kt][rg] = p; lsum += p; }
    lsum += __shfl_xor(lsum, 16); lsum += __shfl_xor(lsum, 32);
    f32x4 o[8];
#pragma unroll
    for (int db = 0; db < 8; ++db) o[db] = (f32x4){0.f, 0.f, 0.f, 0.f};
#pragma unroll
    for (int ks = 0; ks < 5; ++ks) {
        u32x4 pw;
        pw.x = cvt_pk_bf16(st[2 * ks][0], st[2 * ks][1]); pw.y = cvt_pk_bf16(st[2 * ks][2], st[2 * ks][3]);
        if (ks < 4) { pw.z = cvt_pk_bf16(st[2 * ks + 1][0], st[2 * ks + 1][1]); pw.w = cvt_pk_bf16(st[2 * ks + 1][2], st[2 * ks + 1][3]); }
        else { pw.z = 0u; pw.w = 0u; }
        const bf16x8 pf = __builtin_bit_cast(bf16x8, pw);
        const int t0 = (w + 2 * ks + tb) & 15, t1 = (w + 2 * ks + 1 + tb) & 15;
#pragma unroll
        for (int db = 0; db < 8; ++db) {
            const LAS unsigned char* vp = Vt + (4 * q4 + (li >> 2)) * AT_VSTR + 32 * db + 8 * (li & 3);
            u32x4 av; const u32x2 a0 = lds_tr16(vp + t0 * (16 * AT_VSTR)), a1 = lds_tr16(vp + t1 * (16 * AT_VSTR));
            av.x = a0.x; av.y = a0.y; av.z = a1.x; av.w = a1.y;
            o[db] = __builtin_amdgcn_mfma_f32_16x16x32_bf16(__builtin_bit_cast(bf16x8, av), pf, o[db], 0, 0, 0);
        }
    }
    const float inv = 1.f / lsum;
    bf16_t* dst = V_AO + ((size_t)g * M + rowq) * 512 + h * 128 + 4 * q4;
#pragma unroll
    for (int db = 0; db < 8; ++db) { u32x2 wv; wv.x = cvt_pk_bf16(o[db][0] * inv, o[db][1] * inv); wv.y = cvt_pk_bf16(o[db][2] * inv, o[db][3] * inv); *(u32x2*)(dst + 16 * db) = wv; }
    if (q4 == 0) V_LSE[((size_t)g * M + rowq) * 4 + h] = mx * 0.08838834764831845f + __logf(lsum);
}
__device__ __forceinline__ void attn_mfma_item(Ctx& F, int item) {
    const int tid = F.tid, lane = F.lane, w = F.wave, li = lane & 15, q4 = lane >> 4;
    const int nbr = item & 15; int rest = item >> 4; const int h = rest & 3; rest >>= 2; const int g = rest % 3, b = rest / 3;
    const int sh = 2 * g, psh = 4 - sh, r = nbr >> psh, nbp = nbr & ((1 << psh) - 1), n0 = nbp * 256;
    const bf16_t* proj = V_PROJ;
    LAS unsigned char* Ks = F.lds; LAS unsigned char* Vt = F.lds + AT_VOFF;
    u32x4 k2[4], v2[4];
    {
        u32x4 kv[8], vv[8];
        attn_ld<8>(proj, b, sh, r, g, h, n0 - 128, tid, kv, vv);
        attn_ld<4>(proj, b, sh, r, g, h, n0 + 128, tid, k2, v2);
        attn_st<8>(Ks, Vt, 0, tid, kv, vv);
    }
    const int ql = 16 * w + li;
#pragma unroll 1
    for (int j = 0; j < 2; ++j) {
        const size_t rowq = (size_t)(b * SEQ + ((n0 + 128 * j + ql) << sh) + r);
        bf16x8 qf[4];
#pragma unroll
        for (int s = 0; s < 4; ++s) qf[s] = *(const bf16x8*)(proj + rowq * NPROJ + PC_AQ + g * 512 + h * 128 + 32 * s + 8 * q4);
        __syncthreads();
        attn_blk(F, Ks, Vt, 8 * j, j == 0 ? 128 - n0 : 0, rowq, g, h, qf);
        __syncthreads();
        if (j == 0) attn_st<4>(Ks, Vt, 0, tid, k2, v2);
    }
}
constexpr int DP_Q = 0, DP_K = 17408, DP_V = 34816, DP_AM = 52224, DP_TM = 68608, DP_RTV = 77824, DP_RTK = 96256, DP_GC = 114688, DP_BT = 114944;
__device__ __forceinline__ f32x4 mfma16(const bf16x8 a, const bf16x8 b, const f32x4 c) { return __builtin_amdgcn_mfma_f32_16x16x32_bf16(a, b, c, 0, 0, 0); }
__device__ __forceinline__ void delta_prep_item(Ctx& F, int l, int ch) {
    const int tid = F.tid, lane = F.lane, w = F.wave, li = lane & 15, q4 = lane >> 4;
    const int c = ch & 63, h = (ch >> 6) & 3, b = ch >> 8;
    const int row0 = b * SEQ + 64 * c;
    const bf16_t* proj = V_PROJ;
    LAS unsigned char* L = F.lds;
    LAS float* gcs = (LAS float*)(L + DP_GC); LAS float* bts = (LAS float*)(L + DP_BT);
    float b_x = 0.f, b_y = 0.f;
    if (tid < 64) { const bf16_t* pr = proj + (size_t)(row0 + tid) * NPROJ; b_x = bf1(pr[PC_BETA + h]); b_y = bf1(pr[PC_BA + h]); }
    {
        f32x2 wg[3][4]; unsigned xr[3][11];
#pragma unroll
        for (int typ = 0; typ < 3; ++typ) {
            const int cc = typ * 512 + h * 128 + 2 * lane;
#pragma unroll
            for (int i = 0; i < 4; ++i) wg[typ][i] = *(const f32x2*)(F.in[12] + (size_t)(l * 4 + i) * 1536 + cc);
#pragma unroll
            for (int rr = 0; rr < 11; ++rr) { const int tl = 64 * c + 8 * w + rr - 3; xr[typ][rr] = tl >= 0 ? *(const unsigned*)(proj + (size_t)(b * SEQ + tl) * NPROJ + PC_BQKV + cc) : 0u; }
        }
#pragma unroll
        for (int typ = 0; typ < 3; ++typ) {
#pragma unroll
            for (int rr = 0; rr < 8; ++rr) {
                float a0 = 0.f, a1 = 0.f;
#pragma unroll
                for (int i = 0; i < 4; ++i) { a0 += wg[typ][i][0] * bf_lo(xr[typ][rr + i]); a1 += wg[typ][i][1] * bf_hi(xr[typ][rr + i]); }
                a0 = a0 * sigmoidf_(a0); a1 = a1 * sigmoidf_(a1);
                if (typ < 2) { const float ss = wave_sum(a0 * a0 + a1 * a1); const float sc = rsqrtf(ss + EPS) * (typ == 0 ? 0.08838834764831845f : 1.f); a0 *= sc; a1 *= sc; }
                *(LAS unsigned*)(L + typ * 17408 + (8 * w + rr) * 272 + 4 * lane) = cvt_pk_bf16(a0, a1);
            }
        }
    }
    if (tid < 64) {
        const float be = 1.f / (1.f + expf(-b_x));
        const float y = b_y + F.in[14][l * 4 + h]; const float sp = y > 20.f ? y : log1pf(expf(y));
        float g = -expf(F.in[13][l * 4 + h]) * sp;
#pragma unroll
        for (int o = 1; o < 64; o <<= 1) { const float v = __shfl_up(g, o); if (lane >= o) g += v; }
        gcs[tid] = g; bts[tid] = be;
    }
    __syncthreads();
    const size_t chs = (size_t)ch;
    {
        const int mi = w >> 1;
#pragma unroll
        for (int t2 = 0; t2 < 2; ++t2) {
            const int nj = 2 * (w & 1) + t2;
            bf16_t* ad = V_DAT + chs * 4096 + (size_t)(16 * mi + li) * 64 + 32 * (nj >> 1) + 8 * q4 + 4 * (nj & 1);
            if (nj <= mi) {
                f32x4 akk = (f32x4){0.f, 0.f, 0.f, 0.f}, aqk = akk;
                const LAS unsigned char* ki = L + DP_K + (16 * mi + li) * 272 + 16 * q4; const LAS unsigned char* kj = L + DP_K + (16 * nj + li) * 272 + 16 * q4;
                const LAS unsigned char* qi = L + DP_Q + (16 * mi + li) * 272 + 16 * q4;
#pragma unroll
                for (int s2 = 0; s2 < 4; ++s2) { const bf16x8 fkj = *(const LAS bf16x8*)(kj + 64 * s2);
                    akk = mfma16(*(const LAS bf16x8*)(ki + 64 * s2), fkj, akk);
                    aqk = mfma16(fkj, *(const LAS bf16x8*)(qi + 64 * s2), aqk); }
                const float gj = gcs[16 * nj + li], gi2 = gcs[16 * mi + li];
                float ov[4];
#pragma unroll
                for (int rg = 0; rg < 4; ++rg) {
                    const int i = 16 * mi + 4 * q4 + rg, j = 16 * nj + li;
                    ((LAS float*)(L + DP_AM))[i * 64 + j] = (i > j) ? bts[i] * akk[rg] * __expf(gcs[i] - gj) : 0.f;
                    const int j2 = 16 * nj + 4 * q4 + rg, i2 = 16 * mi + li;
                    ov[rg] = (i2 >= j2) ? aqk[rg] * __expf(gi2 - gcs[j2]) : 0.f;
                }
                u32x2 pk; pk.x = cvt_pk_bf16(ov[0], ov[1]); pk.y = cvt_pk_bf16(ov[2], ov[3]); *(u32x2*)ad = pk;
            } else { *(u32x2*)ad = (u32x2){0u, 0u}; }
        }
    }
    __syncthreads();
    if (w == 0) {
        const LAS float* Am = (const LAS float*)(L + DP_AM);
        float t[64];
#pragma unroll
        for (int i = 0; i < 64; ++i) {
            float a0 = (lane == i) ? 1.f : 0.f, a1 = 0.f;
#pragma unroll
            for (int j = 0; j < i; j += 4) {
                const f32x4 av = *(const LAS f32x4*)(Am + i * 64 + j);
                a0 -= av[0] * t[j];
                if (j + 1 < i) a1 -= av[1] * t[j + 1];
                if (j + 2 < i) a0 -= av[2] * t[j + 2];
                if (j + 3 < i) a1 -= av[3] * t[j + 3];
            }
            t[i] = a0 + a1;
            *(LAS unsigned short*)(L + DP_TM + i * 144 + 2 * lane) = (unsigned short)(cvt_pk_bf16(t[i], 0.f) & 0xffffu);
        }
    } else {
        const int e0 = tid - 64;
        const float gl = gcs[63];
        for (int e = e0; e < 8192; e += 448) {
            const int kk = e >> 12, t = e & 63, dp = (e >> 6) & 63;
            const unsigned u = *(const LAS unsigned*)(L + (kk ? DP_K : DP_V) + t * 272 + 4 * dp);
            const float sc = kk ? bts[t] * __expf(gcs[t]) : bts[t];
            const unsigned pk = cvt_pk_bf16(bf_lo(u) * sc, bf_hi(u) * sc);
            LAS unsigned short* d0 = (LAS unsigned short*)(L + (kk ? DP_RTK : DP_RTV) + (2 * dp) * 144 + 2 * t);
            d0[0] = (unsigned short)(pk & 0xffffu); d0[72] = (unsigned short)(pk >> 16);
        }
        for (int e = e0; e < 1024; e += 448) {
            const int t = e >> 4, c16 = e & 15; const float sc = __expf(gcs[t]);
            const u32x4 u = *(const LAS u32x4*)(L + DP_Q + t * 272 + 16 * c16);
            u32x4 o; o.x = cvt_pk_bf16(bf_lo(u.x) * sc, bf_hi(u.x) * sc); o.y = cvt_pk_bf16(bf_lo(u.y) * sc, bf_hi(u.y) * sc); o.z = cvt_pk_bf16(bf_lo(u.z) * sc, bf_hi(u.z) * sc); o.w = cvt_pk_bf16(bf_lo(u.w) * sc, bf_hi(u.w) * sc);
            { bf16_t* qd = V_DQG + chs * 8192 + (size_t)t * 128 + 32 * (c16 >> 2) + 16 * (c16 & 1) + 4 * ((c16 >> 1) & 1); *(u32x2*)qd = (u32x2){o.x, o.y}; *(u32x2*)(qd + 8) = (u32x2){o.z, o.w}; }
        }
        for (int e = e0; e < 1024; e += 448) {
            const int dk = e >> 3, t8 = (e & 7) * 8;
            float v[8];
#pragma unroll
            for (int q = 0; q < 8; ++q) v[q] = bf1(*(const LAS unsigned short*)(L + DP_K + (t8 + q) * 272 + 2 * dk)) * __expf(gl - gcs[t8 + q]);
            u32x4 o; o.x = cvt_pk_bf16(v[0], v[1]); o.y = cvt_pk_bf16(v[2], v[3]); o.z = cvt_pk_bf16(v[4], v[5]); o.w = cvt_pk_bf16(v[6], v[7]);
            { bf16_t* kd = V_DKT + chs * 8192 + (size_t)dk * 64 + 32 * (t8 >> 5) + 16 * ((t8 >> 3) & 1) + 4 * ((t8 >> 4) & 1); *(u32x2*)kd = (u32x2){o.x, o.y}; *(u32x2*)(kd + 8) = (u32x2){o.z, o.w}; }
        }
        if (tid == 64) V_DDL[ch] = __expf(gl);
    }
    __syncthreads();
#pragma unroll
    for (int q = 0; q < 4; ++q) {
        const int id = 4 * w + q;
        { const int m = id >> 2, n = id & 3;
          const LAS unsigned char* ap = L + DP_RTK + (16 * m + li) * 144 + 16 * q4; const LAS unsigned char* bp = L + DP_TM + (16 * n + li) * 144 + 16 * q4;
          f32x4 acc = (f32x4){0.f, 0.f, 0.f, 0.f};
#pragma unroll
          for (int s2 = 0; s2 < 2; ++s2) acc = mfma16(*(const LAS bf16x8*)(ap + 64 * s2), *(const LAS bf16x8*)(bp + 64 * s2), acc);
          u32x2 pk; pk.x = cvt_pk_bf16(acc[0], acc[1]); pk.y = cvt_pk_bf16(acc[2], acc[3]);
          *(u32x2*)(V_DW + chs * 8192 + (size_t)(16 * n + li) * 128 + 32 * (m >> 1) + 8 * q4 + 4 * (m & 1)) = pk; }
        { const int mb = id & 3, nj = id >> 2;
          const LAS unsigned char* ap = L + DP_TM + (16 * mb + li) * 144 + 16 * q4; const LAS unsigned char* bp = L + DP_RTV + (16 * nj + li) * 144 + 16 * q4;
          f32x4 acc = (f32x4){0.f, 0.f, 0.f, 0.f};
#pragma unroll
          for (int s2 = 0; s2 < 2; ++s2) acc = mfma16(*(const LAS bf16x8*)(ap + 64 * s2), *(const LAS bf16x8*)(bp + 64 * s2), acc);
          *(f32x4*)(V_DU + ((chs * 8 + nj) * 64 + lane) * 16 + 4 * mb) = acc; }
    }
    __syncthreads();
}
__device__ __forceinline__ bf16x8 ld_perm(const LAS unsigned char* p) { const u32x2 a = *(const LAS u32x2*)p, b = *(const LAS u32x2*)(p + 32); u32x4 r; r.x = a.x; r.y = a.y; r.z = b.x; r.w = b.y; return __builtin_bit_cast(bf16x8, r); }
__device__ __forceinline__ bf16x8 pack_b(const f32x4 lo, const f32x4 hi) { u32x4 r; r.x = cvt_pk_bf16(lo[0], lo[1]); r.y = cvt_pk_bf16(lo[2], lo[3]); r.z = cvt_pk_bf16(hi[0], hi[1]); r.w = cvt_pk_bf16(hi[2], hi[3]); return __builtin_bit_cast(bf16x8, r); }
template <int DK, bool HAS_W>
__device__ __forceinline__ void chunk_scan_item(Ctx& F, const bf16_t* gW, const bf16_t* gQG, const bf16_t* gKT, const bf16_t* gAT, const float* gU, const bf16_t* vrow  , const float* gDL, float dl_const,
                                                float* obase  , float* Sout  ) {
    constexpr int RS_ = DK * 2 + 16;
    constexpr int OFF_QG = HAS_W ? 64 * RS_ : 0, OFF_KT = OFF_QG + 64 * RS_, OFF_AT = OFF_KT + DK * 144, BUF = OFF_AT + 64 * 144;
    constexpr int NWQ = (64 * DK / 8) / 512;
    constexpr int MT = DK / 16, KS = DK / 32;
    const int tid = F.tid, lane = F.lane, w = F.wave, li = lane & 15, q4 = lane >> 4;
    LAS unsigned char* L = F.lds;
    f32x4 S[MT];
#pragma unroll
    for (int m = 0; m < MT; ++m) S[m] = (f32x4){0.f, 0.f, 0.f, 0.f};
    u32x4 pfw[NWQ], pfq[NWQ], pfk[NWQ], pfa; f32x4 un[4];
#define CS_LOAD(cv) do { const size_t c_ = (cv); \
        _Pragma("unroll") for (int i_ = 0; i_ < NWQ; ++i_) { if (HAS_W) pfw[i_] = *(const u32x4*)(gW + c_ * (64 * DK) + (size_t)(tid + 512 * i_) * 8); \
            pfq[i_] = *(const u32x4*)(gQG + c_ * (64 * DK) + (size_t)(tid + 512 * i_) * 8); pfk[i_] = *(const u32x4*)(gKT + c_ * (64 * DK) + (size_t)(tid + 512 * i_) * 8); } \
        pfa = *(const u32x4*)(gAT + c_ * 4096 + (size_t)tid * 8); \
        if (HAS_W) { _Pragma("unroll") for (int m_ = 0; m_ < 4; ++m_) un[m_] = *(const f32x4*)(gU + ((c_ * 8 + w) * 64 + lane) * 16 + 4 * m_); } \
        else { const bf16_t* vp_ = vrow + (size_t)(64 * c_ + 4 * q4) * NPROJ + 16 * w + li; _Pragma("unroll") for (int m_ = 0; m_ < 4; ++m_) _Pragma("unroll") for (int r_ = 0; r_ < 4; ++r_) un[m_][r_] = bf1(vp_[(size_t)(16 * m_ + r_) * NPROJ]); } } while (0)
#define CS_STORE(bufv) do { LAS unsigned char* B_ = L + (bufv) * BUF; \
        _Pragma("unroll") for (int i_ = 0; i_ < NWQ; ++i_) { const int u_ = tid + 512 * i_; \
            if (HAS_W) *(LAS u32x4*)(B_ + (u_ / (DK / 8)) * RS_ + (u_ % (DK / 8)) * 16) = pfw[i_]; \
            *(LAS u32x4*)(B_ + OFF_QG + (u_ / (DK / 8)) * RS_ + (u_ % (DK / 8)) * 16) = pfq[i_]; \
            *(LAS u32x4*)(B_ + OFF_KT + (u_ >> 3) * 144 + (u_ & 7) * 16) = pfk[i_]; } \
        *(LAS u32x4*)(B_ + OFF_AT + (tid >> 3) * 144 + (tid & 7) * 16) = pfa; } while (0)
    CS_LOAD(0);
    CS_STORE(0);
    f32x4 uc[4];
#pragma unroll
    for (int m = 0; m < 4; ++m) uc[m] = un[m];
    float dl = gDL ? gDL[0] : dl_const;
    __syncthreads();
#pragma unroll 1
    for (int c = 0; c < 64; ++c) {
        const LAS unsigned char* Bf = L + (c & 1) * BUF;
        float dln = dl_const;
        if (c + 1 < 64) { CS_LOAD(c + 1); if (gDL) dln = gDL[c + 1]; }
        bf16x8 Sb[KS];
#pragma unroll
        for (int s2 = 0; s2 < KS; ++s2) Sb[s2] = pack_b(S[2 * s2], S[2 * s2 + 1]);
        const LAS unsigned char* fb = Bf + li * RS_ + 16 * q4;
        const LAS unsigned char* fb2 = Bf + li * 144 + 16 * q4;
        f32x4 vn[4];
        if (HAS_W) {
            bf16x8 fw[4][KS];
#pragma unroll
            for (int mb = 0; mb < 4; ++mb)
#pragma unroll
                for (int s2 = 0; s2 < KS; ++s2) fw[mb][s2] = *(const LAS bf16x8*)(fb + mb * 16 * RS_ + 64 * s2);
#pragma unroll
            for (int mb = 0; mb < 4; ++mb) vn[mb] = (f32x4){0.f, 0.f, 0.f, 0.f};
#pragma unroll
            for (int s2 = 0; s2 < KS; ++s2)
#pragma unroll
                for (int mb = 0; mb < 4; ++mb) vn[mb] = mfma16(fw[mb][s2], Sb[s2], vn[mb]);
#pragma unroll
            for (int mb = 0; mb < 4; ++mb) vn[mb] = uc[mb] - vn[mb];
        } else {
#pragma unroll
            for (int mb = 0; mb < 4; ++mb) vn[mb] = uc[mb];
        }
        bf16x8 Vb[2];
        Vb[0] = pack_b(vn[0], vn[1]); Vb[1] = pack_b(vn[2], vn[3]);
        {
            bf16x8 fq[4][KS], fa[4][2];
#pragma unroll
            for (int mb = 0; mb < 4; ++mb) {
#pragma unroll
                for (int s2 = 0; s2 < KS; ++s2) fq[mb][s2] = *(const LAS bf16x8*)(fb + OFF_QG + mb * 16 * RS_ + 64 * s2);
#pragma unroll
                for (int s2 = 0; s2 < 2; ++s2) fa[mb][s2] = *(const LAS bf16x8*)(fb2 + OFF_AT + mb * 16 * 144 + 64 * s2);
            }
            f32x4 oa[4];
#pragma unroll
            for (int mb = 0; mb < 4; ++mb) oa[mb] = (f32x4){0.f, 0.f, 0.f, 0.f};
#pragma unroll
            for (int s2 = 0; s2 < KS; ++s2)
#pragma unroll
                for (int mb = 0; mb < 4; ++mb) oa[mb] = mfma16(fq[mb][s2], Sb[s2], oa[mb]);
#pragma unroll
            for (int s2 = 0; s2 < 2; ++s2)
#pragma unroll
                for (int mb = 0; mb < 4; ++mb) oa[mb] = mfma16(fa[mb][s2], Vb[s2], oa[mb]);
            float* od = obase + (size_t)(64 * c + 4 * q4) * 512 + 16 * w + li;
#pragma unroll
            for (int mb = 0; mb < 4; ++mb)
#pragma unroll
                for (int rg = 0; rg < 4; ++rg) od[(size_t)(16 * mb + rg) * 512] = oa[mb][rg];
        }
        {
            bf16x8 fk[MT][2];
#pragma unroll
            for (int m = 0; m < MT; ++m)
#pragma unroll
                for (int s2 = 0; s2 < 2; ++s2) fk[m][s2] = *(const LAS bf16x8*)(fb2 + OFF_KT + m * 16 * 144 + 64 * s2);
#pragma unroll
            for (int m = 0; m < MT; ++m) S[m] = S[m] * dl;
#pragma unroll
            for (int s2 = 0; s2 < 2; ++s2)
#pragma unroll
                for (int m = 0; m < MT; ++m) S[m] = mfma16(fk[m][s2], Vb[s2], S[m]);
        }
        if (c + 1 < 64) { CS_STORE((c + 1) & 1);
#pragma unroll
            for (int m = 0; m < 4; ++m) uc[m] = un[m];
            dl = dln; }
        __syncthreads();
    }
#undef CS_LOAD
#undef CS_STORE
    float* So = Sout + 16 * w + li;
#pragma unroll
    for (int m = 0; m < MT; ++m)
#pragma unroll
        for (int rg = 0; rg < 4; ++rg) So[(size_t)(16 * m + 4 * q4 + rg) * 128] = S[m][rg];
    __syncthreads();
}


constexpr int D2P_Q = 0, D2P_K = 18432, D2P_RTV = 35840, D2P_AM = 54272, D2P_GC = 70656, D2P_BT = 70912, D2P_HALF = 71168;
__device__ __forceinline__ void delta_prep_item2(Ctx& F, int l, int item) {
    const int tid = F.tid, lane = F.lane, w = F.wave, li = lane & 15, q4 = lane >> 4;
    const int hf = w >> 2, lw = w & 3, lt = tid & 255;
    const int ch = 2 * item + hf, c = ch & 63, h = (ch >> 6) & 3, b = ch >> 8;
    const int row0 = b * SEQ + 64 * c;
    const bf16_t* proj = V_PROJ;
    LAS unsigned char* L = F.lds + hf * D2P_HALF;
    LAS float* gcs = (LAS float*)(L + D2P_GC); LAS float* bts = (LAS float*)(L + D2P_BT);
    const size_t chs = (size_t)ch;
    float b_x = 0.f, b_y = 0.f;
    if (lt < 64) { const bf16_t* pr = proj + (size_t)(row0 + lt) * NPROJ; b_x = bf1(pr[PC_BETA + h]); b_y = bf1(pr[PC_BA + h]); }
    {
        f32x2 wg[3][4];
#pragma unroll
        for (int typ = 0; typ < 3; ++typ)
#pragma unroll
            for (int i = 0; i < 4; ++i) wg[typ][i] = *(const f32x2*)(F.in[12] + (size_t)(l * 4 + i) * 1536 + typ * 512 + h * 128 + 2 * lane);
#pragma unroll 1
        for (int p = 0; p < 2; ++p) {
            const int r8 = 16 * lw + 8 * p;
            unsigned xr[3][11]; float bx[8];
#pragma unroll
            for (int typ = 0; typ < 3; ++typ)
#pragma unroll
                for (int rr = 0; rr < 11; ++rr) { const int tl = 64 * c + r8 + rr - 3; xr[typ][rr] = tl >= 0 ? *(const unsigned*)(proj + (size_t)(b * SEQ + tl) * NPROJ + PC_BQKV + typ * 512 + h * 128 + 2 * lane) : 0u; }
#pragma unroll
            for (int rr = 0; rr < 8; ++rr) bx[rr] = bf1(proj[(size_t)(row0 + r8 + rr) * NPROJ + PC_BETA + h]);
#pragma unroll
            for (int typ = 0; typ < 3; ++typ) {
#pragma unroll
                for (int rr = 0; rr < 8; ++rr) {
                    float a0 = 0.f, a1 = 0.f;
#pragma unroll
                    for (int i = 0; i < 4; ++i) { a0 += wg[typ][i][0] * bf_lo(xr[typ][rr + i]); a1 += wg[typ][i][1] * bf_hi(xr[typ][rr + i]); }
                    a0 = a0 * sigmoidf_(a0); a1 = a1 * sigmoidf_(a1);
                    if (typ < 2) { const float ss = wave_sum(a0 * a0 + a1 * a1); const float sc = rsqrtf(ss + EPS) * (typ == 0 ? 0.08838834764831845f : 1.f); a0 *= sc; a1 *= sc;
                        *(LAS unsigned*)(L + (typ ? D2P_K : D2P_Q) + (r8 + rr) * 272 + 4 * lane) = cvt_pk_bf16(a0, a1); }
                    else { const float be = 1.f / (1.f + __expf(-bx[rr])); const unsigned pk = cvt_pk_bf16(a0 * be, a1 * be);
                        LAS unsigned short* d0 = (LAS unsigned short*)(L + D2P_RTV + (2 * lane) * 144 + 2 * (r8 + rr)); d0[0] = (unsigned short)(pk & 0xffffu); d0[72] = (unsigned short)(pk >> 16); }
                }
            }
        }
    }
    if (lt < 64) {
        const float be = 1.f / (1.f + __expf(-b_x));
        const float y = b_y + F.in[14][l * 4 + h]; const float sp = y > 20.f ? y : log1pf(expf(y));
        float g = -expf(F.in[13][l * 4 + h]) * sp;
#pragma unroll
        for (int o = 1; o < 64; o <<= 1) { const float v = __shfl_up(g, o); if (lane >= o) g += v; }
        gcs[lt] = g; bts[lt] = be;
    }
    __syncthreads();
    {
        const int mi = lw;
#pragma unroll
        for (int nj = 0; nj < 4; ++nj) {
            bf16_t* ad = V_DAT + chs * 4096 + (size_t)(16 * mi + li) * 64 + 32 * (nj >> 1) + 8 * q4 + 4 * (nj & 1);
            if (nj <= mi) {
                f32x4 akk = (f32x4){0.f, 0.f, 0.f, 0.f}, aqk = akk;
                const LAS unsigned char* ki = L + D2P_K + (16 * mi + li) * 272 + 16 * q4; const LAS unsigned char* kj = L + D2P_K + (16 * nj + li) * 272 + 16 * q4;
                const LAS unsigned char* qi = L + D2P_Q + (16 * mi + li) * 272 + 16 * q4;
#pragma unroll
                for (int s2 = 0; s2 < 4; ++s2) { const bf16x8 fkj = *(const LAS bf16x8*)(kj + 64 * s2);
                    akk = mfma16(*(const LAS bf16x8*)(ki + 64 * s2), fkj, akk);
                    aqk = mfma16(fkj, *(const LAS bf16x8*)(qi + 64 * s2), aqk); }
                const float gj = gcs[16 * nj + li], gi2 = gcs[16 * mi + li];
                float ov[4];
#pragma unroll
                for (int rg = 0; rg < 4; ++rg) {
                    const int i = 16 * mi + 4 * q4 + rg, j = 16 * nj + li;
                    ((LAS float*)(L + D2P_AM))[i * 64 + j] = (i > j) ? bts[i] * akk[rg] * __expf(gcs[i] - gj) : 0.f;
                    const int j2 = 16 * nj + 4 * q4 + rg, i2 = 16 * mi + li;
                    ov[rg] = (i2 >= j2) ? aqk[rg] * __expf(gi2 - gcs[j2]) : 0.f;
                }
                u32x2 pk; pk.x = cvt_pk_bf16(ov[0], ov[1]); pk.y = cvt_pk_bf16(ov[2], ov[3]); *(u32x2*)ad = pk;
            } else { *(u32x2*)ad = (u32x2){0u, 0u}; }
        }
#pragma unroll
        for (int k4 = 0; k4 < 4; ++k4) {
            const int e = lt + 256 * k4, t = e >> 4, c16 = e & 15; const float sc = __expf(gcs[t]);
            const u32x4 u = *(const LAS u32x4*)(L + D2P_Q + t * 272 + 16 * c16);
            u32x4 o; o.x = cvt_pk_bf16(bf_lo(u.x) * sc, bf_hi(u.x) * sc); o.y = cvt_pk_bf16(bf_lo(u.y) * sc, bf_hi(u.y) * sc); o.z = cvt_pk_bf16(bf_lo(u.z) * sc, bf_hi(u.z) * sc); o.w = cvt_pk_bf16(bf_lo(u.w) * sc, bf_hi(u.w) * sc);
            bf16_t* qd = V_DQG + chs * 8192 + (size_t)t * 128 + 32 * (c16 >> 2) + 16 * (c16 & 1) + 4 * ((c16 >> 1) & 1); *(u32x2*)qd = (u32x2){o.x, o.y}; *(u32x2*)(qd + 8) = (u32x2){o.z, o.w};
        }
    }
    __syncthreads();
    if (lw == 0) {
        const LAS float* Am = (const LAS float*)(L + D2P_AM);
        float t[64];
#pragma unroll
        for (int i = 0; i < 64; ++i) {
            float a0 = (lane == i) ? 1.f : 0.f, a1 = 0.f;
#pragma unroll
            for (int j = 0; j < i; j += 4) {
                const f32x4 av = *(const LAS f32x4*)(Am + i * 64 + j);
                a0 -= av[0] * t[j];
                if (j + 1 < i) a1 -= av[1] * t[j + 1];
                if (j + 2 < i) a0 -= av[2] * t[j + 2];
                if (j + 3 < i) a1 -= av[3] * t[j + 3];
            }
            t[i] = a0 + a1;
        }
        asm volatile("s_waitcnt lgkmcnt(0)" ::: "memory");
#pragma unroll
        for (int i = 0; i < 64; ++i) *(LAS unsigned short*)(L + D2P_AM + i * 144 + 2 * lane) = (unsigned short)(cvt_pk_bf16(t[i], 0.f) & 0xffffu);
    } else {
        const int e0 = lt - 64;
        const float gl = gcs[63];
        for (int e = e0; e < 4096; e += 192) {
            const int t = e & 63, dp = e >> 6;
            const unsigned u = *(const LAS unsigned*)(L + D2P_K + t * 272 + 4 * dp);
            const float sc = bts[t] * __expf(gcs[t]);
            const unsigned pk = cvt_pk_bf16(bf_lo(u) * sc, bf_hi(u) * sc);
            LAS unsigned short* d0 = (LAS unsigned short*)(L + D2P_Q + (2 * dp) * 144 + 2 * t);
            d0[0] = (unsigned short)(pk & 0xffffu); d0[72] = (unsigned short)(pk >> 16);
        }
        for (int e = e0; e < 1024; e += 192) {
            const int dk = e >> 3, t8 = (e & 7) * 8;
            float v[8];
#pragma unroll
            for (int q = 0; q < 8; ++q) v[q] = bf1(*(const LAS unsigned short*)(L + D2P_K + (t8 + q) * 272 + 2 * dk)) * __expf(gl - gcs[t8 + q]);
            u32x4 o; o.x = cvt_pk_bf16(v[0], v[1]); o.y = cvt_pk_bf16(v[2], v[3]); o.z = cvt_pk_bf16(v[4], v[5]); o.w = cvt_pk_bf16(v[6], v[7]);
            bf16_t* kd = V_DKT + chs * 8192 + (size_t)dk * 64 + 32 * (t8 >> 5) + 16 * ((t8 >> 3) & 1) + 4 * ((t8 >> 4) & 1); *(u32x2*)kd = (u32x2){o.x, o.y}; *(u32x2*)(kd + 8) = (u32x2){o.z, o.w};
        }
        if (lt == 64) V_DDL[ch] = __expf(gl);
    }
    __syncthreads();
#pragma unroll
    for (int q = 0; q < 8; ++q) {
        const int id = 8 * lw + q;
        { const int m = id >> 2, n = id & 3;
          const LAS unsigned char* ap = L + D2P_Q + (16 * m + li) * 144 + 16 * q4; const LAS unsigned char* bp = L + D2P_AM + (16 * n + li) * 144 + 16 * q4;
          f32x4 acc = (f32x4){0.f, 0.f, 0.f, 0.f};
#pragma unroll
          for (int s2 = 0; s2 < 2; ++s2) acc = mfma16(*(const LAS bf16x8*)(ap + 64 * s2), *(const LAS bf16x8*)(bp + 64 * s2), acc);
          u32x2 pk; pk.x = cvt_pk_bf16(acc[0], acc[1]); pk.y = cvt_pk_bf16(acc[2], acc[3]);
          *(u32x2*)(V_DW + chs * 8192 + (size_t)(16 * n + li) * 128 + 32 * (m >> 1) + 8 * q4 + 4 * (m & 1)) = pk; }
        { const int mb = id & 3, nj = id >> 2;
          const LAS unsigned char* ap = L + D2P_AM + (16 * mb + li) * 144 + 16 * q4; const LAS unsigned char* bp = L + D2P_RTV + (16 * nj + li) * 144 + 16 * q4;
          f32x4 acc = (f32x4){0.f, 0.f, 0.f, 0.f};
#pragma unroll
          for (int s2 = 0; s2 < 2; ++s2) acc = mfma16(*(const LAS bf16x8*)(ap + 64 * s2), *(const LAS bf16x8*)(bp + 64 * s2), acc);
          *(f32x4*)(V_DU + ((chs * 8 + nj) * 64 + lane) * 16 + 4 * mb) = acc; }
    }
    __syncthreads();
}
constexpr int D2_BUF = 35840, D2_KT = 17408;
__device__ __forceinline__ void delta_scan2_item(Ctx& F, int l, int b, int h) {
    const int tid = F.tid, lane = F.lane, w = F.wave, li = lane & 15, q4 = lane >> 4;
    LAS unsigned char* L = F.lds;
    const size_t ch0 = (size_t)(b * 4 + h) * 64;
    const bf16_t* gW = V_DW + ch0 * 8192; const bf16_t* gKT = V_DKT + ch0 * 8192; const float* gU = V_DU + ch0 * 8192; const float* gDL = V_DDL + ch0;
    bf16_t* gSB = V_SB + ch0 * 16384; bf16_t* gVB = V_VB + ch0 * 8192;
    f32x4 S[8];
#pragma unroll
    for (int m = 0; m < 8; ++m) S[m] = (f32x4){0.f, 0.f, 0.f, 0.f};
    u32x4 pa[4], pb[4]; f32x4 ua[4], ub[4], uc[4]; float dla = 0.f, dlb = 0.f, dl;
#define D2_LOAD(P, U_, DL_, cv) do { const size_t c_ = (cv); \
        P[0] = *(const u32x4*)(gW + c_ * 8192 + (size_t)tid * 8); P[1] = *(const u32x4*)(gW + c_ * 8192 + (size_t)(tid + 512) * 8); \
        P[2] = *(const u32x4*)(gKT + c_ * 8192 + (size_t)tid * 8); P[3] = *(const u32x4*)(gKT + c_ * 8192 + (size_t)(tid + 512) * 8); \
        _Pragma("unroll") for (int m_ = 0; m_ < 4; ++m_) U_[m_] = *(const f32x4*)(gU + ((c_ * 8 + w) * 64 + lane) * 16 + 4 * m_); DL_ = gDL[c_]; } while (0)
#define D2_STORE(P, bufv) do { LAS unsigned char* B_ = L + (bufv) * D2_BUF; \
        *(LAS u32x4*)(B_ + (tid >> 4) * 272 + (tid & 15) * 16) = P[0]; *(LAS u32x4*)(B_ + ((tid >> 4) + 32) * 272 + (tid & 15) * 16) = P[1]; \
        *(LAS u32x4*)(B_ + D2_KT + (tid >> 3) * 144 + (tid & 7) * 16) = P[2]; *(LAS u32x4*)(B_ + D2_KT + ((tid >> 3) + 64) * 144 + (tid & 7) * 16) = P[3]; } while (0)
#define D2_COMPUTE(bufv, cv) do { const LAS unsigned char* Bf = L + (bufv) * D2_BUF; const size_t c_ = (cv); \
        bf16x8 Sb[4]; \
        _Pragma("unroll") for (int s2 = 0; s2 < 4; ++s2) { Sb[s2] = pack_b(S[2 * s2], S[2 * s2 + 1]); *(bf16x8*)(gSB + (((c_ * 8 + w) * 4 + s2) * 64 + lane) * 8) = Sb[s2]; } \
        const LAS unsigned char* fb = Bf + li * 272 + 16 * q4; const LAS unsigned char* fb2 = Bf + D2_KT + li * 144 + 16 * q4; \
        f32x4 vn[4]; \
        { bf16x8 fw[4][4]; \
          _Pragma("unroll") for (int mb = 0; mb < 4; ++mb) _Pragma("unroll") for (int s2 = 0; s2 < 4; ++s2) fw[mb][s2] = *(const LAS bf16x8*)(fb + mb * 16 * 272 + 64 * s2); \
          _Pragma("unroll") for (int mb = 0; mb < 4; ++mb) vn[mb] = (f32x4){0.f, 0.f, 0.f, 0.f}; \
          _Pragma("unroll") for (int s2 = 0; s2 < 4; ++s2) _Pragma("unroll") for (int mb = 0; mb < 4; ++mb) vn[mb] = mfma16(fw[mb][s2], Sb[s2], vn[mb]); } \
        _Pragma("unroll") for (int mb = 0; mb < 4; ++mb) vn[mb] = uc[mb] - vn[mb]; \
        bf16x8 Vb[2]; Vb[0] = pack_b(vn[0], vn[1]); Vb[1] = pack_b(vn[2], vn[3]); \
        _Pragma("unroll") for (int s2 = 0; s2 < 2; ++s2) *(bf16x8*)(gVB + (((c_ * 8 + w) * 2 + s2) * 64 + lane) * 8) = Vb[s2]; \
        { bf16x8 fk[8][2]; \
          _Pragma("unroll") for (int m = 0; m < 8; ++m) _Pragma("unroll") for (int s2 = 0; s2 < 2; ++s2) fk[m][s2] = *(const LAS bf16x8*)(fb2 + m * 16 * 144 + 64 * s2); \
          _Pragma("unroll") for (int m = 0; m < 8; ++m) S[m] = S[m] * dl; \
          _Pragma("unroll") for (int s2 = 0; s2 < 2; ++s2) _Pragma("unroll") for (int m = 0; m < 8; ++m) S[m] = mfma16(fk[m][s2], Vb[s2], S[m]); } } while (0)
    D2_LOAD(pa, ua, dla, 0);
    D2_LOAD(pb, ub, dlb, 1);
    D2_STORE(pa, 0);
#pragma unroll
    for (int m = 0; m < 4; ++m) uc[m] = ua[m];
    dl = dla;
    __syncthreads();
#pragma unroll 1
    for (int c = 0; c < 64; c += 2) {
        if (c + 2 < 64) D2_LOAD(pa, ua, dla, c + 2);
        D2_COMPUTE(0, c);
        D2_STORE(pb, 1);
#pragma unroll
        for (int m = 0; m < 4; ++m) uc[m] = ub[m];
        dl = dlb;
        __syncthreads();
        if (c + 3 < 64) D2_LOAD(pb, ub, dlb, c + 3);
        D2_COMPUTE(1, c + 1);
        if (c + 2 < 64) { D2_STORE(pa, 0);
#pragma unroll
            for (int m = 0; m < 4; ++m) uc[m] = ua[m];
            dl = dla; }
        __syncthreads();
    }
#undef D2_LOAD
#undef D2_STORE
#undef D2_COMPUTE
    float* So = F.out + O_BSP + ((size_t)(l * BATCH + b) * 4 + h) * 16384 + 16 * w + li;
#pragma unroll
    for (int m = 0; m < 8; ++m)
#pragma unroll
        for (int rg = 0; rg < 4; ++rg) So[(size_t)(16 * m + 4 * q4 + rg) * 128] = S[m][rg];
    __syncthreads();
}
__device__ __forceinline__ void delta_out_item(Ctx& F, int l, int ch) {
    const int tid = F.tid, lane = F.lane, w = F.wave, li = lane & 15, q4 = lane >> 4;
    const int c = ch & 63, h = (ch >> 6) & 3, b = ch >> 8;
    const int row0 = b * SEQ + 64 * c;
    LAS unsigned char* L = F.lds;
    const size_t chs = (size_t)ch;
    const u32x4 q0 = *(const u32x4*)(V_DQG + chs * 8192 + (size_t)tid * 8), q1 = *(const u32x4*)(V_DQG + chs * 8192 + (size_t)(tid + 512) * 8), a0 = *(const u32x4*)(V_DAT + chs * 4096 + (size_t)tid * 8);
    bf16x8 Sb[4], Vb[2];
#pragma unroll
    for (int s2 = 0; s2 < 4; ++s2) Sb[s2] = *(const bf16x8*)(V_SB + (((chs * 8 + w) * 4 + s2) * 64 + lane) * 8);
#pragma unroll
    for (int s2 = 0; s2 < 2; ++s2) Vb[s2] = *(const bf16x8*)(V_VB + (((chs * 8 + w) * 2 + s2) * 64 + lane) * 8);
    const float gn = F.in[15][l * 128 + 16 * w + li];
    const bf16_t* zp = V_PROJ + (size_t)(row0 + 4 * q4) * NPROJ + PC_BZ + h * 128 + 16 * w + li;
    float zz[16];
#pragma unroll
    for (int i = 0; i < 16; ++i) zz[i] = bf1(zp[(size_t)(16 * (i >> 2) + (i & 3)) * NPROJ]);
    *(LAS u32x4*)(L + (tid >> 4) * 272 + (tid & 15) * 16) = q0; *(LAS u32x4*)(L + ((tid >> 4) + 32) * 272 + (tid & 15) * 16) = q1;
    *(LAS u32x4*)(L + 17408 + (tid >> 3) * 144 + (tid & 7) * 16) = a0;
    __syncthreads();
    f32x4 oa[4];
    {
        const LAS unsigned char* fb = L + li * 272 + 16 * q4; const LAS unsigned char* fb2 = L + 17408 + li * 144 + 16 * q4;
        bf16x8 fq[4][4], fa[4][2];
#pragma unroll
        for (int mb = 0; mb < 4; ++mb) {
#pragma unroll
            for (int s2 = 0; s2 < 4; ++s2) fq[mb][s2] = *(const LAS bf16x8*)(fb + mb * 16 * 272 + 64 * s2);
#pragma unroll
            for (int s2 = 0; s2 < 2; ++s2) fa[mb][s2] = *(const LAS bf16x8*)(fb2 + mb * 16 * 144 + 64 * s2);
        }
#pragma unroll
        for (int mb = 0; mb < 4; ++mb) oa[mb] = (f32x4){0.f, 0.f, 0.f, 0.f};
#pragma unroll
        for (int s2 = 0; s2 < 4; ++s2)
#pragma unroll
            for (int mb = 0; mb < 4; ++mb) oa[mb] = mfma16(fq[mb][s2], Sb[s2], oa[mb]);
#pragma unroll
        for (int s2 = 0; s2 < 2; ++s2)
#pragma unroll
            for (int mb = 0; mb < 4; ++mb) oa[mb] = mfma16(fa[mb][s2], Vb[s2], oa[mb]);
    }
    LAS float* part = (LAS float*)(L + 32768);
#pragma unroll
    for (int mb = 0; mb < 4; ++mb)
#pragma unroll
        for (int rg = 0; rg < 4; ++rg) { float ss = oa[mb][rg] * oa[mb][rg];
            ss = row_sum16(ss);
            if (li == 0) part[(16 * mb + 4 * q4 + rg) * 8 + w] = ss; }
    __syncthreads();
    bf16_t* od = V_OABC + (size_t)M * 512 + (size_t)(row0 + 4 * q4) * 512 + h * 128 + 16 * w + li;
#pragma unroll
    for (int mb = 0; mb < 4; ++mb)
#pragma unroll
        for (int rg = 0; rg < 4; ++rg) { const int tk = 16 * mb + 4 * q4 + rg;
            const f32x4 p0 = *(const LAS f32x4*)(part + tk * 8), p1 = *(const LAS f32x4*)(part + tk * 8 + 4);
            const float rstd = rsqrtf(((p0[0] + p0[1]) + (p0[2] + p0[3]) + (p1[0] + p1[1]) + (p1[2] + p1[3])) * (1.f / 128.f) + EPS);
            const float z = zz[4 * mb + rg];
            od[(size_t)(16 * mb + rg) * 512] = (bf16_t)(cvt_pk_bf16(oa[mb][rg] * rstd * gn * z * sigmoidf_(z), 0.f) & 0xffffu); }
    __syncthreads();
}
__device__ __forceinline__ void delta_scan_item(Ctx& F, int l, int b, int h) {
    const size_t ch0 = (size_t)(b * 4 + h) * 64;
    chunk_scan_item<128, true>(F, V_DW + ch0 * 8192, V_DQG + ch0 * 8192, V_DKT + ch0 * 8192, V_DAT + ch0 * 4096, V_DU + ch0 * 8192, nullptr, V_DDL + ch0, 0.f,
                               V_OBR + (size_t)(b * SEQ) * 512 + h * 128, F.out + O_BSP + ((size_t)(l * BATCH + b) * 4 + h) * 16384);
}
__device__ __forceinline__ void ret_scan_item(Ctx& F, int l, int b, int h) {
    const size_t ch0 = (size_t)(b * 4 + h) * 64;
    const float lg2 = log2f(1.f - exp2f(-5.f - (float)h));
    chunk_scan_item<64, false>(F, nullptr, V_RQG + ch0 * 4096, V_RKT + ch0 * 4096, V_RAT + ch0 * 4096, nullptr, V_PROJ + (size_t)(b * SEQ) * NPROJ + PC_CV + h * 128, nullptr, exp2f(64.f * lg2),
                               V_OCR + (size_t)(b * SEQ) * 512 + h * 128, F.out + O_CRP + ((size_t)(l * BATCH + b) * 4 + h) * 8192);
}
__device__ __forceinline__ void ret_prep_item(Ctx& F, int l, int item) {
    const int tid = F.tid, lane = F.lane, w = F.wave, li = lane & 15, q4 = lane >> 4;
    const int pj = w >> 1, t2 = tid & 127, w2 = w & 1;
    const int ch = 4 * item + pj, c = ch & 63, h = (ch >> 6) & 3, b = ch >> 8;
    const int row0 = b * SEQ + 64 * c;
    const bf16_t* proj = V_PROJ;
    LAS unsigned char* L = F.lds + pj * 18432;
    const float lg2 = log2f(1.f - exp2f(-5.f - (float)h));
    const size_t chs = (size_t)ch;
#pragma unroll
    for (int k8 = 0; k8 < 8; ++k8) {
        const int task = t2 + 128 * k8, qk = task >> 9, t = (task >> 3) & 63, i0 = 4 * (task & 7);
        const float* cs = V_ROPEC + ((size_t)(64 * c + t) * 32 + i0) * 2;
        const f32x4 c01 = *(const f32x4*)cs, c23 = *(const f32x4*)(cs + 4);
        const f32x4 cc = (f32x4){c01[0], c01[2], c23[0], c23[2]}, sn = (f32x4){c01[1], c01[3], c23[1], c23[3]};
        const bf16_t* p = proj + (size_t)(row0 + t) * NPROJ + (qk ? PC_CK : PC_CQ) + h * 64;
        const u32x2 ulo = *(const u32x2*)(p + i0), uhi = *(const u32x2*)(p + 32 + i0);
        const f32x4 lo = (f32x4){bf_lo(ulo.x), bf_hi(ulo.x), bf_lo(ulo.y), bf_hi(ulo.y)}, hi = (f32x4){bf_lo(uhi.x), bf_hi(uhi.x), bf_lo(uhi.y), bf_hi(uhi.y)};
        const float sc = qk ? 0.125f : 1.f;
        const f32x4 olo = (lo * cc - hi * sn) * sc, ohi = (hi * cc + lo * sn) * sc;
        u32x2 plo, phi; plo.x = cvt_pk_bf16(olo[0], olo[1]); plo.y = cvt_pk_bf16(olo[2], olo[3]); phi.x = cvt_pk_bf16(ohi[0], ohi[1]); phi.y = cvt_pk_bf16(ohi[2], ohi[3]);
        *(LAS u32x2*)(L + qk * 9216 + t * 144 + 2 * i0) = plo; *(LAS u32x2*)(L + qk * 9216 + t * 144 + 64 + 2 * i0) = phi;
    }
    __syncthreads();
#pragma unroll
    for (int t8 = 0; t8 < 8; ++t8) {
        const int tile = 8 * w2 + t8, mi = tile >> 2, nj = tile & 3;
        bf16_t* ad = V_RAT + chs * 4096 + (size_t)(16 * mi + li) * 64 + 32 * (nj >> 1) + 8 * q4 + 4 * (nj & 1);
        if (nj <= mi) {
            f32x4 aqk = (f32x4){0.f, 0.f, 0.f, 0.f};
            const LAS unsigned char* kj = L + 9216 + (16 * nj + li) * 144 + 16 * q4; const LAS unsigned char* qi = L + (16 * mi + li) * 144 + 16 * q4;
#pragma unroll
            for (int s2 = 0; s2 < 2; ++s2) aqk = mfma16(*(const LAS bf16x8*)(kj + 64 * s2), *(const LAS bf16x8*)(qi + 64 * s2), aqk);
            float ov[4];
#pragma unroll
            for (int rg = 0; rg < 4; ++rg) { const int j2 = 16 * nj + 4 * q4 + rg, i2 = 16 * mi + li; ov[rg] = (i2 >= j2) ? aqk[rg] * exp2f((float)(i2 - j2) * lg2) : 0.f; }
            u32x2 pk; pk.x = cvt_pk_bf16(ov[0], ov[1]); pk.y = cvt_pk_bf16(ov[2], ov[3]); *(u32x2*)ad = pk;
        } else { *(u32x2*)ad = (u32x2){0u, 0u}; }
    }
#pragma unroll
    for (int k4 = 0; k4 < 4; ++k4) {
        const int u_ = t2 + 128 * k4;
        { const int t = u_ >> 3, c8 = u_ & 7; const float sc = exp2f((float)(t + 1) * lg2);
          const u32x4 u = *(const LAS u32x4*)(L + t * 144 + 16 * c8);
          u32x4 o; o.x = cvt_pk_bf16(bf_lo(u.x) * sc, bf_hi(u.x) * sc); o.y = cvt_pk_bf16(bf_lo(u.y) * sc, bf_hi(u.y) * sc); o.z = cvt_pk_bf16(bf_lo(u.z) * sc, bf_hi(u.z) * sc); o.w = cvt_pk_bf16(bf_lo(u.w) * sc, bf_hi(u.w) * sc);
          bf16_t* qd = V_RQG + chs * 4096 + (size_t)t * 64 + 32 * (c8 >> 2) + 16 * (c8 & 1) + 4 * ((c8 >> 1) & 1); *(u32x2*)qd = (u32x2){o.x, o.y}; *(u32x2*)(qd + 8) = (u32x2){o.z, o.w}; }
        { const int dk = u_ >> 3, t8 = (u_ & 7) * 8;
          float v[8];
#pragma unroll
          for (int q = 0; q < 8; ++q) v[q] = bf1(*(const LAS unsigned short*)(L + 9216 + (t8 + q) * 144 + 2 * dk)) * exp2f((float)(63 - t8 - q) * lg2);
          u32x4 o2; o2.x = cvt_pk_bf16(v[0], v[1]); o2.y = cvt_pk_bf16(v[2], v[3]); o2.z = cvt_pk_bf16(v[4], v[5]); o2.w = cvt_pk_bf16(v[6], v[7]);
          bf16_t* kd = V_RKT + chs * 4096 + (size_t)dk * 64 + 32 * (t8 >> 5) + 16 * ((t8 >> 3) & 1) + 4 * ((t8 >> 4) & 1); *(u32x2*)kd = (u32x2){o2.x, o2.y}; *(u32x2*)(kd + 8) = (u32x2){o2.z, o2.w}; }
    }
    __syncthreads();
}
__device__ __forceinline__ void delta_item(Ctx& F, int l, bool sample, int b, int h) {
    LAS float* sm = (LAS float*)F.lds;
    LAS float* qs = sm, *ks = sm + 2048, *vs = sm + 4096, *bgs = sm + 6144, *pa = sm + 6400, *pb = sm + 6912;
    const int tid = F.tid, c = tid & 127, qr = tid >> 7;
    float s[32];
    if (sample) { const float* S0 = F.in[6] + ((size_t)(l * DB + b) * 4 + h) * 16384;
#pragma unroll
        for (int i = 0; i < 32; ++i) s[i] = S0[(32 * qr + i) * 128 + c]; }
    else {
#pragma unroll
        for (int i = 0; i < 32; ++i) s[i] = 0.f; }
    const int T = sample ? DS : SEQ, row0 = sample ? MP + b * DS : b * SEQ;
    for (int t0 = 0; t0 < T; t0 += 16) {
        const int nt = min(16, T - t0);
        __syncthreads();
#pragma unroll
        for (int r = 0; r < 12; ++r) { const int e = tid + 512 * r, tok = e / 384, w = e - tok * 384, typ = w >> 7, d = w & 127;
            if (tok < nt) sm[typ * 2048 + tok * 128 + d] = V_BQKV[(size_t)(row0 + t0 + tok) * 1536 + typ * 512 + h * 128 + d]; }
        if (tid < 32) { const int tok = tid >> 1, wh = tid & 1; if (tok < nt) bgs[tok * 2 + wh] = V_BG[(size_t)(row0 + t0 + tok) * 8 + wh * 4 + h]; }
        __syncthreads();
        for (int tt = 0; tt < nt; ++tt) {
            const LAS float* kk = ks + tt * 128 + 32 * qr; const LAS float* qq = qs + tt * 128 + 32 * qr;
            float a = 0.f;
#pragma unroll
            for (int i = 0; i < 32; ++i) a += kk[i] * s[i];
            pa[qr * 128 + c] = a;
            __syncthreads();
            const float kS = (pa[c] + pa[128 + c]) + (pa[256 + c] + pa[384 + c]);
            const float e = __expf(bgs[tt * 2 + 1]), be = bgs[tt * 2];
            const float vn = be * (vs[tt * 128 + c] - e * kS);
            float o = 0.f;
#pragma unroll
            for (int i = 0; i < 32; ++i) { s[i] = e * s[i] + kk[i] * vn; o += qq[i] * s[i]; }
            pb[qr * 128 + c] = o;
            __syncthreads();
            if (qr == 0) V_OBR[(size_t)(row0 + t0 + tt) * 512 + h * 128 + c] = (pb[c] + pb[128 + c]) + (pb[256 + c] + pb[384 + c]);
        }
    }
    float* So = F.out + (sample ? O_BSS + ((size_t)(l * DB + b) * 4 + h) * 16384 : O_BSP + ((size_t)(l * BATCH + b) * 4 + h) * 16384);
#pragma unroll
    for (int i = 0; i < 32; ++i) So[(32 * qr + i) * 128 + c] = s[i];
    __syncthreads();
}
__device__ __forceinline__ void ret_item(Ctx& F, int l, bool sample, int b, int h) {
    LAS float* sm = (LAS float*)F.lds;
    LAS float* qs = sm, *ks = sm + 1024, *vs = sm + 2048, *pp = sm + 4096;
    const int tid = F.tid, c = tid & 127, qr = tid >> 7;
    const float gam = 1.f - exp2f(-5.f - (float)h);
    float r[16];
    if (sample) { const float* R0 = F.in[7] + ((size_t)(l * DB + b) * 4 + h) * 8192;
#pragma unroll
        for (int i = 0; i < 16; ++i) r[i] = R0[(16 * qr + i) * 128 + c]; }
    else {
#pragma unroll
        for (int i = 0; i < 16; ++i) r[i] = 0.f; }
    const int T = sample ? DS : SEQ, row0 = sample ? MP + b * DS : b * SEQ;
    for (int t0 = 0; t0 < T; t0 += 16) {
        const int nt = min(16, T - t0);
        __syncthreads();
#pragma unroll
        for (int rr = 0; rr < 4; ++rr) { const int e = tid + 512 * rr, tok = e >> 7, w = e & 127, typ = w >> 6, d = w & 63;
            if (tok < nt) sm[typ * 1024 + tok * 64 + d] = V_CQK[(size_t)(row0 + t0 + tok) * 512 + typ * 256 + h * 64 + d]; }
#pragma unroll
        for (int rr = 0; rr < 4; ++rr) { const int e = tid + 512 * rr, tok = e >> 7, d = e & 127;
            if (tok < nt) vs[tok * 128 + d] = bf1(V_PROJ[(size_t)(row0 + t0 + tok) * NPROJ + PC_CV + h * 128 + d]); }
        __syncthreads();
        for (int tt = 0; tt < nt; ++tt) {
            const LAS float* kk = ks + tt * 64 + 16 * qr; const LAS float* qq = qs + tt * 64 + 16 * qr;
            const float v = vs[tt * 128 + c];
            float o = 0.f;
#pragma unroll
            for (int i = 0; i < 16; ++i) { r[i] = gam * r[i] + kk[i] * v; o += qq[i] * r[i]; }
            LAS float* pq = pp + (tt & 1) * 512;
            pq[qr * 128 + c] = o;
            __syncthreads();
            if (qr == 0) V_OCR[(size_t)(row0 + t0 + tt) * 512 + h * 128 + c] = (pq[c] + pq[128 + c]) + (pq[256 + c] + pq[384 + c]);
        }
    }
    float* Ro = F.out + (sample ? O_CRS + ((size_t)(l * DB + b) * 4 + h) * 8192 : O_CRP + ((size_t)(l * BATCH + b) * 4 + h) * 8192);
#pragma unroll
    for (int i = 0; i < 16; ++i) Ro[(16 * qr + i) * 128 + c] = r[i];
    __syncthreads();
}
constexpr int IT_DP = 0, IT_RP = 16, IT_ATS = 32, IT_DS = IT_ATS + 384, IT_RS = IT_DS + 128, IT_AT = IT_RS + 128, IT_END = IT_AT + 768;
__device__ __forceinline__ void phase_mix(Ctx& F, int l, int rep) {
    volatile LAS int* slot = (volatile LAS int*)(F.lds + LDS_BYTES - 64);
    unsigned* ctr = V_CTL + (l == 0 ? CW_MIX0 : CW_MIX1) + 256 * rep;
    for (;;) {
        __syncthreads();
        if (F.tid == 0) *slot = (int)atomicAdd(ctr, 1u);
        __syncthreads();
        const int it = __builtin_amdgcn_readfirstlane(*slot);
        { int t_ = F.tid; asm volatile("" : "+v"(t_)); F.tid = t_; F.lane = t_ & 63; }
        if (it >= IT_END + (l == 0 ? (DEPTH * I_LAYER - I_IN) / 8 : 0)) break;
#ifndef MIXSEL
#define MIXSEL 15
#endif
        if (it < IT_RP) delta_scan2_item(F, l, it >> 2, it & 3);
        else if (it < IT_ATS) ret_scan_item(F, l, (it - IT_RP) >> 2, (it - IT_RP) & 3);
        else if (it < IT_DS) { const int u = (it - IT_ATS) * 8 + F.wave; attn_sample_unit(F, l, u / 12, (u % 12) & 3, (u % 12) >> 2); }
        else if (it < IT_RS) delta_item(F, l, true, (it - IT_DS) >> 2, (it - IT_DS) & 3);
        else if (it < IT_AT) ret_item(F, l, true, (it - IT_RS) >> 2, (it - IT_RS) & 3);
        else if (it < IT_END) attn_mfma_item(F, it - IT_AT);
        else { const int wi = I_IN + (it - IT_END) * 8 + F.wave; prep_weight_item(F, wi, (LAS float*)(F.lds + F.wave * 16896), F.lane); }
    }
}
__device__ __forceinline__ void fin_row(Ctx& F, int l, int row) {
    const int lane = F.lane, h = lane >> 4, j8 = 8 * (lane & 15);
    {
        const float l0 = V_LSE[((size_t)0 * M + row) * 4 + h], l1 = V_LSE[((size_t)1 * M + row) * 4 + h], l2 = V_LSE[((size_t)2 * M + row) * 4 + h];
        const u32x4 a0 = *(const u32x4*)(V_AO + ((size_t)0 * M + row) * 512 + h * 128 + j8), a1 = *(const u32x4*)(V_AO + ((size_t)1 * M + row) * 512 + h * 128 + j8), a2 = *(const u32x4*)(V_AO + ((size_t)2 * M + row) * 512 + h * 128 + j8);
        const float mm = fmaxf(l0, fmaxf(l1, l2)); float e0 = __expf(l0 - mm), e1 = __expf(l1 - mm), e2 = __expf(l2 - mm); const float iv = 1.f / (e0 + e1 + e2); e0 *= iv; e1 *= iv; e2 *= iv;
        u32x4 o;
        o.x = cvt_pk_bf16(e0 * bf_lo(a0.x) + e1 * bf_lo(a1.x) + e2 * bf_lo(a2.x), e0 * bf_hi(a0.x) + e1 * bf_hi(a1.x) + e2 * bf_hi(a2.x));
        o.y = cvt_pk_bf16(e0 * bf_lo(a0.y) + e1 * bf_lo(a1.y) + e2 * bf_lo(a2.y), e0 * bf_hi(a0.y) + e1 * bf_hi(a1.y) + e2 * bf_hi(a2.y));
        o.z = cvt_pk_bf16(e0 * bf_lo(a0.z) + e1 * bf_lo(a1.z) + e2 * bf_lo(a2.z), e0 * bf_hi(a0.z) + e1 * bf_hi(a1.z) + e2 * bf_hi(a2.z));
        o.w = cvt_pk_bf16(e0 * bf_lo(a0.w) + e1 * bf_lo(a1.w) + e2 * bf_lo(a2.w), e0 * bf_hi(a0.w) + e1 * bf_hi(a1.w) + e2 * bf_hi(a2.w));
        *(u32x4*)(V_OABC + (size_t)row * 512 + h * 128 + j8) = o;
    }
#pragma unroll
    for (int br = 0; br < 2; ++br) {
        if (br == 0 && row < MP) continue;
        const float* src = (br == 0 ? V_OBR : V_OCR) + (size_t)row * 512 + h * 128 + j8;
        const f32x4 x0 = *(const f32x4*)src, x1 = *(const f32x4*)(src + 4);
        const float* gn = F.in[15 + br] + l * 128 + j8;
        const f32x4 g0 = *(const f32x4*)gn, g1 = *(const f32x4*)(gn + 4);
        const u32x4 zz = *(const u32x4*)(V_PROJ + (size_t)row * NPROJ + (br == 0 ? PC_BZ : PC_CZ) + h * 128 + j8);
        const float ss = row_sum16((x0[0] * x0[0] + x0[1] * x0[1]) + (x0[2] * x0[2] + x0[3] * x0[3]) + (x1[0] * x1[0] + x1[1] * x1[1]) + (x1[2] * x1[2] + x1[3] * x1[3]));
        const float rstd = rsqrtf(ss * (1.f / 128.f) + EPS);
        const float z0 = bf_lo(zz.x), z1 = bf_hi(zz.x), z2 = bf_lo(zz.y), z3 = bf_hi(zz.y), z4 = bf_lo(zz.z), z5 = bf_hi(zz.z), z6 = bf_lo(zz.w), z7 = bf_hi(zz.w);
        u32x4 o;
        o.x = cvt_pk_bf16(x0[0] * rstd * g0[0] * z0 * sigmoidf_(z0), x0[1] * rstd * g0[1] * z1 * sigmoidf_(z1));
        o.y = cvt_pk_bf16(x0[2] * rstd * g0[2] * z2 * sigmoidf_(z2), x0[3] * rstd * g0[3] * z3 * sigmoidf_(z3));
        o.z = cvt_pk_bf16(x1[0] * rstd * g1[0] * z4 * sigmoidf_(z4), x1[1] * rstd * g1[1] * z5 * sigmoidf_(z5));
        o.w = cvt_pk_bf16(x1[2] * rstd * g1[2] * z6 * sigmoidf_(z6), x1[3] * rstd * g1[3] * z7 * sigmoidf_(z7));
        *(u32x4*)(V_OABC + (size_t)(1 + br) * M * 512 + (size_t)row * 512 + h * 128 + j8) = o;
    }
}

template <int NR>
__device__ __forceinline__ void fin_rows(Ctx& F, int l, const int (&rows)[NR]) {
    const int lane = F.lane, h = lane >> 4, j8 = 8 * (lane & 15);
    float ls[NR][3]; u32x4 ao[NR][3]; f32x4 xc[NR][2]; u32x4 zc[NR];
#pragma unroll
    for (int r = 0; r < NR; ++r) { const int row = rows[r];
#pragma unroll
        for (int g = 0; g < 3; ++g) { ls[r][g] = V_LSE[((size_t)g * M + row) * 4 + h]; ao[r][g] = *(const u32x4*)(V_AO + ((size_t)g * M + row) * 512 + h * 128 + j8); }
        const float* src = V_OCR + (size_t)row * 512 + h * 128 + j8; xc[r][0] = *(const f32x4*)src; xc[r][1] = *(const f32x4*)(src + 4);
        zc[r] = *(const u32x4*)(V_PROJ + (size_t)row * NPROJ + PC_CZ + h * 128 + j8);
    }
    const f32x4 gc0 = *(const f32x4*)(F.in[16] + l * 128 + j8), gc1 = *(const f32x4*)(F.in[16] + l * 128 + j8 + 4);
#pragma unroll
    for (int r = 0; r < NR; ++r) { const int row = rows[r];
        {
            const float mm = fmaxf(ls[r][0], fmaxf(ls[r][1], ls[r][2])); float e0 = __expf(ls[r][0] - mm), e1 = __expf(ls[r][1] - mm), e2 = __expf(ls[r][2] - mm); const float iv = 1.f / (e0 + e1 + e2); e0 *= iv; e1 *= iv; e2 *= iv;
            const u32x4 a0 = ao[r][0], a1 = ao[r][1], a2 = ao[r][2]; u32x4 o;
            o.x = cvt_pk_bf16(e0 * bf_lo(a0.x) + e1 * bf_lo(a1.x) + e2 * bf_lo(a2.x), e0 * bf_hi(a0.x) + e1 * bf_hi(a1.x) + e2 * bf_hi(a2.x));
            o.y = cvt_pk_bf16(e0 * bf_lo(a0.y) + e1 * bf_lo(a1.y) + e2 * bf_lo(a2.y), e0 * bf_hi(a0.y) + e1 * bf_hi(a1.y) + e2 * bf_hi(a2.y));
            o.z = cvt_pk_bf16(e0 * bf_lo(a0.z) + e1 * bf_lo(a1.z) + e2 * bf_lo(a2.z), e0 * bf_hi(a0.z) + e1 * bf_hi(a1.z) + e2 * bf_hi(a2.z));
            o.w = cvt_pk_bf16(e0 * bf_lo(a0.w) + e1 * bf_lo(a1.w) + e2 * bf_lo(a2.w), e0 * bf_hi(a0.w) + e1 * bf_hi(a1.w) + e2 * bf_hi(a2.w));
            *(u32x4*)(V_OABC + (size_t)row * 512 + h * 128 + j8) = o;
        }
        {
            const f32x4 x0 = xc[r][0], x1 = xc[r][1]; const u32x4 zz = zc[r]; const f32x4 g0 = gc0, g1 = gc1; const int br = 1;
            const float ss = row_sum16((x0[0] * x0[0] + x0[1] * x0[1]) + (x0[2] * x0[2] + x0[3] * x0[3]) + (x1[0] * x1[0] + x1[1] * x1[1]) + (x1[2] * x1[2] + x1[3] * x1[3]));
            const float rstd = rsqrtf(ss * (1.f / 128.f) + EPS);
            const float z0 = bf_lo(zz.x), z1 = bf_hi(zz.x), z2 = bf_lo(zz.y), z3 = bf_hi(zz.y), z4 = bf_lo(zz.z), z5 = bf_hi(zz.z), z6 = bf_lo(zz.w), z7 = bf_hi(zz.w);
            u32x4 o;
            o.x = cvt_pk_bf16(x0[0] * rstd * g0[0] * z0 * sigmoidf_(z0), x0[1] * rstd * g0[1] * z1 * sigmoidf_(z1));
            o.y = cvt_pk_bf16(x0[2] * rstd * g0[2] * z2 * sigmoidf_(z2), x0[3] * rstd * g0[3] * z3 * sigmoidf_(z3));
            o.z = cvt_pk_bf16(x1[0] * rstd * g1[0] * z4 * sigmoidf_(z4), x1[1] * rstd * g1[1] * z5 * sigmoidf_(z5));
            o.w = cvt_pk_bf16(x1[2] * rstd * g1[2] * z6 * sigmoidf_(z6), x1[3] * rstd * g1[3] * z7 * sigmoidf_(z7));
            *(u32x4*)(V_OABC + (size_t)(1 + br) * M * 512 + (size_t)row * 512 + h * 128 + j8) = o;
        }
    }
}

__device__ __forceinline__ void fin_b_row(Ctx& F, int l, int row) {
    const int lane = F.lane, h = lane >> 4, j8 = 8 * (lane & 15);
    const float* src = V_OBR + (size_t)row * 512 + h * 128 + j8; const f32x4 x0 = *(const f32x4*)src, x1 = *(const f32x4*)(src + 4);
    const u32x4 zz = *(const u32x4*)(V_PROJ + (size_t)row * NPROJ + PC_BZ + h * 128 + j8);
    const f32x4 g0 = *(const f32x4*)(F.in[15] + l * 128 + j8), g1 = *(const f32x4*)(F.in[15] + l * 128 + j8 + 4);
    const float ss = row_sum16((x0[0] * x0[0] + x0[1] * x0[1]) + (x0[2] * x0[2] + x0[3] * x0[3]) + (x1[0] * x1[0] + x1[1] * x1[1]) + (x1[2] * x1[2] + x1[3] * x1[3]));
    const float rstd = rsqrtf(ss * (1.f / 128.f) + EPS);
    const float z0 = bf_lo(zz.x), z1 = bf_hi(zz.x), z2 = bf_lo(zz.y), z3 = bf_hi(zz.y), z4 = bf_lo(zz.z), z5 = bf_hi(zz.z), z6 = bf_lo(zz.w), z7 = bf_hi(zz.w);
    u32x4 o;
    o.x = cvt_pk_bf16(x0[0] * rstd * g0[0] * z0 * sigmoidf_(z0), x0[1] * rstd * g0[1] * z1 * sigmoidf_(z1));
    o.y = cvt_pk_bf16(x0[2] * rstd * g0[2] * z2 * sigmoidf_(z2), x0[3] * rstd * g0[3] * z3 * sigmoidf_(z3));
    o.z = cvt_pk_bf16(x1[0] * rstd * g1[0] * z4 * sigmoidf_(z4), x1[1] * rstd * g1[1] * z5 * sigmoidf_(z5));
    o.w = cvt_pk_bf16(x1[2] * rstd * g1[2] * z6 * sigmoidf_(z6), x1[3] * rstd * g1[3] * z7 * sigmoidf_(z7));
    *(u32x4*)(V_OABC + (size_t)M * 512 + (size_t)row * 512 + h * 128 + j8) = o;
}
typedef float f32x16 __attribute__((ext_vector_type(16)));
template <int NSUB, bool GATED>
__device__ __forceinline__ void mini_gemm_core(Ctx& F, int tile, const bf16_t* A, size_t a_sub, const bf16_t* Bt, size_t b_sub, int K, float (&res)[2], int& orow, int& ocol, int (&oreg)[2]) {
    const int lane = F.lane, w = F.wave, r = lane & 31, hh = lane >> 5;
    const int rb = tile & 7, cb = tile >> 3;
    const int kw = K >> 3, k0 = w * kw;
    f32x16 tot;
#pragma unroll
    for (int i = 0; i < 16; ++i) tot[i] = 0.f;
#pragma unroll 1
    for (int sub = 0; sub < NSUB; ++sub) {
        const bf16_t* ap = A + sub * a_sub + (size_t)(MP + rb * 32 + r) * K + k0 + 8 * hh;
        const bf16_t* bp = Bt + sub * b_sub + (size_t)(cb * 32 + r) * K + k0 + 8 * hh;
        f32x16 acc;
#pragma unroll
        for (int i = 0; i < 16; ++i) acc[i] = 0.f;
#pragma unroll 2
        for (int s2 = 0; s2 < kw; s2 += 16) acc = __builtin_amdgcn_mfma_f32_32x32x16_bf16(*(const bf16x8*)(ap + s2), *(const bf16x8*)(bp + s2), acc, 0, 0, 0);
        if (GATED) {
            const bf16_t* gp = V_PROJ + (size_t)(MP + rb * 32 + 4 * hh) * NPROJ + PC_GATE + sub * 1024 + cb * 32 + r;
#pragma unroll
            for (int i = 0; i < 16; ++i) tot[i] += bf1(gp[(size_t)((i & 3) + 8 * (i >> 2)) * NPROJ]) * acc[i];
        } else tot = acc;
    }
    LAS float* red = (LAS float*)F.lds;
#pragma unroll
    for (int i = 0; i < 16; ++i) red[(w * 16 + i) * 64 + lane] = tot[i];
    __syncthreads();
    const int g = F.tid >> 6;
#pragma unroll
    for (int q = 0; q < 2; ++q) { const int rg = 2 * g + q; float v = 0.f;
#pragma unroll
        for (int ww = 0; ww < 8; ++ww) v += red[(ww * 16 + rg) * 64 + lane];
        res[q] = v; oreg[q] = rg; }
    orow = MP + rb * 32 + 4 * hh; ocol = cb * 32 + r;
    __syncthreads();
}
__device__ __forceinline__ void mini_abc(Ctx& F, int l) {
    for (int tile = F.bid; tile < 256; tile += F.G) {
    float res[2]; int orow, ocol, oreg[2];
    mini_gemm_core<3, true>(F, tile, V_OABC, (size_t)M * 512, V_WABC + (size_t)l * 3 * D * 512, (size_t)D * 512, 512, res, orow, ocol, oreg);
#pragma unroll
    for (int q = 0; q < 2; ++q) { const int row = orow + (oreg[q] & 3) + 8 * (oreg[q] >> 2);
        V_MRG[(size_t)row * D + ocol] = (bf16_t)(cvt_pk_bf16(res[q], 0.f) & 0xffffu); }
    }
}
__device__ __forceinline__ void mini_res(Ctx& F, const bf16_t* A, const bf16_t* Bt, int K, const float* resid  , const bf16_t* resb  , float* out, bf16_t* xb, float* rowss) {
    for (int tile = F.bid; tile < 256; tile += F.G) {
    float res[2]; int orow, ocol, oreg[2];
    mini_gemm_core<1, false>(F, tile, A, 0, Bt, 0, K, res, orow, ocol, oreg);
#pragma unroll
    for (int q = 0; q < 2; ++q) { const int row = orow + (oreg[q] & 3) + 8 * (oreg[q] >> 2);
        const float o = (resb ? bf1(resb[(size_t)row * D + ocol]) : resid[(size_t)(row - MP) * D + ocol]) + res[q];
        if (out) out[(size_t)row * D + ocol] = o; else xb[(size_t)row * D + ocol] = (bf16_t)(cvt_pk_bf16(o, 0.f) & 0xffffu);
        float ss = o * o;
        ss = row_sum16(ss); ss += __shfl_xor(ss, 16);
        if ((F.lane & 31) == 0) atomicAdd(rowss + row, ss); }
    }
}
constexpr int N_PHASES = 1 + 8 * DEPTH;
__global__ void __launch_bounds__(NTHREADS, 2) mega_fwd(Args args) {
    extern __shared__ __attribute__((aligned(16))) unsigned char lds_raw[];
    Ctx F;
    F.in = nullptr; F.out = nullptr; F.ws = nullptr; F.tid = 0; F.lane = 0; F.wave = 0;
    F.lds = (LAS unsigned char*)lds_raw;
    F.G = gridDim.x; F.bid = blockIdx.x;
    volatile LAS unsigned* bst = (volatile LAS unsigned*)(F.lds + LDS_BYTES - 128);
    if (threadIdx.x < 2) bst[threadIdx.x] = 0u;
    __syncthreads();
    (void)xcd_barrier_post((unsigned*)(args.ws + WS_CTL) + CW_BAR, bst);
#define XBAR() do { XcdBarrier xb_; xb_.bar = (unsigned*)(F.ws + WS_CTL) + CW_BAR; xb_.x = xb_xcc_id(); xb_.st = (volatile LAS unsigned*)(F.lds + LDS_BYTES - 128); xcd_barrier(xb_, F.tid); } while (0)
    int ph0 = args.ph_lo;
    if (ph0 == 0) {
        { int tid_ = threadIdx.x; asm volatile("" : "+v"(tid_)); F.tid = tid_; F.lane = tid_ & 63; F.wave = __builtin_amdgcn_readfirstlane(tid_ >> 6);
          { int bid_ = blockIdx.x, g_ = gridDim.x; asm volatile("" : "+s"(bid_), "+s"(g_)); F.bid = bid_; F.G = g_; }
          const __attribute__((address_space(4))) char* ka = (const __attribute__((address_space(4))) char*)__builtin_amdgcn_kernarg_segment_ptr(); asm volatile("" : "+s"(ka));
          F.in = (const float* const __attribute__((address_space(4)))*)ka; F.out = *(float* const __attribute__((address_space(4)))*)(ka + 192); F.ws = *(unsigned char* const __attribute__((address_space(4)))*)(ka + 200); }
        const int gw = F.bid * NWAVES + F.wave, NGW = F.G * NWAVES;
        if (PH_MASK & 1) phase_prep(F);
        if (DUP_K == 8) { cg::this_grid().sync(); phase_prep(F); }
        if (DUP_K == 9) { for (int q_ = 0; q_ < 32; ++q_) XBAR(); }
        ph0 = 1;
        if (args.ph_hi > 1000000) cg::this_grid().sync();
        if (ph0 < args.ph_hi) XBAR();
    }
    for (int ph = ph0, rep = 0; ph < args.ph_hi; ++ph) {
        { int tid_ = threadIdx.x; asm volatile("" : "+v"(tid_)); F.tid = tid_; F.lane = tid_ & 63; F.wave = __builtin_amdgcn_readfirstlane(tid_ >> 6);
          { int bid_ = blockIdx.x, g_ = gridDim.x; asm volatile("" : "+s"(bid_), "+s"(g_)); F.bid = bid_; F.G = g_; }
          const __attribute__((address_space(4))) char* ka = (const __attribute__((address_space(4))) char*)__builtin_amdgcn_kernarg_segment_ptr(); asm volatile("" : "+s"(ka));
          F.in = (const float* const __attribute__((address_space(4)))*)ka; F.out = *(float* const __attribute__((address_space(4)))*)(ka + 192); F.ws = *(unsigned char* const __attribute__((address_space(4)))*)(ka + 200); }
        const int gw = F.bid * NWAVES + F.wave, NGW = F.G * NWAVES;
        {
            const int l = (ph - 1) >> 3, k = (ph - 1) & 7;
            if (k == 0 && (PH_MASK & 2)) {
                pg8::Gemm g{V_XBA, V_WIN + (size_t)l * NPROJ * D, D}; pg8::Order<1> S; S.init(M / 256, NPROJ / 256, F.G, F.bid);
                EpiProj E{V_PROJ, V_RS + (size_t)(2 * l) * M};
                pg8::gemm_phase(F.lds, F.tid, g, S, E);
            } else if (k == 1 && (PH_MASK & 4)) {
                {
                    const bool sq = !(DUP_K == 1 && rep == 0);
                    int row = gw;
                    for (; row + 2 * NGW < M; row += 3 * NGW) { const int rr[3] = {row, row + NGW, row + 2 * NGW}; e1_partA<3>(F, l, rr, sq); }
                    for (; row < M; row += NGW) { const int rr[1] = {row}; e1_partA<1>(F, l, rr, sq); }
                    for (int r2 = gw; r2 < M; r2 += NGW) if (r2 >= MP || (r2 & 4095) >= SEQ - 3) e1_row(F, l, r2);
                }
                __syncthreads();
                for (int it = F.bid; it < NCH / 2; it += F.G) delta_prep_item2(F, l, it);
                for (int it = F.bid; it < NCH / 4; it += F.G) ret_prep_item(F, l, it);
            } else if (k == 2 && (PH_MASK & 8)) {
                phase_mix(F, l, rep);
            } else if (k == 3 && (PH_MASK & 16)) {
                for (int row = gw; row < M; row += 2 * NGW) { if (row + NGW < M) { const int rr[2] = {row, row + NGW}; fin_rows<2>(F, l, rr); } else { const int rr[1] = {row}; fin_rows<1>(F, l, rr); } }
                for (int row = MP + gw; row < M; row += NGW) fin_b_row(F, l, row);
                __syncthreads();
                for (int it = F.bid; it < NCH; it += F.G) delta_out_item(F, l, it);
            } else if (k == 4 && (PH_MASK & 32)) {
                mini_abc(F, l);
                pg8::Gemm g{V_OABC, V_WABC + (size_t)l * 3 * D * 512, 512}; pg8::Order<3> S; S.init(MP / 256, D / 256, F.G, F.bid); S.sub_m = M / 256;
                EpiAbc E{V_PROJ, V_MRG};
                pg8::gemm_phase(F.lds, F.tid, g, S, E);
            } else if (k == 5 && (PH_MASK & 64)) {
                mini_res(F, V_MRG, V_WOUT + (size_t)l * D * D, D, l == 0 ? F.in[1] : nullptr, l == 0 ? nullptr : V_XBA, nullptr, V_XBB, V_RS + (size_t)(2 * l + 1) * M);
                pg8::Gemm g{V_MRG, V_WOUT + (size_t)l * D * D, D}; pg8::Order<1> S; S.init(MP / 256, D / 256, F.G, F.bid);
                EpiRes E{F.in[0], F.in[1], l == 0 ? nullptr : V_XBA, nullptr, V_XBB, V_RS + (size_t)(2 * l + 1) * M};
                pg8::gemm_phase(F.lds, F.tid, g, S, E);
            } else if (k == 6 && (PH_MASK & 128)) {
                pg8::Gemm g{V_XBB, V_WFI + (size_t)l * 2 * DFF * D, D}; pg8::Order<1> S; S.init(M / 256, 2 * DFF / 256, F.G, F.bid);
                EpiFfn E{V_ACT, V_RS + (size_t)(2 * l + 1) * M};
                pg8::gemm_phase(F.lds, F.tid, g, S, E);
            } else if (k == 7 && (PH_MASK & 256)) {
                mini_res(F, V_ACT, V_WFO + (size_t)l * D * DFF, DFF, nullptr, V_XBB, l == DEPTH - 1 ? F.out : nullptr, V_XBA, V_RS + (size_t)(l == DEPTH - 1 ? 3 : 2) * M);
                pg8::Gemm g{V_ACT, V_WFO + (size_t)l * D * DFF, DFF}; pg8::Order<1> S; S.init(MP / 256, D / 256, F.G, F.bid);
                EpiRes E{nullptr, nullptr, V_XBB, l == DEPTH - 1 ? F.out : nullptr, V_XBA, V_RS + (size_t)(l == DEPTH - 1 ? 3 : 2) * M};
                pg8::gemm_phase(F.lds, F.tid, g, S, E);
            }
        }
        if (DUP_K >= 0 && ((ph - 1) & 7) == DUP_K && rep == 0) { rep = 1; --ph; XBAR(); continue; }
        rep = 0;
        if (ph + 1 < args.ph_hi) XBAR();
    }
}

extern "C" void kernel_launch(void* const* d_in, const int* in_sizes, int n_in, void* d_out, int out_size, void* d_ws, size_t ws_size, hipStream_t stream) {
    static int grid = 0;
    if (grid == 0) {
        if (n_in != 24 || (size_t)out_size != O_END || ws_size < WS_END) { fprintf(stderr, "kernel_launch: unexpected shapes (n_in %d out %d ws %zu, need %zu / %zu)\n", n_in, out_size, ws_size, (size_t)O_END, (size_t)WS_END); grid = -1; return; }
        int dev = 0, cus = 0, per_cu = 0;
        if (hipGetDevice(&dev) != hipSuccess || hipDeviceGetAttribute(&cus, hipDeviceAttributeMultiprocessorCount, dev) != hipSuccess) { grid = -1; return; }
        if (hipFuncSetAttribute((const void*)mega_fwd, hipFuncAttributeMaxDynamicSharedMemorySize, LDS_BYTES) != hipSuccess) { fprintf(stderr, "kernel_launch: hipFuncSetAttribute failed\n"); grid = -1; return; }
        if (hipOccupancyMaxActiveBlocksPerMultiprocessor(&per_cu, (const void*)mega_fwd, NTHREADS, LDS_BYTES) != hipSuccess || per_cu < 1) { fprintf(stderr, "kernel_launch: occupancy query says %d\n", per_cu); per_cu = 1; }
        (void)hipGetLastError();
        grid = cus;
    }
    if (grid < 0) return;
    (void)hipMemsetAsync((char*)d_ws + WS_CTL, 0, 32768, stream);
    Args a{};
    for (int i = 0; i < 24; ++i) a.in[i] = (const float*)d_in[i];
    a.out = (float*)d_out; a.ws = (unsigned char*)d_ws;
#if MK_ONE_LAUNCH
    a.ph_lo = 0; a.ph_hi = N_PHASES;
    void* kargs[] = {&a};
    hipError_t e = hipLaunchCooperativeKernel((const void*)mega_fwd, dim3(grid), dim3(NTHREADS), kargs, LDS_BYTES, stream);
    if (e != hipSuccess) fprintf(stderr, "cooperative launch failed: %s (grid %d)\n", hipGetErrorString(e), grid);
#else
    for (int ph = 0; ph < N_PHASES; ++ph) {
        a.ph_lo = ph; a.ph_hi = ph + 1;
        hipLaunchKernelGGL(mega_fwd, dim3(grid), dim3(NTHREADS), LDS_BYTES, stream, a);
    }
#endif
}
```
